# Optimizing an MI355X kernel written in HIP

```python
import jax, jax.numpy as jnp
from jax import lax
import numpy as np


D_MODEL = 1024
BATCH = 32
SEQ = 2048
DEPTH = 4

GLA_HEADS = 4
GLA_VW = D_MODEL // 2
GLA_DV = GLA_VW // GLA_HEADS
GLA_KW = GLA_VW // 2
GLA_DK = GLA_KW // GLA_HEADS
GLA_LORA = 16
GLA_TAU = 16.0
GLA_CHUNK = 64
RWKV_W = D_MODEL - GLA_VW
RWKV_HEAD = 64
RWKV_HEADS = RWKV_W // RWKV_HEAD
RWKV_W_LORA = 32
RWKV_A_LORA = 32
RWKV_G_LORA = 96
RWKV_LNX_EPS = 64e-5
ATT_HEADS = 8
ATT_HEAD = D_MODEL // ATT_HEADS
IDX_HEADS = 8
IDX_DIM = 64
TOPK_MAX = 256
Q_BLOCK = 128
ROPE_THETA = 10000.0
NEG = -1e30
PEER_HEADS = 8
PEER_DKEY = 128
PEER_NKEYS = 128
PEER_N_EXPERTS = PEER_NKEYS * PEER_NKEYS
PEER_TOPK = 16
PEER_TOKEN_BLOCK = 128
DN_ALPHA = (2 * DEPTH) ** 0.25
DN_BETA = (8 * DEPTH) ** -0.25
LN_EPS = 1e-5
N_EVEN = (DEPTH + 1) // 2
N_ODD = DEPTH // 2

GLA_SPLITS = (GLA_KW, GLA_KW, GLA_VW, GLA_VW, GLA_LORA)
RWKV_SPLITS = (RWKV_W, RWKV_W, RWKV_W, RWKV_W_LORA, RWKV_A_LORA, RWKV_G_LORA)
GLA_IN = sum(GLA_SPLITS)
RWKV_IN = sum(RWKV_SPLITS)
EVEN_IN = GLA_IN + RWKV_IN
ODD_SPLITS = (ATT_HEADS * ATT_HEAD, ATT_HEAD, ATT_HEAD, IDX_HEADS * IDX_DIM, IDX_DIM, IDX_HEADS)
ODD_IN = sum(ODD_SPLITS)

kernel_name = 'hybrid_gla_rwkv7_dsa_peer_deepnorm'

F32 = jnp.float32


def _split(t, sizes):
    cuts = [int(c) for c in np.cumsum(sizes)[:-1]]
    return jnp.split(t, cuts, axis=-1)


def layer_norm(x, g, b):
    xf = x.astype(F32)
    mu = xf.mean(-1, keepdims=True)
    var = jnp.square(xf - mu).mean(-1, keepdims=True)
    return ((xf - mu) * lax.rsqrt(var + LN_EPS) * g + b).astype(x.dtype)


def rope_tables(T, dim):
    inv = ROPE_THETA ** (-jnp.arange(0, dim, 2, dtype=F32) / dim)
    ang = jnp.arange(T, dtype=F32)[:, None] * inv[None, :]
    return jnp.cos(ang), jnp.sin(ang)


def apply_rope(x, cos, sin):
    x1, x2 = jnp.split(x, 2, axis=-1)
    return jnp.concatenate([x1 * cos - x2 * sin, x2 * cos + x1 * sin], -1).astype(x.dtype)


def gla_chunked(q, k, v, log_a):
    B, T, H, dk = q.shape
    dv = v.shape[-1]
    C = GLA_CHUNK
    n = T // C

    def chunks(t):
        return t.astype(F32).reshape(B, n, C, H, -1).transpose(0, 3, 1, 2, 4)

    q, k, v, la = chunks(q) * dk ** -0.5, chunks(k), chunks(v), chunks(log_a)
    b = jnp.cumsum(la, axis=3)
    b_last = b[:, :, :, -1:, :]
    q_in = q * jnp.exp(b)
    k_in = k * jnp.exp(-b)
    k_out = k * jnp.exp(b_last - b)
    causal = jnp.tril(jnp.ones((C, C), dtype=bool))
    A = jnp.where(causal, jnp.einsum('bhnid,bhnjd->bhnij', q_in, k_in), 0.0)
    o = jnp.einsum('bhnij,bhnje->bhnie', A, v)
    kv = jnp.einsum('bhnjd,bhnje->bhnde', k_out, v)
    dec = jnp.exp(b_last[:, :, :, 0, :])

    def step(S, inp):
        dec_n, kv_n = inp
        return dec_n[..., None] * S + kv_n, S

    S0 = jnp.zeros((B, H, dk, dv), F32)
    _, S_prev = lax.scan(step, S0, (jnp.moveaxis(dec, 2, 0), jnp.moveaxis(kv, 2, 0)))
    S_prev = jnp.moveaxis(S_prev, 0, 2)
    o = o + jnp.einsum('bhnid,bhnde->bhnie', q_in, S_prev)
    return o.transpose(0, 2, 3, 1, 4).reshape(B, T, H, dv)


def rwkv7_scan(r, w, k, v, a, b):
    B, T, H, N = r.shape

    def step(S, inp):
        r_t, w_t, k_t, v_t, a_t, b_t = inp
        sa = jnp.einsum('bhij,bhj->bhi', S, a_t)
        S = S * w_t[:, :, None, :] + sa[..., None] * b_t[:, :, None, :] + v_t[..., None] * k_t[:, :, None, :]
        return S, jnp.einsum('bhij,bhj->bhi', S, r_t)

    xs = tuple(jnp.moveaxis(t.astype(F32), 1, 0) for t in (r, w, k, v, a, b))
    _, y = lax.scan(step, jnp.zeros((B, H, N, N), F32), xs)
    return jnp.moveaxis(y, 0, 1)


def even_mixer(x, w_in, gla_a_w2, gla_a_b, gla_norm_g, rwkv_mu, rwkv_w0, rwkv_w2, rwkv_a0, rwkv_a2,
               rwkv_g2, rwkv_k_k, rwkv_k_a, rwkv_r_k, rwkv_lnx_g, rwkv_lnx_b, w_out):
    B, T, _ = x.shape

    def heads(t, h):
        return t.reshape(B, T, h, -1)

    p = x @ w_in
    gla_p, rw_p = p[..., :GLA_IN], p[..., GLA_IN:]
    gq, gk, gv, gg, gal = _split(gla_p, GLA_SPLITS)
    log_a = jax.nn.log_sigmoid((gal @ gla_a_w2 + gla_a_b).astype(F32)) / GLA_TAU
    o = gla_chunked(heads(gq, GLA_HEADS), heads(gk, GLA_HEADS), heads(gv, GLA_HEADS), heads(log_a, GLA_HEADS))
    o = o * lax.rsqrt(jnp.mean(jnp.square(o), -1, keepdims=True) + LN_EPS) * gla_norm_g
    gla_out = (o.reshape(B, T, GLA_VW) * jax.nn.silu(gg.astype(F32))).astype(x.dtype)
    prev = jnp.pad(rw_p, ((0, 0), (1, 0), (0, 0)))[:, :-1]
    rw_p = rw_p + (prev - rw_p) * rwkv_mu
    r, k, v, wl, al, gl = _split(rw_p, RWKV_SPLITS)
    w_log = -jax.nn.softplus(-(rwkv_w0 + jnp.tanh(wl) @ rwkv_w2).astype(F32)) - 0.5
    decay = jnp.exp(-jnp.exp(w_log))
    a = jax.nn.sigmoid((rwkv_a0 + al @ rwkv_a2).astype(F32))
    g = jax.nn.sigmoid(gl) @ rwkv_g2
    kk = heads((k * rwkv_k_k).astype(F32), RWKV_HEADS)
    kk = kk / jnp.maximum(jnp.sqrt(jnp.sum(jnp.square(kk), -1, keepdims=True)), 1e-12)
    k = k * (1.0 + (a - 1.0) * rwkv_k_a)
    a_h = heads(a, RWKV_HEADS)
    r_h, k_h, v_h = heads(r, RWKV_HEADS), heads(k, RWKV_HEADS), heads(v, RWKV_HEADS)
    y = rwkv7_scan(r_h, heads(decay, RWKV_HEADS), k_h, v_h, -kk, kk * a_h)
    mu = y.mean(-1, keepdims=True)
    var = jnp.square(y - mu).mean(-1, keepdims=True)
    y = (y - mu) * lax.rsqrt(var + RWKV_LNX_EPS) * rwkv_lnx_g.reshape(RWKV_HEADS, RWKV_HEAD) \
        + rwkv_lnx_b.reshape(RWKV_HEADS, RWKV_HEAD)
    bonus = jnp.sum((r_h * k_h * rwkv_r_k).astype(F32), -1, keepdims=True) * v_h.astype(F32)
    rwkv_out = ((y + bonus).reshape(B, T, RWKV_W) * g.astype(F32)).astype(x.dtype)
    return jnp.concatenate([gla_out, rwkv_out], -1) @ w_out


def dsa_mixer(x, w_in, w_out):
    B, T, _ = x.shape
    q, k, v, qi, ki, wi = _split(x @ w_in, ODD_SPLITS)
    q = q.reshape(B, T, ATT_HEADS, ATT_HEAD)
    qi = qi.reshape(B, T, IDX_HEADS, IDX_DIM)
    cos_a, sin_a = rope_tables(T, ATT_HEAD)
    cos_i, sin_i = rope_tables(T, IDX_DIM)
    q = apply_rope(q, cos_a[:, None], sin_a[:, None])
    k = apply_rope(k, cos_a, sin_a)
    qi = apply_rope(qi, cos_i[:, None], sin_i[:, None])
    ki = apply_rope(ki, cos_i, sin_i)
    wi = wi.astype(F32) * (IDX_HEADS ** -0.5 * IDX_DIM ** -0.5)
    n_sel = min(TOPK_MAX, T // 4)
    key_pos = jnp.arange(T)
    gather = jax.vmap(lambda tab, ids: tab[ids])

    def block(start):
        qb = lax.dynamic_slice_in_dim(q, start, Q_BLOCK, axis=1)
        qib = lax.dynamic_slice_in_dim(qi, start, Q_BLOCK, axis=1)
        wib = lax.dynamic_slice_in_dim(wi, start, Q_BLOCK, axis=1)
        q_pos = start + jnp.arange(Q_BLOCK)
        s = jax.nn.relu(jnp.einsum('bqhd,bsd->bqhs', qib, ki).astype(F32))
        score = jnp.einsum('bqh,bqhs->bqs', wib, s)
        score = jnp.where(key_pos[None, None, :] <= q_pos[None, :, None], score, NEG)
        _, sel = lax.top_k(score, n_sel)
        valid = sel <= q_pos[None, :, None]
        ks, vs = gather(k, sel), gather(v, sel)
        logit = jnp.einsum('bqhd,bqkd->bqhk', qb, ks).astype(F32) * ATT_HEAD ** -0.5
        logit = jnp.where(valid[:, :, None, :], logit, NEG)
        pr = jax.nn.softmax(logit, axis=-1).astype(vs.dtype)
        return jnp.einsum('bqhk,bqkd->bqhd', pr, vs)

    starts = jnp.arange(T // Q_BLOCK, dtype=jnp.int32) * Q_BLOCK
    o = lax.map(block, starts)
    o = jnp.moveaxis(o, 0, 1).reshape(B, T, ATT_HEADS * ATT_HEAD)
    return o @ w_out


def peer_ffn(x, w_q, sub_keys, exp_u, exp_v):
    B, T, D = x.shape
    q = (x @ w_q).reshape(B, T, PEER_HEADS, 2, PEER_DKEY // 2)
    s = jnp.einsum('bthcd,hcnd->bthcn', q, sub_keys).astype(F32)
    top_s, top_i = lax.top_k(s, PEER_TOPK)
    cand_s = (top_s[..., 0, :, None] + top_s[..., 1, None, :]).reshape(B, T, PEER_HEADS, -1)
    cand_i = (top_i[..., 0, :, None] * PEER_NKEYS + top_i[..., 1, None, :]).reshape(B, T, PEER_HEADS, -1)
    best_s, pos = lax.top_k(cand_s, PEER_TOPK)
    idx = jnp.take_along_axis(cand_i, pos, axis=-1)
    gate = jax.nn.softmax(best_s, axis=-1)
    nb = (B * T) // PEER_TOKEN_BLOCK
    hk = PEER_HEADS * PEER_TOPK
    xs = (x.reshape(nb, PEER_TOKEN_BLOCK, D), idx.reshape(nb, PEER_TOKEN_BLOCK, hk),
          gate.reshape(nb, PEER_TOKEN_BLOCK, hk))

    def block(args):
        xb, ib, gb = args
        h = jax.nn.gelu(jnp.einsum('md,mkd->mk', xb, exp_u[ib]).astype(F32), approximate=False)
        coef = (gb * h).astype(xb.dtype)
        return jnp.einsum('mk,mkd->md', coef, exp_v[ib])

    return lax.map(block, xs).reshape(B, T, D)


def setup_inputs(seed: int = 0) -> dict:
    key = jax.random.key(seed)
    ks = iter(jax.random.split(key, 32))

    def nrm(shape, scale):
        return jax.random.normal(next(ks), shape, F32) * scale

    E, O, L, D = N_EVEN, N_ODD, DEPTH, D_MODEL
    return {
        'x': nrm((BATCH, SEQ, D), 1.0),
        'even_w_in': nrm((E, D, EVEN_IN), D ** -0.5),
        'gla_a_w2': nrm((E, GLA_LORA, GLA_KW), GLA_LORA ** -0.5),
        'gla_a_b': nrm((E, GLA_KW), 0.1),
        'gla_norm_g': 1.0 + nrm((E, GLA_DV), 0.05),
        'rwkv_mu': jax.random.uniform(next(ks), (E, RWKV_IN), F32, 0.0, 1.0),
        'rwkv_w0': jax.random.uniform(next(ks), (E, RWKV_W), F32, -6.5, -1.5),
        'rwkv_w2': nrm((E, RWKV_W_LORA, RWKV_W), 0.1 * RWKV_W_LORA ** -0.5),
        'rwkv_a0': nrm((E, RWKV_W), 0.1),
        'rwkv_a2': nrm((E, RWKV_A_LORA, RWKV_W), 0.5 * RWKV_A_LORA ** -0.5),
        'rwkv_g2': nrm((E, RWKV_G_LORA, RWKV_W), 2.0 * RWKV_G_LORA ** -0.5),
        'rwkv_k_k': 0.85 + nrm((E, RWKV_W), 0.05),
        'rwkv_k_a': 1.0 + nrm((E, RWKV_W), 0.05),
        'rwkv_r_k': nrm((E, RWKV_HEADS, RWKV_HEAD), 0.1),
        'rwkv_lnx_g': 1.0 + nrm((E, RWKV_W), 0.05),
        'rwkv_lnx_b': nrm((E, RWKV_W), 0.02),
        'even_w_out': nrm((E, D, D), DN_BETA * D ** -0.5),
        'odd_w_in': nrm((O, D, ODD_IN), D ** -0.5),
        'odd_w_out': nrm((O, D, D), DN_BETA * D ** -0.5),
        'mix_ln_g': 1.0 + nrm((L, D), 0.05),
        'mix_ln_b': nrm((L, D), 0.02),
        'peer_w_q': nrm((L, D, PEER_HEADS * PEER_DKEY), D ** -0.5),
        'peer_sub_keys': nrm((L, PEER_HEADS, 2, PEER_NKEYS, PEER_DKEY // 2), (PEER_DKEY // 2) ** -0.5),
        'peer_u': nrm((L, PEER_N_EXPERTS, D), D ** -0.5),
        'peer_v': nrm((L, PEER_N_EXPERTS, D), DN_BETA * PEER_HEADS ** -0.5),
        'ffn_ln_g': 1.0 + nrm((L, D), 0.05),
        'ffn_ln_b': nrm((L, D), 0.02),
    }


def reference(x, even_w_in, gla_a_w2, gla_a_b, gla_norm_g, rwkv_mu, rwkv_w0, rwkv_w2, rwkv_a0, rwkv_a2,
              rwkv_g2, rwkv_k_k, rwkv_k_a, rwkv_r_k, rwkv_lnx_g, rwkv_lnx_b, even_w_out, odd_w_in,
              odd_w_out, mix_ln_g, mix_ln_b, peer_w_q, peer_sub_keys, peer_u, peer_v, ffn_ln_g, ffn_ln_b):
    for layer in range(DEPTH):
        i = layer // 2
        if layer % 2 == 0:
            mix = even_mixer(x, even_w_in[i], gla_a_w2[i], gla_a_b[i], gla_norm_g[i], rwkv_mu[i], rwkv_w0[i],
                             rwkv_w2[i], rwkv_a0[i], rwkv_a2[i], rwkv_g2[i], rwkv_k_k[i], rwkv_k_a[i],
                             rwkv_r_k[i], rwkv_lnx_g[i], rwkv_lnx_b[i], even_w_out[i])
        else:
            mix = dsa_mixer(x, odd_w_in[i], odd_w_out[i])
        x = layer_norm(DN_ALPHA * x + mix, mix_ln_g[layer], mix_ln_b[layer])
        ffn = peer_ffn(x, peer_w_q[layer], peer_sub_keys[layer], peer_u[layer], peer_v[layer])
        x = layer_norm(DN_ALPHA * x + ffn, ffn_ln_g[layer], ffn_ln_b[layer])
    return x
```

```cpp
#include <hip/hip_runtime.h>
#include <cstdio>
#include <cstdint>
namespace pg8 {
#define PG8_LAS __attribute__((address_space(3)))
typedef unsigned short bf16_t;
typedef short bf16x8 __attribute__((ext_vector_type(8)));
typedef float f32x4 __attribute__((ext_vector_type(4)));
typedef unsigned u32x4 __attribute__((ext_vector_type(4)));
constexpr int BM = 256, BK = 64, HALF = 128, HTB = HALF * BK * 2  , STAGE_BYTES = 8 * HTB, NXCD = 8, WGM = 8;

__host__ __device__ __forceinline__ int lds_byte(int r, int c) { const int st = (r >> 4) * 2 + (c >> 5), rr = r & 15, cc = c & 31, ob = rr * 64 + cc * 2; return st * 1024 + (ob ^ (((ob >> 9) & 1) << 5)); }
__host__ __device__ __forceinline__ void stage_rc(int b, int& R, int& C) { const int st = b / 1024, sb = b % 1024, swz = sb ^ (((sb >> 9) & 1) << 5); R = (st >> 1) * 16 + swz / 64; C = (st & 1) * 32 + (swz % 64) / 2; }
__host__ __device__ __forceinline__ int perm32(int rho) { const int n = rho >> 4, i = rho & 15; return 8 * (i >> 2) + 4 * n + (i & 3); }

struct Unit { int pm, pn; };
struct Gemm { const bf16_t* A; const bf16_t* Bt; int M, N, K; };

struct StaticOrder {
    int nM, nN, nwg, G, c;
    __host__ __device__ void init(int M, int N, int G_, int c_) { nM = M / BM; nN = N / BM; nwg = nM * nN; G = G_; c = c_; }
    __host__ __device__ bool next(int i, Unit& u) const {
        const long L = (long)i * G + c; if (L >= nwg) return false;
        int wgid = (int)L; { const int q = nwg / NXCD, r = nwg % NXCD, xcd = wgid % NXCD, off = wgid / NXCD; wgid = (xcd < r ? xcd * (q + 1) : r * (q + 1) + (xcd - r) * q) + off; }
        const int nig = WGM * nN, gid = wgid / nig, fm = gid * WGM, gsz = (nM - fm) < WGM ? (nM - fm) : WGM;
        u.pm = fm + ((wgid % nig) % gsz); u.pn = (wgid % nig) / gsz; return true;
    }
    __device__ __forceinline__ void a_ready(const Unit&) const {}
    __device__ __forceinline__ void done(const Unit&) const {}
};

__device__ __forceinline__ unsigned cvt_pk_bf16(float lo, float hi) { unsigned r; asm volatile("v_cvt_pk_bf16_f32 %0, %1, %2" : "=v"(r) : "v"(lo), "v"(hi)); return r; }
typedef float f32x2 __attribute__((ext_vector_type(2)));
__device__ __forceinline__ f32x2 gelu_pk(f32x2 v) {
    const f32x2 av = __builtin_elementwise_abs(v), d = av * 0.2316418882f + 1.0f;
    f32x2 t; t.x = __builtin_amdgcn_rcpf(d.x); t.y = __builtin_amdgcn_rcpf(d.y);
    f32x2 q = t * 0.5307027145f + (-0.7265760135f); q = q * t + 0.7107068705f; q = q * t + (-0.142248368f); q = q * t + 0.127414796f; q = q * t;
    const f32x2 s = (v * v) * (-0.72134752044f);
    f32x2 e; e.x = __builtin_amdgcn_exp2f(s.x); e.y = __builtin_amdgcn_exp2f(s.y);
    const f32x2 m = v * (q * e), r = v - m;
    f32x2 o; o.x = v.x < 0.f ? m.x : r.x; o.y = v.y < 0.f ? m.y : r.y; return o;
}

template <int ACT  > struct EpiBf16 {
    static constexpr bool PERM = true, AFTER_DRAIN = false; static_assert(ACT == 0 || ACT == 1, "EpiBf16: ACT is 0 (none) or 1 (gelu_pk)");
    bf16_t* O; int ldc; const float* bias; int split_cols; size_t split_stride; float scale0;
    __device__ __forceinline__ void operator()(const f32x4 (&acc)[2][2][4][2], const Unit& u, int wr, int wc, int fr, int fq) const {
        const int row0 = u.pm * BM + wr * 64 + fr; int colt = u.pn * BM; bf16_t* base = O;
        float sc = 1.f; if (split_cols) { const int t = colt / split_cols; base += (size_t)t * split_stride; colt -= t * split_cols; if (t == 0) sc = scale0; }
        const int col0 = colt + wc * 32 + 8 * fq, bcol0 = u.pn * BM + wc * 32 + 8 * fq;
        f32x4 bv[2][2];
#pragma unroll
        for (int bj = 0; bj < 2; ++bj)
#pragma unroll
            for (int n = 0; n < 2; ++n) bv[bj][n] = bias ? *(const f32x4*)(bias + bcol0 + bj * HALF + 4 * n) : (f32x4){0.f, 0.f, 0.f, 0.f};
#pragma unroll
        for (int ai = 0; ai < 2; ++ai)
#pragma unroll
            for (int m = 0; m < 4; ++m) { bf16_t* rowp = base + (size_t)(row0 + ai * HALF + m * 16) * ldc + col0;
#pragma unroll
                for (int bj = 0; bj < 2; ++bj) { f32x4 v0 = acc[ai][bj][m][0] + bv[bj][0], v1 = acc[ai][bj][m][1] + bv[bj][1];
                    if (ACT == 1) { f32x2 a = gelu_pk((f32x2){v0[0], v0[1]}), b = gelu_pk((f32x2){v0[2], v0[3]}), c = gelu_pk((f32x2){v1[0], v1[1]}), d = gelu_pk((f32x2){v1[2], v1[3]});
                        v0 = (f32x4){a.x, a.y, b.x, b.y}; v1 = (f32x4){c.x, c.y, d.x, d.y}; }
                    v0 = v0 * sc; v1 = v1 * sc; u32x4 w; w.x = cvt_pk_bf16(v0[0], v0[1]); w.y = cvt_pk_bf16(v0[2], v0[3]); w.z = cvt_pk_bf16(v1[0], v1[1]); w.w = cvt_pk_bf16(v1[2], v1[3]);
                    *(u32x4*)(rowp + bj * HALF) = w; } }
    }
};
struct EpiF32 {
    static constexpr bool PERM = false, AFTER_DRAIN = false;
    float* C; int ldc; const float* bias;
    __device__ __forceinline__ void operator()(const f32x4 (&acc)[2][2][4][2], const Unit& u, int wr, int wc, int fr, int fq) const {
        const int row0 = u.pm * BM + wr * 64 + fr, col0 = u.pn * BM + wc * 32 + 4 * fq;
        f32x4 bv[2][2];
#pragma unroll
        for (int bj = 0; bj < 2; ++bj)
#pragma unroll
            for (int n = 0; n < 2; ++n) bv[bj][n] = bias ? *(const f32x4*)(bias + col0 + bj * HALF + n * 16) : (f32x4){0.f, 0.f, 0.f, 0.f};
#pragma unroll
        for (int ai = 0; ai < 2; ++ai)
#pragma unroll
            for (int m = 0; m < 4; ++m) { float* rowp = C + (size_t)(row0 + ai * HALF + m * 16) * ldc + col0;
#pragma unroll
                for (int bj = 0; bj < 2; ++bj)
#pragma unroll
                    for (int n = 0; n < 2; ++n) *(f32x4*)(rowp + bj * HALF + n * 16) = acc[ai][bj][m][n] + bv[bj][n]; }
    }
};
template <class Epi, class Sched, bool ALIGN_EPI = false, bool SP2 = false>
__device__ __forceinline__ void gemm_phase(PG8_LAS unsigned char* lds, const Gemm g, const Sched& S, const Epi& E, const int tid) {
    const int wid = __builtin_amdgcn_readfirstlane(tid >> 6), lane = tid & 63, wr = wid >> 2, wc = wid & 3, fr = lane & 15, fq = lane >> 4;
    const int K = g.K, nt = K / BK;
    unsigned voffA[2], voffB[2];
#pragma unroll
    for (int i = 0; i < 2; ++i) { int R, C; stage_rc(tid * 16 + i * 8192, R, C); const int Rb = Epi::PERM ? ((R & ~31) + perm32(R & 31)) : R;
        voffA[i] = (unsigned)(R * K + C) * 2u; voffB[i] = (unsigned)(Rb * K + C) * 2u; }
    const size_t kstep = (size_t)(BK * 2);
    const size_t hstep = (size_t)HALF * K * 2;
    const size_t tstep = 2 * hstep;
    const unsigned ldsw = (unsigned)wid * 1024u;
    const int aoff = lds_byte(wr * 64 + fr, fq * 8), boff = lds_byte(wc * 32 + fr, fq * 8);
#define PG8_SA(b, h) (((b) * 2 + (h)) * HTB)
#define PG8_SB(b, h) ((4 + (b) * 2 + (h)) * HTB)
#define PG8_STAGE(bufoff, gbase, voff) do { _Pragma("unroll") for (int _i = 0; _i < 2; ++_i) \
        __builtin_amdgcn_global_load_lds((const unsigned*)((const char*)(gbase) + (voff)[_i]), (PG8_LAS unsigned*)(lds + (bufoff) + ldsw + _i * 8192), 16, 0, 0); } while (0)
#define PG8_LDA(dst, b, h) do { _Pragma("unroll") for (int m = 0; m < 4; ++m) _Pragma("unroll") for (int k = 0; k < 2; ++k) dst[m][k] = *(const PG8_LAS bf16x8*)(lds + PG8_SA(b, h) + aoff + m * 2048 + k * 1024); } while (0)
#define PG8_LDB(dst, b, h) do { _Pragma("unroll") for (int n = 0; n < 2; ++n) _Pragma("unroll") for (int k = 0; k < 2; ++k) dst[n][k] = *(const PG8_LAS bf16x8*)(lds + PG8_SB(b, h) + boff + n * 2048 + k * 1024); } while (0)
#define PG8_MMA(ai, bj, At, Bt) do { __builtin_amdgcn_s_setprio(1); _Pragma("unroll") for (int m = 0; m < 4; ++m) _Pragma("unroll") for (int n = 0; n < 2; ++n) _Pragma("unroll") for (int k = 0; k < 2; ++k) \
        acc[ai][bj][m][n] = __builtin_amdgcn_mfma_f32_16x16x32_bf16(Bt[n][k], At[m][k], acc[ai][bj][m][n], 0, 0, 0); __builtin_amdgcn_s_setprio(0); } while (0)
#define PG8_WAIT_V(n) asm volatile("s_waitcnt vmcnt(" #n ")" ::: "memory")
#define PG8_WAIT_L(n) asm volatile("s_waitcnt lgkmcnt(" #n ")" ::: "memory")
#define PG8_BAR __builtin_amdgcn_s_barrier()
#define PG8_SCHED __builtin_amdgcn_sched_barrier(0)
    Unit cur, nxt; int ui = 0;
    if (!S.next(0, cur)) return;
    f32x4 acc[2][2][4][2];
#pragma unroll
    for (int a = 0; a < 2; ++a)
#pragma unroll
        for (int b = 0; b < 2; ++b)
#pragma unroll
            for (int m = 0; m < 4; ++m)
#pragma unroll
                for (int n = 0; n < 2; ++n) acc[a][b][m][n] = (f32x4){0.f, 0.f, 0.f, 0.f};
    bf16x8 At[4][2], B0[2][2], B1[2][2];
    const char* cA = (const char*)g.A + (size_t)cur.pm * tstep; const char* cB = (const char*)g.Bt + (size_t)cur.pn * tstep;
    S.a_ready(cur);
    if constexpr (SP2) {
        PG8_STAGE(PG8_SB(0, 0), cB, voffB); PG8_STAGE(PG8_SB(0, 1), cB + hstep, voffB); PG8_STAGE(PG8_SA(0, 0), cA, voffA); PG8_STAGE(PG8_SA(0, 1), cA + hstep, voffA);
        if (wr == 1) PG8_BAR;
        PG8_WAIT_V(2); PG8_BAR;
        PG8_STAGE(PG8_SB(1, 0), cB + kstep, voffB); PG8_STAGE(PG8_SA(1, 0), cA + kstep, voffA); PG8_STAGE(PG8_SB(1, 1), cB + hstep + kstep, voffB);
        PG8_WAIT_V(6); PG8_BAR;
    } else {
        PG8_STAGE(PG8_SB(0, 0), cB, voffB); PG8_STAGE(PG8_SA(0, 0), cA, voffA); PG8_STAGE(PG8_SB(0, 1), cB + hstep, voffB); PG8_STAGE(PG8_SA(0, 1), cA + hstep, voffA);
        if (wr == 1) PG8_BAR;
        PG8_WAIT_V(4); PG8_BAR;
        PG8_STAGE(PG8_SB(1, 0), cB + kstep, voffB); PG8_STAGE(PG8_SA(1, 0), cA + kstep, voffA); PG8_STAGE(PG8_SB(1, 1), cB + hstep + kstep, voffB);
        PG8_WAIT_V(6); PG8_BAR;
    }
    for (;;) {
        const bool has_next = S.next(ui + 1, nxt);
        const char* nA = has_next ? (const char*)g.A + (size_t)nxt.pm * tstep : cA; const char* nB = has_next ? (const char*)g.Bt + (size_t)nxt.pn * tstep : cB;
        for (int t = 0; t < nt; t += 2) {
            const bool last = (t == nt - 2);
            const char* a1 = cA + (size_t)(t + 1) * kstep;
            const char* a2 = last ? nA : cA + (size_t)(t + 2) * kstep; const char* b2 = last ? nB : cB + (size_t)(t + 2) * kstep;
            const char* a3 = a2 + kstep; const char* b3 = b2 + kstep;
            if (last && has_next) S.a_ready(nxt);
            if constexpr (SP2) {
            PG8_LDB(B0, 0, 0); PG8_LDB(B1, 0, 1); PG8_SCHED; PG8_LDA(At, 0, 0); PG8_STAGE(PG8_SA(1, 1), a1 + hstep, voffA);
            PG8_WAIT_V(8); PG8_WAIT_L(0); PG8_BAR; PG8_MMA(0, 0, At, B0); PG8_MMA(0, 1, At, B1); PG8_BAR; PG8_SCHED;
            PG8_LDA(At, 0, 1); PG8_STAGE(PG8_SB(0, 0), b2, voffB); PG8_STAGE(PG8_SB(0, 1), b2 + hstep, voffB); PG8_STAGE(PG8_SA(0, 0), a2, voffA);
            PG8_WAIT_V(8); PG8_WAIT_L(0); PG8_BAR; PG8_MMA(1, 0, At, B0); PG8_MMA(1, 1, At, B1); PG8_BAR; PG8_SCHED;
            PG8_LDB(B0, 1, 0); PG8_LDB(B1, 1, 1); PG8_SCHED; PG8_LDA(At, 1, 0); PG8_STAGE(PG8_SA(0, 1), a2 + hstep, voffA);
            PG8_WAIT_V(8); PG8_WAIT_L(0); PG8_BAR; PG8_MMA(0, 0, At, B0); PG8_MMA(0, 1, At, B1); PG8_BAR; PG8_SCHED;
            PG8_LDA(At, 1, 1); PG8_STAGE(PG8_SB(1, 0), b3, voffB); PG8_STAGE(PG8_SB(1, 1), b3 + hstep, voffB); PG8_STAGE(PG8_SA(1, 0), a3, voffA);
            PG8_WAIT_V(8); PG8_WAIT_L(0); PG8_BAR; PG8_MMA(1, 0, At, B0); PG8_MMA(1, 1, At, B1); PG8_BAR; PG8_SCHED;
            } else {
            PG8_LDB(B0, 0, 0); PG8_SCHED; PG8_LDA(At, 0, 0); PG8_STAGE(PG8_SA(1, 1), a1 + hstep, voffA);
            PG8_WAIT_L(8); PG8_BAR; PG8_WAIT_L(0); PG8_MMA(0, 0, At, B0); PG8_BAR; PG8_SCHED;
            PG8_LDB(B1, 0, 1); PG8_STAGE(PG8_SB(0, 0), b2, voffB);
            PG8_BAR; PG8_WAIT_L(0); PG8_MMA(0, 1, At, B1); PG8_BAR;
            PG8_LDA(At, 0, 1); PG8_STAGE(PG8_SA(0, 0), a2, voffA);
            PG8_BAR; PG8_WAIT_L(0); PG8_MMA(1, 0, At, B0); PG8_BAR; PG8_SCHED;
            PG8_STAGE(PG8_SB(0, 1), b2 + hstep, voffB);
            PG8_WAIT_V(6); PG8_BAR; PG8_MMA(1, 1, At, B1); PG8_BAR;
            PG8_LDB(B0, 1, 0); PG8_SCHED; PG8_LDA(At, 1, 0); PG8_STAGE(PG8_SA(0, 1), a2 + hstep, voffA);
            PG8_WAIT_L(8); PG8_BAR; PG8_WAIT_L(0); PG8_MMA(0, 0, At, B0); PG8_BAR; PG8_SCHED;
            PG8_LDB(B1, 1, 1); PG8_STAGE(PG8_SB(1, 0), b3, voffB);
            PG8_BAR; PG8_WAIT_L(0); PG8_MMA(0, 1, At, B1); PG8_BAR;
            PG8_LDA(At, 1, 1); PG8_STAGE(PG8_SA(1, 0), a3, voffA);
            PG8_BAR; PG8_WAIT_L(0); PG8_MMA(1, 0, At, B0); PG8_BAR; PG8_SCHED;
            PG8_STAGE(PG8_SB(1, 1), b3 + hstep, voffB);
            PG8_WAIT_V(6); PG8_BAR; PG8_MMA(1, 1, At, B1); PG8_BAR;
            }
        }
        if constexpr (ALIGN_EPI) { if (wr == 0) PG8_BAR; }
        if constexpr (!Epi::AFTER_DRAIN) { E(acc, cur, wr, wc, fr, fq); S.done(cur); }
        if (!has_next) break;
#pragma unroll
        for (int a = 0; a < 2; ++a)
#pragma unroll
            for (int b = 0; b < 2; ++b)
#pragma unroll
                for (int m = 0; m < 4; ++m)
#pragma unroll
                    for (int n = 0; n < 2; ++n) acc[a][b][m][n] = (f32x4){0.f, 0.f, 0.f, 0.f};
        cur = nxt; cA = nA; cB = nB; ++ui;
        if constexpr (ALIGN_EPI) { if (wr == 1) PG8_BAR; }
    }
    PG8_WAIT_V(0);
    if constexpr (!ALIGN_EPI) { if (wr == 0) PG8_BAR; }
    PG8_BAR;
    if constexpr (Epi::AFTER_DRAIN) { E.fused(acc, cur, wr, wc, fr, fq, lds, wid, lane); S.done(cur); }
#undef PG8_SA
#undef PG8_SB
#undef PG8_STAGE
#undef PG8_LDA
#undef PG8_LDB
#undef PG8_MMA
#undef PG8_WAIT_V
#undef PG8_WAIT_L
#undef PG8_BAR
#undef PG8_SCHED
}
}

constexpr int DM = 1024, NBATCH = 32, TSEQ = 2048, MTOK = NBATCH * TSEQ, DEPTH = 4;
constexpr int EVEN_IN = 3248, EVEN_PAD = 3328, ODD_IN = 1864, ODD_PAD = 2048;
constexpr int G_Q = 0, G_K = 256, G_V = 512, G_G = 1024, G_AL = 1536, RW0 = 1552;
constexpr int R_R = RW0, R_K = RW0 + 512, R_V = RW0 + 1024, R_WL = RW0 + 1536;
constexpr int O_Q = 0, O_K = 1024, O_V = 1152, O_QI = 1280, O_KI = 1792, O_WI = 1856;
constexpr float DN_ALPHA = 1.681792830507429f, LN_EPS = 1e-5f;

constexpr size_t MiB = 1u << 20;
constexpr size_t WS_CTL = 0, CTL_ZERO_BYTES = 1 * MiB;
constexpr size_t WS_COSA = 1 * MiB, WS_SINA = WS_COSA + 512 * 1024, WS_COSI = 2 * MiB, WS_SINI = WS_COSI + 256 * 1024;
constexpr size_t WS_WINE = 3 * MiB, WS_WINO = 16 * MiB, WS_WOUTE = 24 * MiB, WS_WOUTO = 28 * MiB, WS_WQ = 32 * MiB, WS_SK = 40 * MiB;
constexpr size_t WS_XB = 48 * MiB, WS_P = 176 * MiB, WS_MIX = WS_P, WS_QP = WS_P + 256 * MiB, WS_CAT = 592 * MiB;
constexpr size_t WS_RIDX = 720 * MiB, WS_RGATE = 736 * MiB, WS_MASK = 768 * MiB, WS_EXP = 784 * MiB, WS_END = 848 * MiB;
constexpr int CW_BAR = 4096;

constexpr int LDS_BYTES = 147456, RING_BYTES = 131072, LDSCTL_OFF = RING_BYTES;

#define GAS __attribute__((address_space(1)))
#define LAS __attribute__((address_space(3)))
typedef unsigned short bf16;
typedef float f32x4 __attribute__((ext_vector_type(4)));
typedef unsigned u32x4 __attribute__((ext_vector_type(4)));
typedef unsigned u32x2 __attribute__((ext_vector_type(2)));
#define LDS_WAIT() asm volatile("s_waitcnt lgkmcnt(0)" ::: "memory")
__device__ __forceinline__ float bf2f(bf16 b) { return __uint_as_float(((unsigned)b) << 16); }
__device__ __forceinline__ unsigned f2bf(float f) { unsigned u = __float_as_uint(f); return (u + 0x7fffu + ((u >> 16) & 1u)) >> 16; }
__device__ __forceinline__ unsigned pk2(float lo, float hi) { return f2bf(lo) | (f2bf(hi) << 16); }
__device__ __forceinline__ float bflo(unsigned w) { return __uint_as_float(w << 16); }
__device__ __forceinline__ float bfhi(unsigned w) { return __uint_as_float(w & 0xffff0000u); }
__device__ __forceinline__ float wave_sum(float v) {
#pragma unroll
    for (int o = 1; o < 64; o <<= 1) v += __shfl_xor(v, o);
    return v;
}
__device__ __forceinline__ float wave_max(float v) {
#pragma unroll
    for (int o = 1; o < 64; o <<= 1) v = fmaxf(v, __shfl_xor(v, o));
    return v;
}
__device__ __forceinline__ int wave_sum_i(int v) {
#pragma unroll
    for (int o = 1; o < 64; o <<= 1) v += __shfl_xor(v, o);
    return v;
}
__device__ __forceinline__ float sigmoidf_(float x) { return 1.f / (1.f + __expf(-x)); }
#define XB_TMO      128
#define XB_XCNT(j)  (256  + 64 * (j))
#define XB_XSUB(j)  (1280 + 64 * (j))
#define XB_XGEN(j)  (2304 + 64 * (j))
#define XB_TOP      3328
#define XB_TOPGEN   3392
#define XCD_BAR_WORDS 3456
#define XB_SPIN_CAP (1u << 18)

__device__ __forceinline__ unsigned xb_ld(unsigned* p)              { return __hip_atomic_load(p, __ATOMIC_RELAXED, __HIP_MEMORY_SCOPE_AGENT); }
__device__ __forceinline__ unsigned xb_add(unsigned* p, unsigned v) { return __hip_atomic_fetch_add(p, v, __ATOMIC_RELAXED, __HIP_MEMORY_SCOPE_AGENT); }
__device__ __forceinline__ unsigned xb_xcc_id() { return (unsigned)__builtin_amdgcn_s_getreg((3 << 11) | 20) & 0xFu; }
#define XB_SPIN(cond, bar) do { unsigned _sp = 0; while (cond) { __builtin_amdgcn_s_sleep(1); \
    if ((++_sp & 255u) == 0u) { if (xb_ld(&(bar)[XB_TMO])) break; if (_sp > XB_SPIN_CAP) { atomicAdd(&(bar)[XB_TMO], 1u); break; } } } } while (0)

struct XcdBarrier {
    unsigned* bar; unsigned x;
    volatile LAS unsigned* st;
};

__device__ __forceinline__ XcdBarrier xcd_barrier_post(unsigned* bar, volatile LAS unsigned* st) {
    XcdBarrier b; b.bar = bar; b.x = xb_xcc_id(); b.st = st;
    if (threadIdx.x == 0) (void)xb_add(&bar[XB_XCNT(b.x)], 1u);
    return b;
}
__device__ __forceinline__ void xcd_barrier_complete(unsigned* bar, unsigned x, unsigned& nloc, unsigned& nx) {
    const unsigned G = gridDim.x * gridDim.y * gridDim.z;
    unsigned sum, cnt, mine, sp = 0u;
    for (;;) {
        sum = 0u; cnt = 0u; mine = 0u;
#pragma unroll
        for (unsigned j = 0; j < 16; ++j) { const unsigned c = xb_ld(&bar[XB_XCNT(j)]); sum += c; cnt += (c > 0u) ? 1u : 0u; mine = (j == x) ? c : mine; }
        if (sum == G) break;
        __builtin_amdgcn_s_sleep(1);
        if ((++sp & 255u) == 0u) { if (xb_ld(&bar[XB_TMO])) break; if (sp > XB_SPIN_CAP) { atomicAdd(&bar[XB_TMO], 1u); break; } }
    }
    nloc = mine > 0u ? mine : 1u; nx = cnt > 0u ? cnt : 1u;
}

__device__ __forceinline__ void xcd_barrier(const XcdBarrier& b) {
    asm volatile("s_waitcnt vmcnt(0)" ::: "memory");
    __syncthreads();
    if (threadIdx.x == 0) {
        unsigned* bar = b.bar;
        __builtin_amdgcn_s_waitcnt(0);
        unsigned nloc = b.st[0], nx = b.st[1];
        if (nloc == 0u) { xcd_barrier_complete(bar, b.x, nloc, nx); b.st[0] = nloc; b.st[1] = nx; }
        const unsigned old = xb_add(&bar[XB_XSUB(b.x)], 1u);
        const unsigned gen = old / nloc;
        if (old + 1u == (gen + 1u) * nloc) {
            __builtin_amdgcn_fence(__ATOMIC_RELEASE, "agent");
            asm volatile("s_waitcnt vmcnt(0)" ::: "memory");
            const unsigned og = xb_add(&bar[XB_TOP], 1u);
            const unsigned tg = og / nx;
            if (og + 1u == (tg + 1u) * nx) xb_add(&bar[XB_TOPGEN], 1u);
            else XB_SPIN(xb_ld(&bar[XB_TOPGEN]) == tg, bar);
            __builtin_amdgcn_fence(__ATOMIC_ACQUIRE, "agent");
            xb_add(&bar[XB_XGEN(b.x)], 1u);
            asm volatile("s_waitcnt vmcnt(0)" ::: "memory");
        } else {
            XB_SPIN(xb_ld(&bar[XB_XGEN(b.x)]) == gen, bar);
            __builtin_amdgcn_fence(__ATOMIC_ACQUIRE, "agent");
            asm volatile("s_waitcnt vmcnt(0)" ::: "memory");
        }
    }
    __syncthreads();
}

struct Args { const float* in[27]; float* out; unsigned char* ws; int ph_lo, ph_hi; };

__device__ __forceinline__ void transpose_item(const float* W, int N, int Npad, bf16* WT, LAS float* scr, int item, int lane) {
    const int nblk = Npad / 32, kb = item / nblk, nb = item % nblk, k0 = 64 * kb, n0 = 32 * nb;
    const int n_in = n0 + (lane & 31);
#pragma unroll 8
    for (int i = 0; i < 32; ++i) { const int kk = 2 * i + (lane >> 5); scr[kk * 33 + (lane & 31)] = (n_in < N) ? W[(size_t)(k0 + kk) * N + n_in] : 0.f; }
    LDS_WAIT(); asm volatile("" ::: "memory");
    const int c = lane & 7;
#pragma unroll
    for (int j = 0; j < 4; ++j) { const int n = (lane >> 3) + 8 * j; const LAS float* s = scr + (8 * c) * 33 + n;
        u32x4 o; o.x = pk2(s[0 * 33], s[1 * 33]); o.y = pk2(s[2 * 33], s[3 * 33]); o.z = pk2(s[4 * 33], s[5 * 33]); o.w = pk2(s[6 * 33], s[7 * 33]);
        *(u32x4*)(WT + (size_t)(n0 + n) * 1024 + k0 + 8 * c) = o; }
    LDS_WAIT(); asm volatile("" ::: "memory");
}
__device__ __forceinline__ void sincos_d(double x, double& s, double& c) {
    const double n = __builtin_rint(x * 0.6366197723675814);
    double r = __builtin_fma(-n, 1.5707963267948966, x); r = __builtin_fma(-n, 6.123233995736766e-17, r);
    const int q = ((int)n) & 3;
    const double r2 = r * r;
    double sp = -1.0 / 1307674368000.0; sp = sp * r2 + 1.0 / 6227020800.0; sp = sp * r2 - 1.0 / 39916800.0; sp = sp * r2 + 1.0 / 362880.0; sp = sp * r2 - 1.0 / 5040.0; sp = sp * r2 + 1.0 / 120.0; sp = sp * r2 - 1.0 / 6.0; sp = sp * r2 + 1.0; sp *= r;
    double cp = 1.0 / 20922789888000.0; cp = cp * r2 - 1.0 / 87178291200.0; cp = cp * r2 + 1.0 / 479001600.0; cp = cp * r2 - 1.0 / 3628800.0; cp = cp * r2 + 1.0 / 40320.0; cp = cp * r2 - 1.0 / 720.0; cp = cp * r2 + 1.0 / 24.0; cp = cp * r2 - 0.5; cp = cp * r2 + 1.0;
    s = (q == 0) ? sp : (q == 1) ? cp : (q == 2) ? -sp : -cp;
    c = (q == 0) ? cp : (q == 1) ? -sp : (q == 2) ? -cp : sp;
}
__device__ __forceinline__ double powi_d(double base, int e) { double r = 1.0, p = base;
#pragma unroll
    for (int b = 0; b < 7; ++b) { if (e & (1 << b)) r *= p; p *= p; } return r; }

__device__ __forceinline__ void ph_prologue(const Args& a, LAS unsigned char* lds, int gw, int NGW, int wave, int lane) {
    unsigned char* ws = a.ws;
    LAS float* scr = (LAS float*)(lds + wave * 16384);
    constexpr int I_WE = 16 * (EVEN_PAD / 32), I_WO = 16 * (ODD_PAD / 32), I_SQ = 16 * 32;
    constexpr int NIT = 2 * I_WE + 2 * I_WO + 8 * I_SQ;
    for (int it = gw; it < NIT; it += NGW) {
        int r = it;
        if (r < 2 * I_WE) { const int i = r / I_WE; transpose_item(a.in[1] + (size_t)i * 1024 * EVEN_IN, EVEN_IN, EVEN_PAD, (bf16*)(ws + WS_WINE) + (size_t)i * EVEN_PAD * 1024, scr, r % I_WE, lane); continue; }
        r -= 2 * I_WE;
        if (r < 2 * I_WO) { const int i = r / I_WO; transpose_item(a.in[17] + (size_t)i * 1024 * ODD_IN, ODD_IN, ODD_PAD, (bf16*)(ws + WS_WINO) + (size_t)i * ODD_PAD * 1024, scr, r % I_WO, lane); continue; }
        r -= 2 * I_WO;
        const int mi = r / I_SQ, item = r % I_SQ; const float* src; bf16* dst;
        if (mi < 2) { src = a.in[16] + (size_t)mi * 1048576; dst = (bf16*)(ws + WS_WOUTE) + (size_t)mi * 1048576; }
        else if (mi < 4) { src = a.in[18] + (size_t)(mi - 2) * 1048576; dst = (bf16*)(ws + WS_WOUTO) + (size_t)(mi - 2) * 1048576; }
        else { src = a.in[21] + (size_t)(mi - 4) * 1048576; dst = (bf16*)(ws + WS_WQ) + (size_t)(mi - 4) * 1048576; }
        transpose_item(src, 1024, 1024, dst, scr, item, lane);
    }
    const int gtid = gw * 64 + lane, NT = NGW * 64;
    for (int idx = gtid; idx < 2048 * 64; idx += NT) { const int t = idx >> 6, i = idx & 63; double s, c; sincos_d((double)t * powi_d(0.8659643233600653, i), s, c);
        ((float*)(ws + WS_COSA))[idx] = (float)c; ((float*)(ws + WS_SINA))[idx] = (float)s; }
    for (int idx = gtid; idx < 2048 * 32; idx += NT) { const int t = idx >> 5, i = idx & 31; double s, c; sincos_d((double)t * powi_d(0.7498942093324559, i), s, c);
        ((float*)(ws + WS_COSI))[idx] = (float)c; ((float*)(ws + WS_SINI))[idx] = (float)s; }
    const f32x4* x4 = (const f32x4*)a.in[0]; u32x4* xb = (u32x4*)(ws + WS_XB);
    for (size_t i = gtid; i < (size_t)MTOK * DM / 8; i += NT) { const f32x4 v0 = x4[2 * i], v1 = x4[2 * i + 1];
        u32x4 o; o.x = pk2(v0.x, v0.y); o.y = pk2(v0.z, v0.w); o.z = pk2(v1.x, v1.y); o.w = pk2(v1.z, v1.w); xb[i] = o; }
}

constexpr int L_W2 = 0, L_A2 = 2048, L_G2 = 4096, L_PAR = 10240, L_LORA = 11040, L_VEC = 16160, L_Y = 30496, L_BON = 32544;
__device__ __forceinline__ void rwkv_unit(const Args& a, LAS float* L, int unit, int i2, const bf16* P, bf16* CAT, int tid) {
    constexpr int PS = EVEN_PAD;
    const int b = unit >> 3, h = unit & 7, lane = tid & 63, wave = __builtin_amdgcn_readfirstlane(tid >> 6);
    const float* mu = a.in[5] + i2 * 1696; const float* w0 = a.in[6] + i2 * 512; const float* w2 = a.in[7] + i2 * 32 * 512; const float* a0 = a.in[8] + i2 * 512;
    const float* a2 = a.in[9] + i2 * 32 * 512; const float* g2 = a.in[10] + i2 * 96 * 512; const float* kk_ = a.in[11] + i2 * 512; const float* ka_ = a.in[12] + i2 * 512;
    const float* rk_ = a.in[13] + i2 * 512; const float* lg = a.in[14] + i2 * 512; const float* lb = a.in[15] + i2 * 512;
    for (int idx = tid; idx < 32 * 64; idx += 512) { const int j = idx >> 6, c = idx & 63; L[L_W2 + idx] = w2[j * 512 + h * 64 + c]; L[L_A2 + idx] = a2[j * 512 + h * 64 + c]; }
    for (int idx = tid; idx < 96 * 64; idx += 512) { const int j = idx >> 6, c = idx & 63; L[L_G2 + idx] = g2[j * 512 + h * 64 + c]; }
    if (tid < 64) { const int c = tid, col = h * 64 + c; L[L_PAR + c] = mu[col]; L[L_PAR + 64 + c] = mu[512 + col]; L[L_PAR + 128 + c] = mu[1024 + col]; L[L_PAR + 192 + c] = w0[col];
        L[L_PAR + 256 + c] = a0[col]; L[L_PAR + 320 + c] = kk_[col]; L[L_PAR + 384 + c] = ka_[col]; L[L_PAR + 448 + c] = rk_[col]; L[L_PAR + 512 + c] = lg[col]; L[L_PAR + 576 + c] = lb[col]; }
    if (tid < 160) L[L_PAR + 640 + tid] = mu[1536 + tid];
    float S[8];
#pragma unroll
    for (int e = 0; e < 8; ++e) S[e] = 0.f;
    __syncthreads();
    const size_t row0 = (size_t)b * 2048;
    for (int t0 = 0; t0 < 2048; t0 += 32) {
#pragma unroll 1
        for (int idx = tid; idx < 32 * 160; idx += 512) { const int tok = idx / 160, j = idx - tok * 160, t = t0 + tok; const bf16* pr = P + (row0 + t) * PS + R_WL + j;
            const float cur = bf2f(pr[0]), prev = t > 0 ? bf2f(pr[-PS]) : 0.f; const float s = cur + (prev - cur) * L[L_PAR + 640 + j];
            L[L_LORA + idx] = j < 32 ? tanhf(s) : (j < 64 ? s : 1.f / (1.f + expf(-s))); }
        __syncthreads();
        { const int c = lane, tg = wave, col = h * 64 + c;
          float rs[4], ks[4], vs[4], wl[4], al[4], gg[4];
#pragma unroll
          for (int i = 0; i < 4; ++i) { const int tok = tg * 4 + i, t = t0 + tok; const bf16* pr = P + (row0 + t) * PS;
              float cur = bf2f(pr[R_R + col]), prev = t > 0 ? bf2f(pr[R_R + col - PS]) : 0.f; rs[i] = cur + (prev - cur) * L[L_PAR + c];
              cur = bf2f(pr[R_K + col]); prev = t > 0 ? bf2f(pr[R_K + col - PS]) : 0.f; ks[i] = cur + (prev - cur) * L[L_PAR + 64 + c];
              cur = bf2f(pr[R_V + col]); prev = t > 0 ? bf2f(pr[R_V + col - PS]) : 0.f; vs[i] = cur + (prev - cur) * L[L_PAR + 128 + c];
              wl[i] = L[L_PAR + 192 + c]; al[i] = L[L_PAR + 256 + c]; gg[i] = 0.f; }
#pragma unroll 2
          for (int j = 0; j < 32; ++j) { const float w = L[L_W2 + j * 64 + c], aa = L[L_A2 + j * 64 + c];
#pragma unroll
              for (int i = 0; i < 4; ++i) { wl[i] += L[L_LORA + (tg * 4 + i) * 160 + j] * w; al[i] += L[L_LORA + (tg * 4 + i) * 160 + 32 + j] * aa; } }
#pragma unroll 2
          for (int j = 0; j < 96; ++j) { const float g_ = L[L_G2 + j * 64 + c];
#pragma unroll
              for (int i = 0; i < 4; ++i) gg[i] += L[L_LORA + (tg * 4 + i) * 160 + 64 + j] * g_; }
#pragma unroll
          for (int i = 0; i < 4; ++i) { const int tok = tg * 4 + i;
              const float wlog = fminf(wl[i], 0.f) - log1pf(expf(-fabsf(wl[i]))) - 0.5f; const float decay = expf(-expf(wlog));
              const float av = 1.f / (1.f + expf(-al[i]));
              const float kkr = ks[i] * L[L_PAR + 320 + c]; const float ss = wave_sum(kkr * kkr); const float kkn = kkr / fmaxf(sqrtf(ss), 1e-12f);
              const float k2 = ks[i] * (1.f + (av - 1.f) * L[L_PAR + 384 + c]);
              const float bon = wave_sum(rs[i] * k2 * L[L_PAR + 448 + c]);
              const int o = L_VEC + tok * 64 + c;
              L[o] = rs[i]; L[o + 2048] = decay; L[o + 4096] = k2; L[o + 6144] = vs[i]; L[o + 8192] = -kkn; L[o + 10240] = kkn * av; L[o + 12288] = gg[i];
              if (c == 0) L[L_BON + tok] = bon; } }
        __syncthreads();
        { const int i = tid >> 3, jq = tid & 7;
#pragma unroll 1
          for (int tok = 0; tok < 32; ++tok) { const int base = L_VEC + tok * 64 + jq * 8;
              const f32x4 r0 = *(const LAS f32x4*)&L[base], r1 = *(const LAS f32x4*)&L[base + 4];
              const f32x4 w0v = *(const LAS f32x4*)&L[base + 2048], w1v = *(const LAS f32x4*)&L[base + 2052];
              const f32x4 k0v = *(const LAS f32x4*)&L[base + 4096], k1v = *(const LAS f32x4*)&L[base + 4100];
              const f32x4 a0v = *(const LAS f32x4*)&L[base + 8192], a1v = *(const LAS f32x4*)&L[base + 8196];
              const f32x4 b0v = *(const LAS f32x4*)&L[base + 10240], b1v = *(const LAS f32x4*)&L[base + 10244];
              const float vi = L[L_VEC + 6144 + tok * 64 + i];
              float sa = 0.f;
#pragma unroll
              for (int e = 0; e < 4; ++e) { sa += S[e] * a0v[e]; sa += S[4 + e] * a1v[e]; }
              sa += __shfl_xor(sa, 1); sa += __shfl_xor(sa, 2); sa += __shfl_xor(sa, 4);
              float y = 0.f;
#pragma unroll
              for (int e = 0; e < 4; ++e) { S[e] = S[e] * w0v[e] + sa * b0v[e] + vi * k0v[e]; S[4 + e] = S[4 + e] * w1v[e] + sa * b1v[e] + vi * k1v[e]; y += S[e] * r0[e]; y += S[4 + e] * r1[e]; }
              y += __shfl_xor(y, 1); y += __shfl_xor(y, 2); y += __shfl_xor(y, 4);
              if (jq == 0) L[L_Y + tok * 64 + i] = y; } }
        __syncthreads();
        { const int c = lane, tg = wave, col = h * 64 + c;
#pragma unroll
          for (int i = 0; i < 4; ++i) { const int tok = tg * 4 + i, t = t0 + tok; const float y = L[L_Y + tok * 64 + c];
              const float mean = wave_sum(y) * (1.f / 64.f); const float d = y - mean; const float var = wave_sum(d * d) * (1.f / 64.f);
              const float yn = d * (1.f / sqrtf(var + 64e-5f)) * L[L_PAR + 512 + c] + L[L_PAR + 576 + c];
              const float o = (yn + L[L_BON + tok] * L[L_VEC + 6144 + tok * 64 + c]) * L[L_VEC + 12288 + tok * 64 + c];
              CAT[(row0 + t) * 1024 + 512 + col] = (bf16)f2bf(o); } }
    }
    __syncthreads();
}
constexpr int LG_W2 = 0, LG_B = 1024, LG_NG = 1088, LG_GAL = 1216, LG_Q = 1728, LG_K = 3776, LG_A = 5824, LG_V = 7872, LG_O = 11968;
__device__ __forceinline__ void gla_unit(const Args& a, LAS float* L, int unit, int i2, const bf16* P, bf16* CAT, int tid) {
    constexpr int PS = EVEN_PAD;
    const int b = unit >> 2, h = unit & 3, lane = tid & 63, wave = __builtin_amdgcn_readfirstlane(tid >> 6);
    const float* w2 = a.in[2] + i2 * 16 * 256; const float* ab = a.in[3] + i2 * 256; const float* ng = a.in[4] + i2 * 128;
    for (int idx = tid; idx < 1024; idx += 512) { const int j = idx >> 6, d = idx & 63; L[LG_W2 + idx] = w2[j * 256 + h * 64 + d]; }
    if (tid < 64) L[LG_B + tid] = ab[h * 64 + tid];
    if (tid < 128) L[LG_NG + tid] = ng[tid];
    float S[64];
#pragma unroll
    for (int d = 0; d < 64; ++d) S[d] = 0.f;
    __syncthreads();
    const size_t row0 = (size_t)b * 2048;
    for (int t0 = 0; t0 < 2048; t0 += 32) {
        { const int tok = tid >> 4, j = tid & 15; L[LG_GAL + tid] = bf2f(P[(row0 + t0 + tok) * PS + G_AL + j]); }
        for (int idx = tid; idx < 32 * 64; idx += 512) { const int tok = idx >> 6, d = idx & 63; const bf16* pr = P + (row0 + t0 + tok) * PS;
            L[LG_Q + idx] = bf2f(pr[G_Q + h * 64 + d]) * 0.125f; L[LG_K + idx] = bf2f(pr[G_K + h * 64 + d]); }
        for (int idx = tid; idx < 32 * 128; idx += 512) { const int tok = idx >> 7, e = idx & 127; L[LG_V + idx] = bf2f(P[(row0 + t0 + tok) * PS + G_V + h * 128 + e]); }
        __syncthreads();
        for (int idx = tid; idx < 32 * 64; idx += 512) { const int tok = idx >> 6, d = idx & 63; float la = L[LG_B + d];
#pragma unroll
            for (int j = 0; j < 16; ++j) la += L[LG_GAL + tok * 16 + j] * L[LG_W2 + j * 64 + d];
            const float ls = fminf(la, 0.f) - log1pf(expf(-fabsf(la))); L[LG_A + idx] = expf(ls * (1.f / 16.f)); }
        __syncthreads();
        if (tid < 128) { const int e = tid;
#pragma unroll 1
            for (int tok = 0; tok < 32; ++tok) { const float ve = L[LG_V + tok * 128 + e]; float o = 0.f;
#pragma unroll
                for (int d4 = 0; d4 < 16; ++d4) { const f32x4 av = *(const LAS f32x4*)&L[LG_A + tok * 64 + d4 * 4], kv = *(const LAS f32x4*)&L[LG_K + tok * 64 + d4 * 4], qv = *(const LAS f32x4*)&L[LG_Q + tok * 64 + d4 * 4];
#pragma unroll
                    for (int u = 0; u < 4; ++u) { S[d4 * 4 + u] = av[u] * S[d4 * 4 + u] + kv[u] * ve; o += qv[u] * S[d4 * 4 + u]; } }
                L[LG_O + tok * 128 + e] = o; } }
        __syncthreads();
#pragma unroll
        for (int i = 0; i < 4; ++i) { const int tok = wave * 4 + i; const size_t row = row0 + t0 + tok; const float o0 = L[LG_O + tok * 128 + lane], o1 = L[LG_O + tok * 128 + 64 + lane];
            const float ms = wave_sum(o0 * o0 + o1 * o1) * (1.f / 128.f); const float r = 1.f / sqrtf(ms + LN_EPS);
            const bf16* pr = P + row * PS + G_G + h * 128; const float g0 = bf2f(pr[lane]), g1 = bf2f(pr[64 + lane]);
            CAT[row * 1024 + h * 128 + lane] = (bf16)f2bf(o0 * r * L[LG_NG + lane] * (g0 / (1.f + expf(-g0))));
            CAT[row * 1024 + h * 128 + 64 + lane] = (bf16)f2bf(o1 * r * L[LG_NG + 64 + lane] * (g1 / (1.f + expf(-g1)))); }
    }
    __syncthreads();
}

__device__ __forceinline__ void ph_rope(const Args& a, int gtid, int NT) {
    bf16* P = (bf16*)(a.ws + WS_P);
    const float* cosA = (const float*)(a.ws + WS_COSA); const float* sinA = (const float*)(a.ws + WS_SINA);
    const float* cosI = (const float*)(a.ws + WS_COSI); const float* sinI = (const float*)(a.ws + WS_SINI);
    for (size_t it = gtid; it < (size_t)MTOK * 108; it += NT) {
        const size_t row = it / 108; int r = (int)(it - row * 108); const int t = (int)(row & 2047);
        int col, half; const float* ct; const float* st;
        if (r < 72) { const int vec = r >> 3, grp = r & 7; col = (vec < 8 ? O_Q + vec * 128 : O_K) + grp * 8; half = 64; ct = cosA + t * 64 + grp * 8; st = sinA + t * 64 + grp * 8; }
        else { r -= 72; const int vec = r >> 2, grp = r & 3; col = (vec < 8 ? O_QI + vec * 64 : O_KI) + grp * 8; half = 32; ct = cosI + t * 32 + grp * 8; st = sinI + t * 32 + grp * 8; }
        u32x4* p1 = (u32x4*)(P + row * ODD_PAD + col); u32x4* p2 = (u32x4*)(P + row * ODD_PAD + col + half);
        const u32x4 x1 = *p1, x2 = *p2; const f32x4 c0 = *(const f32x4*)ct, c1 = *(const f32x4*)(ct + 4), s0 = *(const f32x4*)st, s1 = *(const f32x4*)(st + 4);
        u32x4 o1, o2;
#define ROPE2(W, CA, SA, CB, SB) { const float a1 = bflo(x1.W), a2 = bflo(x2.W), b1 = bfhi(x1.W), b2 = bfhi(x2.W); \
            o1.W = pk2(a1 * (CA) - a2 * (SA), b1 * (CB) - b2 * (SB)); o2.W = pk2(a2 * (CA) + a1 * (SA), b2 * (CB) + b1 * (SB)); }
        ROPE2(x, c0.x, s0.x, c0.y, s0.y) ROPE2(y, c0.z, s0.z, c0.w, s0.w) ROPE2(z, c1.x, s1.x, c1.y, s1.y) ROPE2(w, c1.z, s1.z, c1.w, s1.w)
#undef ROPE2
        *p1 = o1; *p2 = o2;
    }
}
__device__ __forceinline__ unsigned sortable_key(float s) { unsigned u = __float_as_uint(s); if ((u << 1) == 0u) u = 0u; return (u & 0x80000000u) ? ~u : (u | 0x80000000u); }
__device__ __forceinline__ void ph_indexer(const Args& a, LAS unsigned char* lds, int gw, int NGW, int wave, int lane) {
    const bf16* P = (const bf16*)(a.ws + WS_P); unsigned* MASK = (unsigned*)(a.ws + WS_MASK);
    LAS float* qs = (LAS float*)(lds + wave * 10496); LAS unsigned* kl = (LAS unsigned*)(lds + wave * 10496 + 2304);
    for (int m = gw; m < MTOK; m += NGW) {
        const int b = m >> 11, t = m & 2047; const bf16* prow = P + (size_t)m * ODD_PAD;
        { const u32x4 v = *(const u32x4*)(prow + O_QI + lane * 8);
          *(LAS f32x4*)&qs[lane * 8] = (f32x4){bflo(v.x), bfhi(v.x), bflo(v.y), bfhi(v.y)}; *(LAS f32x4*)&qs[lane * 8 + 4] = (f32x4){bflo(v.z), bfhi(v.z), bflo(v.w), bfhi(v.w)}; }
        if (lane < 8) qs[512 + lane] = bf2f(prow[O_WI + lane]) * 0.04419417382415922f;
        LDS_WAIT();
        const int nblk = (t >> 6) + 1;
#pragma unroll 1
        for (int i = 0; i < nblk; ++i) { const int s = i * 64 + lane; unsigned key = 0u;
            if (s <= t) { const u32x4* kr = (const u32x4*)(P + ((size_t)b * 2048 + s) * ODD_PAD + O_KI);
                float kf[64];
#pragma unroll
                for (int q = 0; q < 8; ++q) { const u32x4 v = kr[q]; kf[q * 8 + 0] = bflo(v.x); kf[q * 8 + 1] = bfhi(v.x); kf[q * 8 + 2] = bflo(v.y); kf[q * 8 + 3] = bfhi(v.y); kf[q * 8 + 4] = bflo(v.z); kf[q * 8 + 5] = bfhi(v.z); kf[q * 8 + 6] = bflo(v.w); kf[q * 8 + 7] = bfhi(v.w); }
                float sc = 0.f;
#pragma unroll 1
                for (int h = 0; h < 8; ++h) { float acc = 0.f;
#pragma unroll
                    for (int d4 = 0; d4 < 16; ++d4) { const f32x4 qv = *(const LAS f32x4*)&qs[h * 64 + d4 * 4]; acc += qv.x * kf[d4 * 4] + qv.y * kf[d4 * 4 + 1] + qv.z * kf[d4 * 4 + 2] + qv.w * kf[d4 * 4 + 3]; }
                    sc += qs[512 + h] * fmaxf(acc, 0.f); }
                key = sortable_key(sc); }
            kl[i * 64 + lane] = key; }
        LDS_WAIT();
        unsigned k[32];
#pragma unroll
        for (int i = 0; i < 32; ++i) k[i] = (i < nblk) ? kl[i * 64 + lane] : 0u;
        unsigned T = 0u;
        for (int bit = 31; bit >= 0; --bit) { const unsigned cand = T | (1u << bit); int cnt = 0;
#pragma unroll
            for (int i = 0; i < 32; ++i) cnt += (k[i] >= cand) ? 1 : 0;
            cnt = wave_sum_i(cnt); if (cnt >= 256) T = cand; }
        int cgt = 0;
#pragma unroll
        for (int i = 0; i < 32; ++i) cgt += (k[i] > T) ? 1 : 0;
        cgt = wave_sum_i(cgt);
        const int need = 256 - cgt; int run = 0; unsigned myw = 0u;
#pragma unroll
        for (int i = 0; i < 32; ++i) { const bool gt = k[i] > T, eq = (k[i] == T) && (T != 0u);
            const unsigned long long bal = __ballot(eq); const int pre = __builtin_amdgcn_mbcnt_hi((unsigned)(bal >> 32), __builtin_amdgcn_mbcnt_lo((unsigned)bal, 0u));
            const bool sel = gt || (eq && (run + pre < need)); run += __popcll(bal);
            const unsigned long long sb = __ballot(sel);
            if (lane == 2 * i) myw = (unsigned)sb; if (lane == 2 * i + 1) myw = (unsigned)(sb >> 32); }
        MASK[(size_t)m * 64 + lane] = myw;
    }
}
__device__ __forceinline__ void ph_attention(const Args& a, LAS unsigned char* lds, int gw, int NGW, int wave, int lane) {
    const bf16* P = (const bf16*)(a.ws + WS_P); const unsigned* MASK = (const unsigned*)(a.ws + WS_MASK); bf16* CAT = (bf16*)(a.ws + WS_CAT);
    LAS unsigned short* sel = (LAS unsigned short*)(lds + wave * 4096); LAS float* qh = (LAS float*)(lds + wave * 4096 + 512); LAS float* pp = (LAS float*)(lds + wave * 4096 + 1024);
    for (int m = gw; m < MTOK; m += NGW) {
        const int b = m >> 11; const bf16* prow = P + (size_t)m * ODD_PAD; const bf16* pb = P + (size_t)b * 2048 * ODD_PAD;
        unsigned word = MASK[(size_t)m * 64 + lane]; const int cnt = __popc(word); int x = cnt;
#pragma unroll
        for (int o = 1; o < 64; o <<= 1) { const int y = __shfl_up(x, o); if (lane >= o) x += y; }
        const int nsel = __shfl(x, 63); int pos = x - cnt;
        while (word) { const int bpos = __builtin_ctz(word); word &= word - 1u; sel[pos++] = (unsigned short)(lane * 32 + bpos); }
        LDS_WAIT();
        for (int h = 0; h < 8; ++h) {
            qh[lane] = bf2f(prow[O_Q + h * 128 + lane]); qh[64 + lane] = bf2f(prow[O_Q + h * 128 + 64 + lane]);
            LDS_WAIT();
            float lg[4]; float mx = -3.0e38f;
#pragma unroll
            for (int jj = 0; jj < 4; ++jj) { const int j = lane + 64 * jj; lg[jj] = -3.0e38f;
                if (j < nsel) { const u32x4* kr = (const u32x4*)(pb + (size_t)sel[j] * ODD_PAD + O_K); float acc = 0.f;
#pragma unroll
                    for (int q = 0; q < 16; ++q) { const u32x4 v = kr[q]; const f32x4 q0 = *(const LAS f32x4*)&qh[q * 8], q1 = *(const LAS f32x4*)&qh[q * 8 + 4];
                        acc += q0.x * bflo(v.x) + q0.y * bfhi(v.x) + q0.z * bflo(v.y) + q0.w * bfhi(v.y) + q1.x * bflo(v.z) + q1.y * bfhi(v.z) + q1.z * bflo(v.w) + q1.w * bfhi(v.w); }
                    lg[jj] = acc * 0.08838834764831845f; }
                mx = fmaxf(mx, lg[jj]); }
            mx = wave_max(mx); float sum = 0.f;
#pragma unroll
            for (int jj = 0; jj < 4; ++jj) { const int j = lane + 64 * jj; const float p = (j < nsel) ? expf(lg[jj] - mx) : 0.f; lg[jj] = p; sum += p; }
            sum = wave_sum(sum); const float inv = 1.f / sum;
#pragma unroll
            for (int jj = 0; jj < 4; ++jj) pp[lane + 64 * jj] = lg[jj] * inv;
            LDS_WAIT();
            float o0 = 0.f, o1 = 0.f;
            for (int j = 0; j < nsel; ++j) { const bf16* vr = pb + (size_t)sel[j] * ODD_PAD + O_V; const float p = pp[j]; o0 += p * bf2f(vr[lane]); o1 += p * bf2f(vr[64 + lane]); }
            CAT[(size_t)m * 1024 + h * 128 + lane] = (bf16)f2bf(o0); CAT[(size_t)m * 1024 + h * 128 + 64 + lane] = (bf16)f2bf(o1);
            LDS_WAIT();
        }
    }
}

__device__ __forceinline__ void ph_ln1(const Args& a, int layer, int gw, int NGW, int lane) {
    const float* xin = (layer == 0) ? a.in[0] : a.out; const bf16* mix = (const bf16*)(a.ws + WS_MIX);
    const float* g = a.in[19] + layer * 1024; const float* bb = a.in[20] + layer * 1024; bf16* XB = (bf16*)(a.ws + WS_XB);
    f32x4 gv[4], bv[4];
#pragma unroll
    for (int j = 0; j < 4; ++j) { gv[j] = ((const f32x4*)g)[lane + 64 * j]; bv[j] = ((const f32x4*)bb)[lane + 64 * j]; }
    for (int m = gw; m < MTOK; m += NGW) {
        const f32x4* xr = (const f32x4*)(xin + (size_t)m * 1024) + lane; const u32x2* mr = (const u32x2*)(mix + (size_t)m * 1024) + lane;
        f32x4 v[4]; float s = 0.f;
#pragma unroll
        for (int j = 0; j < 4; ++j) { const u32x2 mw = mr[64 * j]; v[j] = xr[64 * j] * DN_ALPHA + (f32x4){bflo(mw.x), bfhi(mw.x), bflo(mw.y), bfhi(mw.y)}; s += (v[j].x + v[j].y) + (v[j].z + v[j].w); }
        const float mean = wave_sum(s) * (1.f / 1024.f); float s2 = 0.f;
#pragma unroll
        for (int j = 0; j < 4; ++j) { v[j] = v[j] - mean; s2 += (v[j].x * v[j].x + v[j].y * v[j].y) + (v[j].z * v[j].z + v[j].w * v[j].w); }
        const float rstd = 1.f / sqrtf(wave_sum(s2) * (1.f / 1024.f) + LN_EPS);
        f32x4* orow = (f32x4*)(a.out + (size_t)m * 1024) + lane; u32x2* ob = (u32x2*)(XB + (size_t)m * 1024) + lane;
#pragma unroll
        for (int j = 0; j < 4; ++j) { const f32x4 o = v[j] * rstd * gv[j] + bv[j]; orow[64 * j] = o; u32x2 w; w.x = pk2(o.x, o.y); w.y = pk2(o.z, o.w); ob[64 * j] = w; }
    }
}
__device__ __forceinline__ void wave_argmax(float& v, int& idx) {
#pragma unroll
    for (int o = 1; o < 64; o <<= 1) { const float ov = __shfl_xor(v, o); const int oi = __shfl_xor(idx, o); if (ov > v || (ov == v && oi < idx)) { v = ov; idx = oi; } }
}
__device__ __forceinline__ void ph_route(const Args& a, int layer, LAS unsigned char* lds, int gw, int NGW, int wave, int lane) {
    const bf16* Q = (const bf16*)(a.ws + WS_QP); const float* SK = a.in[22] + (size_t)layer * 8 * 2 * 128 * 64;
    unsigned short* RI = (unsigned short*)(a.ws + WS_RIDX); float* RG = (float*)(a.ws + WS_RGATE);
    LAS float* qh = (LAS float*)(lds + wave * 2048); LAS float* ts = (LAS float*)(lds + wave * 2048 + 512); LAS int* ti = (LAS int*)(lds + wave * 2048 + 640);
    const float NEG_INF = -__builtin_inff();
    for (int m = gw; m < MTOK; m += NGW) {
        for (int h = 0; h < 8; ++h) {
            qh[lane] = bf2f(Q[(size_t)m * 1024 + h * 128 + lane]); qh[64 + lane] = bf2f(Q[(size_t)m * 1024 + h * 128 + 64 + lane]);
            LDS_WAIT();
#pragma unroll
            for (int c = 0; c < 2; ++c) {
                float v0, v1;
                { const f32x4* k0 = (const f32x4*)(SK + ((size_t)(h * 2 + c) * 128 + lane) * 64); const f32x4* k1 = (const f32x4*)(SK + ((size_t)(h * 2 + c) * 128 + 64 + lane) * 64); float a0 = 0.f, a1 = 0.f;
#pragma unroll
                  for (int d4 = 0; d4 < 16; ++d4) { const f32x4 qv = *(const LAS f32x4*)&qh[c * 64 + d4 * 4]; const f32x4 x0 = k0[d4], x1 = k1[d4];
                      a0 += qv.x * x0.x + qv.y * x0.y + qv.z * x0.z + qv.w * x0.w; a1 += qv.x * x1.x + qv.y * x1.y + qv.z * x1.z + qv.w * x1.w; }
                  v0 = a0; v1 = a1; }
                for (int r = 0; r < 16; ++r) { float bv = v0; int bi = lane; if (v1 > v0) { bv = v1; bi = lane + 64; }
                    wave_argmax(bv, bi);
                    if (bi == lane) v0 = NEG_INF; if (bi == lane + 64) v1 = NEG_INF;
                    if (lane == 0) { ts[c * 16 + r] = bv; ti[c * 16 + r] = bi; } }
            }
            LDS_WAIT();
            float cv[4];
#pragma unroll
            for (int jj = 0; jj < 4; ++jj) { const int f = lane + 64 * jj; cv[jj] = ts[f >> 4] + ts[16 + (f & 15)]; }
            float bs = 0.f; int bpos = 0;
            for (int r = 0; r < 16; ++r) { float bv = cv[0]; int bi = lane;
#pragma unroll
                for (int jj = 1; jj < 4; ++jj) if (cv[jj] > bv) { bv = cv[jj]; bi = lane + 64 * jj; }
                wave_argmax(bv, bi);
#pragma unroll
                for (int jj = 0; jj < 4; ++jj) if (bi == lane + 64 * jj) cv[jj] = NEG_INF;
                if (lane == r) { bs = bv; bpos = bi; } }
            const float mx = __shfl(bs, 0); const float e = (lane < 16) ? expf(bs - mx) : 0.f; const float sum = wave_sum(e);
            if (lane < 16) { const int ei = ti[bpos >> 4] * 128 + ti[16 + (bpos & 15)]; RI[(size_t)m * 128 + h * 16 + lane] = (unsigned short)ei; RG[(size_t)m * 128 + h * 16 + lane] = e / sum; }
            LDS_WAIT();
        }
    }
}
__device__ __forceinline__ void ph_experts(const Args& a, int layer, int gw, int NGW, int lane) {
    const float* U = a.in[23] + (size_t)layer * 16384 * 1024; const float* V = a.in[24] + (size_t)layer * 16384 * 1024;
    const unsigned short* RI = (const unsigned short*)(a.ws + WS_RIDX); const float* RG = (const float*)(a.ws + WS_RGATE);
    const float* g = a.in[25] + layer * 1024; const float* bb = a.in[26] + layer * 1024; bf16* XB = (bf16*)(a.ws + WS_XB);
    for (int m = gw; m < MTOK; m += NGW) {
        f32x4 x[4], acc[4];
        const f32x4* xr = (const f32x4*)(a.out + (size_t)m * 1024) + lane;
#pragma unroll
        for (int j = 0; j < 4; ++j) { x[j] = xr[64 * j]; acc[j] = (f32x4){0.f, 0.f, 0.f, 0.f}; }
        for (int k = 0; k < 128; ++k) {
            const int e = RI[(size_t)m * 128 + k]; const float gate = RG[(size_t)m * 128 + k];
            const f32x4* ur = (const f32x4*)(U + (size_t)e * 1024) + lane; const f32x4* vr = (const f32x4*)(V + (size_t)e * 1024) + lane;
            f32x4 uv[4], vv[4];
#pragma unroll
            for (int j = 0; j < 4; ++j) { uv[j] = ur[64 * j]; vv[j] = vr[64 * j]; }
            float d = 0.f;
#pragma unroll
            for (int j = 0; j < 4; ++j) d += (x[j].x * uv[j].x + x[j].y * uv[j].y) + (x[j].z * uv[j].z + x[j].w * uv[j].w);
            d = wave_sum(d);
            const float coef = gate * 0.5f * d * (1.f + erff(d * 0.7071067811865476f));
#pragma unroll
            for (int j = 0; j < 4; ++j) acc[j] += vv[j] * coef;
        }
        float s = 0.f;
#pragma unroll
        for (int j = 0; j < 4; ++j) { acc[j] = x[j] * DN_ALPHA + acc[j]; s += (acc[j].x + acc[j].y) + (acc[j].z + acc[j].w); }
        const float mean = wave_sum(s) * (1.f / 1024.f); float s2 = 0.f;
#pragma unroll
        for (int j = 0; j < 4; ++j) { acc[j] = acc[j] - mean; s2 += (acc[j].x * acc[j].x + acc[j].y * acc[j].y) + (acc[j].z * acc[j].z + acc[j].w * acc[j].w); }
        const float rstd = 1.f / sqrtf(wave_sum(s2) * (1.f / 1024.f) + LN_EPS);
        f32x4* orow = (f32x4*)(a.out + (size_t)m * 1024) + lane; u32x2* ob = (u32x2*)(XB + (size_t)m * 1024) + lane;
#pragma unroll
        for (int j = 0; j < 4; ++j) { const f32x4 o = acc[j] * rstd * ((const f32x4*)g)[lane + 64 * j] + ((const f32x4*)bb)[lane + 64 * j]; orow[64 * j] = o; u32x2 w; w.x = pk2(o.x, o.y); w.y = pk2(o.z, o.w); ob[64 * j] = w; }
    }
}

constexpr int NPHASE = 1 + 9 * DEPTH;
__global__ void __launch_bounds__(512, 2) mk_fwd(Args args) {
    extern __shared__ __attribute__((aligned(16))) unsigned char lds_raw[];
    LAS unsigned char* lds = (LAS unsigned char*)lds_raw;
    const int tid = threadIdx.x;
    const int G = gridDim.x, bid = blockIdx.x, NGW = G * 8;
    unsigned char* ws = args.ws;
    for (int u = tid; u < (LDS_BYTES - LDSCTL_OFF) / 4; u += 512) ((LAS unsigned*)(lds + LDSCTL_OFF))[u] = 0u;
    __syncthreads();
    const int lo = args.ph_lo, hi = args.ph_hi;
    XcdBarrier bar; bar.bar = (unsigned*)(ws + WS_CTL) + CW_BAR; bar.x = 0; bar.st = nullptr;
    if (hi - lo > 1) bar = xcd_barrier_post((unsigned*)(ws + WS_CTL) + CW_BAR, (volatile LAS unsigned*)(lds + LDSCTL_OFF + 64));
#define IN(k) (lo <= (k) && (k) < hi)
#define SEAM(k) do { if ((k) + 1 < hi) xcd_barrier(bar); } while (0)
#ifndef SKIP_PRO
    if (IN(0)) { int lt = tid; asm volatile("" : "+v"(lt)); ph_prologue(args, lds, bid * 8 + __builtin_amdgcn_readfirstlane(lt >> 6), NGW, __builtin_amdgcn_readfirstlane(lt >> 6), lt & 63); SEAM(0); }
#endif
    for (int gi = 0; gi < 3 * DEPTH; ++gi) {
        const int layer = gi / 3, kind = gi - 3 * layer, pb = 1 + 9 * layer, i2 = layer >> 1; const bool odd = (layer & 1) != 0;
        const int pg = pb + (kind == 0 ? 0 : (kind == 1 ? 4 : 6));
        if (IN(pg)) {
            int lt = tid; asm volatile("" : "+v"(lt));
            int N = 1024; const bf16* A = (const bf16*)(ws + WS_XB); const bf16* W; bf16* O;
            if (kind == 0) { N = odd ? ODD_PAD : EVEN_PAD; W = odd ? (const bf16*)(ws + WS_WINO) + (size_t)i2 * ODD_PAD * 1024 : (const bf16*)(ws + WS_WINE) + (size_t)i2 * EVEN_PAD * 1024; O = (bf16*)(ws + WS_P); }
            else if (kind == 1) { A = (const bf16*)(ws + WS_CAT); W = (odd ? (const bf16*)(ws + WS_WOUTO) : (const bf16*)(ws + WS_WOUTE)) + (size_t)i2 * 1048576; O = (bf16*)(ws + WS_MIX); }
            else { W = (const bf16*)(ws + WS_WQ) + (size_t)layer * 1048576; O = (bf16*)(ws + WS_QP); }
            pg8::Gemm g{(const pg8::bf16_t*)A, (const pg8::bf16_t*)W, MTOK, N, 1024}; pg8::StaticOrder S; S.init(MTOK, N, G, bid);
            pg8::EpiBf16<0> E{(pg8::bf16_t*)O, N, nullptr, 0, 0, 1.f};
            pg8::gemm_phase<pg8::EpiBf16<0>, pg8::StaticOrder, true, true>(lds, g, S, E, lt);
            SEAM(pg);
        }
        if (kind == 0) {
            if (!odd) {
                if (IN(pb + 1)) {
                    int lt = tid; asm volatile("" : "+v"(lt));
                    for (int it = bid; it < 384; it += G) {
#ifndef SKIP_RWKV
                        if (it < 256) rwkv_unit(args, (LAS float*)lds, it, i2, (const bf16*)(ws + WS_P), (bf16*)(ws + WS_CAT), lt);
#endif
#ifndef SKIP_GLA
                        if (it >= 256) gla_unit(args, (LAS float*)lds, it - 256, i2, (const bf16*)(ws + WS_P), (bf16*)(ws + WS_CAT), lt);
#endif
                    }
                    SEAM(pb + 1);
                }
            } else {
#ifndef SKIP_ROPE
                if (IN(pb + 1)) { int lt = tid; asm volatile("" : "+v"(lt)); ph_rope(args, bid * 512 + lt, NGW * 64); SEAM(pb + 1); }
#endif
#ifndef SKIP_IDX
                if (IN(pb + 2)) { int lt = tid; asm volatile("" : "+v"(lt)); ph_indexer(args, lds, bid * 8 + __builtin_amdgcn_readfirstlane(lt >> 6), NGW, __builtin_amdgcn_readfirstlane(lt >> 6), lt & 63); SEAM(pb + 2); }
#endif
#ifndef SKIP_ATT
                if (IN(pb + 3)) { int lt = tid; asm volatile("" : "+v"(lt)); ph_attention(args, lds, bid * 8 + __builtin_amdgcn_readfirstlane(lt >> 6), NGW, __builtin_amdgcn_readfirstlane(lt >> 6), lt & 63); SEAM(pb + 3); }
#endif
            }
        } else if (kind == 1) {
#ifndef SKIP_LN1
            if (IN(pb + 5)) { int lt = tid; asm volatile("" : "+v"(lt)); ph_ln1(args, layer, bid * 8 + __builtin_amdgcn_readfirstlane(lt >> 6), NGW, lt & 63); SEAM(pb + 5); }
#endif
        } else {
#ifndef SKIP_ROUTE
            if (IN(pb + 7)) { int lt = tid; asm volatile("" : "+v"(lt)); ph_route(args, layer, lds, bid * 8 + __builtin_amdgcn_readfirstlane(lt >> 6), NGW, __builtin_amdgcn_readfirstlane(lt >> 6), lt & 63); SEAM(pb + 7); }
#endif
#ifndef SKIP_EXP
            if (IN(pb + 8)) { int lt = tid; asm volatile("" : "+v"(lt)); ph_experts(args, layer, bid * 8 + __builtin_amdgcn_readfirstlane(lt >> 6), NGW, lt & 63); SEAM(pb + 8); }
#endif
        }
    }
#undef IN
#undef SEAM
}

#ifndef ONE_LAUNCH
#define ONE_LAUNCH 0
#endif
extern "C" void kernel_launch(void* const* d_in, const int* in_sizes, int n_in, void* d_out, int out_size, void* d_ws, size_t ws_size, hipStream_t stream) {
    static int grid = 0;
    if (grid == 0) {
        if (n_in != 27 || in_sizes[0] != MTOK * DM || out_size != MTOK * DM || ws_size < WS_END) { fprintf(stderr, "kernel_launch: unexpected shapes (n_in %d, ws %zu)\n", n_in, ws_size); grid = -1; return; }
        int dev = 0, cus = 0, per_cu = 0;
        if (hipGetDevice(&dev) != hipSuccess || hipDeviceGetAttribute(&cus, hipDeviceAttributeMultiprocessorCount, dev) != hipSuccess) { grid = -1; return; }
        if (hipFuncSetAttribute((const void*)mk_fwd, hipFuncAttributeMaxDynamicSharedMemorySize, LDS_BYTES) != hipSuccess) { grid = -1; return; }
        if (hipOccupancyMaxActiveBlocksPerMultiprocessor(&per_cu, (const void*)mk_fwd, 512, LDS_BYTES) != hipSuccess || per_cu < 1) fprintf(stderr, "kernel_launch: occupancy query says %d\n", per_cu);
        (void)hipGetLastError();
        grid = cus;
    }
    if (grid < 0) return;
    (void)hipMemsetAsync((char*)d_ws + WS_CTL, 0, CTL_ZERO_BYTES, stream);
    Args a{};
    for (int i = 0; i < 27; ++i) a.in[i] = (const float*)d_in[i];
    a.out = (float*)d_out; a.ws = (unsigned char*)d_ws;
#if ONE_LAUNCH
    a.ph_lo = 0; a.ph_hi = NPHASE;
    hipLaunchKernelGGL(mk_fwd, dim3(grid), dim3(512), LDS_BYTES, stream, a);
#else
    for (int k = 0; k < NPHASE; ++k) {
        if (k >= 1) { const int layer = (k - 1) / 9, r = (k - 1) % 9; if ((layer & 1) == 0 && (r == 2 || r == 3)) continue; }
        a.ph_lo = k; a.ph_hi = k + 1;
        hipLaunchKernelGGL(mk_fwd, dim3(grid), dim3(512), LDS_BYTES, stream, a);
    }
#endif
}
```

```cpp
#include <hip/hip_runtime.h>
#include <cstdio>
#include <cstdint>
namespace pg8 {
#define PG8_LAS __attribute__((address_space(3)))
typedef unsigned short bf16_t;
typedef short bf16x8 __attribute__((ext_vector_type(8)));
typedef float f32x4 __attribute__((ext_vector_type(4)));
typedef unsigned u32x4 __attribute__((ext_vector_type(4)));
constexpr int BM = 256, BK = 64, HALF = 128, HTB = HALF * BK * 2  , STAGE_BYTES = 8 * HTB, NXCD = 8, WGM = 8;

__host__ __device__ __forceinline__ int lds_byte(int r, int c) { const int st = (r >> 4) * 2 + (c >> 5), rr = r & 15, cc = c & 31, ob = rr * 64 + cc * 2; return st * 1024 + (ob ^ (((ob >> 9) & 1) << 5)); }
__host__ __device__ __forceinline__ void stage_rc(int b, int& R, int& C) { const int st = b / 1024, sb = b % 1024, swz = sb ^ (((sb >> 9) & 1) << 5); R = (st >> 1) * 16 + swz / 64; C = (st & 1) * 32 + (swz % 64) / 2; }
__host__ __device__ __forceinline__ int perm32(int rho) { const int n = rho >> 4, i = rho & 15; return 8 * (i >> 2) + 4 * n + (i & 3); }

struct Unit { int pm, pn; };
struct Gemm { const bf16_t* A; const bf16_t* Bt; int M, N, K; };

struct StaticOrder {
    int nM, nN, nwg, G, c;
    __host__ __device__ void init(int M, int N, int G_, int c_) { nM = M / BM; nN = N / BM; nwg = nM * nN; G = G_; c = c_; }
    __host__ __device__ bool next(int i, Unit& u) const {
        const long L = (long)i * G + c; if (L >= nwg) return false;
        int wgid = (int)L; { const int q = nwg / NXCD, r = nwg % NXCD, xcd = wgid % NXCD, off = wgid / NXCD; wgid = (xcd < r ? xcd * (q + 1) : r * (q + 1) + (xcd - r) * q) + off; }
        const int nig = WGM * nN, gid = wgid / nig, fm = gid * WGM, gsz = (nM - fm) < WGM ? (nM - fm) : WGM;
        u.pm = fm + ((wgid % nig) % gsz); u.pn = (wgid % nig) / gsz; return true;
    }
    __device__ __forceinline__ void a_ready(const Unit&) const {}
    __device__ __forceinline__ void done(const Unit&) const {}
};

__device__ __forceinline__ unsigned cvt_pk_bf16(float lo, float hi) { unsigned r; asm volatile("v_cvt_pk_bf16_f32 %0, %1, %2" : "=v"(r) : "v"(lo), "v"(hi)); return r; }
typedef float f32x2 __attribute__((ext_vector_type(2)));
__device__ __forceinline__ f32x2 gelu_pk(f32x2 v) {
    const f32x2 av = __builtin_elementwise_abs(v), d = av * 0.2316418882f + 1.0f;
    f32x2 t; t.x = __builtin_amdgcn_rcpf(d.x); t.y = __builtin_amdgcn_rcpf(d.y);
    f32x2 q = t * 0.5307027145f + (-0.7265760135f); q = q * t + 0.7107068705f; q = q * t + (-0.142248368f); q = q * t + 0.127414796f; q = q * t;
    const f32x2 s = (v * v) * (-0.72134752044f);
    f32x2 e; e.x = __builtin_amdgcn_exp2f(s.x); e.y = __builtin_amdgcn_exp2f(s.y);
    const f32x2 m = v * (q * e), r = v - m;
    f32x2 o; o.x = v.x < 0.f ? m.x : r.x; o.y = v.y < 0.f ? m.y : r.y; return o;
}

template <int ACT  > struct EpiBf16 {
    static constexpr bool PERM = true, AFTER_DRAIN = false; static_assert(ACT == 0 || ACT == 1, "EpiBf16: ACT is 0 (none) or 1 (gelu_pk)");
    bf16_t* O; int ldc; const float* bias; int split_cols; size_t split_stride; float scale0;
    __device__ __forceinline__ void operator()(const f32x4 (&acc)[2][2][4][2], const Unit& u, int wr, int wc, int fr, int fq) const {
        const int row0 = u.pm * BM + wr * 64 + fr; int colt = u.pn * BM; bf16_t* base = O;
        float sc = 1.f; if (split_cols) { const int t = colt / split_cols; base += (size_t)t * split_stride; colt -= t * split_cols; if (t == 0) sc = scale0; }
        const int col0 = colt + wc * 32 + 8 * fq, bcol0 = u.pn * BM + wc * 32 + 8 * fq;
        f32x4 bv[2][2];
#pragma unroll
        for (int bj = 0; bj < 2; ++bj)
#pragma unroll
            for (int n = 0; n < 2; ++n) bv[bj][n] = bias ? *(const f32x4*)(bias + bcol0 + bj * HALF + 4 * n) : (f32x4){0.f, 0.f, 0.f, 0.f};
#pragma unroll
        for (int ai = 0; ai < 2; ++ai)
#pragma unroll
            for (int m = 0; m < 4; ++m) { bf16_t* rowp = base + (size_t)(row0 + ai * HALF + m * 16) * ldc + col0;
#pragma unroll
                for (int bj = 0; bj < 2; ++bj) { f32x4 v0 = acc[ai][bj][m][0] + bv[bj][0], v1 = acc[ai][bj][m][1] + bv[bj][1];
                    if (ACT == 1) { f32x2 a = gelu_pk((f32x2){v0[0], v0[1]}), b = gelu_pk((f32x2){v0[2], v0[3]}), c = gelu_pk((f32x2){v1[0], v1[1]}), d = gelu_pk((f32x2){v1[2], v1[3]});
                        v0 = (f32x4){a.x, a.y, b.x, b.y}; v1 = (f32x4){c.x, c.y, d.x, d.y}; }
                    v0 = v0 * sc; v1 = v1 * sc; u32x4 w; w.x = cvt_pk_bf16(v0[0], v0[1]); w.y = cvt_pk_bf16(v0[2], v0[3]); w.z = cvt_pk_bf16(v1[0], v1[1]); w.w = cvt_pk_bf16(v1[2], v1[3]);
                    *(u32x4*)(rowp + bj * HALF) = w; } }
    }
};
struct EpiF32 {
    static constexpr bool PERM = false, AFTER_DRAIN = false;
    float* C; int ldc; const float* bias;
    __device__ __forceinline__ void operator()(const f32x4 (&acc)[2][2][4][2], const Unit& u, int wr, int wc, int fr, int fq) const {
        const int row0 = u.pm * BM + wr * 64 + fr, col0 = u.pn * BM + wc * 32 + 4 * fq;
        f32x4 bv[2][2];
#pragma unroll
        for (int bj = 0; bj < 2; ++bj)
#pragma unroll
            for (int n = 0; n < 2; ++n) bv[bj][n] = bias ? *(const f32x4*)(bias + col0 + bj * HALF + n * 16) : (f32x4){0.f, 0.f, 0.f, 0.f};
#pragma unroll
        for (int ai = 0; ai < 2; ++ai)
#pragma unroll
            for (int m = 0; m < 4; ++m) { float* rowp = C + (size_t)(row0 + ai * HALF + m * 16) * ldc + col0;
#pragma unroll
                for (int bj = 0; bj < 2; ++bj)
#pragma unroll
                    for (int n = 0; n < 2; ++n) *(f32x4*)(rowp + bj * HALF + n * 16) = acc[ai][bj][m][n] + bv[bj][n]; }
    }
};
template <class Epi, class Sched, bool ALIGN_EPI = false, bool SP2 = false>
__device__ __forceinline__ void gemm_phase(PG8_LAS unsigned char* lds, const Gemm g, const Sched& S, const Epi& E, const int tid) {
    const int wid = __builtin_amdgcn_readfirstlane(tid >> 6), lane = tid & 63, wr = wid >> 2, wc = wid & 3, fr = lane & 15, fq = lane >> 4;
    const int K = g.K, nt = K / BK;
    unsigned voffA[2], voffB[2];
#pragma unroll
    for (int i = 0; i < 2; ++i) { int R, C; stage_rc(tid * 16 + i * 8192, R, C); const int Rb = Epi::PERM ? ((R & ~31) + perm32(R & 31)) : R;
        voffA[i] = (unsigned)(R * K + C) * 2u; voffB[i] = (unsigned)(Rb * K + C) * 2u; }
    const size_t kstep = (size_t)(BK * 2);
    const size_t hstep = (size_t)HALF * K * 2;
    const size_t tstep = 2 * hstep;
    const unsigned ldsw = (unsigned)wid * 1024u;
    const int aoff = lds_byte(wr * 64 + fr, fq * 8), boff = lds_byte(wc * 32 + fr, fq * 8);
#define PG8_SA(b, h) (((b) * 2 + (h)) * HTB)
#define PG8_SB(b, h) ((4 + (b) * 2 + (h)) * HTB)
#define PG8_STAGE(bufoff, gbase, voff) do { _Pragma("unroll") for (int _i = 0; _i < 2; ++_i) \
        __builtin_amdgcn_global_load_lds((const unsigned*)((const char*)(gbase) + (voff)[_i]), (PG8_LAS unsigned*)(lds + (bufoff) + ldsw + _i * 8192), 16, 0, 0); } while (0)
#define PG8_LDA(dst, b, h) do { _Pragma("unroll") for (int m = 0; m < 4; ++m) _Pragma("unroll") for (int k = 0; k < 2; ++k) dst[m][k] = *(const PG8_LAS bf16x8*)(lds + PG8_SA(b, h) + aoff + m * 2048 + k * 1024); } while (0)
#define PG8_LDB(dst, b, h) do { _Pragma("unroll") for (int n = 0; n < 2; ++n) _Pragma("unroll") for (int k = 0; k < 2; ++k) dst[n][k] = *(const PG8_LAS bf16x8*)(lds + PG8_SB(b, h) + boff + n * 2048 + k * 1024); } while (0)
#define PG8_MMA(ai, bj, At, Bt) do { __builtin_amdgcn_s_setprio(1); _Pragma("unroll") for (int m = 0; m < 4; ++m) _Pragma("unroll") for (int n = 0; n < 2; ++n) _Pragma("unroll") for (int k = 0; k < 2; ++k) \
        acc[ai][bj][m][n] = __builtin_amdgcn_mfma_f32_16x16x32_bf16(Bt[n][k], At[m][k], acc[ai][bj][m][n], 0, 0, 0); __builtin_amdgcn_s_setprio(0); } while (0)
#define PG8_WAIT_V(n) asm volatile("s_waitcnt vmcnt(" #n ")" ::: "memory")
#define PG8_WAIT_L(n) asm volatile("s_waitcnt lgkmcnt(" #n ")" ::: "memory")
#define PG8_BAR __builtin_amdgcn_s_barrier()
#define PG8_SCHED __builtin_amdgcn_sched_barrier(0)
    Unit cur, nxt; int ui = 0;
    if (!S.next(0, cur)) return;
    f32x4 acc[2][2][4][2];
#pragma unroll
    for (int a = 0; a < 2; ++a)
#pragma unroll
        for (int b = 0; b < 2; ++b)
#pragma unroll
            for (int m = 0; m < 4; ++m)
#pragma unroll
                for (int n = 0; n < 2; ++n) acc[a][b][m][n] = (f32x4){0.f, 0.f, 0.f, 0.f};
    bf16x8 At[4][2], B0[2][2], B1[2][2];
    const char* cA = (const char*)g.A + (size_t)cur.pm * tstep; const char* cB = (const char*)g.Bt + (size_t)cur.pn * tstep;
    S.a_ready(cur);
    if constexpr (SP2) {
        PG8_STAGE(PG8_SB(0, 0), cB, voffB); PG8_STAGE(PG8_SB(0, 1), cB + hstep, voffB); PG8_STAGE(PG8_SA(0, 0), cA, voffA); PG8_STAGE(PG8_SA(0, 1), cA + hstep, voffA);
        if (wr == 1) PG8_BAR;
        PG8_WAIT_V(2); PG8_BAR;
        PG8_STAGE(PG8_SB(1, 0), cB + kstep, voffB); PG8_STAGE(PG8_SA(1, 0), cA + kstep, voffA); PG8_STAGE(PG8_SB(1, 1), cB + hstep + kstep, voffB);
        PG8_WAIT_V(6); PG8_BAR;
    } else {
        PG8_STAGE(PG8_SB(0, 0), cB, voffB); PG8_STAGE(PG8_SA(0, 0), cA, voffA); PG8_STAGE(PG8_SB(0, 1), cB + hstep, voffB); PG8_STAGE(PG8_SA(0, 1), cA + hstep, voffA);
        if (wr == 1) PG8_BAR;
        PG8_WAIT_V(4); PG8_BAR;
        PG8_STAGE(PG8_SB(1, 0), cB + kstep, voffB); PG8_STAGE(PG8_SA(1, 0), cA + kstep, voffA); PG8_STAGE(PG8_SB(1, 1), cB + hstep + kstep, voffB);
        PG8_WAIT_V(6); PG8_BAR;
    }
    for (;;) {
        const bool has_next = S.next(ui + 1, nxt);
        const char* nA = has_next ? (const char*)g.A + (size_t)nxt.pm * tstep : cA; const char* nB = has_next ? (const char*)g.Bt + (size_t)nxt.pn * tstep : cB;
        for (int t = 0; t < nt; t += 2) {
            const bool last = (t == nt - 2);
            const char* a1 = cA + (size_t)(t + 1) * kstep;
            const char* a2 = last ? nA : cA + (size_t)(t + 2) * kstep; const char* b2 = last ? nB : cB + (size_t)(t + 2) * kstep;
            const char* a3 = a2 + kstep; const char* b3 = b2 + kstep;
            if (last && has_next) S.a_ready(nxt);
            if constexpr (SP2) {
            PG8_LDB(B0, 0, 0); PG8_LDB(B1, 0, 1); PG8_SCHED; PG8_LDA(At, 0, 0); PG8_STAGE(PG8_SA(1, 1), a1 + hstep, voffA);
            PG8_WAIT_V(8); PG8_WAIT_L(0); PG8_BAR; PG8_MMA(0, 0, At, B0); PG8_MMA(0, 1, At, B1); PG8_BAR; PG8_SCHED;
            PG8_LDA(At, 0, 1); PG8_STAGE(PG8_SB(0, 0), b2, voffB); PG8_STAGE(PG8_SB(0, 1), b2 + hstep, voffB); PG8_STAGE(PG8_SA(0, 0), a2, voffA);
            PG8_WAIT_V(8); PG8_WAIT_L(0); PG8_BAR; PG8_MMA(1, 0, At, B0); PG8_MMA(1, 1, At, B1); PG8_BAR; PG8_SCHED;
            PG8_LDB(B0, 1, 0); PG8_LDB(B1, 1, 1); PG8_SCHED; PG8_LDA(At, 1, 0); PG8_STAGE(PG8_SA(0, 1), a2 + hstep, voffA);
            PG8_WAIT_V(8); PG8_WAIT_L(0); PG8_BAR; PG8_MMA(0, 0, At, B0); PG8_MMA(0, 1, At, B1); PG8_BAR; PG8_SCHED;
            PG8_LDA(At, 1, 1); PG8_STAGE(PG8_SB(1, 0), b3, voffB); PG8_STAGE(PG8_SB(1, 1), b3 + hstep, voffB); PG8_STAGE(PG8_SA(1, 0), a3, voffA);
            PG8_WAIT_V(8); PG8_WAIT_L(0); PG8_BAR; PG8_MMA(1, 0, At, B0); PG8_MMA(1, 1, At, B1); PG8_BAR; PG8_SCHED;
            } else {
            PG8_LDB(B0, 0, 0); PG8_SCHED; PG8_LDA(At, 0, 0); PG8_STAGE(PG8_SA(1, 1), a1 + hstep, voffA);
            PG8_WAIT_L(8); PG8_BAR; PG8_WAIT_L(0); PG8_MMA(0, 0, At, B0); PG8_BAR; PG8_SCHED;
            PG8_LDB(B1, 0, 1); PG8_STAGE(PG8_SB(0, 0), b2, voffB);
            PG8_BAR; PG8_WAIT_L(0); PG8_MMA(0, 1, At, B1); PG8_BAR;
            PG8_LDA(At, 0, 1); PG8_STAGE(PG8_SA(0, 0), a2, voffA);
            PG8_BAR; PG8_WAIT_L(0); PG8_MMA(1, 0, At, B0); PG8_BAR; PG8_SCHED;
            PG8_STAGE(PG8_SB(0, 1), b2 + hstep, voffB);
            PG8_WAIT_V(6); PG8_BAR; PG8_MMA(1, 1, At, B1); PG8_BAR;
            PG8_LDB(B0, 1, 0); PG8_SCHED; PG8_LDA(At, 1, 0); PG8_STAGE(PG8_SA(0, 1), a2 + hstep, voffA);
            PG8_WAIT_L(8); PG8_BAR; PG8_WAIT_L(0); PG8_MMA(0, 0, At, B0); PG8_BAR; PG8_SCHED;
            PG8_LDB(B1, 1, 1); PG8_STAGE(PG8_SB(1, 0), b3, voffB);
            PG8_BAR; PG8_WAIT_L(0); PG8_MMA(0, 1, At, B1); PG8_BAR;
            PG8_LDA(At, 1, 1); PG8_STAGE(PG8_SA(1, 0), a3, voffA);
            PG8_BAR; PG8_WAIT_L(0); PG8_MMA(1, 0, At, B0); PG8_BAR; PG8_SCHED;
            PG8_STAGE(PG8_SB(1, 1), b3 + hstep, voffB);
            PG8_WAIT_V(6); PG8_BAR; PG8_MMA(1, 1, At, B1); PG8_BAR;
            }
        }
        if constexpr (ALIGN_EPI) { if (wr == 0) PG8_BAR; }
        if constexpr (!Epi::AFTER_DRAIN) { E(acc, cur, wr, wc, fr, fq); S.done(cur); }
        if (!has_next) break;
#pragma unroll
        for (int a = 0; a < 2; ++a)
#pragma unroll
            for (int b = 0; b < 2; ++b)
#pragma unroll
                for (int m = 0; m < 4; ++m)
#pragma unroll
                    for (int n = 0; n < 2; ++n) acc[a][b][m][n] = (f32x4){0.f, 0.f, 0.f, 0.f};
        cur = nxt; cA = nA; cB = nB; ++ui;
        if constexpr (ALIGN_EPI) { if (wr == 1) PG8_BAR; }
    }
    PG8_WAIT_V(0);
    if constexpr (!ALIGN_EPI) { if (wr == 0) PG8_BAR; }
    PG8_BAR;
    if constexpr (Epi::AFTER_DRAIN) { E.fused(acc, cur, wr, wc, fr, fq, lds, wid, lane); S.done(cur); }
#undef PG8_SA
#undef PG8_SB
#undef PG8_STAGE
#undef PG8_LDA
#undef PG8_LDB
#undef PG8_MMA
#undef PG8_WAIT_V
#undef PG8_WAIT_L
#undef PG8_BAR
#undef PG8_SCHED
}
}

constexpr int DM = 1024, NBATCH = 32, TSEQ = 2048, MTOK = NBATCH * TSEQ, DEPTH = 4;
constexpr int EVEN_IN = 3248, EVEN_PAD = 3328, ODD_IN = 1864, ODD_PAD = 2048;
constexpr int G_Q = 0, G_K = 256, G_V = 512, G_G = 1024, G_AL = 1536, RW0 = 1552;
constexpr int R_R = RW0, R_K = RW0 + 512, R_V = RW0 + 1024, R_WL = RW0 + 1536;
constexpr int O_Q = 0, O_K = 1024, O_V = 1152, O_QI = 1280, O_KI = 1792, O_WI = 1856;
constexpr float DN_ALPHA = 1.681792830507429f, LN_EPS = 1e-5f;

constexpr size_t MiB = 1u << 20;
constexpr size_t WS_CTL = 0, CTL_ZERO_BYTES = 1 * MiB;
constexpr size_t WS_COSA = 1 * MiB, WS_SINA = WS_COSA + 512 * 1024, WS_COSI = 2 * MiB, WS_SINI = WS_COSI + 256 * 1024;
constexpr size_t WS_WINE = 3 * MiB, WS_WINO = 16 * MiB, WS_WOUTE = 24 * MiB, WS_WOUTO = 28 * MiB, WS_WQ = 32 * MiB, WS_SK = 40 * MiB;
constexpr size_t WS_XB = 48 * MiB, WS_P = 176 * MiB, WS_MIX = WS_P, WS_QP = WS_P + 256 * MiB, WS_CAT = 592 * MiB;
constexpr size_t WS_RIDX = 720 * MiB, WS_RGATE = 736 * MiB, WS_MASK = 768 * MiB, WS_EXP = 784 * MiB, WS_END = 848 * MiB;
constexpr int CW_BAR = 4096;

constexpr int LDS_BYTES = 147456, RING_BYTES = 131072, LDSCTL_OFF = RING_BYTES;

#define GAS __attribute__((address_space(1)))
#define LAS __attribute__((address_space(3)))
typedef unsigned short bf16;
typedef float f32x4 __attribute__((ext_vector_type(4)));
typedef unsigned u32x4 __attribute__((ext_vector_type(4)));
typedef unsigned u32x2 __attribute__((ext_vector_type(2)));
#define LDS_WAIT() asm volatile("s_waitcnt lgkmcnt(0)" ::: "memory")
__device__ __forceinline__ float bf2f(bf16 b) { return __uint_as_float(((unsigned)b) << 16); }
__device__ __forceinline__ unsigned f2bf(float f) { unsigned u = __float_as_uint(f); return (u + 0x7fffu + ((u >> 16) & 1u)) >> 16; }
__device__ __forceinline__ unsigned pk2(float lo, float hi) { return f2bf(lo) | (f2bf(hi) << 16); }
__device__ __forceinline__ float bflo(unsigned w) { return __uint_as_float(w << 16); }
__device__ __forceinline__ float bfhi(unsigned w) { return __uint_as_float(w & 0xffff0000u); }
__device__ __forceinline__ float wave_sum(float v) {
#pragma unroll
    for (int o = 1; o < 64; o <<= 1) v += __shfl_xor(v, o);
    return v;
}
__device__ __forceinline__ float wave_max(float v) {
#pragma unroll
    for (int o = 1; o < 64; o <<= 1) v = fmaxf(v, __shfl_xor(v, o));
    return v;
}
__device__ __forceinline__ int wave_sum_i(int v) {
#pragma unroll
    for (int o = 1; o < 64; o <<= 1) v += __shfl_xor(v, o);
    return v;
}
__device__ __forceinline__ float sigmoidf_(float x) { return 1.f / (1.f + __expf(-x)); }
#define XB_TMO      128
#define XB_XCNT(j)  (256  + 64 * (j))
#define XB_XSUB(j)  (1280 + 64 * (j))
#define XB_XGEN(j)  (2304 + 64 * (j))
#define XB_TOP      3328
#define XB_TOPGEN   3392
#define XCD_BAR_WORDS 3456
#define XB_SPIN_CAP (1u << 18)

__device__ __forceinline__ unsigned xb_ld(unsigned* p)              { return __hip_atomic_load(p, __ATOMIC_RELAXED, __HIP_MEMORY_SCOPE_AGENT); }
__device__ __forceinline__ unsigned xb_add(unsigned* p, unsigned v) { return __hip_atomic_fetch_add(p, v, __ATOMIC_RELAXED, __HIP_MEMORY_SCOPE_AGENT); }
__device__ __forceinline__ unsigned xb_xcc_id() { return (unsigned)__builtin_amdgcn_s_getreg((3 << 11) | 20) & 0xFu; }
#define XB_SPIN(cond, bar) do { unsigned _sp = 0; while (cond) { __builtin_amdgcn_s_sleep(1); \
    if ((++_sp & 255u) == 0u) { if (xb_ld(&(bar)[XB_TMO])) break; if (_sp > XB_SPIN_CAP) { atomicAdd(&(bar)[XB_TMO], 1u); break; } } } } while (0)

struct XcdBarrier {
    unsigned* bar; unsigned x;
    volatile LAS unsigned* st;
};

__device__ __forceinline__ XcdBarrier xcd_barrier_post(unsigned* bar, volatile LAS unsigned* st) {
    XcdBarrier b; b.bar = bar; b.x = xb_xcc_id(); b.st = st;
    if (threadIdx.x == 0) (void)xb_add(&bar[XB_XCNT(b.x)], 1u);
    return b;
}
__device__ __forceinline__ void xcd_barrier_complete(unsigned* bar, unsigned x, unsigned& nloc, unsigned& nx) {
    const unsigned G = gridDim.x * gridDim.y * gridDim.z;
    unsigned sum, cnt, mine, sp = 0u;
    for (;;) {
        sum = 0u; cnt = 0u; mine = 0u;
#pragma unroll
        for (unsigned j = 0; j < 16; ++j) { const unsigned c = xb_ld(&bar[XB_XCNT(j)]); sum += c; cnt += (c > 0u) ? 1u : 0u; mine = (j == x) ? c : mine; }
        if (sum == G) break;
        __builtin_amdgcn_s_sleep(1);
        if ((++sp & 255u) == 0u) { if (xb_ld(&bar[XB_TMO])) break; if (sp > XB_SPIN_CAP) { atomicAdd(&bar[XB_TMO], 1u); break; } }
    }
    nloc = mine > 0u ? mine : 1u; nx = cnt > 0u ? cnt : 1u;
}

__device__ __forceinline__ void xcd_barrier(const XcdBarrier& b) {
    asm volatile("s_waitcnt vmcnt(0)" ::: "memory");
    __syncthreads();
    if (threadIdx.x == 0) {
        unsigned* bar = b.bar;
        __builtin_amdgcn_s_waitcnt(0);
        unsigned nloc = b.st[0], nx = b.st[1];
        if (nloc == 0u) { xcd_barrier_complete(bar, b.x, nloc, nx); b.st[0] = nloc; b.st[1] = nx; }
        const unsigned old = xb_add(&bar[XB_XSUB(b.x)], 1u);
        const unsigned gen = old / nloc;
        if (old + 1u == (gen + 1u) * nloc) {
            __builtin_amdgcn_fence(__ATOMIC_RELEASE, "agent");
            asm volatile("s_waitcnt vmcnt(0)" ::: "memory");
            const unsigned og = xb_add(&bar[XB_TOP], 1u);
            const unsigned tg = og / nx;
            if (og + 1u == (tg + 1u) * nx) xb_add(&bar[XB_TOPGEN], 1u);
            else XB_SPIN(xb_ld(&bar[XB_TOPGEN]) == tg, bar);
            __builtin_amdgcn_fence(__ATOMIC_ACQUIRE, "agent");
            xb_add(&bar[XB_XGEN(b.x)], 1u);
            asm volatile("s_waitcnt vmcnt(0)" ::: "memory");
        } else {
            XB_SPIN(xb_ld(&bar[XB_XGEN(b.x)]) == gen, bar);
            __builtin_amdgcn_fence(__ATOMIC_ACQUIRE, "agent");
            asm volatile("s_waitcnt vmcnt(0)" ::: "memory");
        }
    }
    __syncthreads();
}

struct Args { const float* in[27]; float* out; unsigned char* ws; int ph_lo, ph_hi; };

__device__ __forceinline__ void transpose_item(const float* W, int N, int Npad, bf16* WT, LAS float* scr, int item, int lane) {
    const int nblk = Npad / 32, kb = item / nblk, nb = item % nblk, k0 = 64 * kb, n0 = 32 * nb;
    const int n_in = n0 + (lane & 31);
#pragma unroll 8
    for (int i = 0; i < 32; ++i) { const int kk = 2 * i + (lane >> 5); scr[kk * 33 + (lane & 31)] = (n_in < N) ? W[(size_t)(k0 + kk) * N + n_in] : 0.f; }
    LDS_WAIT(); asm volatile("" ::: "memory");
    const int c = lane & 7;
#pragma unroll
    for (int j = 0; j < 4; ++j) { const int n = (lane >> 3) + 8 * j; const LAS float* s = scr + (8 * c) * 33 + n;
        u32x4 o; o.x = pk2(s[0 * 33], s[1 * 33]); o.y = pk2(s[2 * 33], s[3 * 33]); o.z = pk2(s[4 * 33], s[5 * 33]); o.w = pk2(s[6 * 33], s[7 * 33]);
        *(u32x4*)(WT + (size_t)(n0 + n) * 1024 + k0 + 8 * c) = o; }
    LDS_WAIT(); asm volatile("" ::: "memory");
}
__device__ __forceinline__ void sincos_d(double x, double& s, double& c) {
    const double n = __builtin_rint(x * 0.6366197723675814);
    double r = __builtin_fma(-n, 1.5707963267948966, x); r = __builtin_fma(-n, 6.123233995736766e-17, r);
    const int q = ((int)n) & 3;
    const double r2 = r * r;
    double sp = -1.0 / 1307674368000.0; sp = sp * r2 + 1.0 / 6227020800.0; sp = sp * r2 - 1.0 / 39916800.0; sp = sp * r2 + 1.0 / 362880.0; sp = sp * r2 - 1.0 / 5040.0; sp = sp * r2 + 1.0 / 120.0; sp = sp * r2 - 1.0 / 6.0; sp = sp * r2 + 1.0; sp *= r;
    double cp = 1.0 / 20922789888000.0; cp = cp * r2 - 1.0 / 87178291200.0; cp = cp * r2 + 1.0 / 479001600.0; cp = cp * r2 - 1.0 / 3628800.0; cp = cp * r2 + 1.0 / 40320.0; cp = cp * r2 - 1.0 / 720.0; cp = cp * r2 + 1.0 / 24.0; cp = cp * r2 - 0.5; cp = cp * r2 + 1.0;
    s = (q == 0) ? sp : (q == 1) ? cp : (q == 2) ? -sp : -cp;
    c = (q == 0) ? cp : (q == 1) ? -sp : (q == 2) ? -cp : sp;
}
__device__ __forceinline__ double powi_d(double base, int e) { double r = 1.0, p = base;
#pragma unroll
    for (int b = 0; b < 7; ++b) { if (e & (1 << b)) r *= p; p *= p; } return r; }

__device__ __forceinline__ void ph_prologue(const Args& a, LAS unsigned char* lds, int gw, int NGW, int wave, int lane) {
    unsigned char* ws = a.ws;
    LAS float* scr = (LAS float*)(lds + wave * 16384);
    constexpr int I_WE = 16 * (EVEN_PAD / 32), I_WO = 16 * (ODD_PAD / 32), I_SQ = 16 * 32;
    constexpr int NIT = 2 * I_WE + 2 * I_WO + 8 * I_SQ;
    for (int it = gw; it < NIT; it += NGW) {
        int r = it;
        if (r < 2 * I_WE) { const int i = r / I_WE; transpose_item(a.in[1] + (size_t)i * 1024 * EVEN_IN, EVEN_IN, EVEN_PAD, (bf16*)(ws + WS_WINE) + (size_t)i * EVEN_PAD * 1024, scr, r % I_WE, lane); continue; }
        r -= 2 * I_WE;
        if (r < 2 * I_WO) { const int i = r / I_WO; transpose_item(a.in[17] + (size_t)i * 1024 * ODD_IN, ODD_IN, ODD_PAD, (bf16*)(ws + WS_WINO) + (size_t)i * ODD_PAD * 1024, scr, r % I_WO, lane); continue; }
        r -= 2 * I_WO;
        const int mi = r / I_SQ, item = r % I_SQ; const float* src; bf16* dst;
        if (mi < 2) { src = a.in[16] + (size_t)mi * 1048576; dst = (bf16*)(ws + WS_WOUTE) + (size_t)mi * 1048576; }
        else if (mi < 4) { src = a.in[18] + (size_t)(mi - 2) * 1048576; dst = (bf16*)(ws + WS_WOUTO) + (size_t)(mi - 2) * 1048576; }
        else { src = a.in[21] + (size_t)(mi - 4) * 1048576; dst = (bf16*)(ws + WS_WQ) + (size_t)(mi - 4) * 1048576; }
        transpose_item(src, 1024, 1024, dst, scr, item, lane);
    }
    const int gtid = gw * 64 + lane, NT = NGW * 64;
    for (int idx = gtid; idx < 2048 * 64; idx += NT) { const int t = idx >> 6, i = idx & 63; double s, c; sincos_d((double)t * powi_d(0.8659643233600653, i), s, c);
        ((float*)(ws + WS_COSA))[idx] = (float)c; ((float*)(ws + WS_SINA))[idx] = (float)s; }
    for (int idx = gtid; idx < 2048 * 32; idx += NT) { const int t = idx >> 5, i = idx & 31; double s, c; sincos_d((double)t * powi_d(0.7498942093324559, i), s, c);
        ((float*)(ws + WS_COSI))[idx] = (float)c; ((float*)(ws + WS_SINI))[idx] = (float)s; }
    const f32x4* x4 = (const f32x4*)a.in[0]; u32x4* xb = (u32x4*)(ws + WS_XB);
    for (size_t i = gtid; i < (size_t)MTOK * DM / 8; i += NT) { const f32x4 v0 = x4[2 * i], v1 = x4[2 * i + 1];
        u32x4 o; o.x = pk2(v0.x, v0.y); o.y = pk2(v0.z, v0.w); o.z = pk2(v1.x, v1.y); o.w = pk2(v1.z, v1.w); xb[i] = o; }
}

constexpr int L_W2 = 0, L_A2 = 2048, L_G2 = 4096, L_PAR = 10240, L_LORA = 11040, L_VEC = 16160, L_Y = 30496, L_BON = 32544;
__device__ __forceinline__ void rwkv_unit(const Args& a, LAS float* L, int unit, int i2, const bf16* P, bf16* CAT, int tid) {
    constexpr int PS = EVEN_PAD;
    const int b = unit >> 3, h = unit & 7, lane = tid & 63, wave = __builtin_amdgcn_readfirstlane(tid >> 6);
    const float* mu = a.in[5] + i2 * 1696; const float* w0 = a.in[6] + i2 * 512; const float* w2 = a.in[7] + i2 * 32 * 512; const float* a0 = a.in[8] + i2 * 512;
    const float* a2 = a.in[9] + i2 * 32 * 512; const float* g2 = a.in[10] + i2 * 96 * 512; const float* kk_ = a.in[11] + i2 * 512; const float* ka_ = a.in[12] + i2 * 512;
    const float* rk_ = a.in[13] + i2 * 512; const float* lg = a.in[14] + i2 * 512; const float* lb = a.in[15] + i2 * 512;
    for (int idx = tid; idx < 32 * 64; idx += 512) { const int j = idx >> 6, c = idx & 63; L[L_W2 + idx] = w2[j * 512 + h * 64 + c]; L[L_A2 + idx] = a2[j * 512 + h * 64 + c]; }
    for (int idx = tid; idx < 96 * 64; idx += 512) { const int j = idx >> 6, c = idx & 63; L[L_G2 + idx] = g2[j * 512 + h * 64 + c]; }
    if (tid < 64) { const int c = tid, col = h * 64 + c; L[L_PAR + c] = mu[col]; L[L_PAR + 64 + c] = mu[512 + col]; L[L_PAR + 128 + c] = mu[1024 + col]; L[L_PAR + 192 + c] = w0[col];
        L[L_PAR + 256 + c] = a0[col]; L[L_PAR + 320 + c] = kk_[col]; L[L_PAR + 384 + c] = ka_[col]; L[L_PAR + 448 + c] = rk_[col]; L[L_PAR + 512 + c] = lg[col]; L[L_PAR + 576 + c] = lb[col]; }
    if (tid < 160) L[L_PAR + 640 + tid] = mu[1536 + tid];
    float S[8];
#pragma unroll
    for (int e = 0; e < 8; ++e) S[e] = 0.f;
    __syncthreads();
    const size_t row0 = (size_t)b * 2048;
    for (int t0 = 0; t0 < 2048; t0 += 32) {
#pragma unroll 1
        for (int idx = tid; idx < 32 * 160; idx += 512) { const int tok = idx / 160, j = idx - tok * 160, t = t0 + tok; const bf16* pr = P + (row0 + t) * PS + R_WL + j;
            const float cur = bf2f(pr[0]), prev = t > 0 ? bf2f(pr[-PS]) : 0.f; const float s = cur + (prev - cur) * L[L_PAR + 640 + j];
            L[L_LORA + idx] = j < 32 ? tanhf(s) : (j < 64 ? s : 1.f / (1.f + expf(-s))); }
        __syncthreads();
        { const int c = lane, tg = wave, col = h * 64 + c;
          float rs[4], ks[4], vs[4], wl[4], al[4], gg[4];
#pragma unroll
          for (int i = 0; i < 4; ++i) { const int tok = tg * 4 + i, t = t0 + tok; const bf16* pr = P + (row0 + t) * PS;
              float cur = bf2f(pr[R_R + col]), prev = t > 0 ? bf2f(pr[R_R + col - PS]) : 0.f; rs[i] = cur + (prev - cur) * L[L_PAR + c];
              cur = bf2f(pr[R_K + col]); prev = t > 0 ? bf2f(pr[R_K + col - PS]) : 0.f; ks[i] = cur + (prev - cur) * L[L_PAR + 64 + c];
              cur = bf2f(pr[R_V + col]); prev = t > 0 ? bf2f(pr[R_V + col - PS]) : 0.f; vs[i] = cur + (prev - cur) * L[L_PAR + 128 + c];
              wl[i] = L[L_PAR + 192 + c]; al[i] = L[L_PAR + 256 + c]; gg[i] = 0.f; }
#pragma unroll 2
          for (int j = 0; j < 32; ++j) { const float w = L[L_W2 + j * 64 + c], aa = L[L_A2 + j * 64 + c];
#pragma unroll
              for (int i = 0; i < 4; ++i) { wl[i] += L[L_LORA + (tg * 4 + i) * 160 + j] * w; al[i] += L[L_LORA + (tg * 4 + i) * 160 + 32 + j] * aa; } }
#pragma unroll 2
          for (int j = 0; j < 96; ++j) { const float g_ = L[L_G2 + j * 64 + c];
#pragma unroll
              for (int i = 0; i < 4; ++i) gg[i] += L[L_LORA + (tg * 4 + i) * 160 + 64 + j] * g_; }
#pragma unroll
          for (int i = 0; i < 4; ++i) { const int tok = tg * 4 + i;
              const float wlog = fminf(wl[i], 0.f) - log1pf(expf(-fabsf(wl[i]))) - 0.5f; const float decay = expf(-expf(wlog));
              const float av = 1.f / (1.f + expf(-al[i]));
              const float kkr = ks[i] * L[L_PAR + 320 + c]; const float ss = wave_sum(kkr * kkr); const float kkn = kkr / fmaxf(sqrtf(ss), 1e-12f);
              const float k2 = ks[i] * (1.f + (av - 1.f) * L[L_PAR + 384 + c]);
              const float bon = wave_sum(rs[i] * k2 * L[L_PAR + 448 + c]);
              const int o = L_VEC + tok * 64 + c;
              L[o] = rs[i]; L[o + 2048] = decay; L[o + 4096] = k2; L[o + 6144] = vs[i]; L[o + 8192] = -kkn; L[o + 10240] = kkn * av; L[o + 12288] = gg[i];
              if (c == 0) L[L_BON + tok] = bon; } }
        __syncthreads();
        { const int i = tid >> 3, jq = tid & 7;
#pragma unroll 1
          for (int tok = 0; tok < 32; ++tok) { const int base = L_VEC + tok * 64 + jq * 8;
              const f32x4 r0 = *(const LAS f32x4*)&L[base], r1 = *(const LAS f32x4*)&L[base + 4];
              const f32x4 w0v = *(const LAS f32x4*)&L[base + 2048], w1v = *(const LAS f32x4*)&L[base + 2052];
              const f32x4 k0v = *(const LAS f32x4*)&L[base + 4096], k1v = *(const LAS f32x4*)&L[base + 4100];
              const f32x4 a0v = *(const LAS f32x4*)&L[base + 8192], a1v = *(const LAS f32x4*)&L[base + 8196];
              const f32x4 b0v = *(const LAS f32x4*)&L[base + 10240], b1v = *(const LAS f32x4*)&L[base + 10244];
              const float vi = L[L_VEC + 6144 + tok * 64 + i];
              float sa = 0.f;
#pragma unroll
              for (int e = 0; e < 4; ++e) { sa += S[e] * a0v[e]; sa += S[4 + e] * a1v[e]; }
              sa += __shfl_xor(sa, 1); sa += __shfl_xor(sa, 2); sa += __shfl_xor(sa, 4);
              float y = 0.f;
#pragma unroll
              for (int e = 0; e < 4; ++e) { S[e] = S[e] * w0v[e] + sa * b0v[e] + vi * k0v[e]; S[4 + e] = S[4 + e] * w1v[e] + sa * b1v[e] + vi * k1v[e]; y += S[e] * r0[e]; y += S[4 + e] * r1[e]; }
              y += __shfl_xor(y, 1); y += __shfl_xor(y, 2); y += __shfl_xor(y, 4);
              if (jq == 0) L[L_Y + tok * 64 + i] = y; } }
        __syncthreads();
        { const int c = lane, tg = wave, col = h * 64 + c;
#pragma unroll
          for (int i = 0; i < 4; ++i) { const int tok = tg * 4 + i, t = t0 + tok; const float y = L[L_Y + tok * 64 + c];
              const float mean = wave_sum(y) * (1.f / 64.f); const float d = y - mean; const float var = wave_sum(d * d) * (1.f / 64.f);
              const float yn = d * (1.f / sqrtf(var + 64e-5f)) * L[L_PAR + 512 + c] + L[L_PAR + 576 + c];
              const float o = (yn + L[L_BON + tok] * L[L_VEC + 6144 + tok * 64 + c]) * L[L_VEC + 12288 + tok * 64 + c];
              CAT[(row0 + t) * 1024 + 512 + col] = (bf16)f2bf(o); } }
    }
    __syncthreads();
}
constexpr int LG_W2 = 0, LG_B = 1024, LG_NG = 1088, LG_GAL = 1216, LG_Q = 1728, LG_K = 3776, LG_A = 5824, LG_V = 7872, LG_O = 11968;
__device__ __forceinline__ void gla_unit(const Args& a, LAS float* L, int unit, int i2, const bf16* P, bf16* CAT, int tid) {
    constexpr int PS = EVEN_PAD;
    const int b = unit >> 2, h = unit & 3, lane = tid & 63, wave = __builtin_amdgcn_readfirstlane(tid >> 6);
    const float* w2 = a.in[2] + i2 * 16 * 256; const float* ab = a.in[3] + i2 * 256; const float* ng = a.in[4] + i2 * 128;
    for (int idx = tid; idx < 1024; idx += 512) { const int j = idx >> 6, d = idx & 63; L[LG_W2 + idx] = w2[j * 256 + h * 64 + d]; }
    if (tid < 64) L[LG_B + tid] = ab[h * 64 + tid];
    if (tid < 128) L[LG_NG + tid] = ng[tid];
    float S[64];
#pragma unroll
    for (int d = 0; d < 64; ++d) S[d] = 0.f;
    __syncthreads();
    const size_t row0 = (size_t)b * 2048;
    for (int t0 = 0; t0 < 2048; t0 += 32) {
        { const int tok = tid >> 4, j = tid & 15; L[LG_GAL + tid] = bf2f(P[(row0 + t0 + tok) * PS + G_AL + j]); }
        for (int idx = tid; idx < 32 * 64; idx += 512) { const int tok = idx >> 6, d = idx & 63; const bf16* pr = P + (row0 + t0 + tok) * PS;
            L[LG_Q + idx] = bf2f(pr[G_Q + h * 64 + d]) * 0.125f; L[LG_K + idx] = bf2f(pr[G_K + h * 64 + d]); }
        for (int idx = tid; idx < 32 * 128; idx += 512) { const int tok = idx >> 7, e = idx & 127; L[LG_V + idx] = bf2f(P[(row0 + t0 + tok) * PS + G_V + h * 128 + e]); }
        __syncthreads();
        for (int idx = tid; idx < 32 * 64; idx += 512) { const int tok = idx >> 6, d = idx & 63; float la = L[LG_B + d];
#pragma unroll
            for (int j = 0; j < 16; ++j) la += L[LG_GAL + tok * 16 + j] * L[LG_W2 + j * 64 + d];
            const float ls = fminf(la, 0.f) - log1pf(expf(-fabsf(la))); L[LG_A + idx] = expf(ls * (1.f / 16.f)); }
        __syncthreads();
        if (tid < 128) { const int e = tid;
#pragma unroll 1
            for (int tok = 0; tok < 32; ++tok) { const float ve = L[LG_V + tok * 128 + e]; float o = 0.f;
#pragma unroll
                for (int d4 = 0; d4 < 16; ++d4) { const f32x4 av = *(const LAS f32x4*)&L[LG_A + tok * 64 + d4 * 4], kv = *(const LAS f32x4*)&L[LG_K + tok * 64 + d4 * 4], qv = *(const LAS f32x4*)&L[LG_Q + tok * 64 + d4 * 4];
#pragma unroll
                    for (int u = 0; u < 4; ++u) { S[d4 * 4 + u] = av[u] * S[d4 * 4 + u] + kv[u] * ve; o += qv[u] * S[d4 * 4 + u]; } }
                L[LG_O + tok * 128 + e] = o; } }
        __syncthreads();
#pragma unroll
        for (int i = 0; i < 4; ++i) { const int tok = wave * 4 + i; const size_t row = row0 + t0 + tok; const float o0 = L[LG_O + tok * 128 + lane], o1 = L[LG_O + tok * 128 + 64 + lane];
            const float ms = wave_sum(o0 * o0 + o1 * o1) * (1.f / 128.f); const float r = 1.f / sqrtf(ms + LN_EPS);
            const bf16* pr = P + row * PS + G_G + h * 128; const float g0 = bf2f(pr[lane]), g1 = bf2f(pr[64 + lane]);
            CAT[row * 1024 + h * 128 + lane] = (bf16)f2bf(o0 * r * L[LG_NG + lane] * (g0 / (1.f + expf(-g0))));
            CAT[row * 1024 + h * 128 + 64 + lane] = (bf16)f2bf(o1 * r * L[LG_NG + 64 + lane] * (g1 / (1.f + expf(-g1)))); }
    }
    __syncthreads();
}

__device__ __forceinline__ void ph_rope(const Args& a, int gtid, int NT) {
    bf16* P = (bf16*)(a.ws + WS_P);
    const float* cosA = (const float*)(a.ws + WS_COSA); const float* sinA = (const float*)(a.ws + WS_SINA);
    const float* cosI = (const float*)(a.ws + WS_COSI); const float* sinI = (const float*)(a.ws + WS_SINI);
    for (size_t it = gtid; it < (size_t)MTOK * 108; it += NT) {
        const size_t row = it / 108; int r = (int)(it - row * 108); const int t = (int)(row & 2047);
        int col, half; const float* ct; const float* st;
        if (r < 72) { const int vec = r >> 3, grp = r & 7; col = (vec < 8 ? O_Q + vec * 128 : O_K) + grp * 8; half = 64; ct = cosA + t * 64 + grp * 8; st = sinA + t * 64 + grp * 8; }
        else { r -= 72; const int vec = r >> 2, grp = r & 3; col = (vec < 8 ? O_QI + vec * 64 : O_KI) + grp * 8; half = 32; ct = cosI + t * 32 + grp * 8; st = sinI + t * 32 + grp * 8; }
        u32x4* p1 = (u32x4*)(P + row * ODD_PAD + col); u32x4* p2 = (u32x4*)(P + row * ODD_PAD + col + half);
        const u32x4 x1 = *p1, x2 = *p2; const f32x4 c0 = *(const f32x4*)ct, c1 = *(const f32x4*)(ct + 4), s0 = *(const f32x4*)st, s1 = *(const f32x4*)(st + 4);
        u32x4 o1, o2;
#define ROPE2(W, CA, SA, CB, SB) { const float a1 = bflo(x1.W), a2 = bflo(x2.W), b1 = bfhi(x1.W), b2 = bfhi(x2.W); \
            o1.W = pk2(a1 * (CA) - a2 * (SA), b1 * (CB) - b2 * (SB)); o2.W = pk2(a2 * (CA) + a1 * (SA), b2 * (CB) + b1 * (SB)); }
        ROPE2(x, c0.x, s0.x, c0.y, s0.y) ROPE2(y, c0.z, s0.z, c0.w, s0.w) ROPE2(z, c1.x, s1.x, c1.y, s1.y) ROPE2(w, c1.z, s1.z, c1.w, s1.w)
#undef ROPE2
        *p1 = o1; *p2 = o2;
    }
}
__device__ __forceinline__ unsigned sortable_key(float s) { unsigned u = __float_as_uint(s); if ((u << 1) == 0u) u = 0u; return (u & 0x80000000u) ? ~u : (u | 0x80000000u); }
__device__ __forceinline__ void ph_indexer(const Args& a, LAS unsigned char* lds, int gw, int NGW, int wave, int lane) {
    const bf16* P = (const bf16*)(a.ws + WS_P); unsigned* MASK = (unsigned*)(a.ws + WS_MASK);
    LAS float* qs = (LAS float*)(lds + wave * 10496); LAS unsigned* kl = (LAS unsigned*)(lds + wave * 10496 + 2304);
    for (int m = gw; m < MTOK; m += NGW) {
        const int b = m >> 11, t = m & 2047; const bf16* prow = P + (size_t)m * ODD_PAD;
        { const u32x4 v = *(const u32x4*)(prow + O_QI + lane * 8);
          *(LAS f32x4*)&qs[lane * 8] = (f32x4){bflo(v.x), bfhi(v.x), bflo(v.y), bfhi(v.y)}; *(LAS f32x4*)&qs[lane * 8 + 4] = (f32x4){bflo(v.z), bfhi(v.z), bflo(v.w), bfhi(v.w)}; }
        if (lane < 8) qs[512 + lane] = bf2f(prow[O_WI + lane]) * 0.04419417382415922f;
        LDS_WAIT();
        const int nblk = (t >> 6) + 1;
#pragma unroll 1
        for (int i = 0; i < nblk; ++i) { const int s = i * 64 + lane; unsigned key = 0u;
            if (s <= t) { const u32x4* kr = (const u32x4*)(P + ((size_t)b * 2048 + s) * ODD_PAD + O_KI);
                float kf[64];
#pragma unroll
                for (int q = 0; q < 8; ++q) { const u32x4 v = kr[q]; kf[q * 8 + 0] = bflo(v.x); kf[q * 8 + 1] = bfhi(v.x); kf[q * 8 + 2] = bflo(v.y); kf[q * 8 + 3] = bfhi(v.y); kf[q * 8 + 4] = bflo(v.z); kf[q * 8 + 5] = bfhi(v.z); kf[q * 8 + 6] = bflo(v.w); kf[q * 8 + 7] = bfhi(v.w); }
                float sc = 0.f;
#pragma unroll 1
                for (int h = 0; h < 8; ++h) { float acc = 0.f;
#pragma unroll
                    for (int d4 = 0; d4 < 16; ++d4) { const f32x4 qv = *(const LAS f32x4*)&qs[h * 64 + d4 * 4]; acc += qv.x * kf[d4 * 4] + qv.y * kf[d4 * 4 + 1] + qv.z * kf[d4 * 4 + 2] + qv.w * kf[d4 * 4 + 3]; }
                    sc += qs[512 + h] * fmaxf(acc, 0.f); }
                key = sortable_key(sc); }
            kl[i * 64 + lane] = key; }
        LDS_WAIT();
        unsigned k[32];
#pragma unroll
        for (int i = 0; i < 32; ++i) k[i] = (i < nblk) ? kl[i * 64 + lane] : 0u;
        unsigned T = 0u;
        for (int bit = 31; bit >= 0; --bit) { const unsigned cand = T | (1u << bit); int cnt = 0;
#pragma unroll
            for (int i = 0; i < 32; ++i) cnt += (k[i] >= cand) ? 1 : 0;
            cnt = wave_sum_i(cnt); if (cnt >= 256) T = cand; }
        int cgt = 0;
#pragma unroll
        for (int i = 0; i < 32; ++i) cgt += (k[i] > T) ? 1 : 0;
        cgt = wave_sum_i(cgt);
        const int need = 256 - cgt; int run = 0; unsigned myw = 0u;
#pragma unroll
        for (int i = 0; i < 32; ++i) { const bool gt = k[i] > T, eq = (k[i] == T) && (T != 0u);
            const unsigned long long bal = __ballot(eq); const int pre = __builtin_amdgcn_mbcnt_hi((unsigned)(bal >> 32), __builtin_amdgcn_mbcnt_lo((unsigned)bal, 0u));
            const bool sel = gt || (eq && (run + pre < need)); run += __popcll(bal);
            const unsigned long long sb = __ballot(sel);
            if (lane == 2 * i) myw = (unsigned)sb; if (lane == 2 * i + 1) myw = (unsigned)(sb >> 32); }
        MASK[(size_t)m * 64 + lane] = myw;
    }
}
__device__ __forceinline__ void ph_attention(const Args& a, LAS unsigned char* lds, int gw, int NGW, int wave, int lane) {
    const bf16* P = (const bf16*)(a.ws + WS_P); const unsigned* MASK = (const unsigned*)(a.ws + WS_MASK); bf16* CAT = (bf16*)(a.ws + WS_CAT);
    LAS unsigned short* sel = (LAS unsigned short*)(lds + wave * 4096); LAS float* qh = (LAS float*)(lds + wave * 4096 + 512); LAS float* pp = (LAS float*)(lds + wave * 4096 + 1024);
    for (int m = gw; m < MTOK; m += NGW) {
        const int b = m >> 11; const bf16* prow = P + (size_t)m * ODD_PAD; const bf16* pb = P + (size_t)b * 2048 * ODD_PAD;
        unsigned word = MASK[(size_t)m * 64 + lane]; const int cnt = __popc(word); int x = cnt;
#pragma unroll
        for (int o = 1; o < 64; o <<= 1) { const int y = __shfl_up(x, o); if (lane >= o) x += y; }
        const int nsel = __shfl(x, 63); int pos = x - cnt;
        while (word) { const int bpos = __builtin_ctz(word); word &= word - 1u; sel[pos++] = (unsigned short)(lane * 32 + bpos); }
        LDS_WAIT();
        for (int h = 0; h < 8; ++h) {
            qh[lane] = bf2f(prow[O_Q + h * 128 + lane]); qh[64 + lane] = bf2f(prow[O_Q + h * 128 + 64 + lane]);
            LDS_WAIT();
            float lg[4]; float mx = -3.0e38f;
#pragma unroll
            for (int jj = 0; jj < 4; ++jj) { const int j = lane + 64 * jj; lg[jj] = -3.0e38f;
                if (j < nsel) { const u32x4* kr = (const u32x4*)(pb + (size_t)sel[j] * ODD_PAD + O_K); float acc = 0.f;
#pragma unroll
                    for (int q = 0; q < 16; ++q) { const u32x4 v = kr[q]; const f32x4 q0 = *(const LAS f32x4*)&qh[q * 8], q1 = *(const LAS f32x4*)&qh[q * 8 + 4];
                        acc += q0.x * bflo(v.x) + q0.y * bfhi(v.x) + q0.z * bflo(v.y) + q0.w * bfhi(v.y) + q1.x * bflo(v.z) + q1.y * bfhi(v.z) + q1.z * bflo(v.w) + q1.w * bfhi(v.w); }
                    lg[jj] = acc * 0.08838834764831845f; }
                mx = fmaxf(mx, lg[jj]); }
            mx = wave_max(mx); float sum = 0.f;
#pragma unroll
            for (int jj = 0; jj < 4; ++jj) { const int j = lane + 64 * jj; const float p = (j < nsel) ? expf(lg[jj] - mx) : 0.f; lg[jj] = p; sum += p; }
            sum = wave_sum(sum); const float inv = 1.f / sum;
#pragma unroll
            for (int jj = 0; jj < 4; ++jj) pp[lane + 64 * jj] = lg[jj] * inv;
            LDS_WAIT();
            float o0 = 0.f, o1 = 0.f;
            for (int j = 0; j < nsel; ++j) { const bf16* vr = pb + (size_t)sel[j] * ODD_PAD + O_V; const float p = pp[j]; o0 += p * bf2f(vr[lane]); o1 += p * bf2f(vr[64 + lane]); }
            CAT[(size_t)m * 1024 + h * 128 + lane] = (bf16)f2bf(o0); CAT[(size_t)m * 1024 + h * 128 + 64 + lane] = (bf16)f2bf(o1);
            LDS_WAIT();
        }
    }
}

__device__ __forceinline__ void ph_ln1(const Args& a, int layer, int gw, int NGW, int lane) {
    const float* xin = (layer == 0) ? a.in[0] : a.out; const bf16* mix = (const bf16*)(a.ws + WS_MIX);
    const float* g = a.in[19] + layer * 1024; const float* bb = a.in[20] + layer * 1024; bf16* XB = (bf16*)(a.ws + WS_XB);
    f32x4 gv[4], bv[4];
#pragma unroll
    for (int j = 0; j < 4; ++j) { gv[j] = ((const f32x4*)g)[lane + 64 * j]; bv[j] = ((const f32x4*)bb)[lane + 64 * j]; }
    for (int m = gw; m < MTOK; m += NGW) {
        const f32x4* xr = (const f32x4*)(xin + (size_t)m * 1024) + lane; const u32x2* mr = (const u32x2*)(mix + (size_t)m * 1024) + lane;
        f32x4 v[4]; float s = 0.f;
#pragma unroll
        for (int j = 0; j < 4; ++j) { const u32x2 mw = mr[64 * j]; v[j] = xr[64 * j] * DN_ALPHA + (f32x4){bflo(mw.x), bfhi(mw.x), bflo(mw.y), bfhi(mw.y)}; s += (v[j].x + v[j].y) + (v[j].z + v[j].w); }
        const float mean = wave_sum(s) * (1.f / 1024.f); float s2 = 0.f;
#pragma unroll
        for (int j = 0; j < 4; ++j) { v[j] = v[j] - mean; s2 += (v[j].x * v[j].x + v[j].y * v[j].y) + (v[j].z * v[j].z + v[j].w * v[j].w); }
        const float rstd = 1.f / sqrtf(wave_sum(s2) * (1.f / 1024.f) + LN_EPS);
        f32x4* orow = (f32x4*)(a.out + (size_t)m * 1024) + lane; u32x2* ob = (u32x2*)(XB + (size_t)m * 1024) + lane;
#pragma unroll
        for (int j = 0; j < 4; ++j) { const f32x4 o = v[j] * rstd * gv[j] + bv[j]; orow[64 * j] = o; u32x2 w; w.x = pk2(o.x, o.y); w.y = pk2(o.z, o.w); ob[64 * j] = w; }
    }
}
__device__ __forceinline__ void wave_argmax(float& v, int& idx) {
#pragma unroll
    for (int o = 1; o < 64; o <<= 1) { const float ov = __shfl_xor(v, o); const int oi = __shfl_xor(idx, o); if (ov > v || (ov == v && oi < idx)) { v = ov; idx = oi; } }
}
__device__ __forceinline__ void ph_route(const Args& a, int layer, LAS unsigned char* lds, int gw, int NGW, int wave, int lane) {
    const bf16* Q = (const bf16*)(a.ws + WS_QP); const float* SK = a.in[22] + (size_t)layer * 8 * 2 * 128 * 64;
    unsigned short* RI = (unsigned short*)(a.ws + WS_RIDX); float* RG = (float*)(a.ws + WS_RGATE);
    LAS float* qh = (LAS float*)(lds + wave * 2048); LAS float* ts = (LAS float*)(lds + wave * 2048 + 512); LAS int* ti = (LAS int*)(lds + wave * 2048 + 640);
    const float NEG_INF = -__builtin_inff();
    for (int m = gw; m < MTOK; m += NGW) {
        for (int h = 0; h < 8; ++h) {
            qh[lane] = bf2f(Q[(size_t)m * 1024 + h * 128 + lane]); qh[64 + lane] = bf2f(Q[(size_t)m * 1024 + h * 128 + 64 + lane]);
            LDS_WAIT();
#pragma unroll
            for (int c = 0; c < 2; ++c) {
                float v0, v1;
                { const f32x4* k0 = (const f32x4*)(SK + ((size_t)(h * 2 + c) * 128 + lane) * 64); const f32x4* k1 = (const f32x4*)(SK + ((size_t)(h * 2 + c) * 128 + 64 + lane) * 64); float a0 = 0.f, a1 = 0.f;
#pragma unroll
                  for (int d4 = 0; d4 < 16; ++d4) { const f32x4 qv = *(const LAS f32x4*)&qh[c * 64 + d4 * 4]; const f32x4 x0 = k0[d4], x1 = k1[d4];
                      a0 += qv.x * x0.x + qv.y * x0.y + qv.z * x0.z + qv.w * x0.w; a1 += qv.x * x1.x + qv.y * x1.y + qv.z * x1.z + qv.w * x1.w; }
                  v0 = a0; v1 = a1; }
                for (int r = 0; r < 16; ++r) { float bv = v0; int bi = lane; if (v1 > v0) { bv = v1; bi = lane + 64; }
                    wave_argmax(bv, bi);
                    if (bi == lane) v0 = NEG_INF; if (bi == lane + 64) v1 = NEG_INF;
                    if (lane == 0) { ts[c * 16 + r] = bv; ti[c * 16 + r] = bi; } }
            }
            LDS_WAIT();
            float cv[4];
#pragma unroll
            for (int jj = 0; jj < 4; ++jj) { const int f = lane + 64 * jj; cv[jj] = ts[f >> 4] + ts[16 + (f & 15)]; }
            float bs = 0.f; int bpos = 0;
            for (int r = 0; r < 16; ++r) { float bv = cv[0]; int bi = lane;
#pragma unroll
                for (int jj = 1; jj < 4; ++jj) if (cv[jj] > bv) { bv = cv[jj]; bi = lane + 64 * jj; }
                wave_argmax(bv, bi);
#pragma unroll
                for (int jj = 0; jj < 4; ++jj) if (bi == lane + 64 * jj) cv[jj] = NEG_INF;
                if (lane == r) { bs = bv; bpos = bi; } }
            const float mx = __shfl(bs, 0); const float e = (lane < 16) ? expf(bs - mx) : 0.f; const float sum = wave_sum(e);
            if (lane < 16) { const int ei = ti[bpos >> 4] * 128 + ti[16 + (bpos & 15)]; RI[(size_t)m * 128 + h * 16 + lane] = (unsigned short)ei; RG[(size_t)m * 128 + h * 16 + lane] = e / sum; }
            LDS_WAIT();
        }
    }
}
__device__ __forceinline__ void ph_experts(const Args& a, int layer, int gw, int NGW, int lane) {
    const float* U = a.in[23] + (size_t)layer * 16384 * 1024; const float* V = a.in[24] + (size_t)layer * 16384 * 1024;
    const unsigned short* RI = (const unsigned short*)(a.ws + WS_RIDX); const float* RG = (const float*)(a.ws + WS_RGATE);
    const float* g = a.in[25] + layer * 1024; const float* bb = a.in[26] + layer * 1024; bf16* XB = (bf16*)(a.ws + WS_XB);
    for (int m = gw; m < MTOK; m += NGW) {
        f32x4 x[4], acc[4];
        const f32x4* xr = (const f32x4*)(a.out + (size_t)m * 1024) + lane;
#pragma unroll
        for (int j = 0; j < 4; ++j) { x[j] = xr[64 * j]; acc[j] = (f32x4){0.f, 0.f, 0.f, 0.f}; }
        for (int k = 0; k < 128; ++k) {
            const int e = RI[(size_t)m * 128 + k]; const float gate = RG[(size_t)m * 128 + k];
            const f32x4* ur = (const f32x4*)(U + (size_t)e * 1024) + lane; const f32x4* vr = (const f32x4*)(V + (size_t)e * 1024) + lane;
            f32x4 uv[4], vv[4];
#pragma unroll
            for (int j = 0; j < 4; ++j) { uv[j] = ur[64 * j]; vv[j] = vr[64 * j]; }
            float d = 0.f;
#pragma unroll
            for (int j = 0; j < 4; ++j) d += (x[j].x * uv[j].x + x[j].y * uv[j].y) + (x[j].z * uv[j].z + x[j].w * uv[j].w);
            d = wave_sum(d);
            const float coef = gate * 0.5f * d * (1.f + erff(d * 0.7071067811865476f));
#pragma unroll
            for (int j = 0; j < 4; ++j) acc[j] += vv[j] * coef;
        }
        float s = 0.f;
#pragma unroll
        for (int j = 0; j < 4; ++j) { acc[j] = x[j] * DN_ALPHA + acc[j]; s += (acc[j].x + acc[j].y) + (acc[j].z + acc[j].w); }
        const float mean = wave_sum(s) * (1.f / 1024.f); float s2 = 0.f;
#pragma unroll
        for (int j = 0; j < 4; ++j) { acc[j] = acc[j] - mean; s2 += (acc[j].x * acc[j].x + acc[j].y * acc[j].y) + (acc[j].z * acc[j].z + acc[j].w * acc[j].w); }
        const float rstd = 1.f / sqrtf(wave_sum(s2) * (1.f / 1024.f) + LN_EPS);
        f32x4* orow = (f32x4*)(a.out + (size_t)m * 1024) + lane; u32x2* ob = (u32x2*)(XB + (size_t)m * 1024) + lane;
#pragma unroll
        for (int j = 0; j < 4; ++j) { const f32x4 o = acc[j] * rstd * ((const f32x4*)g)[lane + 64 * j] + ((const f32x4*)bb)[lane + 64 * j]; orow[64 * j] = o; u32x2 w; w.x = pk2(o.x, o.y); w.y = pk2(o.z, o.w); ob[64 * j] = w; }
    }
}

constexpr int NPHASE = 1 + 9 * DEPTH;
__global__ void __launch_bounds__(512, 2) mk_fwd(Args args) {
    extern __shared__ __attribute__((aligned(16))) unsigned char lds_raw[];
    LAS unsigned char* lds = (LAS unsigned char*)lds_raw;
    const int tid = threadIdx.x;
    const int G = gridDim.x, bid = blockIdx.x, NGW = G * 8;
    unsigned char* ws = args.ws;
    for (int u = tid; u < (LDS_BYTES - LDSCTL_OFF) / 4; u += 512) ((LAS unsigned*)(lds + LDSCTL_OFF))[u] = 0u;
    __syncthreads();
    const int lo = args.ph_lo, hi = args.ph_hi;
    XcdBarrier bar; bar.bar = (unsigned*)(ws + WS_CTL) + CW_BAR; bar.x = 0; bar.st = nullptr;
    if (hi - lo > 1) bar = xcd_barrier_post((unsigned*)(ws + WS_CTL) + CW_BAR, (volatile LAS unsigned*)(lds + LDSCTL_OFF + 64));
#define IN(k) (lo <= (k) && (k) < hi)
#define SEAM(k) do { if ((k) + 1 < hi) xcd_barrier(bar); } while (0)
#ifndef SKIP_PRO
    if (IN(0)) { int lt = tid; asm volatile("" : "+v"(lt)); ph_prologue(args, lds, bid * 8 + __builtin_amdgcn_readfirstlane(lt >> 6), NGW, __builtin_amdgcn_readfirstlane(lt >> 6), lt & 63); SEAM(0); }
#endif
    for (int gi = 0; gi < 3 * DEPTH; ++gi) {
        const int layer = gi / 3, kind = gi - 3 * layer, pb = 1 + 9 * layer, i2 = layer >> 1; const bool odd = (layer & 1) != 0;
        const int pg = pb + (kind == 0 ? 0 : (kind == 1 ? 4 : 6));
        if (IN(pg)) {
            int lt = tid; asm volatile("" : "+v"(lt));
            int N = 1024; const bf16* A = (const bf16*)(ws + WS_XB); const bf16* W; bf16* O;
            if (kind == 0) { N = odd ? ODD_PAD : EVEN_PAD; W = odd ? (const bf16*)(ws + WS_WINO) + (size_t)i2 * ODD_PAD * 1024 : (const bf16*)(ws + WS_WINE) + (size_t)i2 * EVEN_PAD * 1024; O = (bf16*)(ws + WS_P); }
            else if (kind == 1) { A = (const bf16*)(ws + WS_CAT); W = (odd ? (const bf16*)(ws + WS_WOUTO) : (const bf16*)(ws + WS_WOUTE)) + (size_t)i2 * 1048576; O = (bf16*)(ws + WS_MIX); }
            else { W = (const bf16*)(ws + WS_WQ) + (size_t)layer * 1048576; O = (bf16*)(ws + WS_QP); }
            pg8::Gemm g{(const pg8::bf16_t*)A, (const pg8::bf16_t*)W, MTOK, N, 1024}; pg8::StaticOrder S; S.init(MTOK, N, G, bid);
            pg8::EpiBf16<0> E{(pg8::bf16_t*)O, N, nullptr, 0, 0, 1.f};
            pg8::gemm_phase<pg8::EpiBf16<0>, pg8::StaticOrder, true, true>(lds, g, S, E, lt);
            SEAM(pg);
        }
        if (kind == 0) {
            if (!odd) {
                if (IN(pb + 1)) {
                    int lt = tid; asm volatile("" : "+v"(lt));
                    for (int it = bid; it < 384; it += G) {
#ifndef SKIP_RWKV
                        if (it < 256) rwkv_unit(args, (LAS float*)lds, it, i2, (const bf16*)(ws + WS_P), (bf16*)(ws + WS_CAT), lt);
#endif
#ifndef SKIP_GLA
                        if (it >= 256) gla_unit(args, (LAS float*)lds, it - 256, i2, (const bf16*)(ws + WS_P), (bf16*)(ws + WS_CAT), lt);
#endif
                    }
                    SEAM(pb + 1);
                }
            } else {
#ifndef SKIP_ROPE
                if (IN(pb + 1)) { int lt = tid; asm volatile("" : "+v"(lt)); ph_rope(args, bid * 512 + lt, NGW * 64); SEAM(pb + 1); }
#endif
#ifndef SKIP_IDX
                if (IN(pb + 2)) { int lt = tid; asm volatile("" : "+v"(lt)); ph_indexer(args, lds, bid * 8 + __builtin_amdgcn_readfirstlane(lt >> 6), NGW, __builtin_amdgcn_readfirstlane(lt >> 6), lt & 63); SEAM(pb + 2); }
#endif
#ifndef SKIP_ATT
                if (IN(pb + 3)) { int lt = tid; asm volatile("" : "+v"(lt)); ph_attention(args, lds, bid * 8 + __builtin_amdgcn_readfirstlane(lt >> 6), NGW, __builtin_amdgcn_readfirstlane(lt >> 6), lt & 63); SEAM(pb + 3); }
#endif
            }
        } else if (kind == 1) {
#ifndef SKIP_LN1
            if (IN(pb + 5)) { int lt = tid; asm volatile("" : "+v"(lt)); ph_ln1(args, layer, bid * 8 + __builtin_amdgcn_readfirstlane(lt >> 6), NGW, lt & 63); SEAM(pb + 5); }
#endif
        } else {
#ifndef SKIP_ROUTE
            if (IN(pb + 7)) { int lt = tid; asm volatile("" : "+v"(lt)); ph_route(args, layer, lds, bid * 8 + __builtin_amdgcn_readfirstlane(lt >> 6), NGW, __builtin_amdgcn_readfirstlane(lt >> 6), lt & 63); SEAM(pb + 7); }
#endif
#ifndef SKIP_EXP
            if (IN(pb + 8)) { int lt = tid; asm volatile("" : "+v"(lt)); ph_experts(args, layer, bid * 8 + __builtin_amdgcn_readfirstlane(lt >> 6), NGW, lt & 63); SEAM(pb + 8); }
#endif
        }
    }
#undef IN
#undef SEAM
}

#ifndef ONE_LAUNCH
#define ONE_LAUNCH 1
#endif
extern "C" void kernel_launch(void* const* d_in, const int* in_sizes, int n_in, void* d_out, int out_size, void* d_ws, size_t ws_size, hipStream_t stream) {
    static int grid = 0;
    if (grid == 0) {
        if (n_in != 27 || in_sizes[0] != MTOK * DM || out_size != MTOK * DM || ws_size < WS_END) { fprintf(stderr, "kernel_launch: unexpected shapes (n_in %d, ws %zu)\n", n_in, ws_size); grid = -1; return; }
        int dev = 0, cus = 0, per_cu = 0;
        if (hipGetDevice(&dev) != hipSuccess || hipDeviceGetAttribute(&cus, hipDeviceAttributeMultiprocessorCount, dev) != hipSuccess) { grid = -1; return; }
        if (hipFuncSetAttribute((const void*)mk_fwd, hipFuncAttributeMaxDynamicSharedMemorySize, LDS_BYTES) != hipSuccess) { grid = -1; return; }
        if (hipOccupancyMaxActiveBlocksPerMultiprocessor(&per_cu, (const void*)mk_fwd, 512, LDS_BYTES) != hipSuccess || per_cu < 1) fprintf(stderr, "kernel_launch: occupancy query says %d\n", per_cu);
        (void)hipGetLastError();
        grid = cus;
    }
    if (grid < 0) return;
    (void)hipMemsetAsync((char*)d_ws + WS_CTL, 0, CTL_ZERO_BYTES, stream);
    Args a{};
    for (int i = 0; i < 27; ++i) a.in[i] = (const float*)d_in[i];
    a.out = (float*)d_out; a.ws = (unsigned char*)d_ws;
#if ONE_LAUNCH
    a.ph_lo = 0; a.ph_hi = NPHASE;
    hipLaunchKernelGGL(mk_fwd, dim3(grid), dim3(512), LDS_BYTES, stream, a);
#else
    for (int k = 0; k < NPHASE; ++k) {
        if (k >= 1) { const int layer = (k - 1) / 9, r = (k - 1) % 9; if ((layer & 1) == 0 && (r == 2 || r == 3)) continue; }
        a.ph_lo = k; a.ph_hi = k + 1;
        hipLaunchKernelGGL(mk_fwd, dim3(grid), dim3(512), LDS_BYTES, stream, a);
    }
#endif
}
```

```cpp
#include <hip/hip_runtime.h>
#include <cstdio>
#include <cstdint>
namespace pg8 {
#define PG8_LAS __attribute__((address_space(3)))
typedef unsigned short bf16_t;
typedef short bf16x8 __attribute__((ext_vector_type(8)));
typedef float f32x4 __attribute__((ext_vector_type(4)));
typedef unsigned u32x4 __attribute__((ext_vector_type(4)));
constexpr int BM = 256, BK = 64, HALF = 128, HTB = HALF * BK * 2  , STAGE_BYTES = 8 * HTB, NXCD = 8, WGM = 8;

__host__ __device__ __forceinline__ int lds_byte(int r, int c) { const int st = (r >> 4) * 2 + (c >> 5), rr = r & 15, cc = c & 31, ob = rr * 64 + cc * 2; return st * 1024 + (ob ^ (((ob >> 9) & 1) << 5)); }
__host__ __device__ __forceinline__ void stage_rc(int b, int& R, int& C) { const int st = b / 1024, sb = b % 1024, swz = sb ^ (((sb >> 9) & 1) << 5); R = (st >> 1) * 16 + swz / 64; C = (st & 1) * 32 + (swz % 64) / 2; }
__host__ __device__ __forceinline__ int perm32(int rho) { const int n = rho >> 4, i = rho & 15; return 8 * (i >> 2) + 4 * n + (i & 3); }

struct Unit { int pm, pn; };
struct Gemm { const bf16_t* A; const bf16_t* Bt; int M, N, K; };

struct StaticOrder {
    int nM, nN, nwg, G, c;
    __host__ __device__ void init(int M, int N, int G_, int c_) { nM = M / BM; nN = N / BM; nwg = nM * nN; G = G_; c = c_; }
    __host__ __device__ bool next(int i, Unit& u) const {
        const long L = (long)i * G + c; if (L >= nwg) return false;
        int wgid = (int)L; { const int q = nwg / NXCD, r = nwg % NXCD, xcd = wgid % NXCD, off = wgid / NXCD; wgid = (xcd < r ? xcd * (q + 1) : r * (q + 1) + (xcd - r) * q) + off; }
        const int nig = WGM * nN, gid = wgid / nig, fm = gid * WGM, gsz = (nM - fm) < WGM ? (nM - fm) : WGM;
        u.pm = fm + ((wgid % nig) % gsz); u.pn = (wgid % nig) / gsz; return true;
    }
    __device__ __forceinline__ void a_ready(const Unit&) const {}
    __device__ __forceinline__ void done(const Unit&) const {}
};

__device__ __forceinline__ unsigned cvt_pk_bf16(float lo, float hi) { unsigned r; asm volatile("v_cvt_pk_bf16_f32 %0, %1, %2" : "=v"(r) : "v"(lo), "v"(hi)); return r; }
typedef float f32x2 __attribute__((ext_vector_type(2)));
__device__ __forceinline__ f32x2 gelu_pk(f32x2 v) {
    const f32x2 av = __builtin_elementwise_abs(v), d = av * 0.2316418882f + 1.0f;
    f32x2 t; t.x = __builtin_amdgcn_rcpf(d.x); t.y = __builtin_amdgcn_rcpf(d.y);
    f32x2 q = t * 0.5307027145f + (-0.7265760135f); q = q * t + 0.7107068705f; q = q * t + (-0.142248368f); q = q * t + 0.127414796f; q = q * t;
    const f32x2 s = (v * v) * (-0.72134752044f);
    f32x2 e; e.x = __builtin_amdgcn_exp2f(s.x); e.y = __builtin_amdgcn_exp2f(s.y);
    const f32x2 m = v * (q * e), r = v - m;
    f32x2 o; o.x = v.x < 0.f ? m.x : r.x; o.y = v.y < 0.f ? m.y : r.y; return o;
}

template <int ACT  > struct EpiBf16 {
    static constexpr bool PERM = true, AFTER_DRAIN = false; static_assert(ACT == 0 || ACT == 1, "EpiBf16: ACT is 0 (none) or 1 (gelu_pk)");
    bf16_t* O; int ldc; const float* bias; int split_cols; size_t split_stride; float scale0;
    __device__ __forceinline__ void operator()(const f32x4 (&acc)[2][2][4][2], const Unit& u, int wr, int wc, int fr, int fq) const {
        const int row0 = u.pm * BM + wr * 64 + fr; int colt = u.pn * BM; bf16_t* base = O;
        float sc = 1.f; if (split_cols) { const int t = colt / split_cols; base += (size_t)t * split_stride; colt -= t * split_cols; if (t == 0) sc = scale0; }
        const int col0 = colt + wc * 32 + 8 * fq, bcol0 = u.pn * BM + wc * 32 + 8 * fq;
        f32x4 bv[2][2];
#pragma unroll
        for (int bj = 0; bj < 2; ++bj)
#pragma unroll
            for (int n = 0; n < 2; ++n) bv[bj][n] = bias ? *(const f32x4*)(bias + bcol0 + bj * HALF + 4 * n) : (f32x4){0.f, 0.f, 0.f, 0.f};
#pragma unroll
        for (int ai = 0; ai < 2; ++ai)
#pragma unroll
            for (int m = 0; m < 4; ++m) { bf16_t* rowp = base + (size_t)(row0 + ai * HALF + m * 16) * ldc + col0;
#pragma unroll
                for (int bj = 0; bj < 2; ++bj) { f32x4 v0 = acc[ai][bj][m][0] + bv[bj][0], v1 = acc[ai][bj][m][1] + bv[bj][1];
                    if (ACT == 1) { f32x2 a = gelu_pk((f32x2){v0[0], v0[1]}), b = gelu_pk((f32x2){v0[2], v0[3]}), c = gelu_pk((f32x2){v1[0], v1[1]}), d = gelu_pk((f32x2){v1[2], v1[3]});
                        v0 = (f32x4){a.x, a.y, b.x, b.y}; v1 = (f32x4){c.x, c.y, d.x, d.y}; }
                    v0 = v0 * sc; v1 = v1 * sc; u32x4 w; w.x = cvt_pk_bf16(v0[0], v0[1]); w.y = cvt_pk_bf16(v0[2], v0[3]); w.z = cvt_pk_bf16(v1[0], v1[1]); w.w = cvt_pk_bf16(v1[2], v1[3]);
                    *(u32x4*)(rowp + bj * HALF) = w; } }
    }
};
struct EpiF32 {
    static constexpr bool PERM = false, AFTER_DRAIN = false;
    float* C; int ldc; const float* bias;
    __device__ __forceinline__ void operator()(const f32x4 (&acc)[2][2][4][2], const Unit& u, int wr, int wc, int fr, int fq) const {
        const int row0 = u.pm * BM + wr * 64 + fr, col0 = u.pn * BM + wc * 32 + 4 * fq;
        f32x4 bv[2][2];
#pragma unroll
        for (int bj = 0; bj < 2; ++bj)
#pragma unroll
            for (int n = 0; n < 2; ++n) bv[bj][n] = bias ? *(const f32x4*)(bias + col0 + bj * HALF + n * 16) : (f32x4){0.f, 0.f, 0.f, 0.f};
#pragma unroll
        for (int ai = 0; ai < 2; ++ai)
#pragma unroll
            for (int m = 0; m < 4; ++m) { float* rowp = C + (size_t)(row0 + ai * HALF + m * 16) * ldc + col0;
#pragma unroll
                for (int bj = 0; bj < 2; ++bj)
#pragma unroll
                    for (int n = 0; n < 2; ++n) *(f32x4*)(rowp + bj * HALF + n * 16) = acc[ai][bj][m][n] + bv[bj][n]; }
    }
};
template <class Epi, class Sched, bool ALIGN_EPI = false, bool SP2 = false>
__device__ __forceinline__ void gemm_phase(PG8_LAS unsigned char* lds, const Gemm g, const Sched& S, const Epi& E, const int tid) {
    const int wid = __builtin_amdgcn_readfirstlane(tid >> 6), lane = tid & 63, wr = wid >> 2, wc = wid & 3, fr = lane & 15, fq = lane >> 4;
    const int K = g.K, nt = K / BK;
    unsigned voffA[2], voffB[2];
#pragma unroll
    for (int i = 0; i < 2; ++i) { int R, C; stage_rc(tid * 16 + i * 8192, R, C); const int Rb = Epi::PERM ? ((R & ~31) + perm32(R & 31)) : R;
        voffA[i] = (unsigned)(R * K + C) * 2u; voffB[i] = (unsigned)(Rb * K + C) * 2u; }
    const size_t kstep = (size_t)(BK * 2);
    const size_t hstep = (size_t)HALF * K * 2;
    const size_t tstep = 2 * hstep;
    const unsigned ldsw = (unsigned)wid * 1024u;
    const int aoff = lds_byte(wr * 64 + fr, fq * 8), boff = lds_byte(wc * 32 + fr, fq * 8);
#define PG8_SA(b, h) (((b) * 2 + (h)) * HTB)
#define PG8_SB(b, h) ((4 + (b) * 2 + (h)) * HTB)
#define PG8_STAGE(bufoff, gbase, voff) do { _Pragma("unroll") for (int _i = 0; _i < 2; ++_i) \
        __builtin_amdgcn_global_load_lds((const unsigned*)((const char*)(gbase) + (voff)[_i]), (PG8_LAS unsigned*)(lds + (bufoff) + ldsw + _i * 8192), 16, 0, 0); } while (0)
#define PG8_LDA(dst, b, h) do { _Pragma("unroll") for (int m = 0; m < 4; ++m) _Pragma("unroll") for (int k = 0; k < 2; ++k) dst[m][k] = *(const PG8_LAS bf16x8*)(lds + PG8_SA(b, h) + aoff + m * 2048 + k * 1024); } while (0)
#define PG8_LDB(dst, b, h) do { _Pragma("unroll") for (int n = 0; n < 2; ++n) _Pragma("unroll") for (int k = 0; k < 2; ++k) dst[n][k] = *(const PG8_LAS bf16x8*)(lds + PG8_SB(b, h) + boff + n * 2048 + k * 1024); } while (0)
#define PG8_MMA(ai, bj, At, Bt) do { __builtin_amdgcn_s_setprio(1); _Pragma("unroll") for (int m = 0; m < 4; ++m) _Pragma("unroll") for (int n = 0; n < 2; ++n) _Pragma("unroll") for (int k = 0; k < 2; ++k) \
        acc[ai][bj][m][n] = __builtin_amdgcn_mfma_f32_16x16x32_bf16(Bt[n][k], At[m][k], acc[ai][bj][m][n], 0, 0, 0); __builtin_amdgcn_s_setprio(0); } while (0)
#define PG8_WAIT_V(n) asm volatile("s_waitcnt vmcnt(" #n ")" ::: "memory")
#define PG8_WAIT_L(n) asm volatile("s_waitcnt lgkmcnt(" #n ")" ::: "memory")
#define PG8_BAR __builtin_amdgcn_s_barrier()
#define PG8_SCHED __builtin_amdgcn_sched_barrier(0)
    Unit cur, nxt; int ui = 0;
    if (!S.next(0, cur)) return;
    f32x4 acc[2][2][4][2];
#pragma unroll
    for (int a = 0; a < 2; ++a)
#pragma unroll
        for (int b = 0; b < 2; ++b)
#pragma unroll
            for (int m = 0; m < 4; ++m)
#pragma unroll
                for (int n = 0; n < 2; ++n) acc[a][b][m][n] = (f32x4){0.f, 0.f, 0.f, 0.f};
    bf16x8 At[4][2], B0[2][2], B1[2][2];
    const char* cA = (const char*)g.A + (size_t)cur.pm * tstep; const char* cB = (const char*)g.Bt + (size_t)cur.pn * tstep;
    S.a_ready(cur);
    if constexpr (SP2) {
        PG8_STAGE(PG8_SB(0, 0), cB, voffB); PG8_STAGE(PG8_SB(0, 1), cB + hstep, voffB); PG8_STAGE(PG8_SA(0, 0), cA, voffA); PG8_STAGE(PG8_SA(0, 1), cA + hstep, voffA);
        if (wr == 1) PG8_BAR;
        PG8_WAIT_V(2); PG8_BAR;
        PG8_STAGE(PG8_SB(1, 0), cB + kstep, voffB); PG8_STAGE(PG8_SA(1, 0), cA + kstep, voffA); PG8_STAGE(PG8_SB(1, 1), cB + hstep + kstep, voffB);
        PG8_WAIT_V(6); PG8_BAR;
    } else {
        PG8_STAGE(PG8_SB(0, 0), cB, voffB); PG8_STAGE(PG8_SA(0, 0), cA, voffA); PG8_STAGE(PG8_SB(0, 1), cB + hstep, voffB); PG8_STAGE(PG8_SA(0, 1), cA + hstep, voffA);
        if (wr == 1) PG8_BAR;
        PG8_WAIT_V(4); PG8_BAR;
        PG8_STAGE(PG8_SB(1, 0), cB + kstep, voffB); PG8_STAGE(PG8_SA(1, 0), cA + kstep, voffA); PG8_STAGE(PG8_SB(1, 1), cB + hstep + kstep, voffB);
        PG8_WAIT_V(6); PG8_BAR;
    }
    for (;;) {
        const bool has_next = S.next(ui + 1, nxt);
        const char* nA = has_next ? (const char*)g.A + (size_t)nxt.pm * tstep : cA; const char* nB = has_next ? (const char*)g.Bt + (size_t)nxt.pn * tstep : cB;
        for (int t = 0; t < nt; t += 2) {
            const bool last = (t == nt - 2);
            const char* a1 = cA + (size_t)(t + 1) * kstep;
            const char* a2 = last ? nA : cA + (size_t)(t + 2) * kstep; const char* b2 = last ? nB : cB + (size_t)(t + 2) * kstep;
            const char* a3 = a2 + kstep; const char* b3 = b2 + kstep;
            if (last && has_next) S.a_ready(nxt);
            if constexpr (SP2) {
            PG8_LDB(B0, 0, 0); PG8_LDB(B1, 0, 1); PG8_SCHED; PG8_LDA(At, 0, 0); PG8_STAGE(PG8_SA(1, 1), a1 + hstep, voffA);
            PG8_WAIT_V(8); PG8_WAIT_L(0); PG8_BAR; PG8_MMA(0, 0, At, B0); PG8_MMA(0, 1, At, B1); PG8_BAR; PG8_SCHED;
            PG8_LDA(At, 0, 1); PG8_STAGE(PG8_SB(0, 0), b2, voffB); PG8_STAGE(PG8_SB(0, 1), b2 + hstep, voffB); PG8_STAGE(PG8_SA(0, 0), a2, voffA);
            PG8_WAIT_V(8); PG8_WAIT_L(0); PG8_BAR; PG8_MMA(1, 0, At, B0); PG8_MMA(1, 1, At, B1); PG8_BAR; PG8_SCHED;
            PG8_LDB(B0, 1, 0); PG8_LDB(B1, 1, 1); PG8_SCHED; PG8_LDA(At, 1, 0); PG8_STAGE(PG8_SA(0, 1), a2 + hstep, voffA);
            PG8_WAIT_V(8); PG8_WAIT_L(0); PG8_BAR; PG8_MMA(0, 0, At, B0); PG8_MMA(0, 1, At, B1); PG8_BAR; PG8_SCHED;
            PG8_LDA(At, 1, 1); PG8_STAGE(PG8_SB(1, 0), b3, voffB); PG8_STAGE(PG8_SB(1, 1), b3 + hstep, voffB); PG8_STAGE(PG8_SA(1, 0), a3, voffA);
            PG8_WAIT_V(8); PG8_WAIT_L(0); PG8_BAR; PG8_MMA(1, 0, At, B0); PG8_MMA(1, 1, At, B1); PG8_BAR; PG8_SCHED;
            } else {
            PG8_LDB(B0, 0, 0); PG8_SCHED; PG8_LDA(At, 0, 0); PG8_STAGE(PG8_SA(1, 1), a1 + hstep, voffA);
            PG8_WAIT_L(8); PG8_BAR; PG8_WAIT_L(0); PG8_MMA(0, 0, At, B0); PG8_BAR; PG8_SCHED;
            PG8_LDB(B1, 0, 1); PG8_STAGE(PG8_SB(0, 0), b2, voffB);
            PG8_BAR; PG8_WAIT_L(0); PG8_MMA(0, 1, At, B1); PG8_BAR;
            PG8_LDA(At, 0, 1); PG8_STAGE(PG8_SA(0, 0), a2, voffA);
            PG8_BAR; PG8_WAIT_L(0); PG8_MMA(1, 0, At, B0); PG8_BAR; PG8_SCHED;
            PG8_STAGE(PG8_SB(0, 1), b2 + hstep, voffB);
            PG8_WAIT_V(6); PG8_BAR; PG8_MMA(1, 1, At, B1); PG8_BAR;
            PG8_LDB(B0, 1, 0); PG8_SCHED; PG8_LDA(At, 1, 0); PG8_STAGE(PG8_SA(0, 1), a2 + hstep, voffA);
            PG8_WAIT_L(8); PG8_BAR; PG8_WAIT_L(0); PG8_MMA(0, 0, At, B0); PG8_BAR; PG8_SCHED;
            PG8_LDB(B1, 1, 1); PG8_STAGE(PG8_SB(1, 0), b3, voffB);
            PG8_BAR; PG8_WAIT_L(0); PG8_MMA(0, 1, At, B1); PG8_BAR;
            PG8_LDA(At, 1, 1); PG8_STAGE(PG8_SA(1, 0), a3, voffA);
            PG8_BAR; PG8_WAIT_L(0); PG8_MMA(1, 0, At, B0); PG8_BAR; PG8_SCHED;
            PG8_STAGE(PG8_SB(1, 1), b3 + hstep, voffB);
            PG8_WAIT_V(6); PG8_BAR; PG8_MMA(1, 1, At, B1); PG8_BAR;
            }
        }
        if constexpr (ALIGN_EPI) { if (wr == 0) PG8_BAR; }
        if constexpr (!Epi::AFTER_DRAIN) { E(acc, cur, wr, wc, fr, fq); S.done(cur); }
        if (!has_next) break;
#pragma unroll
        for (int a = 0; a < 2; ++a)
#pragma unroll
            for (int b = 0; b < 2; ++b)
#pragma unroll
                for (int m = 0; m < 4; ++m)
#pragma unroll
                    for (int n = 0; n < 2; ++n) acc[a][b][m][n] = (f32x4){0.f, 0.f, 0.f, 0.f};
        cur = nxt; cA = nA; cB = nB; ++ui;
        if constexpr (ALIGN_EPI) { if (wr == 1) PG8_BAR; }
    }
    PG8_WAIT_V(0);
    if constexpr (!ALIGN_EPI) { if (wr == 0) PG8_BAR; }
    PG8_BAR;
    if constexpr (Epi::AFTER_DRAIN) { E.fused(acc, cur, wr, wc, fr, fq, lds, wid, lane); S.done(cur); }
#undef PG8_SA
#undef PG8_SB
#undef PG8_STAGE
#undef PG8_LDA
#undef PG8_LDB
#undef PG8_MMA
#undef PG8_WAIT_V
#undef PG8_WAIT_L
#undef PG8_BAR
#undef PG8_SCHED
}
}

constexpr int DM = 1024, NBATCH = 32, TSEQ = 2048, MTOK = NBATCH * TSEQ, DEPTH = 4;
constexpr int EVEN_IN = 3248, EVEN_PAD = 3328, ODD_IN = 1864, ODD_PAD = 2048;
constexpr int G_Q = 0, G_K = 256, G_V = 512, G_G = 1024, G_AL = 1536, RW0 = 1552;
constexpr int R_R = RW0, R_K = RW0 + 512, R_V = RW0 + 1024, R_WL = RW0 + 1536;
constexpr int O_Q = 0, O_K = 1024, O_V = 1152, O_QI = 1280, O_KI = 1792, O_WI = 1856;
constexpr float DN_ALPHA = 1.681792830507429f, LN_EPS = 1e-5f;

constexpr size_t MiB = 1u << 20;
constexpr size_t WS_CTL = 0, CTL_ZERO_BYTES = 1 * MiB;
constexpr size_t WS_COSA = 1 * MiB, WS_SINA = WS_COSA + 512 * 1024, WS_COSI = 2 * MiB, WS_SINI = WS_COSI + 256 * 1024;
constexpr size_t WS_WINE = 3 * MiB, WS_WINO = 16 * MiB, WS_WOUTE = 24 * MiB, WS_WOUTO = 28 * MiB, WS_WQ = 32 * MiB, WS_SK = 40 * MiB;
constexpr size_t WS_XB = 48 * MiB, WS_P = 176 * MiB, WS_MIX = WS_P, WS_QP = WS_P + 256 * MiB, WS_CAT = 592 * MiB;
constexpr size_t WS_RIDX = 720 * MiB, WS_RGATE = 736 * MiB, WS_MASK = 768 * MiB, WS_VT = 784 * MiB, WS_EXP = 800 * MiB, WS_END = 864 * MiB;
constexpr int CW_BAR = 4096;

constexpr int LDS_BYTES = 147456, RING_BYTES = 131072, LDSCTL_OFF = RING_BYTES;

#define GAS __attribute__((address_space(1)))
#define LAS __attribute__((address_space(3)))
typedef unsigned short bf16;
typedef float f32x4 __attribute__((ext_vector_type(4)));
typedef unsigned u32x4 __attribute__((ext_vector_type(4)));
typedef unsigned u32x2 __attribute__((ext_vector_type(2)));
typedef short bf16x8 __attribute__((ext_vector_type(8)));
typedef float f32x16 __attribute__((ext_vector_type(16)));
#define LDS_WAIT() asm volatile("s_waitcnt lgkmcnt(0)" ::: "memory")
__device__ __forceinline__ float bf2f(bf16 b) { return __uint_as_float(((unsigned)b) << 16); }
__device__ __forceinline__ unsigned f2bf(float f) { unsigned u = __float_as_uint(f); return (u + 0x7fffu + ((u >> 16) & 1u)) >> 16; }
__device__ __forceinline__ unsigned pk2(float lo, float hi) { return f2bf(lo) | (f2bf(hi) << 16); }
__device__ __forceinline__ float bflo(unsigned w) { return __uint_as_float(w << 16); }
__device__ __forceinline__ float bfhi(unsigned w) { return __uint_as_float(w & 0xffff0000u); }
__device__ __forceinline__ float wave_sum(float v) {
#pragma unroll
    for (int o = 1; o < 64; o <<= 1) v += __shfl_xor(v, o);
    return v;
}
__device__ __forceinline__ float wave_max(float v) {
#pragma unroll
    for (int o = 1; o < 64; o <<= 1) v = fmaxf(v, __shfl_xor(v, o));
    return v;
}
__device__ __forceinline__ int wave_sum_i(int v) {
#pragma unroll
    for (int o = 1; o < 64; o <<= 1) v += __shfl_xor(v, o);
    return v;
}
__device__ __forceinline__ float sigmoidf_(float x) { return 1.f / (1.f + __expf(-x)); }
#define XB_TMO      128
#define XB_XCNT(j)  (256  + 64 * (j))
#define XB_XSUB(j)  (1280 + 64 * (j))
#define XB_XGEN(j)  (2304 + 64 * (j))
#define XB_TOP      3328
#define XB_TOPGEN   3392
#define XCD_BAR_WORDS 3456
#define XB_SPIN_CAP (1u << 18)

__device__ __forceinline__ unsigned xb_ld(unsigned* p)              { return __hip_atomic_load(p, __ATOMIC_RELAXED, __HIP_MEMORY_SCOPE_AGENT); }
__device__ __forceinline__ unsigned xb_add(unsigned* p, unsigned v) { return __hip_atomic_fetch_add(p, v, __ATOMIC_RELAXED, __HIP_MEMORY_SCOPE_AGENT); }
__device__ __forceinline__ unsigned xb_xcc_id() { return (unsigned)__builtin_amdgcn_s_getreg((3 << 11) | 20) & 0xFu; }
#define XB_SPIN(cond, bar) do { unsigned _sp = 0; while (cond) { __builtin_amdgcn_s_sleep(1); \
    if ((++_sp & 255u) == 0u) { if (xb_ld(&(bar)[XB_TMO])) break; if (_sp > XB_SPIN_CAP) { atomicAdd(&(bar)[XB_TMO], 1u); break; } } } } while (0)

struct XcdBarrier {
    unsigned* bar; unsigned x;
    volatile LAS unsigned* st;
};

__device__ __forceinline__ XcdBarrier xcd_barrier_post(unsigned* bar, volatile LAS unsigned* st) {
    XcdBarrier b; b.bar = bar; b.x = xb_xcc_id(); b.st = st;
    if (threadIdx.x == 0) (void)xb_add(&bar[XB_XCNT(b.x)], 1u);
    return b;
}
__device__ __forceinline__ void xcd_barrier_complete(unsigned* bar, unsigned x, unsigned& nloc, unsigned& nx) {
    const unsigned G = gridDim.x * gridDim.y * gridDim.z;
    unsigned sum, cnt, mine, sp = 0u;
    for (;;) {
        sum = 0u; cnt = 0u; mine = 0u;
#pragma unroll
        for (unsigned j = 0; j < 16; ++j) { const unsigned c = xb_ld(&bar[XB_XCNT(j)]); sum += c; cnt += (c > 0u) ? 1u : 0u; mine = (j == x) ? c : mine; }
        if (sum == G) break;
        __builtin_amdgcn_s_sleep(1);
        if ((++sp & 255u) == 0u) { if (xb_ld(&bar[XB_TMO])) break; if (sp > XB_SPIN_CAP) { atomicAdd(&bar[XB_TMO], 1u); break; } }
    }
    nloc = mine > 0u ? mine : 1u; nx = cnt > 0u ? cnt : 1u;
}

__device__ __forceinline__ void xcd_barrier(const XcdBarrier& b) {
    asm volatile("s_waitcnt vmcnt(0)" ::: "memory");
    __syncthreads();
    if (threadIdx.x == 0) {
        unsigned* bar = b.bar;
        __builtin_amdgcn_s_waitcnt(0);
        unsigned nloc = b.st[0], nx = b.st[1];
        if (nloc == 0u) { xcd_barrier_complete(bar, b.x, nloc, nx); b.st[0] = nloc; b.st[1] = nx; }
        const unsigned old = xb_add(&bar[XB_XSUB(b.x)], 1u);
        const unsigned gen = old / nloc;
        if (old + 1u == (gen + 1u) * nloc) {
            __builtin_amdgcn_fence(__ATOMIC_RELEASE, "agent");
            asm volatile("s_waitcnt vmcnt(0)" ::: "memory");
            const unsigned og = xb_add(&bar[XB_TOP], 1u);
            const unsigned tg = og / nx;
            if (og + 1u == (tg + 1u) * nx) xb_add(&bar[XB_TOPGEN], 1u);
            else XB_SPIN(xb_ld(&bar[XB_TOPGEN]) == tg, bar);
            __builtin_amdgcn_fence(__ATOMIC_ACQUIRE, "agent");
            xb_add(&bar[XB_XGEN(b.x)], 1u);
            asm volatile("s_waitcnt vmcnt(0)" ::: "memory");
        } else {
            XB_SPIN(xb_ld(&bar[XB_XGEN(b.x)]) == gen, bar);
            __builtin_amdgcn_fence(__ATOMIC_ACQUIRE, "agent");
            asm volatile("s_waitcnt vmcnt(0)" ::: "memory");
        }
    }
    __syncthreads();
}

struct Args { const float* in[27]; float* out; unsigned char* ws; int ph_lo, ph_hi; };

__device__ __forceinline__ void transpose_item(const float* W, int N, int Npad, bf16* WT, LAS float* scr, int item, int lane) {
    const int nblk = Npad / 32, kb = item / nblk, nb = item % nblk, k0 = 64 * kb, n0 = 32 * nb;
    const int n_in = n0 + (lane & 31);
#pragma unroll 8
    for (int i = 0; i < 32; ++i) { const int kk = 2 * i + (lane >> 5); scr[kk * 33 + (lane & 31)] = (n_in < N) ? W[(size_t)(k0 + kk) * N + n_in] : 0.f; }
    LDS_WAIT(); asm volatile("" ::: "memory");
    const int c = lane & 7;
#pragma unroll
    for (int j = 0; j < 4; ++j) { const int n = (lane >> 3) + 8 * j; const LAS float* s = scr + (8 * c) * 33 + n;
        u32x4 o; o.x = pk2(s[0 * 33], s[1 * 33]); o.y = pk2(s[2 * 33], s[3 * 33]); o.z = pk2(s[4 * 33], s[5 * 33]); o.w = pk2(s[6 * 33], s[7 * 33]);
        *(u32x4*)(WT + (size_t)(n0 + n) * 1024 + k0 + 8 * c) = o; }
    LDS_WAIT(); asm volatile("" ::: "memory");
}
__device__ __forceinline__ void sincos_d(double x, double& s, double& c) {
    const double n = __builtin_rint(x * 0.6366197723675814);
    double r = __builtin_fma(-n, 1.5707963267948966, x); r = __builtin_fma(-n, 6.123233995736766e-17, r);
    const int q = ((int)n) & 3;
    const double r2 = r * r;
    double sp = -1.0 / 1307674368000.0; sp = sp * r2 + 1.0 / 6227020800.0; sp = sp * r2 - 1.0 / 39916800.0; sp = sp * r2 + 1.0 / 362880.0; sp = sp * r2 - 1.0 / 5040.0; sp = sp * r2 + 1.0 / 120.0; sp = sp * r2 - 1.0 / 6.0; sp = sp * r2 + 1.0; sp *= r;
    double cp = 1.0 / 20922789888000.0; cp = cp * r2 - 1.0 / 87178291200.0; cp = cp * r2 + 1.0 / 479001600.0; cp = cp * r2 - 1.0 / 3628800.0; cp = cp * r2 + 1.0 / 40320.0; cp = cp * r2 - 1.0 / 720.0; cp = cp * r2 + 1.0 / 24.0; cp = cp * r2 - 0.5; cp = cp * r2 + 1.0;
    s = (q == 0) ? sp : (q == 1) ? cp : (q == 2) ? -sp : -cp;
    c = (q == 0) ? cp : (q == 1) ? -sp : (q == 2) ? -cp : sp;
}
__device__ __forceinline__ double powi_d(double base, int e) { double r = 1.0, p = base;
#pragma unroll
    for (int b = 0; b < 7; ++b) { if (e & (1 << b)) r *= p; p *= p; } return r; }

__device__ __forceinline__ void ph_prologue(const Args& a, LAS unsigned char* lds, int gw, int NGW, int wave, int lane) {
    unsigned char* ws = a.ws;
    LAS float* scr = (LAS float*)(lds + wave * 16384);
    constexpr int I_WE = 16 * (EVEN_PAD / 32), I_WO = 16 * (ODD_PAD / 32), I_SQ = 16 * 32;
    constexpr int NIT = 2 * I_WE + 2 * I_WO + 8 * I_SQ;
    for (int it = gw; it < NIT; it += NGW) {
        int r = it;
        if (r < 2 * I_WE) { const int i = r / I_WE; transpose_item(a.in[1] + (size_t)i * 1024 * EVEN_IN, EVEN_IN, EVEN_PAD, (bf16*)(ws + WS_WINE) + (size_t)i * EVEN_PAD * 1024, scr, r % I_WE, lane); continue; }
        r -= 2 * I_WE;
        if (r < 2 * I_WO) { const int i = r / I_WO; transpose_item(a.in[17] + (size_t)i * 1024 * ODD_IN, ODD_IN, ODD_PAD, (bf16*)(ws + WS_WINO) + (size_t)i * ODD_PAD * 1024, scr, r % I_WO, lane); continue; }
        r -= 2 * I_WO;
        const int mi = r / I_SQ, item = r % I_SQ; const float* src; bf16* dst;
        if (mi < 2) { src = a.in[16] + (size_t)mi * 1048576; dst = (bf16*)(ws + WS_WOUTE) + (size_t)mi * 1048576; }
        else if (mi < 4) { src = a.in[18] + (size_t)(mi - 2) * 1048576; dst = (bf16*)(ws + WS_WOUTO) + (size_t)(mi - 2) * 1048576; }
        else { src = a.in[21] + (size_t)(mi - 4) * 1048576; dst = (bf16*)(ws + WS_WQ) + (size_t)(mi - 4) * 1048576; }
        transpose_item(src, 1024, 1024, dst, scr, item, lane);
    }
    const int gtid = gw * 64 + lane, NT = NGW * 64;
    for (int idx = gtid; idx < 2048 * 64; idx += NT) { const int t = idx >> 6, i = idx & 63; double s, c; sincos_d((double)t * powi_d(0.8659643233600653, i), s, c);
        ((float*)(ws + WS_COSA))[idx] = (float)c; ((float*)(ws + WS_SINA))[idx] = (float)s; }
    for (int idx = gtid; idx < 2048 * 32; idx += NT) { const int t = idx >> 5, i = idx & 31; double s, c; sincos_d((double)t * powi_d(0.7498942093324559, i), s, c);
        ((float*)(ws + WS_COSI))[idx] = (float)c; ((float*)(ws + WS_SINI))[idx] = (float)s; }
    { const f32x4* sk = (const f32x4*)a.in[22]; u32x2* skb = (u32x2*)(ws + WS_SK);
      for (int i = gtid; i < 4 * 8 * 2 * 128 * 64 / 4; i += NT) { const f32x4 v = sk[i]; u32x2 o; o.x = pk2(v.x, v.y); o.y = pk2(v.z, v.w); skb[i] = o; } }
    const f32x4* x4 = (const f32x4*)a.in[0]; u32x4* xb = (u32x4*)(ws + WS_XB);
    for (size_t i = gtid; i < (size_t)MTOK * DM / 8; i += NT) { const f32x4 v0 = x4[2 * i], v1 = x4[2 * i + 1];
        u32x4 o; o.x = pk2(v0.x, v0.y); o.y = pk2(v0.z, v0.w); o.z = pk2(v1.x, v1.y); o.w = pk2(v1.z, v1.w); xb[i] = o; }
}

constexpr int L_W2 = 0, L_A2 = 2048, L_G2 = 4096, L_PAR = 10240, L_LORA = 11040, L_VEC = 16160, L_Y = 30496, L_BON = 32544;
__device__ __forceinline__ void rwkv_unit(const Args& a, LAS float* L, int unit, int i2, const bf16* P, bf16* CAT, int tid) {
    constexpr int PS = EVEN_PAD;
    const int b = unit >> 3, h = unit & 7, lane = tid & 63, wave = __builtin_amdgcn_readfirstlane(tid >> 6);
    const float* mu = a.in[5] + i2 * 1696; const float* w0 = a.in[6] + i2 * 512; const float* w2 = a.in[7] + i2 * 32 * 512; const float* a0 = a.in[8] + i2 * 512;
    const float* a2 = a.in[9] + i2 * 32 * 512; const float* g2 = a.in[10] + i2 * 96 * 512; const float* kk_ = a.in[11] + i2 * 512; const float* ka_ = a.in[12] + i2 * 512;
    const float* rk_ = a.in[13] + i2 * 512; const float* lg = a.in[14] + i2 * 512; const float* lb = a.in[15] + i2 * 512;
    for (int idx = tid; idx < 32 * 64; idx += 512) { const int j = idx >> 6, c = idx & 63; L[L_W2 + idx] = w2[j * 512 + h * 64 + c]; L[L_A2 + idx] = a2[j * 512 + h * 64 + c]; }
    for (int idx = tid; idx < 96 * 64; idx += 512) { const int j = idx >> 6, c = idx & 63; L[L_G2 + idx] = g2[j * 512 + h * 64 + c]; }
    if (tid < 64) { const int c = tid, col = h * 64 + c; L[L_PAR + c] = mu[col]; L[L_PAR + 64 + c] = mu[512 + col]; L[L_PAR + 128 + c] = mu[1024 + col]; L[L_PAR + 192 + c] = w0[col];
        L[L_PAR + 256 + c] = a0[col]; L[L_PAR + 320 + c] = kk_[col]; L[L_PAR + 384 + c] = ka_[col]; L[L_PAR + 448 + c] = rk_[col]; L[L_PAR + 512 + c] = lg[col]; L[L_PAR + 576 + c] = lb[col]; }
    if (tid < 160) L[L_PAR + 640 + tid] = mu[1536 + tid];
    float S[8];
#pragma unroll
    for (int e = 0; e < 8; ++e) S[e] = 0.f;
    __syncthreads();
    const size_t row0 = (size_t)b * 2048;
    for (int t0 = 0; t0 < 2048; t0 += 32) {
#pragma unroll 1
        for (int idx = tid; idx < 32 * 160; idx += 512) { const int tok = idx / 160, j = idx - tok * 160, t = t0 + tok; const bf16* pr = P + (row0 + t) * PS + R_WL + j;
            const float cur = bf2f(pr[0]), prev = t > 0 ? bf2f(pr[-PS]) : 0.f; const float s = cur + (prev - cur) * L[L_PAR + 640 + j];
            L[L_LORA + idx] = j < 32 ? tanhf(s) : (j < 64 ? s : 1.f / (1.f + expf(-s))); }
        __syncthreads();
        { const int c = lane, tg = wave, col = h * 64 + c;
          float rs[4], ks[4], vs[4], wl[4], al[4], gg[4];
#pragma unroll
          for (int i = 0; i < 4; ++i) { const int tok = tg * 4 + i, t = t0 + tok; const bf16* pr = P + (row0 + t) * PS;
              float cur = bf2f(pr[R_R + col]), prev = t > 0 ? bf2f(pr[R_R + col - PS]) : 0.f; rs[i] = cur + (prev - cur) * L[L_PAR + c];
              cur = bf2f(pr[R_K + col]); prev = t > 0 ? bf2f(pr[R_K + col - PS]) : 0.f; ks[i] = cur + (prev - cur) * L[L_PAR + 64 + c];
              cur = bf2f(pr[R_V + col]); prev = t > 0 ? bf2f(pr[R_V + col - PS]) : 0.f; vs[i] = cur + (prev - cur) * L[L_PAR + 128 + c];
              wl[i] = L[L_PAR + 192 + c]; al[i] = L[L_PAR + 256 + c]; gg[i] = 0.f; }
#pragma unroll 2
          for (int j = 0; j < 32; ++j) { const float w = L[L_W2 + j * 64 + c], aa = L[L_A2 + j * 64 + c];
#pragma unroll
              for (int i = 0; i < 4; ++i) { wl[i] += L[L_LORA + (tg * 4 + i) * 160 + j] * w; al[i] += L[L_LORA + (tg * 4 + i) * 160 + 32 + j] * aa; } }
#pragma unroll 2
          for (int j = 0; j < 96; ++j) { const float g_ = L[L_G2 + j * 64 + c];
#pragma unroll
              for (int i = 0; i < 4; ++i) gg[i] += L[L_LORA + (tg * 4 + i) * 160 + 64 + j] * g_; }
#pragma unroll
          for (int i = 0; i < 4; ++i) { const int tok = tg * 4 + i;
              const float wlog = fminf(wl[i], 0.f) - log1pf(expf(-fabsf(wl[i]))) - 0.5f; const float decay = expf(-expf(wlog));
              const float av = 1.f / (1.f + expf(-al[i]));
              const float kkr = ks[i] * L[L_PAR + 320 + c]; const float ss = wave_sum(kkr * kkr); const float kkn = kkr / fmaxf(sqrtf(ss), 1e-12f);
              const float k2 = ks[i] * (1.f + (av - 1.f) * L[L_PAR + 384 + c]);
              const float bon = wave_sum(rs[i] * k2 * L[L_PAR + 448 + c]);
              const int o = L_VEC + tok * 64 + c;
              L[o] = rs[i]; L[o + 2048] = decay; L[o + 4096] = k2; L[o + 6144] = vs[i]; L[o + 8192] = -kkn; L[o + 10240] = kkn * av; L[o + 12288] = gg[i];
              if (c == 0) L[L_BON + tok] = bon; } }
        __syncthreads();
        { const int i = tid >> 3, jq = tid & 7;
#pragma unroll 1
          for (int tok = 0; tok < 32; ++tok) { const int base = L_VEC + tok * 64 + jq * 8;
              const f32x4 r0 = *(const LAS f32x4*)&L[base], r1 = *(const LAS f32x4*)&L[base + 4];
              const f32x4 w0v = *(const LAS f32x4*)&L[base + 2048], w1v = *(const LAS f32x4*)&L[base + 2052];
              const f32x4 k0v = *(const LAS f32x4*)&L[base + 4096], k1v = *(const LAS f32x4*)&L[base + 4100];
              const f32x4 a0v = *(const LAS f32x4*)&L[base + 8192], a1v = *(const LAS f32x4*)&L[base + 8196];
              const f32x4 b0v = *(const LAS f32x4*)&L[base + 10240], b1v = *(const LAS f32x4*)&L[base + 10244];
              const float vi = L[L_VEC + 6144 + tok * 64 + i];
              float sa = 0.f;
#pragma unroll
              for (int e = 0; e < 4; ++e) { sa += S[e] * a0v[e]; sa += S[4 + e] * a1v[e]; }
              sa += __shfl_xor(sa, 1); sa += __shfl_xor(sa, 2); sa += __shfl_xor(sa, 4);
              float y = 0.f;
#pragma unroll
              for (int e = 0; e < 4; ++e) { S[e] = S[e] * w0v[e] + sa * b0v[e] + vi * k0v[e]; S[4 + e] = S[4 + e] * w1v[e] + sa * b1v[e] + vi * k1v[e]; y += S[e] * r0[e]; y += S[4 + e] * r1[e]; }
              y += __shfl_xor(y, 1); y += __shfl_xor(y, 2); y += __shfl_xor(y, 4);
              if (jq == 0) L[L_Y + tok * 64 + i] = y; } }
        __syncthreads();
        { const int c = lane, tg = wave, col = h * 64 + c;
#pragma unroll
          for (int i = 0; i < 4; ++i) { const int tok = tg * 4 + i, t = t0 + tok; const float y = L[L_Y + tok * 64 + c];
              const float mean = wave_sum(y) * (1.f / 64.f); const float d = y - mean; const float var = wave_sum(d * d) * (1.f / 64.f);
              const float yn = d * (1.f / sqrtf(var + 64e-5f)) * L[L_PAR + 512 + c] + L[L_PAR + 576 + c];
              const float o = (yn + L[L_BON + tok] * L[L_VEC + 6144 + tok * 64 + c]) * L[L_VEC + 12288 + tok * 64 + c];
              CAT[(row0 + t) * 1024 + 512 + col] = (bf16)f2bf(o); } }
    }
    __syncthreads();
}
constexpr int LG_W2 = 0, LG_B = 1024, LG_NG = 1088, LG_GAL = 1216, LG_Q = 1728, LG_K = 3776, LG_A = 5824, LG_V = 7872, LG_O = 11968;
__device__ __forceinline__ void gla_unit(const Args& a, LAS float* L, int unit, int i2, const bf16* P, bf16* CAT, int tid) {
    constexpr int PS = EVEN_PAD;
    const int b = unit >> 2, h = unit & 3, lane = tid & 63, wave = __builtin_amdgcn_readfirstlane(tid >> 6);
    const float* w2 = a.in[2] + i2 * 16 * 256; const float* ab = a.in[3] + i2 * 256; const float* ng = a.in[4] + i2 * 128;
    for (int idx = tid; idx < 1024; idx += 512) { const int j = idx >> 6, d = idx & 63; L[LG_W2 + idx] = w2[j * 256 + h * 64 + d]; }
    if (tid < 64) L[LG_B + tid] = ab[h * 64 + tid];
    if (tid < 128) L[LG_NG + tid] = ng[tid];
    float S[64];
#pragma unroll
    for (int d = 0; d < 64; ++d) S[d] = 0.f;
    __syncthreads();
    const size_t row0 = (size_t)b * 2048;
    for (int t0 = 0; t0 < 2048; t0 += 32) {
        { const int tok = tid >> 4, j = tid & 15; L[LG_GAL + tid] = bf2f(P[(row0 + t0 + tok) * PS + G_AL + j]); }
        for (int idx = tid; idx < 32 * 64; idx += 512) { const int tok = idx >> 6, d = idx & 63; const bf16* pr = P + (row0 + t0 + tok) * PS;
            L[LG_Q + idx] = bf2f(pr[G_Q + h * 64 + d]) * 0.125f; L[LG_K + idx] = bf2f(pr[G_K + h * 64 + d]); }
        for (int idx = tid; idx < 32 * 128; idx += 512) { const int tok = idx >> 7, e = idx & 127; L[LG_V + idx] = bf2f(P[(row0 + t0 + tok) * PS + G_V + h * 128 + e]); }
        __syncthreads();
        for (int idx = tid; idx < 32 * 64; idx += 512) { const int tok = idx >> 6, d = idx & 63; float la = L[LG_B + d];
#pragma unroll
            for (int j = 0; j < 16; ++j) la += L[LG_GAL + tok * 16 + j] * L[LG_W2 + j * 64 + d];
            const float ls = fminf(la, 0.f) - log1pf(expf(-fabsf(la))); L[LG_A + idx] = expf(ls * (1.f / 16.f)); }
        __syncthreads();
        if (tid < 128) { const int e = tid;
#pragma unroll 1
            for (int tok = 0; tok < 32; ++tok) { const float ve = L[LG_V + tok * 128 + e]; float o = 0.f;
#pragma unroll
                for (int d4 = 0; d4 < 16; ++d4) { const f32x4 av = *(const LAS f32x4*)&L[LG_A + tok * 64 + d4 * 4], kv = *(const LAS f32x4*)&L[LG_K + tok * 64 + d4 * 4], qv = *(const LAS f32x4*)&L[LG_Q + tok * 64 + d4 * 4];
#pragma unroll
                    for (int u = 0; u < 4; ++u) { S[d4 * 4 + u] = av[u] * S[d4 * 4 + u] + kv[u] * ve; o += qv[u] * S[d4 * 4 + u]; } }
                L[LG_O + tok * 128 + e] = o; } }
        __syncthreads();
#pragma unroll
        for (int i = 0; i < 4; ++i) { const int tok = wave * 4 + i; const size_t row = row0 + t0 + tok; const float o0 = L[LG_O + tok * 128 + lane], o1 = L[LG_O + tok * 128 + 64 + lane];
            const float ms = wave_sum(o0 * o0 + o1 * o1) * (1.f / 128.f); const float r = 1.f / sqrtf(ms + LN_EPS);
            const bf16* pr = P + row * PS + G_G + h * 128; const float g0 = bf2f(pr[lane]), g1 = bf2f(pr[64 + lane]);
            CAT[row * 1024 + h * 128 + lane] = (bf16)f2bf(o0 * r * L[LG_NG + lane] * (g0 / (1.f + expf(-g0))));
            CAT[row * 1024 + h * 128 + 64 + lane] = (bf16)f2bf(o1 * r * L[LG_NG + 64 + lane] * (g1 / (1.f + expf(-g1)))); }
    }
    __syncthreads();
}

__device__ __forceinline__ void ph_rope(const Args& a, int gtid, int NT) {
    bf16* P = (bf16*)(a.ws + WS_P);
    const float* cosA = (const float*)(a.ws + WS_COSA); const float* sinA = (const float*)(a.ws + WS_SINA);
    const float* cosI = (const float*)(a.ws + WS_COSI); const float* sinI = (const float*)(a.ws + WS_SINI);
    for (size_t it = gtid; it < (size_t)MTOK * 108; it += NT) {
        const size_t row = it / 108; int r = (int)(it - row * 108); const int t = (int)(row & 2047);
        int col, half; const float* ct; const float* st;
        if (r < 72) { const int vec = r >> 3, grp = r & 7; col = (vec < 8 ? O_Q + vec * 128 : O_K) + grp * 8; half = 64; ct = cosA + t * 64 + grp * 8; st = sinA + t * 64 + grp * 8; }
        else { r -= 72; const int vec = r >> 2, grp = r & 3; col = (vec < 8 ? O_QI + vec * 64 : O_KI) + grp * 8; half = 32; ct = cosI + t * 32 + grp * 8; st = sinI + t * 32 + grp * 8; }
        u32x4* p1 = (u32x4*)(P + row * ODD_PAD + col); u32x4* p2 = (u32x4*)(P + row * ODD_PAD + col + half);
        const u32x4 x1 = *p1, x2 = *p2; const f32x4 c0 = *(const f32x4*)ct, c1 = *(const f32x4*)(ct + 4), s0 = *(const f32x4*)st, s1 = *(const f32x4*)(st + 4);
        u32x4 o1, o2;
#define ROPE2(W, CA, SA, CB, SB) { const float a1 = bflo(x1.W), a2 = bflo(x2.W), b1 = bfhi(x1.W), b2 = bfhi(x2.W); \
            o1.W = pk2(a1 * (CA) - a2 * (SA), b1 * (CB) - b2 * (SB)); o2.W = pk2(a2 * (CA) + a1 * (SA), b2 * (CB) + b1 * (SB)); }
        ROPE2(x, c0.x, s0.x, c0.y, s0.y) ROPE2(y, c0.z, s0.z, c0.w, s0.w) ROPE2(z, c1.x, s1.x, c1.y, s1.y) ROPE2(w, c1.z, s1.z, c1.w, s1.w)
#undef ROPE2
        *p1 = o1; *p2 = o2;
    }
    bf16* VT = (bf16*)(a.ws + WS_VT);
    for (int it = gtid; it < MTOK / 8 * 128; it += NT) { const int d = it & 127, tg = it >> 7; const size_t row = (size_t)tg * 8; const int b = (int)(row >> 11), t = (int)(row & 2047);
        const bf16* src = P + row * ODD_PAD + O_V + d; u32x4 o;
        o.x = (unsigned)src[0] | ((unsigned)src[ODD_PAD] << 16); o.y = (unsigned)src[2 * ODD_PAD] | ((unsigned)src[3 * ODD_PAD] << 16);
        o.z = (unsigned)src[4 * ODD_PAD] | ((unsigned)src[5 * ODD_PAD] << 16); o.w = (unsigned)src[6 * ODD_PAD] | ((unsigned)src[7 * ODD_PAD] << 16);
        *(u32x4*)(VT + ((size_t)b * 128 + d) * 2048 + t) = o; }
}
__device__ __forceinline__ unsigned sortable_key(float s) { unsigned u = __float_as_uint(s); if ((u << 1) == 0u) u = 0u; return (u & 0x80000000u) ? ~u : (u | 0x80000000u); }
__device__ __forceinline__ void ph_indexer(const Args& a, LAS unsigned char* lds, int gw, int NGW, int wave, int lane) {
    const bf16* P = (const bf16*)(a.ws + WS_P); unsigned* MASK = (unsigned*)(a.ws + WS_MASK);
    LAS float* qs = (LAS float*)(lds + wave * 10496); LAS unsigned* kl = (LAS unsigned*)(lds + wave * 10496 + 2304);
    for (int m = gw; m < MTOK; m += NGW) {
        const int b = m >> 11, t = m & 2047; const bf16* prow = P + (size_t)m * ODD_PAD;
        { const u32x4 v = *(const u32x4*)(prow + O_QI + lane * 8);
          *(LAS f32x4*)&qs[lane * 8] = (f32x4){bflo(v.x), bfhi(v.x), bflo(v.y), bfhi(v.y)}; *(LAS f32x4*)&qs[lane * 8 + 4] = (f32x4){bflo(v.z), bfhi(v.z), bflo(v.w), bfhi(v.w)}; }
        if (lane < 8) qs[512 + lane] = bf2f(prow[O_WI + lane]) * 0.04419417382415922f;
        LDS_WAIT();
        const int nblk = (t >> 6) + 1;
#pragma unroll 1
        for (int i = 0; i < nblk; ++i) { const int s = i * 64 + lane; unsigned key = 0u;
            if (s <= t) { const u32x4* kr = (const u32x4*)(P + ((size_t)b * 2048 + s) * ODD_PAD + O_KI);
                float kf[64];
#pragma unroll
                for (int q = 0; q < 8; ++q) { const u32x4 v = kr[q]; kf[q * 8 + 0] = bflo(v.x); kf[q * 8 + 1] = bfhi(v.x); kf[q * 8 + 2] = bflo(v.y); kf[q * 8 + 3] = bfhi(v.y); kf[q * 8 + 4] = bflo(v.z); kf[q * 8 + 5] = bfhi(v.z); kf[q * 8 + 6] = bflo(v.w); kf[q * 8 + 7] = bfhi(v.w); }
                float sc = 0.f;
#pragma unroll 1
                for (int h = 0; h < 8; ++h) { float acc = 0.f;
#pragma unroll
                    for (int d4 = 0; d4 < 16; ++d4) { const f32x4 qv = *(const LAS f32x4*)&qs[h * 64 + d4 * 4]; acc += qv.x * kf[d4 * 4] + qv.y * kf[d4 * 4 + 1] + qv.z * kf[d4 * 4 + 2] + qv.w * kf[d4 * 4 + 3]; }
                    sc += qs[512 + h] * fmaxf(acc, 0.f); }
                key = sortable_key(sc); }
            kl[i * 64 + lane] = key; }
        LDS_WAIT();
        unsigned k[32];
#pragma unroll
        for (int i = 0; i < 32; ++i) k[i] = (i < nblk) ? kl[i * 64 + lane] : 0u;
        unsigned T = 0u;
        for (int bit = 31; bit >= 0; --bit) { const unsigned cand = T | (1u << bit); int cnt = 0;
#pragma unroll
            for (int i = 0; i < 32; ++i) cnt += (k[i] >= cand) ? 1 : 0;
            cnt = wave_sum_i(cnt); if (cnt >= 256) T = cand; }
        int cgt = 0;
#pragma unroll
        for (int i = 0; i < 32; ++i) cgt += (k[i] > T) ? 1 : 0;
        cgt = wave_sum_i(cgt);
        const int need = 256 - cgt; int run = 0; unsigned myw = 0u;
#pragma unroll
        for (int i = 0; i < 32; ++i) { const bool gt = k[i] > T, eq = (k[i] == T) && (T != 0u);
            const unsigned long long bal = __ballot(eq); const int pre = __builtin_amdgcn_mbcnt_hi((unsigned)(bal >> 32), __builtin_amdgcn_mbcnt_lo((unsigned)bal, 0u));
            const bool sel = gt || (eq && (run + pre < need)); run += __popcll(bal);
            const unsigned long long sb = __ballot(sel);
            if (lane == 2 * i) myw = (unsigned)sb; if (lane == 2 * i + 1) myw = (unsigned)(sb >> 32); }
        MASK[(size_t)m * 64 + lane] = myw;
    }
}
__device__ __forceinline__ void ph_attention(const Args& a, LAS unsigned char* lds, int gw, int NGW, int wave, int lane) {
    const bf16* P = (const bf16*)(a.ws + WS_P); const unsigned* MASK = (const unsigned*)(a.ws + WS_MASK); bf16* CAT = (bf16*)(a.ws + WS_CAT);
    LAS unsigned short* sel = (LAS unsigned short*)(lds + wave * 4096); LAS float* qh = (LAS float*)(lds + wave * 4096 + 512); LAS float* pp = (LAS float*)(lds + wave * 4096 + 1024);
    for (int m = gw; m < MTOK; m += NGW) {
        const int b = m >> 11; const bf16* prow = P + (size_t)m * ODD_PAD; const bf16* pb = P + (size_t)b * 2048 * ODD_PAD;
        unsigned word = MASK[(size_t)m * 64 + lane]; const int cnt = __popc(word); int x = cnt;
#pragma unroll
        for (int o = 1; o < 64; o <<= 1) { const int y = __shfl_up(x, o); if (lane >= o) x += y; }
        const int nsel = __shfl(x, 63); int pos = x - cnt;
        while (word) { const int bpos = __builtin_ctz(word); word &= word - 1u; sel[pos++] = (unsigned short)(lane * 32 + bpos); }
        LDS_WAIT();
        for (int h = 0; h < 8; ++h) {
            qh[lane] = bf2f(prow[O_Q + h * 128 + lane]); qh[64 + lane] = bf2f(prow[O_Q + h * 128 + 64 + lane]);
            LDS_WAIT();
            float lg[4]; float mx = -3.0e38f;
#pragma unroll
            for (int jj = 0; jj < 4; ++jj) { const int j = lane + 64 * jj; lg[jj] = -3.0e38f;
                if (j < nsel) { const u32x4* kr = (const u32x4*)(pb + (size_t)sel[j] * ODD_PAD + O_K); float acc = 0.f;
#pragma unroll
                    for (int q = 0; q < 16; ++q) { const u32x4 v = kr[q]; const f32x4 q0 = *(const LAS f32x4*)&qh[q * 8], q1 = *(const LAS f32x4*)&qh[q * 8 + 4];
                        acc += q0.x * bflo(v.x) + q0.y * bfhi(v.x) + q0.z * bflo(v.y) + q0.w * bfhi(v.y) + q1.x * bflo(v.z) + q1.y * bfhi(v.z) + q1.z * bflo(v.w) + q1.w * bfhi(v.w); }
                    lg[jj] = acc * 0.08838834764831845f; }
                mx = fmaxf(mx, lg[jj]); }
            mx = wave_max(mx); float sum = 0.f;
#pragma unroll
            for (int jj = 0; jj < 4; ++jj) { const int j = lane + 64 * jj; const float p = (j < nsel) ? expf(lg[jj] - mx) : 0.f; lg[jj] = p; sum += p; }
            sum = wave_sum(sum); const float inv = 1.f / sum;
#pragma unroll
            for (int jj = 0; jj < 4; ++jj) pp[lane + 64 * jj] = lg[jj] * inv;
            LDS_WAIT();
            float o0 = 0.f, o1 = 0.f;
            for (int j = 0; j < nsel; ++j) { const bf16* vr = pb + (size_t)sel[j] * ODD_PAD + O_V; const float p = pp[j]; o0 += p * bf2f(vr[lane]); o1 += p * bf2f(vr[64 + lane]); }
            CAT[(size_t)m * 1024 + h * 128 + lane] = (bf16)f2bf(o0); CAT[(size_t)m * 1024 + h * 128 + 64 + lane] = (bf16)f2bf(o1);
            LDS_WAIT();
        }
    }
}

__device__ __forceinline__ void ph_attention2(const Args& a, int bid, int G, int wave, int lane) {
    const bf16* P = (const bf16*)(a.ws + WS_P); const unsigned* MASK = (const unsigned*)(a.ws + WS_MASK); const bf16* VT = (const bf16*)(a.ws + WS_VT); bf16* CAT = (bf16*)(a.ws + WS_CAT);
    const int n = lane & 31, hi = lane >> 5, tl = n >> 3, head = n & 7;
    const float C = 0.12751743f;
    for (int it = bid; it < 2048; it += G) {
        const int j = it >> 8, r = it & 255, b = r >> 3, q8 = r & 7; const int qt = j * 8 + ((j & 1) ? 7 - q8 : q8);
        const int t0 = qt * 32 + wave * 4; const size_t rowbase = (size_t)b * 2048; const size_t m = rowbase + t0 + tl;
        bf16x8 qf[8];
        { const bf16* qp = P + m * ODD_PAD + O_Q + head * 128 + hi * 8;
#pragma unroll
          for (int ks = 0; ks < 8; ++ks) qf[ks] = *(const bf16x8*)(qp + ks * 16); }
        unsigned mw[4];
#pragma unroll
        for (int i = 0; i < 4; ++i) mw[i] = MASK[(rowbase + t0 + i) * 64 + lane];
        f32x16 o[4];
#pragma unroll
        for (int mt = 0; mt < 4; ++mt)
#pragma unroll
            for (int e = 0; e < 16; ++e) o[mt][e] = 0.f;
        float mrow = -1e30f, lrow = 0.f;
        const int ntile = ((t0 + 3) >> 5) + 1;
        bf16x8 kf[8];
        { const bf16* kp = P + (rowbase + n) * ODD_PAD + O_K + hi * 8;
#pragma unroll
          for (int ks = 0; ks < 8; ++ks) kf[ks] = *(const bf16x8*)(kp + ks * 16); }
#pragma unroll 1
        for (int kt = 0; kt < ntile; ++kt) {
            f32x16 s;
#pragma unroll
            for (int e = 0; e < 16; ++e) s[e] = 0.f;
#pragma unroll
            for (int ks = 0; ks < 8; ++ks) s = __builtin_amdgcn_mfma_f32_32x32x16_bf16(kf[ks], qf[ks], s, 0, 0, 0);
            if (kt + 1 < ntile) { const bf16* kp = P + (rowbase + (kt + 1) * 32 + n) * ODD_PAD + O_K + hi * 8;
#pragma unroll
                for (int ks = 0; ks < 8; ++ks) kf[ks] = *(const bf16x8*)(kp + ks * 16); }
            u32x2 vf[4][2][2];
            { const bf16* vp = VT + ((size_t)b * 128 + n) * 2048 + kt * 32 + 4 * hi;
#pragma unroll
              for (int mt = 0; mt < 4; ++mt)
#pragma unroll
                  for (int s2 = 0; s2 < 2; ++s2)
#pragma unroll
                      for (int ii = 0; ii < 2; ++ii) vf[mt][s2][ii] = *(const u32x2*)(vp + (size_t)mt * 32 * 2048 + 16 * s2 + 8 * ii); }
            const unsigned w0 = (unsigned)__builtin_amdgcn_readlane((int)mw[0], kt), w1 = (unsigned)__builtin_amdgcn_readlane((int)mw[1], kt), w2 = (unsigned)__builtin_amdgcn_readlane((int)mw[2], kt), w3 = (unsigned)__builtin_amdgcn_readlane((int)mw[3], kt);
            const unsigned word = (tl == 0 ? w0 : (tl == 1 ? w1 : (tl == 2 ? w2 : w3))) >> (4 * hi);
            float mx = -1e30f;
#pragma unroll
            for (int e = 0; e < 16; ++e) { const int key = (e & 3) + 8 * (e >> 2); if ((word >> key) & 1u) mx = fmaxf(mx, s[e]); }
            mx = fmaxf(mx, __shfl_xor(mx, 32));
            const float mnew = fmaxf(mrow, mx); const float alpha = __builtin_amdgcn_exp2f((mrow - mnew) * C); mrow = mnew;
            float psum = 0.f; float p[16];
#pragma unroll
            for (int e = 0; e < 16; ++e) { const int key = (e & 3) + 8 * (e >> 2); p[e] = ((word >> key) & 1u) ? __builtin_amdgcn_exp2f((s[e] - mnew) * C) : 0.f; psum += p[e]; }
            lrow = lrow * alpha + psum;
#pragma unroll
            for (int mt = 0; mt < 4; ++mt)
#pragma unroll
                for (int e = 0; e < 16; ++e) o[mt][e] *= alpha;
            bf16x8 pf[2];
#pragma unroll
            for (int s2 = 0; s2 < 2; ++s2) { u32x4 w; w.x = pk2(p[8 * s2 + 0], p[8 * s2 + 1]); w.y = pk2(p[8 * s2 + 2], p[8 * s2 + 3]); w.z = pk2(p[8 * s2 + 4], p[8 * s2 + 5]); w.w = pk2(p[8 * s2 + 6], p[8 * s2 + 7]); pf[s2] = __builtin_bit_cast(bf16x8, w); }
#pragma unroll
            for (int mt = 0; mt < 4; ++mt)
#pragma unroll
                for (int s2 = 0; s2 < 2; ++s2) { u32x4 w; w.x = vf[mt][s2][0].x; w.y = vf[mt][s2][0].y; w.z = vf[mt][s2][1].x; w.w = vf[mt][s2][1].y;
                    o[mt] = __builtin_amdgcn_mfma_f32_32x32x16_bf16(__builtin_bit_cast(bf16x8, w), pf[s2], o[mt], 0, 0, 0); }
        }
        const float l = lrow + __shfl_xor(lrow, 32); const float inv = 1.f / l;
        bf16* op = CAT + m * 1024 + head * 128 + 4 * hi;
#pragma unroll
        for (int mt = 0; mt < 4; ++mt)
#pragma unroll
            for (int i = 0; i < 4; ++i) { u32x2 w; w.x = pk2(o[mt][4 * i] * inv, o[mt][4 * i + 1] * inv); w.y = pk2(o[mt][4 * i + 2] * inv, o[mt][4 * i + 3] * inv); *(u32x2*)(op + 32 * mt + 8 * i) = w; }
    }
}

__device__ __forceinline__ void ph_ln1(const Args& a, int layer, int gw, int NGW, int lane) {
    const float* xin = (layer == 0) ? a.in[0] : a.out; const bf16* mix = (const bf16*)(a.ws + WS_MIX);
    const float* g = a.in[19] + layer * 1024; const float* bb = a.in[20] + layer * 1024; bf16* XB = (bf16*)(a.ws + WS_XB);
    f32x4 gv[4], bv[4];
#pragma unroll
    for (int j = 0; j < 4; ++j) { gv[j] = ((const f32x4*)g)[lane + 64 * j]; bv[j] = ((const f32x4*)bb)[lane + 64 * j]; }
    for (int m = gw; m < MTOK; m += NGW) {
        const f32x4* xr = (const f32x4*)(xin + (size_t)m * 1024) + lane; const u32x2* mr = (const u32x2*)(mix + (size_t)m * 1024) + lane;
        f32x4 v[4]; float s = 0.f;
#pragma unroll
        for (int j = 0; j < 4; ++j) { const u32x2 mw = mr[64 * j]; v[j] = xr[64 * j] * DN_ALPHA + (f32x4){bflo(mw.x), bfhi(mw.x), bflo(mw.y), bfhi(mw.y)}; s += (v[j].x + v[j].y) + (v[j].z + v[j].w); }
        const float mean = wave_sum(s) * (1.f / 1024.f); float s2 = 0.f;
#pragma unroll
        for (int j = 0; j < 4; ++j) { v[j] = v[j] - mean; s2 += (v[j].x * v[j].x + v[j].y * v[j].y) + (v[j].z * v[j].z + v[j].w * v[j].w); }
        const float rstd = 1.f / sqrtf(wave_sum(s2) * (1.f / 1024.f) + LN_EPS);
        f32x4* orow = (f32x4*)(a.out + (size_t)m * 1024) + lane; u32x2* ob = (u32x2*)(XB + (size_t)m * 1024) + lane;
#pragma unroll
        for (int j = 0; j < 4; ++j) { const f32x4 o = v[j] * rstd * gv[j] + bv[j]; orow[64 * j] = o; u32x2 w; w.x = pk2(o.x, o.y); w.y = pk2(o.z, o.w); ob[64 * j] = w; }
    }
}
__device__ __forceinline__ void wave_argmax(float& v, int& idx) {
#pragma unroll
    for (int o = 1; o < 64; o <<= 1) { const float ov = __shfl_xor(v, o); const int oi = __shfl_xor(idx, o); if (ov > v || (ov == v && oi < idx)) { v = ov; idx = oi; } }
}
__device__ __forceinline__ void ph_route(const Args& a, int layer, LAS unsigned char* lds, int gw, int NGW, int wave, int lane) {
    const bf16* Q = (const bf16*)(a.ws + WS_QP); const float* SK = a.in[22] + (size_t)layer * 8 * 2 * 128 * 64;
    unsigned short* RI = (unsigned short*)(a.ws + WS_RIDX); float* RG = (float*)(a.ws + WS_RGATE);
    LAS float* qh = (LAS float*)(lds + wave * 2048); LAS float* ts = (LAS float*)(lds + wave * 2048 + 512); LAS int* ti = (LAS int*)(lds + wave * 2048 + 640);
    const float NEG_INF = -__builtin_inff();
    for (int m = gw; m < MTOK; m += NGW) {
        for (int h = 0; h < 8; ++h) {
            qh[lane] = bf2f(Q[(size_t)m * 1024 + h * 128 + lane]); qh[64 + lane] = bf2f(Q[(size_t)m * 1024 + h * 128 + 64 + lane]);
            LDS_WAIT();
#pragma unroll
            for (int c = 0; c < 2; ++c) {
                float v0, v1;
                { const f32x4* k0 = (const f32x4*)(SK + ((size_t)(h * 2 + c) * 128 + lane) * 64); const f32x4* k1 = (const f32x4*)(SK + ((size_t)(h * 2 + c) * 128 + 64 + lane) * 64); float a0 = 0.f, a1 = 0.f;
#pragma unroll
                  for (int d4 = 0; d4 < 16; ++d4) { const f32x4 qv = *(const LAS f32x4*)&qh[c * 64 + d4 * 4]; const f32x4 x0 = k0[d4], x1 = k1[d4];
                      a0 += qv.x * x0.x + qv.y * x0.y + qv.z * x0.z + qv.w * x0.w; a1 += qv.x * x1.x + qv.y * x1.y + qv.z * x1.z + qv.w * x1.w; }
                  v0 = a0; v1 = a1; }
                for (int r = 0; r < 16; ++r) { float bv = v0; int bi = lane; if (v1 > v0) { bv = v1; bi = lane + 64; }
                    wave_argmax(bv, bi);
                    if (bi == lane) v0 = NEG_INF; if (bi == lane + 64) v1 = NEG_INF;
                    if (lane == 0) { ts[c * 16 + r] = bv; ti[c * 16 + r] = bi; } }
            }
            LDS_WAIT();
            float cv[4];
#pragma unroll
            for (int jj = 0; jj < 4; ++jj) { const int f = lane + 64 * jj; cv[jj] = ts[f >> 4] + ts[16 + (f & 15)]; }
            float bs = 0.f; int bpos = 0;
            for (int r = 0; r < 16; ++r) { float bv = cv[0]; int bi = lane;
#pragma unroll
                for (int jj = 1; jj < 4; ++jj) if (cv[jj] > bv) { bv = cv[jj]; bi = lane + 64 * jj; }
                wave_argmax(bv, bi);
#pragma unroll
                for (int jj = 0; jj < 4; ++jj) if (bi == lane + 64 * jj) cv[jj] = NEG_INF;
                if (lane == r) { bs = bv; bpos = bi; } }
            const float mx = __shfl(bs, 0); const float e = (lane < 16) ? expf(bs - mx) : 0.f; const float sum = wave_sum(e);
            if (lane < 16) { const int ei = ti[bpos >> 4] * 128 + ti[16 + (bpos & 15)]; RI[(size_t)m * 128 + h * 16 + lane] = (unsigned short)ei; RG[(size_t)m * 128 + h * 16 + lane] = e / sum; }
            LDS_WAIT();
        }
    }
}
__device__ __forceinline__ void ph_experts(const Args& a, int layer, int gw, int NGW, int lane) {
    const float* U = a.in[23] + (size_t)layer * 16384 * 1024; const float* V = a.in[24] + (size_t)layer * 16384 * 1024;
    const unsigned short* RI = (const unsigned short*)(a.ws + WS_RIDX); const float* RG = (const float*)(a.ws + WS_RGATE);
    const float* g = a.in[25] + layer * 1024; const float* bb = a.in[26] + layer * 1024; bf16* XB = (bf16*)(a.ws + WS_XB);
    for (int m = gw; m < MTOK; m += NGW) {
        f32x4 x[4], acc[4];
        const f32x4* xr = (const f32x4*)(a.out + (size_t)m * 1024) + lane;
#pragma unroll
        for (int j = 0; j < 4; ++j) { x[j] = xr[64 * j]; acc[j] = (f32x4){0.f, 0.f, 0.f, 0.f}; }
        for (int k = 0; k < 128; ++k) {
            const int e = RI[(size_t)m * 128 + k]; const float gate = RG[(size_t)m * 128 + k];
            const f32x4* ur = (const f32x4*)(U + (size_t)e * 1024) + lane; const f32x4* vr = (const f32x4*)(V + (size_t)e * 1024) + lane;
            f32x4 uv[4], vv[4];
#pragma unroll
            for (int j = 0; j < 4; ++j) { uv[j] = ur[64 * j]; vv[j] = vr[64 * j]; }
            float d = 0.f;
#pragma unroll
            for (int j = 0; j < 4; ++j) d += (x[j].x * uv[j].x + x[j].y * uv[j].y) + (x[j].z * uv[j].z + x[j].w * uv[j].w);
            d = wave_sum(d);
            const float coef = gate * 0.5f * d * (1.f + erff(d * 0.7071067811865476f));
#pragma unroll
            for (int j = 0; j < 4; ++j) acc[j] += vv[j] * coef;
        }
        float s = 0.f;
#pragma unroll
        for (int j = 0; j < 4; ++j) { acc[j] = x[j] * DN_ALPHA + acc[j]; s += (acc[j].x + acc[j].y) + (acc[j].z + acc[j].w); }
        const float mean = wave_sum(s) * (1.f / 1024.f); float s2 = 0.f;
#pragma unroll
        for (int j = 0; j < 4; ++j) { acc[j] = acc[j] - mean; s2 += (acc[j].x * acc[j].x + acc[j].y * acc[j].y) + (acc[j].z * acc[j].z + acc[j].w * acc[j].w); }
        const float rstd = 1.f / sqrtf(wave_sum(s2) * (1.f / 1024.f) + LN_EPS);
        f32x4* orow = (f32x4*)(a.out + (size_t)m * 1024) + lane; u32x2* ob = (u32x2*)(XB + (size_t)m * 1024) + lane;
#pragma unroll
        for (int j = 0; j < 4; ++j) { const f32x4 o = acc[j] * rstd * ((const f32x4*)g)[lane + 64 * j] + ((const f32x4*)bb)[lane + 64 * j]; orow[64 * j] = o; u32x2 w; w.x = pk2(o.x, o.y); w.y = pk2(o.z, o.w); ob[64 * j] = w; }
    }
}

__device__ __forceinline__ void cas_desc(int& x, int& y) { const int h = max(x, y), l = min(x, y); x = h; y = l; }
__device__ __forceinline__ void sort16_desc(int (&v)[16]) {
#pragma unroll
    for (int k = 2; k <= 16; k <<= 1)
#pragma unroll
        for (int j = k >> 1; j > 0; j >>= 1)
#pragma unroll
            for (int i = 0; i < 16; ++i) { const int l = i ^ j; if (l > i) { if ((i & k) == 0) cas_desc(v[i], v[l]); else cas_desc(v[l], v[i]); } }
}
__device__ __forceinline__ void merge16_desc(int (&v)[16]) {
#pragma unroll
    for (int j = 8; j > 0; j >>= 1)
#pragma unroll
        for (int i = 0; i < 16; ++i) { const int l = i ^ j; if (l > i) cas_desc(v[i], v[l]); }
}
__device__ __forceinline__ void topmerge16(int (&x)[16], const int (&y)[16]) {
#pragma unroll
    for (int i = 0; i < 16; ++i) x[i] = max(x[i], y[15 - i]);
    merge16_desc(x);
}
__device__ __forceinline__ int skey_of(float f) { const int u = __float_as_int(f); return u ^ ((u >> 31) & 0x7fffffff); }
__device__ __forceinline__ float f_of_skey(int s) { return __int_as_float(s ^ ((s >> 31) & 0x7fffffff)); }
__device__ __forceinline__ int packc(float f, int pos) { return (skey_of(f) & ~255) | (255 - pos); }
__device__ __forceinline__ void route_top128(const bf16* SKb, const bf16* qrow, int hi, int n, int (&L)[16]) {
    bf16x8 qf[4];
#pragma unroll
    for (int ks = 0; ks < 4; ++ks) qf[ks] = *(const bf16x8*)(qrow + ks * 16);
    f32x16 acc[4];
#pragma unroll
    for (int mt = 0; mt < 4; ++mt) {
#pragma unroll
        for (int e = 0; e < 16; ++e) acc[mt][e] = 0.f;
#pragma unroll
        for (int ks = 0; ks < 4; ++ks) { const bf16x8 af = *(const bf16x8*)(SKb + (size_t)(32 * mt + n) * 64 + ks * 16 + hi * 8); acc[mt] = __builtin_amdgcn_mfma_f32_32x32x16_bf16(af, qf[ks], acc[mt], 0, 0, 0); }
    }
    const int hx = 4 * hi;
#pragma unroll
    for (int mt = 0; mt < 4; ++mt) { int v[16];
#pragma unroll
        for (int r = 0; r < 16; ++r) { const int cst = 127 - (32 * mt + 8 * (r >> 2) + (r & 3)); v[r] = ((skey_of(acc[mt][r]) & ~127) | cst) ^ hx; }
        sort16_desc(v);
        if (mt == 0) {
#pragma unroll
            for (int r = 0; r < 16; ++r) L[r] = v[r]; }
        else topmerge16(L, v); }
    int o[16];
#pragma unroll
    for (int r = 0; r < 16; ++r) o[r] = __shfl_xor(L[r], 32);
    topmerge16(L, o);
}
__device__ __forceinline__ void ph_route2(const Args& a, int layer, LAS unsigned char* lds, int bid, int G, int wave, int lane) {
    const bf16* Q = (const bf16*)(a.ws + WS_QP); const bf16* SKb = (const bf16*)(a.ws + WS_SK) + (size_t)layer * 8 * 2 * 128 * 64 + (size_t)wave * 2 * 128 * 64;
    unsigned short* RI = (unsigned short*)(a.ws + WS_RIDX); float* RG = (float*)(a.ws + WS_RGATE);
    LAS unsigned char* lk = lds + wave * 2048 + lane * 32;
    const int n = lane & 31, hi = lane >> 5, h = wave;
    for (int tile = bid; tile < MTOK / 32; tile += G) {
        const size_t tok = (size_t)tile * 32 + n; const bf16* qrow = Q + tok * 1024 + h * 128 + hi * 8;
        int A[16], B[16];
        route_top128(SKb, qrow, hi, n, A);
        route_top128(SKb + 128 * 64, qrow + 64, hi, n, B);
        float fa[16], fb[16];
#pragma unroll
        for (int i = 0; i < 16; ++i) { fa[i] = f_of_skey(A[i] & ~127); fb[i] = f_of_skey(B[i] & ~127); }
        { unsigned wa[4], wb[4];
#pragma unroll
          for (int q = 0; q < 4; ++q) { wa[q] = 0u; wb[q] = 0u;
#pragma unroll
              for (int e = 0; e < 4; ++e) { wa[q] |= (unsigned)(127 - (A[4 * q + e] & 127)) << (8 * e); wb[q] |= (unsigned)(127 - (B[4 * q + e] & 127)) << (8 * e); } }
#pragma unroll
          for (int q = 0; q < 4; ++q) { ((LAS unsigned*)lk)[q] = wa[q]; ((LAS unsigned*)lk)[4 + q] = wb[q]; } }
        int T[16], S1[16], S2[16], S3[16];
#pragma unroll
        for (int j = 0; j < 16; ++j) T[j] = packc(fa[0] + fb[j], j);
#pragma unroll
        for (int j = 0; j < 8; ++j) { S1[j] = packc(fa[1] + fb[j], 16 + j); S1[15 - j] = packc(fa[8 + j] + fb[0], (8 + j) * 16); }
        merge16_desc(S1);
        S2[0] = packc(fa[2] + fb[0], 32); S2[1] = packc(fa[2] + fb[1], 33); S2[2] = packc(fa[2] + fb[2], 34); S2[3] = packc(fa[2] + fb[3], 35); S2[4] = packc(fa[2] + fb[4], 36);
        S2[5] = packc(fa[3] + fb[0], 48); S2[6] = packc(fa[3] + fb[1], 49); S2[7] = packc(fa[3] + fb[2], 50); S2[8] = packc(fa[3] + fb[3], 51);
        S2[9] = packc(fa[4] + fb[0], 64); S2[10] = packc(fa[4] + fb[1], 65); S2[11] = packc(fa[4] + fb[2], 66);
        S2[12] = packc(fa[5] + fb[0], 80); S2[13] = packc(fa[5] + fb[1], 81); S2[14] = packc(fa[6] + fb[0], 96); S2[15] = packc(fa[6] + fb[1], 97);
        sort16_desc(S2);
        S3[0] = packc(fa[7] + fb[0], 112); S3[1] = packc(fa[7] + fb[1], 113);
#pragma unroll
        for (int j = 2; j < 16; ++j) S3[j] = (int)0x80000000;
        topmerge16(T, S1); topmerge16(T, S2); topmerge16(T, S3);
        LDS_WAIT();
        float ev[16]; float sum = 0.f; const float mx = f_of_skey(T[0] & ~255);
#pragma unroll
        for (int r = 0; r < 16; ++r) { ev[r] = expf(f_of_skey(T[r] & ~255) - mx); sum += ev[r]; }
        const float inv = 1.f / sum;
        unsigned ei[16];
#pragma unroll
        for (int r = 0; r < 16; ++r) { const int pos = 255 - (T[r] & 255); ei[r] = (unsigned)lk[pos >> 4] * 128u + (unsigned)lk[16 + (pos & 15)]; }
        unsigned short* ri = RI + tok * 128 + h * 16 + hi * 8; float* rg = RG + tok * 128 + h * 16 + hi * 8;
        u32x4 wi; f32x4 g0, g1;
        if (hi == 0) { wi.x = ei[0] | (ei[1] << 16); wi.y = ei[2] | (ei[3] << 16); wi.z = ei[4] | (ei[5] << 16); wi.w = ei[6] | (ei[7] << 16); g0 = (f32x4){ev[0], ev[1], ev[2], ev[3]}; g1 = (f32x4){ev[4], ev[5], ev[6], ev[7]}; }
        else { wi.x = ei[8] | (ei[9] << 16); wi.y = ei[10] | (ei[11] << 16); wi.z = ei[12] | (ei[13] << 16); wi.w = ei[14] | (ei[15] << 16); g0 = (f32x4){ev[8], ev[9], ev[10], ev[11]}; g1 = (f32x4){ev[12], ev[13], ev[14], ev[15]}; }
        *(u32x4*)ri = wi; *(f32x4*)rg = g0 * inv; *(f32x4*)(rg + 4) = g1 * inv;
        LDS_WAIT();
    }
}

__device__ __forceinline__ void convert_experts(const Args& a, int layer, int gtid, int NT) {
    const f32x4* U = (const f32x4*)(a.in[23] + (size_t)layer * 16384 * 1024); const f32x4* V = (const f32x4*)(a.in[24] + (size_t)layer * 16384 * 1024);
    u32x4* DU = (u32x4*)(a.ws + WS_EXP); u32x4* DV = DU + (size_t)16384 * 1024 / 8;
    for (size_t i = gtid; i < (size_t)16384 * 1024 / 8; i += NT) {
        const f32x4 a0 = U[2 * i], a1 = U[2 * i + 1], b0 = V[2 * i], b1 = V[2 * i + 1];
        u32x4 o; o.x = pk2(a0.x, a0.y); o.y = pk2(a0.z, a0.w); o.z = pk2(a1.x, a1.y); o.w = pk2(a1.z, a1.w); DU[i] = o;
        u32x4 p; p.x = pk2(b0.x, b0.y); p.y = pk2(b0.z, b0.w); p.z = pk2(b1.x, b1.y); p.w = pk2(b1.z, b1.w); DV[i] = p; }
}
__device__ __forceinline__ float dot8(const f32x4 xa, const f32x4 xb, const u32x4 w) {
    return (xa.x * bflo(w.x) + xa.y * bfhi(w.x)) + (xa.z * bflo(w.y) + xa.w * bfhi(w.y)) + (xb.x * bflo(w.z) + xb.y * bfhi(w.z)) + (xb.z * bflo(w.w) + xb.w * bfhi(w.w));
}
__device__ __forceinline__ void axpy8(f32x4& aa, f32x4& ab, const float c, const u32x4 w) {
    aa.x += c * bflo(w.x); aa.y += c * bfhi(w.x); aa.z += c * bflo(w.y); aa.w += c * bfhi(w.y); ab.x += c * bflo(w.z); ab.y += c * bfhi(w.z); ab.z += c * bflo(w.w); ab.w += c * bfhi(w.w);
}
__device__ __forceinline__ float gelu_exact(float d) { return 0.5f * d * (1.f + erff(d * 0.7071067811865476f)); }
__device__ __forceinline__ void ph_experts2(const Args& a, int layer, int gw, int NGW, int lane, float* OUTP, bf16* XBP) {
    const bf16* U = (const bf16*)(a.ws + WS_EXP); const bf16* V = U + (size_t)16384 * 1024;
    const unsigned short* RI = (const unsigned short*)(a.ws + WS_RIDX); const float* RG = (const float*)(a.ws + WS_RGATE);
    const float* g = a.in[25] + layer * 1024; const float* bb = a.in[26] + layer * 1024; bf16* XB = XBP;
    for (int m = gw; m < MTOK; m += NGW) {
        const f32x4* xr = (const f32x4*)(a.out + (size_t)m * 1024);
        const f32x4 x0 = xr[2 * lane], x1 = xr[2 * lane + 1], x2 = xr[128 + 2 * lane], x3 = xr[128 + 2 * lane + 1];
        const unsigned idxp = ((const unsigned*)(RI + (size_t)m * 128))[lane];
        const float gp0 = RG[(size_t)m * 128 + 2 * lane], gp1 = RG[(size_t)m * 128 + 2 * lane + 1];
        f32x4 c0 = {0.f, 0.f, 0.f, 0.f}, c1 = c0, c2 = c0, c3 = c0;
        u32x4 Au0a, Au0b, Av0a, Av0b, Au1a, Au1b, Av1a, Av1b, Bu0a, Bu0b, Bv0a, Bv0b, Bu1a, Bu1b, Bv1a, Bv1b;
#define LOADG(X, gg) { const unsigned word = (unsigned)__builtin_amdgcn_readlane((int)idxp, (gg)); const unsigned e0 = word & 0xffffu, e1 = word >> 16; \
        const u32x4* pu0 = (const u32x4*)(U + (size_t)e0 * 1024) + lane; const u32x4* pv0 = (const u32x4*)(V + (size_t)e0 * 1024) + lane; \
        const u32x4* pu1 = (const u32x4*)(U + (size_t)e1 * 1024) + lane; const u32x4* pv1 = (const u32x4*)(V + (size_t)e1 * 1024) + lane; \
        X##u0a = pu0[0]; X##u0b = pu0[64]; X##u1a = pu1[0]; X##u1b = pu1[64]; X##v0a = pv0[0]; X##v0b = pv0[64]; X##v1a = pv1[0]; X##v1b = pv1[64]; }
#define COMPG(X, gg) { float d0 = dot8(x0, x1, X##u0a) + dot8(x2, x3, X##u0b), d1 = dot8(x0, x1, X##u1a) + dot8(x2, x3, X##u1b); \
        d0 = wave_sum(d0); d1 = wave_sum(d1); \
        const float k0 = __builtin_bit_cast(float, __builtin_amdgcn_readlane(__builtin_bit_cast(int, gp0), (gg))) * gelu_exact(d0); \
        const float k1 = __builtin_bit_cast(float, __builtin_amdgcn_readlane(__builtin_bit_cast(int, gp1), (gg))) * gelu_exact(d1); \
        axpy8(c0, c1, k0, X##v0a); axpy8(c2, c3, k0, X##v0b); axpy8(c0, c1, k1, X##v1a); axpy8(c2, c3, k1, X##v1b); }
        LOADG(A, 0) LOADG(B, 1)
#pragma unroll 1
        for (int gg = 0; gg < 64; gg += 2) {
            COMPG(A, gg) if (gg + 2 < 64) LOADG(A, gg + 2)
            COMPG(B, gg + 1) if (gg + 3 < 64) LOADG(B, gg + 3)
        }
#undef LOADG
#undef COMPG
        float s = 0.f;
        c0 = x0 * DN_ALPHA + c0; c1 = x1 * DN_ALPHA + c1; c2 = x2 * DN_ALPHA + c2; c3 = x3 * DN_ALPHA + c3;
        s = ((c0.x + c0.y) + (c0.z + c0.w)) + ((c1.x + c1.y) + (c1.z + c1.w)) + ((c2.x + c2.y) + (c2.z + c2.w)) + ((c3.x + c3.y) + (c3.z + c3.w));
        const float mean = wave_sum(s) * (1.f / 1024.f);
        c0 = c0 - mean; c1 = c1 - mean; c2 = c2 - mean; c3 = c3 - mean;
        const float s2 = ((c0.x * c0.x + c0.y * c0.y) + (c0.z * c0.z + c0.w * c0.w)) + ((c1.x * c1.x + c1.y * c1.y) + (c1.z * c1.z + c1.w * c1.w)) + ((c2.x * c2.x + c2.y * c2.y) + (c2.z * c2.z + c2.w * c2.w)) + ((c3.x * c3.x + c3.y * c3.y) + (c3.z * c3.z + c3.w * c3.w));
        const float rstd = 1.f / sqrtf(wave_sum(s2) * (1.f / 1024.f) + LN_EPS);
        const f32x4* g4 = (const f32x4*)g; const f32x4* b4 = (const f32x4*)bb;
        const f32x4 o0 = c0 * rstd * g4[2 * lane] + b4[2 * lane], o1 = c1 * rstd * g4[2 * lane + 1] + b4[2 * lane + 1], o2 = c2 * rstd * g4[128 + 2 * lane] + b4[128 + 2 * lane], o3 = c3 * rstd * g4[128 + 2 * lane + 1] + b4[128 + 2 * lane + 1];
        f32x4* orow = (f32x4*)(OUTP + (size_t)m * 1024);
        orow[2 * lane] = o0; orow[2 * lane + 1] = o1; orow[128 + 2 * lane] = o2; orow[128 + 2 * lane + 1] = o3;
        u32x4* ob = (u32x4*)(XB + (size_t)m * 1024);
        u32x4 w0; w0.x = pk2(o0.x, o0.y); w0.y = pk2(o0.z, o0.w); w0.z = pk2(o1.x, o1.y); w0.w = pk2(o1.z, o1.w); ob[lane] = w0;
        u32x4 w1; w1.x = pk2(o2.x, o2.y); w1.y = pk2(o2.z, o2.w); w1.z = pk2(o3.x, o3.y); w1.w = pk2(o3.z, o3.w); ob[64 + lane] = w1;
    }
}

constexpr int NPHASE = 1 + 9 * DEPTH;
__global__ void __launch_bounds__(512, 2) mk_fwd(Args args) {
    extern __shared__ __attribute__((aligned(16))) unsigned char lds_raw[];
    LAS unsigned char* lds = (LAS unsigned char*)lds_raw;
    const int tid = threadIdx.x;
    const int G = gridDim.x, bid = blockIdx.x, NGW = G * 8;
    unsigned char* ws = args.ws;
    for (int u = tid; u < (LDS_BYTES - LDSCTL_OFF) / 4; u += 512) ((LAS unsigned*)(lds + LDSCTL_OFF))[u] = 0u;
    __syncthreads();
    const int lo = args.ph_lo, hi = args.ph_hi;
    XcdBarrier bar; bar.bar = (unsigned*)(ws + WS_CTL) + CW_BAR; bar.x = 0; bar.st = nullptr;
    if (hi - lo > 1) bar = xcd_barrier_post((unsigned*)(ws + WS_CTL) + CW_BAR, (volatile LAS unsigned*)(lds + LDSCTL_OFF + 64));
#define IN(k) (lo <= (k) && (k) < hi)
#define SEAM(k) do { if ((k) + 1 < hi) xcd_barrier(bar); } while (0)
#ifndef SKIP_PRO
    if (IN(0)) { int lt = tid; asm volatile("" : "+v"(lt)); ph_prologue(args, lds, bid * 8 + __builtin_amdgcn_readfirstlane(lt >> 6), NGW, __builtin_amdgcn_readfirstlane(lt >> 6), lt & 63); SEAM(0); }
#endif
    for (int gi = 0; gi < 3 * DEPTH; ++gi) {
        const int layer = gi / 3, kind = gi - 3 * layer, pb = 1 + 9 * layer, i2 = layer >> 1; const bool odd = (layer & 1) != 0;
        const int pg = pb + (kind == 0 ? 0 : (kind == 1 ? 4 : 6));
        if (IN(pg)) {
            int lt = tid; asm volatile("" : "+v"(lt));
            int N = 1024; const bf16* A = (const bf16*)(ws + WS_XB); const bf16* W; bf16* O;
            if (kind == 0) { N = odd ? ODD_PAD : EVEN_PAD; W = odd ? (const bf16*)(ws + WS_WINO) + (size_t)i2 * ODD_PAD * 1024 : (const bf16*)(ws + WS_WINE) + (size_t)i2 * EVEN_PAD * 1024; O = (bf16*)(ws + WS_P); }
            else if (kind == 1) { A = (const bf16*)(ws + WS_CAT); W = (odd ? (const bf16*)(ws + WS_WOUTO) : (const bf16*)(ws + WS_WOUTE)) + (size_t)i2 * 1048576; O = (bf16*)(ws + WS_MIX); }
            else { W = (const bf16*)(ws + WS_WQ) + (size_t)layer * 1048576; O = (bf16*)(ws + WS_QP); }
            pg8::Gemm g{(const pg8::bf16_t*)A, (const pg8::bf16_t*)W, MTOK, N, 1024}; pg8::StaticOrder S; S.init(MTOK, N, G, bid);
            pg8::EpiBf16<0> E{(pg8::bf16_t*)O, N, nullptr, 0, 0, 1.f};
#ifdef REP_GEMM
            for (int rep = 0; rep < 2; ++rep)
#endif
            pg8::gemm_phase<pg8::EpiBf16<0>, pg8::StaticOrder, true, true>(lds, g, S, E, lt);
            SEAM(pg);
        }
        if (kind == 0) {
            if (!odd) {
                if (IN(pb + 1)) {
                    int lt = tid; asm volatile("" : "+v"(lt));
                    for (int it = bid; it < 384; it += G) {
#ifndef SKIP_RWKV
                        if (it < 256) rwkv_unit(args, (LAS float*)lds, it, i2, (const bf16*)(ws + WS_P), (bf16*)(ws + WS_CAT), lt);
#endif
#ifndef SKIP_GLA
                        if (it >= 256) gla_unit(args, (LAS float*)lds, it - 256, i2, (const bf16*)(ws + WS_P), (bf16*)(ws + WS_CAT), lt);
#endif
                    }
                    SEAM(pb + 1);
                }
            } else {
#ifndef SKIP_ROPE
                if (IN(pb + 1)) { int lt = tid; asm volatile("" : "+v"(lt)); ph_rope(args, bid * 512 + lt, NGW * 64); SEAM(pb + 1); }
#endif
#ifndef SKIP_IDX
                if (IN(pb + 2)) { int lt = tid; asm volatile("" : "+v"(lt)); ph_indexer(args, lds, bid * 8 + __builtin_amdgcn_readfirstlane(lt >> 6), NGW, __builtin_amdgcn_readfirstlane(lt >> 6), lt & 63); SEAM(pb + 2); }
#endif
#ifndef SKIP_ATT
                if (IN(pb + 3)) { int lt = tid; asm volatile("" : "+v"(lt)); ph_attention2(args, bid, G, __builtin_amdgcn_readfirstlane(lt >> 6), lt & 63); SEAM(pb + 3); }
#endif
            }
        } else if (kind == 1) {
#ifndef SKIP_LN1
            if (IN(pb + 5)) { int lt = tid; asm volatile("" : "+v"(lt)); ph_ln1(args, layer, bid * 8 + __builtin_amdgcn_readfirstlane(lt >> 6), NGW, lt & 63); SEAM(pb + 5); }
#endif
        } else {
#ifndef SKIP_ROUTE
            if (IN(pb + 7)) { int lt = tid; asm volatile("" : "+v"(lt)); convert_experts(args, layer, bid * 512 + lt, NGW * 64); ph_route2(args, layer, lds, bid, G, __builtin_amdgcn_readfirstlane(lt >> 6), lt & 63); SEAM(pb + 7); }
#endif
#ifndef SKIP_EXP
            if (IN(pb + 8)) { int lt = tid; asm volatile("" : "+v"(lt));
#ifdef REP_EXP
                ph_experts2(args, layer, bid * 8 + __builtin_amdgcn_readfirstlane(lt >> 6), NGW, lt & 63, (float*)(ws + WS_P), (bf16*)(ws + WS_CAT)); { int l2 = lt; asm volatile("" : "+v"(l2)); lt = l2; }
#endif
                ph_experts2(args, layer, bid * 8 + __builtin_amdgcn_readfirstlane(lt >> 6), NGW, lt & 63, args.out, (bf16*)(ws + WS_XB)); SEAM(pb + 8); }
#endif
        }
    }
#undef IN
#undef SEAM
}

#ifndef ONE_LAUNCH
#define ONE_LAUNCH 1
#endif
extern "C" void kernel_launch(void* const* d_in, const int* in_sizes, int n_in, void* d_out, int out_size, void* d_ws, size_t ws_size, hipStream_t stream) {
    static int grid = 0;
    if (grid == 0) {
        if (n_in != 27 || in_sizes[0] != MTOK * DM || out_size != MTOK * DM || ws_size < WS_END) { fprintf(stderr, "kernel_launch: unexpected shapes (n_in %d, ws %zu)\n", n_in, ws_size); grid = -1; return; }
        int dev = 0, cus = 0, per_cu = 0;
        if (hipGetDevice(&dev) != hipSuccess || hipDeviceGetAttribute(&cus, hipDeviceAttributeMultiprocessorCount, dev) != hipSuccess) { grid = -1; return; }
        if (hipFuncSetAttribute((const void*)mk_fwd, hipFuncAttributeMaxDynamicSharedMemorySize, LDS_BYTES) != hipSuccess) { grid = -1; return; }
        if (hipOccupancyMaxActiveBlocksPerMultiprocessor(&per_cu, (const void*)mk_fwd, 512, LDS_BYTES) != hipSuccess || per_cu < 1) fprintf(stderr, "kernel_launch: occupancy query says %d\n", per_cu);
        (void)hipGetLastError();
        grid = cus;
    }
    if (grid < 0) return;
    (void)hipMemsetAsync((char*)d_ws + WS_CTL, 0, CTL_ZERO_BYTES, stream);
    Args a{};
    for (int i = 0; i < 27; ++i) a.in[i] = (const float*)d_in[i];
    a.out = (float*)d_out; a.ws = (unsigned char*)d_ws;
#if ONE_LAUNCH
    a.ph_lo = 0; a.ph_hi = NPHASE;
    hipLaunchKernelGGL(mk_fwd, dim3(grid), dim3(512), LDS_BYTES, stream, a);
#else
    for (int k = 0; k < NPHASE; ++k) {
        if (k >= 1) { const int layer = (k - 1) / 9, r = (k - 1) % 9; if ((layer & 1) == 0 && (r == 2 || r == 3)) continue; }
        a.ph_lo = k; a.ph_hi = k + 1;
        hipLaunchKernelGGL(mk_fwd, dim3(grid), dim3(512), LDS_BYTES, stream, a);
    }
#endif
}
```

```cpp
#include <hip/hip_runtime.h>
#include <cstdio>
#include <cstdint>
namespace pg8 {
#define PG8_LAS __attribute__((address_space(3)))
typedef unsigned short bf16_t;
typedef short bf16x8 __attribute__((ext_vector_type(8)));
typedef float f32x4 __attribute__((ext_vector_type(4)));
typedef unsigned u32x4 __attribute__((ext_vector_type(4)));
constexpr int BM = 256, BK = 64, HALF = 128, HTB = HALF * BK * 2  , STAGE_BYTES = 8 * HTB, NXCD = 8, WGM = 8;

__host__ __device__ __forceinline__ int lds_byte(int r, int c) { const int st = (r >> 4) * 2 + (c >> 5), rr = r & 15, cc = c & 31, ob = rr * 64 + cc * 2; return st * 1024 + (ob ^ (((ob >> 9) & 1) << 5)); }
__host__ __device__ __forceinline__ void stage_rc(int b, int& R, int& C) { const int st = b / 1024, sb = b % 1024, swz = sb ^ (((sb >> 9) & 1) << 5); R = (st >> 1) * 16 + swz / 64; C = (st & 1) * 32 + (swz % 64) / 2; }
__host__ __device__ __forceinline__ int perm32(int rho) { const int n = rho >> 4, i = rho & 15; return 8 * (i >> 2) + 4 * n + (i & 3); }

struct Unit { int pm, pn; };
struct Gemm { const bf16_t* A; const bf16_t* Bt; int M, N, K; };

struct StaticOrder {
    int nM, nN, nwg, G, c;
    __host__ __device__ void init(int M, int N, int G_, int c_) { nM = M / BM; nN = N / BM; nwg = nM * nN; G = G_; c = c_; }
    __host__ __device__ bool next(int i, Unit& u) const {
        const long L = (long)i * G + c; if (L >= nwg) return false;
        int wgid = (int)L; { const int q = nwg / NXCD, r = nwg % NXCD, xcd = wgid % NXCD, off = wgid / NXCD; wgid = (xcd < r ? xcd * (q + 1) : r * (q + 1) + (xcd - r) * q) + off; }
        const int nig = WGM * nN, gid = wgid / nig, fm = gid * WGM, gsz = (nM - fm) < WGM ? (nM - fm) : WGM;
        u.pm = fm + ((wgid % nig) % gsz); u.pn = (wgid % nig) / gsz; return true;
    }
    __device__ __forceinline__ void a_ready(const Unit&) const {}
    __device__ __forceinline__ void done(const Unit&) const {}
};

__device__ __forceinline__ unsigned cvt_pk_bf16(float lo, float hi) { unsigned r; asm volatile("v_cvt_pk_bf16_f32 %0, %1, %2" : "=v"(r) : "v"(lo), "v"(hi)); return r; }
typedef float f32x2 __attribute__((ext_vector_type(2)));
__device__ __forceinline__ f32x2 gelu_pk(f32x2 v) {
    const f32x2 av = __builtin_elementwise_abs(v), d = av * 0.2316418882f + 1.0f;
    f32x2 t; t.x = __builtin_amdgcn_rcpf(d.x); t.y = __builtin_amdgcn_rcpf(d.y);
    f32x2 q = t * 0.5307027145f + (-0.7265760135f); q = q * t + 0.7107068705f; q = q * t + (-0.142248368f); q = q * t + 0.127414796f; q = q * t;
    const f32x2 s = (v * v) * (-0.72134752044f);
    f32x2 e; e.x = __builtin_amdgcn_exp2f(s.x); e.y = __builtin_amdgcn_exp2f(s.y);
    const f32x2 m = v * (q * e), r = v - m;
    f32x2 o; o.x = v.x < 0.f ? m.x : r.x; o.y = v.y < 0.f ? m.y : r.y; return o;
}

template <int ACT  > struct EpiBf16 {
    static constexpr bool PERM = true, AFTER_DRAIN = false; static_assert(ACT == 0 || ACT == 1, "EpiBf16: ACT is 0 (none) or 1 (gelu_pk)");
    bf16_t* O; int ldc; const float* bias; int split_cols; size_t split_stride; float scale0;
    __device__ __forceinline__ void operator()(const f32x4 (&acc)[2][2][4][2], const Unit& u, int wr, int wc, int fr, int fq) const {
        const int row0 = u.pm * BM + wr * 64 + fr; int colt = u.pn * BM; bf16_t* base = O;
        float sc = 1.f; if (split_cols) { const int t = colt / split_cols; base += (size_t)t * split_stride; colt -= t * split_cols; if (t == 0) sc = scale0; }
        const int col0 = colt + wc * 32 + 8 * fq, bcol0 = u.pn * BM + wc * 32 + 8 * fq;
        f32x4 bv[2][2];
#pragma unroll
        for (int bj = 0; bj < 2; ++bj)
#pragma unroll
            for (int n = 0; n < 2; ++n) bv[bj][n] = bias ? *(const f32x4*)(bias + bcol0 + bj * HALF + 4 * n) : (f32x4){0.f, 0.f, 0.f, 0.f};
#pragma unroll
        for (int ai = 0; ai < 2; ++ai)
#pragma unroll
            for (int m = 0; m < 4; ++m) { bf16_t* rowp = base + (size_t)(row0 + ai * HALF + m * 16) * ldc + col0;
#pragma unroll
                for (int bj = 0; bj < 2; ++bj) { f32x4 v0 = acc[ai][bj][m][0] + bv[bj][0], v1 = acc[ai][bj][m][1] + bv[bj][1];
                    if (ACT == 1) { f32x2 a = gelu_pk((f32x2){v0[0], v0[1]}), b = gelu_pk((f32x2){v0[2], v0[3]}), c = gelu_pk((f32x2){v1[0], v1[1]}), d = gelu_pk((f32x2){v1[2], v1[3]});
                        v0 = (f32x4){a.x, a.y, b.x, b.y}; v1 = (f32x4){c.x, c.y, d.x, d.y}; }
                    v0 = v0 * sc; v1 = v1 * sc; u32x4 w; w.x = cvt_pk_bf16(v0[0], v0[1]); w.y = cvt_pk_bf16(v0[2], v0[3]); w.z = cvt_pk_bf16(v1[0], v1[1]); w.w = cvt_pk_bf16(v1[2], v1[3]);
                    *(u32x4*)(rowp + bj * HALF) = w; } }
    }
};
struct EpiF32 {
    static constexpr bool PERM = false, AFTER_DRAIN = false;
    float* C; int ldc; const float* bias;
    __device__ __forceinline__ void operator()(const f32x4 (&acc)[2][2][4][2], const Unit& u, int wr, int wc, int fr, int fq) const {
        const int row0 = u.pm * BM + wr * 64 + fr, col0 = u.pn * BM + wc * 32 + 4 * fq;
        f32x4 bv[2][2];
#pragma unroll
        for (int bj = 0; bj < 2; ++bj)
#pragma unroll
            for (int n = 0; n < 2; ++n) bv[bj][n] = bias ? *(const f32x4*)(bias + col0 + bj * HALF + n * 16) : (f32x4){0.f, 0.f, 0.f, 0.f};
#pragma unroll
        for (int ai = 0; ai < 2; ++ai)
#pragma unroll
            for (int m = 0; m < 4; ++m) { float* rowp = C + (size_t)(row0 + ai * HALF + m * 16) * ldc + col0;
#pragma unroll
                for (int bj = 0; bj < 2; ++bj)
#pragma unroll
                    for (int n = 0; n < 2; ++n) *(f32x4*)(rowp + bj * HALF + n * 16) = acc[ai][bj][m][n] + bv[bj][n]; }
    }
};
template <class Epi, class Sched, bool ALIGN_EPI = false, bool SP2 = false>
__device__ __forceinline__ void gemm_phase(PG8_LAS unsigned char* lds, const Gemm g, const Sched& S, const Epi& E, const int tid) {
    const int wid = __builtin_amdgcn_readfirstlane(tid >> 6), lane = tid & 63, wr = wid >> 2, wc = wid & 3, fr = lane & 15, fq = lane >> 4;
    const int K = g.K, nt = K / BK;
    unsigned voffA[2], voffB[2];
#pragma unroll
    for (int i = 0; i < 2; ++i) { int R, C; stage_rc(tid * 16 + i * 8192, R, C); const int Rb = Epi::PERM ? ((R & ~31) + perm32(R & 31)) : R;
        voffA[i] = (unsigned)(R * K + C) * 2u; voffB[i] = (unsigned)(Rb * K + C) * 2u; }
    const size_t kstep = (size_t)(BK * 2);
    const size_t hstep = (size_t)HALF * K * 2;
    const size_t tstep = 2 * hstep;
    const unsigned ldsw = (unsigned)wid * 1024u;
    const int aoff = lds_byte(wr * 64 + fr, fq * 8), boff = lds_byte(wc * 32 + fr, fq * 8);
#define PG8_SA(b, h) (((b) * 2 + (h)) * HTB)
#define PG8_SB(b, h) ((4 + (b) * 2 + (h)) * HTB)
#define PG8_STAGE(bufoff, gbase, voff) do { _Pragma("unroll") for (int _i = 0; _i < 2; ++_i) \
        __builtin_amdgcn_global_load_lds((const unsigned*)((const char*)(gbase) + (voff)[_i]), (PG8_LAS unsigned*)(lds + (bufoff) + ldsw + _i * 8192), 16, 0, 0); } while (0)
#define PG8_LDA(dst, b, h) do { _Pragma("unroll") for (int m = 0; m < 4; ++m) _Pragma("unroll") for (int k = 0; k < 2; ++k) dst[m][k] = *(const PG8_LAS bf16x8*)(lds + PG8_SA(b, h) + aoff + m * 2048 + k * 1024); } while (0)
#define PG8_LDB(dst, b, h) do { _Pragma("unroll") for (int n = 0; n < 2; ++n) _Pragma("unroll") for (int k = 0; k < 2; ++k) dst[n][k] = *(const PG8_LAS bf16x8*)(lds + PG8_SB(b, h) + boff + n * 2048 + k * 1024); } while (0)
#define PG8_MMA(ai, bj, At, Bt) do { __builtin_amdgcn_s_setprio(1); _Pragma("unroll") for (int m = 0; m < 4; ++m) _Pragma("unroll") for (int n = 0; n < 2; ++n) _Pragma("unroll") for (int k = 0; k < 2; ++k) \
        acc[ai][bj][m][n] = __builtin_amdgcn_mfma_f32_16x16x32_bf16(Bt[n][k], At[m][k], acc[ai][bj][m][n], 0, 0, 0); __builtin_amdgcn_s_setprio(0); } while (0)
#define PG8_WAIT_V(n) asm volatile("s_waitcnt vmcnt(" #n ")" ::: "memory")
#define PG8_WAIT_L(n) asm volatile("s_waitcnt lgkmcnt(" #n ")" ::: "memory")
#define PG8_BAR __builtin_amdgcn_s_barrier()
#define PG8_SCHED __builtin_amdgcn_sched_barrier(0)
    Unit cur, nxt; int ui = 0;
    if (!S.next(0, cur)) return;
    f32x4 acc[2][2][4][2];
#pragma unroll
    for (int a = 0; a < 2; ++a)
#pragma unroll
        for (int b = 0; b < 2; ++b)
#pragma unroll
            for (int m = 0; m < 4; ++m)
#pragma unroll
                for (int n = 0; n < 2; ++n) acc[a][b][m][n] = (f32x4){0.f, 0.f, 0.f, 0.f};
    bf16x8 At[4][2], B0[2][2], B1[2][2];
    const char* cA = (const char*)g.A + (size_t)cur.pm * tstep; const char* cB = (const char*)g.Bt + (size_t)cur.pn * tstep;
    S.a_ready(cur);
    if constexpr (SP2) {
        PG8_STAGE(PG8_SB(0, 0), cB, voffB); PG8_STAGE(PG8_SB(0, 1), cB + hstep, voffB); PG8_STAGE(PG8_SA(0, 0), cA, voffA); PG8_STAGE(PG8_SA(0, 1), cA + hstep, voffA);
        if (wr == 1) PG8_BAR;
        PG8_WAIT_V(2); PG8_BAR;
        PG8_STAGE(PG8_SB(1, 0), cB + kstep, voffB); PG8_STAGE(PG8_SA(1, 0), cA + kstep, voffA); PG8_STAGE(PG8_SB(1, 1), cB + hstep + kstep, voffB);
        PG8_WAIT_V(6); PG8_BAR;
    } else {
        PG8_STAGE(PG8_SB(0, 0), cB, voffB); PG8_STAGE(PG8_SA(0, 0), cA, voffA); PG8_STAGE(PG8_SB(0, 1), cB + hstep, voffB); PG8_STAGE(PG8_SA(0, 1), cA + hstep, voffA);
        if (wr == 1) PG8_BAR;
        PG8_WAIT_V(4); PG8_BAR;
        PG8_STAGE(PG8_SB(1, 0), cB + kstep, voffB); PG8_STAGE(PG8_SA(1, 0), cA + kstep, voffA); PG8_STAGE(PG8_SB(1, 1), cB + hstep + kstep, voffB);
        PG8_WAIT_V(6); PG8_BAR;
    }
    for (;;) {
        const bool has_next = S.next(ui + 1, nxt);
        const char* nA = has_next ? (const char*)g.A + (size_t)nxt.pm * tstep : cA; const char* nB = has_next ? (const char*)g.Bt + (size_t)nxt.pn * tstep : cB;
        for (int t = 0; t < nt; t += 2) {
            const bool last = (t == nt - 2);
            const char* a1 = cA + (size_t)(t + 1) * kstep;
            const char* a2 = last ? nA : cA + (size_t)(t + 2) * kstep; const char* b2 = last ? nB : cB + (size_t)(t + 2) * kstep;
            const char* a3 = a2 + kstep; const char* b3 = b2 + kstep;
            if (last && has_next) S.a_ready(nxt);
            if constexpr (SP2) {
            PG8_LDB(B0, 0, 0); PG8_LDB(B1, 0, 1); PG8_SCHED; PG8_LDA(At, 0, 0); PG8_STAGE(PG8_SA(1, 1), a1 + hstep, voffA);
            PG8_WAIT_V(8); PG8_WAIT_L(0); PG8_BAR; PG8_MMA(0, 0, At, B0); PG8_MMA(0, 1, At, B1); PG8_BAR; PG8_SCHED;
            PG8_LDA(At, 0, 1); PG8_STAGE(PG8_SB(0, 0), b2, voffB); PG8_STAGE(PG8_SB(0, 1), b2 + hstep, voffB); PG8_STAGE(PG8_SA(0, 0), a2, voffA);
            PG8_WAIT_V(8); PG8_WAIT_L(0); PG8_BAR; PG8_MMA(1, 0, At, B0); PG8_MMA(1, 1, At, B1); PG8_BAR; PG8_SCHED;
            PG8_LDB(B0, 1, 0); PG8_LDB(B1, 1, 1); PG8_SCHED; PG8_LDA(At, 1, 0); PG8_STAGE(PG8_SA(0, 1), a2 + hstep, voffA);
            PG8_WAIT_V(8); PG8_WAIT_L(0); PG8_BAR; PG8_MMA(0, 0, At, B0); PG8_MMA(0, 1, At, B1); PG8_BAR; PG8_SCHED;
            PG8_LDA(At, 1, 1); PG8_STAGE(PG8_SB(1, 0), b3, voffB); PG8_STAGE(PG8_SB(1, 1), b3 + hstep, voffB); PG8_STAGE(PG8_SA(1, 0), a3, voffA);
            PG8_WAIT_V(8); PG8_WAIT_L(0); PG8_BAR; PG8_MMA(1, 0, At, B0); PG8_MMA(1, 1, At, B1); PG8_BAR; PG8_SCHED;
            } else {
            PG8_LDB(B0, 0, 0); PG8_SCHED; PG8_LDA(At, 0, 0); PG8_STAGE(PG8_SA(1, 1), a1 + hstep, voffA);
            PG8_WAIT_L(8); PG8_BAR; PG8_WAIT_L(0); PG8_MMA(0, 0, At, B0); PG8_BAR; PG8_SCHED;
            PG8_LDB(B1, 0, 1); PG8_STAGE(PG8_SB(0, 0), b2, voffB);
            PG8_BAR; PG8_WAIT_L(0); PG8_MMA(0, 1, At, B1); PG8_BAR;
            PG8_LDA(At, 0, 1); PG8_STAGE(PG8_SA(0, 0), a2, voffA);
            PG8_BAR; PG8_WAIT_L(0); PG8_MMA(1, 0, At, B0); PG8_BAR; PG8_SCHED;
            PG8_STAGE(PG8_SB(0, 1), b2 + hstep, voffB);
            PG8_WAIT_V(6); PG8_BAR; PG8_MMA(1, 1, At, B1); PG8_BAR;
            PG8_LDB(B0, 1, 0); PG8_SCHED; PG8_LDA(At, 1, 0); PG8_STAGE(PG8_SA(0, 1), a2 + hstep, voffA);
            PG8_WAIT_L(8); PG8_BAR; PG8_WAIT_L(0); PG8_MMA(0, 0, At, B0); PG8_BAR; PG8_SCHED;
            PG8_LDB(B1, 1, 1); PG8_STAGE(PG8_SB(1, 0), b3, voffB);
            PG8_BAR; PG8_WAIT_L(0); PG8_MMA(0, 1, At, B1); PG8_BAR;
            PG8_LDA(At, 1, 1); PG8_STAGE(PG8_SA(1, 0), a3, voffA);
            PG8_BAR; PG8_WAIT_L(0); PG8_MMA(1, 0, At, B0); PG8_BAR; PG8_SCHED;
            PG8_STAGE(PG8_SB(1, 1), b3 + hstep, voffB);
            PG8_WAIT_V(6); PG8_BAR; PG8_MMA(1, 1, At, B1); PG8_BAR;
            }
        }
        if constexpr (ALIGN_EPI) { if (wr == 0) PG8_BAR; }
        if constexpr (!Epi::AFTER_DRAIN) { E(acc, cur, wr, wc, fr, fq); S.done(cur); }
        if (!has_next) break;
#pragma unroll
        for (int a = 0; a < 2; ++a)
#pragma unroll
            for (int b = 0; b < 2; ++b)
#pragma unroll
                for (int m = 0; m < 4; ++m)
#pragma unroll
                    for (int n = 0; n < 2; ++n) acc[a][b][m][n] = (f32x4){0.f, 0.f, 0.f, 0.f};
        cur = nxt; cA = nA; cB = nB; ++ui;
        if constexpr (ALIGN_EPI) { if (wr == 1) PG8_BAR; }
    }
    PG8_WAIT_V(0);
    if constexpr (!ALIGN_EPI) { if (wr == 0) PG8_BAR; }
    PG8_BAR;
    if constexpr (Epi::AFTER_DRAIN) { E.fused(acc, cur, wr, wc, fr, fq, lds, wid, lane); S.done(cur); }
#undef PG8_SA
#undef PG8_SB
#undef PG8_STAGE
#undef PG8_LDA
#undef PG8_LDB
#undef PG8_MMA
#undef PG8_WAIT_V
#undef PG8_WAIT_L
#undef PG8_BAR
#undef PG8_SCHED
}
}

constexpr int DM = 1024, NBATCH = 32, TSEQ = 2048, MTOK = NBATCH * TSEQ, DEPTH = 4;
constexpr int EVEN_IN = 3248, EVEN_PAD = 3328, ODD_IN = 1864, ODD_PAD = 2048;
constexpr int G_Q = 0, G_K = 256, G_V = 512, G_G = 1024, G_AL = 1536, RW0 = 1552;
constexpr int R_R = RW0, R_K = RW0 + 512, R_V = RW0 + 1024, R_WL = RW0 + 1536;
constexpr int O_Q = 0, O_K = 1024, O_V = 1152, O_QI = 1280, O_KI = 1792, O_WI = 1856;
constexpr float DN_ALPHA = 1.681792830507429f, LN_EPS = 1e-5f;

constexpr size_t MiB = 1u << 20;
constexpr size_t WS_CTL = 0, CTL_ZERO_BYTES = 1 * MiB;
constexpr size_t WS_COSA = 1 * MiB, WS_SINA = WS_COSA + 512 * 1024, WS_COSI = 2 * MiB, WS_SINI = WS_COSI + 256 * 1024;
constexpr size_t WS_WINE = 3 * MiB, WS_WINO = 16 * MiB, WS_WOUTE = 24 * MiB, WS_WOUTO = 28 * MiB, WS_WQ = 32 * MiB, WS_SK = 40 * MiB;
constexpr size_t WS_XB = 48 * MiB, WS_P = 176 * MiB, WS_MIX = WS_P, WS_QP = WS_P + 256 * MiB, WS_CAT = 592 * MiB;
constexpr size_t WS_RIDX = 720 * MiB, WS_RGATE = 736 * MiB, WS_MASK = 768 * MiB, WS_VT = 784 * MiB, WS_EXP = 800 * MiB, WS_END = 1000 * MiB;
constexpr int CW_BAR = 4096, CW_Q = 8192;
constexpr size_t WS_FFN = WS_P, WS_HC = WS_P + 384 * MiB;

constexpr int LDS_BYTES = 163840, RING_BYTES = 131072, LDSCTL_OFF = LDS_BYTES - 1024;

#define GAS __attribute__((address_space(1)))
#define LAS __attribute__((address_space(3)))
typedef unsigned short bf16;
typedef float f32x4 __attribute__((ext_vector_type(4)));
typedef unsigned u32x4 __attribute__((ext_vector_type(4)));
typedef unsigned u32x2 __attribute__((ext_vector_type(2)));
typedef short bf16x8 __attribute__((ext_vector_type(8)));
typedef float f32x16 __attribute__((ext_vector_type(16)));
#define LDS_WAIT() asm volatile("s_waitcnt lgkmcnt(0)" ::: "memory")
__device__ __forceinline__ float bf2f(bf16 b) { return __uint_as_float(((unsigned)b) << 16); }
typedef __bf16 bf16x2n_ __attribute__((ext_vector_type(2)));
typedef float f32x2n_ __attribute__((ext_vector_type(2)));
__device__ __forceinline__ unsigned pk2(float lo, float hi) { const f32x2n_ v = {lo, hi}; return __builtin_bit_cast(unsigned, __builtin_convertvector(v, bf16x2n_)); }
__device__ __forceinline__ unsigned f2bf(float f) { return pk2(f, 0.f) & 0xffffu; }
__device__ __forceinline__ unsigned f2bf_acc(float f) { unsigned u = __float_as_uint(f); return (u + 0x7fffu + ((u >> 16) & 1u)) >> 16; }
__device__ __forceinline__ unsigned pk2_acc(float lo, float hi) { return f2bf_acc(lo) | (f2bf_acc(hi) << 16); }
__device__ __forceinline__ float bflo(unsigned w) { return __uint_as_float(w << 16); }
__device__ __forceinline__ float bfhi(unsigned w) { return __uint_as_float(w & 0xffff0000u); }
__device__ __forceinline__ float wave_sum(float v) {
#pragma unroll
    for (int o = 1; o < 64; o <<= 1) v += __shfl_xor(v, o);
    return v;
}
__device__ __forceinline__ float wave_max(float v) {
#pragma unroll
    for (int o = 1; o < 64; o <<= 1) v = fmaxf(v, __shfl_xor(v, o));
    return v;
}
__device__ __forceinline__ int wave_sum_i(int v) {
#pragma unroll
    for (int o = 1; o < 64; o <<= 1) v += __shfl_xor(v, o);
    return v;
}
__device__ __forceinline__ float sigmoidf_(float x) { return 1.f / (1.f + __expf(-x)); }

template <int CTRL> __device__ __forceinline__ float dpp_f(float v) { return __int_as_float(__builtin_amdgcn_mov_dpp(__float_as_int(v), CTRL, 0xF, 0xF, true)); }
template <int CTRL> __device__ __forceinline__ int dpp_i(int v) { return __builtin_amdgcn_mov_dpp(v, CTRL, 0xF, 0xF, true); }
__device__ __forceinline__ float reduce8(float v) { v += dpp_f<0xB1>(v); v += dpp_f<0x4E>(v); v += dpp_f<0x141>(v); return v; }
__device__ __forceinline__ float reduce16(float v) { v = reduce8(v); v += dpp_f<0x140>(v); return v; }
__device__ __forceinline__ float wave_max_dpp(float v) {
    v = fmaxf(v, dpp_f<0xB1>(v)); v = fmaxf(v, dpp_f<0x4E>(v)); v = fmaxf(v, dpp_f<0x141>(v)); v = fmaxf(v, dpp_f<0x140>(v));
    const int iv = __float_as_int(v);
    return fmaxf(fmaxf(__int_as_float(__builtin_amdgcn_readlane(iv, 0)), __int_as_float(__builtin_amdgcn_readlane(iv, 16))), fmaxf(__int_as_float(__builtin_amdgcn_readlane(iv, 32)), __int_as_float(__builtin_amdgcn_readlane(iv, 48))));
}
__device__ __forceinline__ int reduce16_i(int v) { v += dpp_i<0xB1>(v); v += dpp_i<0x4E>(v); v += dpp_i<0x141>(v); v += dpp_i<0x140>(v); return v; }
__device__ __forceinline__ float hswap32_add(float lo, float hi) { const auto r = __builtin_amdgcn_permlane32_swap(__float_as_uint(lo), __float_as_uint(hi), false, false); return __uint_as_float(r[0]) + __uint_as_float(r[1]); }
__device__ __forceinline__ float hswap16_add(float lo, float hi) { const auto r = __builtin_amdgcn_permlane16_swap(__float_as_uint(lo), __float_as_uint(hi), false, false); return __uint_as_float(r[0]) + __uint_as_float(r[1]); }
__device__ __forceinline__ int hswap32_add_i(int lo, int hi) { const auto r = __builtin_amdgcn_permlane32_swap((unsigned)lo, (unsigned)hi, false, false); return (int)(r[0] + r[1]); }
#define XB_TMO      128
#define XB_XCNT(j)  (256  + 64 * (j))
#define XB_XSUB(j)  (1280 + 64 * (j))
#define XB_XGEN(j)  (2304 + 64 * (j))
#define XB_TOP      3328
#define XB_TOPGEN   3392
#define XCD_BAR_WORDS 3456
#define XB_SPIN_CAP (1u << 18)

__device__ __forceinline__ unsigned xb_ld(unsigned* p)              { return __hip_atomic_load(p, __ATOMIC_RELAXED, __HIP_MEMORY_SCOPE_AGENT); }
__device__ __forceinline__ unsigned xb_add(unsigned* p, unsigned v) { return __hip_atomic_fetch_add(p, v, __ATOMIC_RELAXED, __HIP_MEMORY_SCOPE_AGENT); }
__device__ __forceinline__ unsigned xb_xcc_id() { return (unsigned)__builtin_amdgcn_s_getreg((3 << 11) | 20) & 0xFu; }
#define XB_SPIN(cond, bar) do { unsigned _sp = 0; while (cond) { __builtin_amdgcn_s_sleep(1); \
    if ((++_sp & 255u) == 0u) { if (xb_ld(&(bar)[XB_TMO])) break; if (_sp > XB_SPIN_CAP) { atomicAdd(&(bar)[XB_TMO], 1u); break; } } } } while (0)

struct XcdBarrier {
    unsigned* bar; unsigned x;
    volatile LAS unsigned* st;
};

__device__ __forceinline__ XcdBarrier xcd_barrier_post(unsigned* bar, volatile LAS unsigned* st) {
    XcdBarrier b; b.bar = bar; b.x = xb_xcc_id(); b.st = st;
    if (threadIdx.x == 0) (void)xb_add(&bar[XB_XCNT(b.x)], 1u);
    return b;
}
__device__ __forceinline__ void xcd_barrier_complete(unsigned* bar, unsigned x, unsigned& nloc, unsigned& nx) {
    const unsigned G = gridDim.x * gridDim.y * gridDim.z;
    unsigned sum, cnt, mine, sp = 0u;
    for (;;) {
        sum = 0u; cnt = 0u; mine = 0u;
#pragma unroll
        for (unsigned j = 0; j < 16; ++j) { const unsigned c = xb_ld(&bar[XB_XCNT(j)]); sum += c; cnt += (c > 0u) ? 1u : 0u; mine = (j == x) ? c : mine; }
        if (sum == G) break;
        __builtin_amdgcn_s_sleep(1);
        if ((++sp & 255u) == 0u) { if (xb_ld(&bar[XB_TMO])) break; if (sp > XB_SPIN_CAP) { atomicAdd(&bar[XB_TMO], 1u); break; } }
    }
    nloc = mine > 0u ? mine : 1u; nx = cnt > 0u ? cnt : 1u;
}

__device__ __forceinline__ void xcd_barrier(const XcdBarrier& b) {
    asm volatile("s_waitcnt vmcnt(0)" ::: "memory");
    __syncthreads();
    if (threadIdx.x == 0) {
        unsigned* bar = b.bar;
        __builtin_amdgcn_s_waitcnt(0);
        unsigned nloc = b.st[0], nx = b.st[1];
        if (nloc == 0u) { xcd_barrier_complete(bar, b.x, nloc, nx); b.st[0] = nloc; b.st[1] = nx; }
        const unsigned old = xb_add(&bar[XB_XSUB(b.x)], 1u);
        const unsigned gen = old / nloc;
        if (old + 1u == (gen + 1u) * nloc) {
            __builtin_amdgcn_fence(__ATOMIC_RELEASE, "agent");
            asm volatile("s_waitcnt vmcnt(0)" ::: "memory");
            const unsigned og = xb_add(&bar[XB_TOP], 1u);
            const unsigned tg = og / nx;
            if (og + 1u == (tg + 1u) * nx) xb_add(&bar[XB_TOPGEN], 1u);
            else XB_SPIN(xb_ld(&bar[XB_TOPGEN]) == tg, bar);
            __builtin_amdgcn_fence(__ATOMIC_ACQUIRE, "agent");
            xb_add(&bar[XB_XGEN(b.x)], 1u);
            asm volatile("s_waitcnt vmcnt(0)" ::: "memory");
        } else {
            XB_SPIN(xb_ld(&bar[XB_XGEN(b.x)]) == gen, bar);
            __builtin_amdgcn_fence(__ATOMIC_ACQUIRE, "agent");
            asm volatile("s_waitcnt vmcnt(0)" ::: "memory");
        }
    }
    __syncthreads();
}

struct Args { const float* in[27]; float* out; unsigned char* ws; int ph_lo, ph_hi; };

__device__ __forceinline__ void transpose_item(const float* W, int N, int Npad, bf16* WT, LAS float* scr, int item, int lane) {
    const int nblk = Npad / 32, kb = item / nblk, nb = item % nblk, k0 = 64 * kb, n0 = 32 * nb;
    const int nq = n0 + 4 * (lane & 7);
#pragma unroll
    for (int i = 0; i < 8; ++i) { const int kk = 8 * i + (lane >> 3); const f32x4 v = (nq < N) ? *(const f32x4*)(W + (size_t)(k0 + kk) * N + nq) : (f32x4){0.f, 0.f, 0.f, 0.f};
        LAS float* d = scr + kk * 33 + 4 * (lane & 7); d[0] = v.x; d[1] = v.y; d[2] = v.z; d[3] = v.w; }
    LDS_WAIT(); asm volatile("" ::: "memory");
    const int c = lane & 7;
#pragma unroll
    for (int j = 0; j < 4; ++j) { const int n = (lane >> 3) + 8 * j; const LAS float* s = scr + (8 * c) * 33 + n;
        u32x4 o; o.x = pk2(s[0 * 33], s[1 * 33]); o.y = pk2(s[2 * 33], s[3 * 33]); o.z = pk2(s[4 * 33], s[5 * 33]); o.w = pk2(s[6 * 33], s[7 * 33]);
        *(u32x4*)(WT + (size_t)(n0 + n) * 1024 + k0 + 8 * c) = o; }
    LDS_WAIT(); asm volatile("" ::: "memory");
}
__device__ __forceinline__ void sincos_d(double x, double& s, double& c) {
    const double n = __builtin_rint(x * 0.6366197723675814);
    double r = __builtin_fma(-n, 1.5707963267948966, x); r = __builtin_fma(-n, 6.123233995736766e-17, r);
    const int q = ((int)n) & 3;
    const double r2 = r * r;
    double sp = -1.0 / 1307674368000.0; sp = sp * r2 + 1.0 / 6227020800.0; sp = sp * r2 - 1.0 / 39916800.0; sp = sp * r2 + 1.0 / 362880.0; sp = sp * r2 - 1.0 / 5040.0; sp = sp * r2 + 1.0 / 120.0; sp = sp * r2 - 1.0 / 6.0; sp = sp * r2 + 1.0; sp *= r;
    double cp = 1.0 / 20922789888000.0; cp = cp * r2 - 1.0 / 87178291200.0; cp = cp * r2 + 1.0 / 479001600.0; cp = cp * r2 - 1.0 / 3628800.0; cp = cp * r2 + 1.0 / 40320.0; cp = cp * r2 - 1.0 / 720.0; cp = cp * r2 + 1.0 / 24.0; cp = cp * r2 - 0.5; cp = cp * r2 + 1.0;
    s = (q == 0) ? sp : (q == 1) ? cp : (q == 2) ? -sp : -cp;
    c = (q == 0) ? cp : (q == 1) ? -sp : (q == 2) ? -cp : sp;
}
__device__ __forceinline__ double powi_d(double base, int e) { double r = 1.0, p = base;
#pragma unroll
    for (int b = 0; b < 7; ++b) { if (e & (1 << b)) r *= p; p *= p; } return r; }

__device__ __forceinline__ void ph_prologue(const Args& a, LAS unsigned char* lds, int gw, int NGW, int wave, int lane) {
    unsigned char* ws = a.ws;
    LAS float* scr = (LAS float*)(lds + wave * 16384);
    constexpr int I_WE = 16 * (EVEN_PAD / 32), I_WO = 16 * (ODD_PAD / 32), I_SQ = 16 * 32;
    constexpr int NIT = 2 * I_WE + 2 * I_WO + 8 * I_SQ;
    for (int it = gw; it < NIT; it += NGW) {
        int r = it;
        if (r < 2 * I_WE) { const int i = r / I_WE; transpose_item(a.in[1] + (size_t)i * 1024 * EVEN_IN, EVEN_IN, EVEN_PAD, (bf16*)(ws + WS_WINE) + (size_t)i * EVEN_PAD * 1024, scr, r % I_WE, lane); continue; }
        r -= 2 * I_WE;
        if (r < 2 * I_WO) { const int i = r / I_WO; transpose_item(a.in[17] + (size_t)i * 1024 * ODD_IN, ODD_IN, ODD_PAD, (bf16*)(ws + WS_WINO) + (size_t)i * ODD_PAD * 1024, scr, r % I_WO, lane); continue; }
        r -= 2 * I_WO;
        const int mi = r / I_SQ, item = r % I_SQ; const float* src; bf16* dst;
        if (mi < 2) { src = a.in[16] + (size_t)mi * 1048576; dst = (bf16*)(ws + WS_WOUTE) + (size_t)mi * 1048576; }
        else if (mi < 4) { src = a.in[18] + (size_t)(mi - 2) * 1048576; dst = (bf16*)(ws + WS_WOUTO) + (size_t)(mi - 2) * 1048576; }
        else { src = a.in[21] + (size_t)(mi - 4) * 1048576; dst = (bf16*)(ws + WS_WQ) + (size_t)(mi - 4) * 1048576; }
        transpose_item(src, 1024, 1024, dst, scr, item, lane);
    }
    const int gtid = gw * 64 + lane, NT = NGW * 64;
    for (int idx = gtid; idx < 2048 * 64; idx += NT) { const int t = idx >> 6, i = idx & 63; double s, c; sincos_d((double)t * powi_d(0.8659643233600653, i), s, c);
        ((float*)(ws + WS_COSA))[idx] = (float)c; ((float*)(ws + WS_SINA))[idx] = (float)s; }
    for (int idx = gtid; idx < 2048 * 32; idx += NT) { const int t = idx >> 5, i = idx & 31; double s, c; sincos_d((double)t * powi_d(0.7498942093324559, i), s, c);
        ((float*)(ws + WS_COSI))[idx] = (float)c; ((float*)(ws + WS_SINI))[idx] = (float)s; }
    { const f32x4* sk = (const f32x4*)a.in[22]; u32x2* skb = (u32x2*)(ws + WS_SK);
      for (int i = gtid; i < 4 * 8 * 2 * 128 * 64 / 4; i += NT) { const f32x4 v = sk[i]; u32x2 o; o.x = pk2(v.x, v.y); o.y = pk2(v.z, v.w); skb[i] = o; } }
    const f32x4* x4 = (const f32x4*)a.in[0]; u32x4* xb = (u32x4*)(ws + WS_XB);
    for (size_t i = gtid; i < (size_t)MTOK * DM / 8; i += NT) { const f32x4 v0 = x4[2 * i], v1 = x4[2 * i + 1];
        u32x4 o; o.x = pk2(v0.x, v0.y); o.y = pk2(v0.z, v0.w); o.z = pk2(v1.x, v1.y); o.w = pk2(v1.z, v1.w); xb[i] = o; }
}

constexpr int L_W2 = 0, L_A2 = 2048, L_G2 = 4096, L_PAR = 10240, L_LORA = 11040, L_VEC = 16160, L_Y = 30496, L_BON = 32544;
__device__ __forceinline__ void rwkv_unit(const Args& a, LAS float* L, int unit, int i2, const bf16* P, bf16* CAT, int tid) {
    constexpr int PS = EVEN_PAD;
    const int b = unit >> 3, h = unit & 7, lane = tid & 63, wave = __builtin_amdgcn_readfirstlane(tid >> 6);
    const float* mu = a.in[5] + i2 * 1696; const float* w0 = a.in[6] + i2 * 512; const float* w2 = a.in[7] + i2 * 32 * 512; const float* a0 = a.in[8] + i2 * 512;
    const float* a2 = a.in[9] + i2 * 32 * 512; const float* g2 = a.in[10] + i2 * 96 * 512; const float* kk_ = a.in[11] + i2 * 512; const float* ka_ = a.in[12] + i2 * 512;
    const float* rk_ = a.in[13] + i2 * 512; const float* lg = a.in[14] + i2 * 512; const float* lb = a.in[15] + i2 * 512;
    for (int idx = tid; idx < 32 * 64; idx += 512) { const int j = idx >> 6, c = idx & 63; L[L_W2 + idx] = w2[j * 512 + h * 64 + c]; L[L_A2 + idx] = a2[j * 512 + h * 64 + c]; }
    for (int idx = tid; idx < 96 * 64; idx += 512) { const int j = idx >> 6, c = idx & 63; L[L_G2 + idx] = g2[j * 512 + h * 64 + c]; }
    if (tid < 64) { const int c = tid, col = h * 64 + c; L[L_PAR + c] = mu[col]; L[L_PAR + 64 + c] = mu[512 + col]; L[L_PAR + 128 + c] = mu[1024 + col]; L[L_PAR + 192 + c] = w0[col];
        L[L_PAR + 256 + c] = a0[col]; L[L_PAR + 320 + c] = kk_[col]; L[L_PAR + 384 + c] = ka_[col]; L[L_PAR + 448 + c] = rk_[col]; L[L_PAR + 512 + c] = lg[col]; L[L_PAR + 576 + c] = lb[col]; }
    if (tid < 160) L[L_PAR + 640 + tid] = mu[1536 + tid];
    float S[8];
#pragma unroll
    for (int e = 0; e < 8; ++e) S[e] = 0.f;
    __syncthreads();
    const size_t row0 = (size_t)b * 2048;
    for (int t0 = 0; t0 < 2048; t0 += 32) {
#pragma unroll 1
        for (int idx = tid; idx < 32 * 160; idx += 512) { const int tok = idx / 160, j = idx - tok * 160, t = t0 + tok; const bf16* pr = P + (row0 + t) * PS + R_WL + j;
            const float cur = bf2f(pr[0]), prev = t > 0 ? bf2f(pr[-PS]) : 0.f; const float s = cur + (prev - cur) * L[L_PAR + 640 + j];
            L[L_LORA + idx] = j < 32 ? tanhf(s) : (j < 64 ? s : 1.f / (1.f + expf(-s))); }
        __syncthreads();
        { const int c = lane, tg = wave, col = h * 64 + c;
          float rs[4], ks[4], vs[4], wl[4], al[4], gg[4];
#pragma unroll
          for (int i = 0; i < 4; ++i) { const int tok = tg * 4 + i, t = t0 + tok; const bf16* pr = P + (row0 + t) * PS;
              float cur = bf2f(pr[R_R + col]), prev = t > 0 ? bf2f(pr[R_R + col - PS]) : 0.f; rs[i] = cur + (prev - cur) * L[L_PAR + c];
              cur = bf2f(pr[R_K + col]); prev = t > 0 ? bf2f(pr[R_K + col - PS]) : 0.f; ks[i] = cur + (prev - cur) * L[L_PAR + 64 + c];
              cur = bf2f(pr[R_V + col]); prev = t > 0 ? bf2f(pr[R_V + col - PS]) : 0.f; vs[i] = cur + (prev - cur) * L[L_PAR + 128 + c];
              wl[i] = L[L_PAR + 192 + c]; al[i] = L[L_PAR + 256 + c]; gg[i] = 0.f; }
#pragma unroll 2
          for (int j = 0; j < 32; ++j) { const float w = L[L_W2 + j * 64 + c], aa = L[L_A2 + j * 64 + c];
#pragma unroll
              for (int i = 0; i < 4; ++i) { wl[i] += L[L_LORA + (tg * 4 + i) * 160 + j] * w; al[i] += L[L_LORA + (tg * 4 + i) * 160 + 32 + j] * aa; } }
#pragma unroll 2
          for (int j = 0; j < 96; ++j) { const float g_ = L[L_G2 + j * 64 + c];
#pragma unroll
              for (int i = 0; i < 4; ++i) gg[i] += L[L_LORA + (tg * 4 + i) * 160 + 64 + j] * g_; }
#pragma unroll
          for (int i = 0; i < 4; ++i) { const int tok = tg * 4 + i;
              const float wlog = fminf(wl[i], 0.f) - log1pf(expf(-fabsf(wl[i]))) - 0.5f; const float decay = expf(-expf(wlog));
              const float av = 1.f / (1.f + expf(-al[i]));
              const float kkr = ks[i] * L[L_PAR + 320 + c]; const float ss = wave_sum(kkr * kkr); const float kkn = kkr / fmaxf(sqrtf(ss), 1e-12f);
              const float k2 = ks[i] * (1.f + (av - 1.f) * L[L_PAR + 384 + c]);
              const float bon = wave_sum(rs[i] * k2 * L[L_PAR + 448 + c]);
              const int o = L_VEC + tok * 64 + c;
              L[o] = rs[i]; L[o + 2048] = decay; L[o + 4096] = k2; L[o + 6144] = vs[i]; L[o + 8192] = -kkn; L[o + 10240] = kkn * av; L[o + 12288] = gg[i];
              if (c == 0) L[L_BON + tok] = bon; } }
        __syncthreads();
        { const int i = tid >> 3, jq = tid & 7;
#pragma unroll 1
          for (int tok = 0; tok < 32; ++tok) { const int base = L_VEC + tok * 64 + jq * 8;
              const f32x4 r0 = *(const LAS f32x4*)&L[base], r1 = *(const LAS f32x4*)&L[base + 4];
              const f32x4 w0v = *(const LAS f32x4*)&L[base + 2048], w1v = *(const LAS f32x4*)&L[base + 2052];
              const f32x4 k0v = *(const LAS f32x4*)&L[base + 4096], k1v = *(const LAS f32x4*)&L[base + 4100];
              const f32x4 a0v = *(const LAS f32x4*)&L[base + 8192], a1v = *(const LAS f32x4*)&L[base + 8196];
              const f32x4 b0v = *(const LAS f32x4*)&L[base + 10240], b1v = *(const LAS f32x4*)&L[base + 10244];
              const float vi = L[L_VEC + 6144 + tok * 64 + i];
              float sa = 0.f;
#pragma unroll
              for (int e = 0; e < 4; ++e) { sa += S[e] * a0v[e]; sa += S[4 + e] * a1v[e]; }
              sa += __shfl_xor(sa, 1); sa += __shfl_xor(sa, 2); sa += __shfl_xor(sa, 4);
              float y = 0.f;
#pragma unroll
              for (int e = 0; e < 4; ++e) { S[e] = S[e] * w0v[e] + sa * b0v[e] + vi * k0v[e]; S[4 + e] = S[4 + e] * w1v[e] + sa * b1v[e] + vi * k1v[e]; y += S[e] * r0[e]; y += S[4 + e] * r1[e]; }
              y += __shfl_xor(y, 1); y += __shfl_xor(y, 2); y += __shfl_xor(y, 4);
              if (jq == 0) L[L_Y + tok * 64 + i] = y; } }
        __syncthreads();
        { const int c = lane, tg = wave, col = h * 64 + c;
#pragma unroll
          for (int i = 0; i < 4; ++i) { const int tok = tg * 4 + i, t = t0 + tok; const float y = L[L_Y + tok * 64 + c];
              const float mean = wave_sum(y) * (1.f / 64.f); const float d = y - mean; const float var = wave_sum(d * d) * (1.f / 64.f);
              const float yn = d * (1.f / sqrtf(var + 64e-5f)) * L[L_PAR + 512 + c] + L[L_PAR + 576 + c];
              const float o = (yn + L[L_BON + tok] * L[L_VEC + 6144 + tok * 64 + c]) * L[L_VEC + 12288 + tok * 64 + c];
              CAT[(row0 + t) * 1024 + 512 + col] = (bf16)f2bf(o); } }
    }
    __syncthreads();
}

constexpr int L2_PAR = 2688, L2_PART = 3488, L2_SC = 4000, L2_VEC = 4096, L2_Y = 18432, XSTR = 168;
__device__ __forceinline__ void rwkv_unit2(const Args& a, LAS float* L, int unit, int i2, const bf16* P, bf16* CAT, int tid) {
    typedef float f32x4v __attribute__((ext_vector_type(4)));
    constexpr int PS = EVEN_PAD;
    const int b = unit >> 3, h = unit & 7, lane = tid & 63, wave = __builtin_amdgcn_readfirstlane(tid >> 6);
    LAS bf16* X = (LAS bf16*)L;
    const float* mu = a.in[5] + i2 * 1696;
    if (tid < 64) { const int c = tid, col = h * 64 + c; L[L2_PAR + c] = mu[col]; L[L2_PAR + 64 + c] = mu[512 + col]; L[L2_PAR + 128 + c] = mu[1024 + col]; L[L2_PAR + 192 + c] = (a.in[6] + i2 * 512)[col];
        L[L2_PAR + 256 + c] = (a.in[8] + i2 * 512)[col]; L[L2_PAR + 320 + c] = (a.in[11] + i2 * 512)[col]; L[L2_PAR + 384 + c] = (a.in[12] + i2 * 512)[col]; L[L2_PAR + 448 + c] = (a.in[13] + i2 * 512)[col];
        L[L2_PAR + 512 + c] = (a.in[14] + i2 * 512)[col]; L[L2_PAR + 576 + c] = (a.in[15] + i2 * 512)[col]; }
    if (tid < 160) L[L2_PAR + 640 + tid] = mu[1536 + tid];
    const int mt = wave & 3, nt = wave >> 2, n16 = lane & 15, q = lane >> 4;
    bf16x8 Aw, Aa, Ag0, Ag1, Ag2;
    { const int col = h * 64 + 16 * mt + n16; const float* w2 = a.in[7] + i2 * 32 * 512 + col; const float* a2 = a.in[9] + i2 * 32 * 512 + col; const float* g2 = a.in[10] + i2 * 96 * 512 + col;
      u32x4 t;
#define LDF(dst, src, k0) t.x = pk2(src[((k0) + 8 * q + 0) * 512], src[((k0) + 8 * q + 1) * 512]); t.y = pk2(src[((k0) + 8 * q + 2) * 512], src[((k0) + 8 * q + 3) * 512]); \
          t.z = pk2(src[((k0) + 8 * q + 4) * 512], src[((k0) + 8 * q + 5) * 512]); t.w = pk2(src[((k0) + 8 * q + 6) * 512], src[((k0) + 8 * q + 7) * 512]); dst = __builtin_bit_cast(bf16x8, t);
      LDF(Aw, w2, 0) LDF(Aa, a2, 0) LDF(Ag0, g2, 0) LDF(Ag1, g2, 32) LDF(Ag2, g2, 64)
#undef LDF
    }
    typedef float f32x2s __attribute__((ext_vector_type(2)));
    f32x2s S2[4];
#pragma unroll
    for (int e = 0; e < 4; ++e) S2[e] = (f32x2s){0.f, 0.f};
    __syncthreads();
    const size_t row0 = (size_t)b * 2048;
    LAS bf16* RAWL = (LAS bf16*)(L + 20480);
    u32x4 pf0, pf1; u32x2 prc, pkc, pvc, prp, pkp, pvp;
    const int pr0 = tid / 20, pc0 = tid - pr0 * 20, pr1 = (tid + 512) / 20, pc1 = (tid + 512) - pr1 * 20;
#define RWKV_PREFETCH(tt) { const int tq = (tt); const u32x4 z4 = {0u, 0u, 0u, 0u}; const u32x2 z2 = {0u, 0u}; \
        { const int t = tq - 1 + pr0; pf0 = t >= 0 ? *(const u32x4*)(P + (row0 + t) * PS + R_WL + pc0 * 8) : z4; } \
        if (tid + 512 < 660) { const int t = tq - 1 + pr1; pf1 = t >= 0 ? *(const u32x4*)(P + (row0 + t) * PS + R_WL + pc1 * 8) : z4; } \
        { const int t = tq + 16 * nt + n16; const bf16* pr = P + (row0 + t) * PS + h * 64 + 16 * mt + 4 * q; \
          prc = *(const u32x2*)(pr + R_R); pkc = *(const u32x2*)(pr + R_K); pvc = *(const u32x2*)(pr + R_V); \
          prp = t > 0 ? *(const u32x2*)(pr + R_R - PS) : z2; pkp = t > 0 ? *(const u32x2*)(pr + R_K - PS) : z2; pvp = t > 0 ? *(const u32x2*)(pr + R_V - PS) : z2; } }
    const int s1tok = tid >> 4, s1cg = tid & 15; float s1mu[10];
#pragma unroll
    for (int u = 0; u < 10; ++u) s1mu[u] = mu[1536 + 10 * s1cg + u];
    RWKV_PREFETCH(0)
#pragma unroll 1
    for (int t0 = 0; t0 < 2048; t0 += 32) {
        *(LAS u32x4*)(RAWL + pr0 * 160 + pc0 * 8) = pf0; if (tid + 512 < 660) *(LAS u32x4*)(RAWL + pr1 * 160 + pc1 * 8) = pf1;
        const u32x2 rc = prc, kc = pkc, vc = pvc, rp = prp, kp = pkp, vp = pvp;
        __syncthreads();
#ifdef REP_PREP
#pragma unroll 1
        for (int rep_ = 0; rep_ < 2; ++rep_) {
#endif
        { const LAS unsigned* rc = (const LAS unsigned*)(RAWL + (s1tok + 1) * 160 + 10 * s1cg); const LAS unsigned* rq = (const LAS unsigned*)(RAWL + s1tok * 160 + 10 * s1cg);
          LAS unsigned* xo = (LAS unsigned*)(X + s1tok * XSTR + 10 * s1cg);
#pragma unroll
          for (int u2 = 0; u2 < 5; ++u2) { const unsigned cw = rc[u2], pw = rq[u2]; float vv2[2];
#pragma unroll
              for (int hh = 0; hh < 2; ++hh) { const int u = 2 * u2 + hh; const float cur = hh ? bfhi(cw) : bflo(cw), prev = hh ? bfhi(pw) : bflo(pw); const float sft = cur + (prev - cur) * s1mu[u];
                  const int jcol = 10 * s1cg + u; const float K = jcol < 32 ? 2.8853900817779268f : -1.4426950408889634f; const float t = __builtin_amdgcn_rcpf(1.f + __builtin_amdgcn_exp2f(K * sft));
                  vv2[hh] = jcol < 32 ? 1.f - 2.f * t : (jcol < 64 ? sft : t); }
              xo[u2] = pk2(vv2[0], vv2[1]); } }
        __syncthreads();
        float rs[4], vs[4], dec[4], av[4], kkr[4], k2[4], gv[4];
        { const LAS bf16* xr = X + (16 * nt + n16) * XSTR + 8 * q;
          const bf16x8 B0 = *(const LAS bf16x8*)xr, B1 = *(const LAS bf16x8*)(xr + 32), B2 = *(const LAS bf16x8*)(xr + 64), B3 = *(const LAS bf16x8*)(xr + 96), B4 = *(const LAS bf16x8*)(xr + 128);
          f32x4v cw = {0.f, 0.f, 0.f, 0.f}, ca = cw, cg = cw;
          cw = __builtin_amdgcn_mfma_f32_16x16x32_bf16(Aw, B0, cw, 0, 0, 0); ca = __builtin_amdgcn_mfma_f32_16x16x32_bf16(Aa, B1, ca, 0, 0, 0);
          cg = __builtin_amdgcn_mfma_f32_16x16x32_bf16(Ag0, B2, cg, 0, 0, 0); cg = __builtin_amdgcn_mfma_f32_16x16x32_bf16(Ag1, B3, cg, 0, 0, 0); cg = __builtin_amdgcn_mfma_f32_16x16x32_bf16(Ag2, B4, cg, 0, 0, 0);
          const int ch0 = 16 * mt + 4 * q;
          const f32x4v mur = *(const LAS f32x4v*)&L[L2_PAR + ch0], muk = *(const LAS f32x4v*)&L[L2_PAR + 64 + ch0], muv = *(const LAS f32x4v*)&L[L2_PAR + 128 + ch0], w0v = *(const LAS f32x4v*)&L[L2_PAR + 192 + ch0];
          const f32x4v a0v = *(const LAS f32x4v*)&L[L2_PAR + 256 + ch0], kkv = *(const LAS f32x4v*)&L[L2_PAR + 320 + ch0], kav = *(const LAS f32x4v*)&L[L2_PAR + 384 + ch0], rkv = *(const LAS f32x4v*)&L[L2_PAR + 448 + ch0];
          const float rcf[4] = {bflo(rc.x), bfhi(rc.x), bflo(rc.y), bfhi(rc.y)}, rpf[4] = {bflo(rp.x), bfhi(rp.x), bflo(rp.y), bfhi(rp.y)};
          const float kcf[4] = {bflo(kc.x), bfhi(kc.x), bflo(kc.y), bfhi(kc.y)}, kpf[4] = {bflo(kp.x), bfhi(kp.x), bflo(kp.y), bfhi(kp.y)};
          const float vcf[4] = {bflo(vc.x), bfhi(vc.x), bflo(vc.y), bfhi(vc.y)}, vpf[4] = {bflo(vp.x), bfhi(vp.x), bflo(vp.y), bfhi(vp.y)};
          float ss = 0.f, bon = 0.f, sbar = 0.f, kr = 0.f;
#pragma unroll
          for (int r = 0; r < 4; ++r) { rs[r] = rcf[r] + (rpf[r] - rcf[r]) * mur[r]; const float ks_ = kcf[r] + (kpf[r] - kcf[r]) * muk[r]; vs[r] = vcf[r] + (vpf[r] - vcf[r]) * muv[r];
              const float wl = w0v[r] + cw[r], al = a0v[r] + ca[r]; gv[r] = cg[r];
              const float wlog = fminf(wl, 0.f) - __logf(1.f + __expf(-fabsf(wl))) - 0.5f; dec[r] = __expf(-__expf(wlog));
              av[r] = __builtin_amdgcn_rcpf(1.f + __expf(-al)); kkr[r] = ks_ * kkv[r]; k2[r] = ks_ * (1.f + (av[r] - 1.f) * kav[r]);
              ss += kkr[r] * kkr[r]; bon += rs[r] * k2[r] * rkv[r]; sbar += kkr[r] * av[r] * rs[r]; kr += k2[r] * rs[r]; }
          ss = hswap16_add(ss, ss); ss = hswap32_add(ss, ss); bon = hswap16_add(bon, bon); bon = hswap32_add(bon, bon); sbar = hswap16_add(sbar, sbar); sbar = hswap32_add(sbar, sbar); kr = hswap16_add(kr, kr); kr = hswap32_add(kr, kr);
          if (q == 0) *(LAS f32x4v*)&L[L2_PART + ((16 * nt + n16) * 4 + mt) * 4] = (f32x4v){ss, bon, sbar, kr}; }
        __syncthreads();
        { const int tok = 16 * nt + n16, ch0 = 16 * mt + 4 * q;
          const f32x4v p0 = *(const LAS f32x4v*)&L[L2_PART + tok * 16], p1 = *(const LAS f32x4v*)&L[L2_PART + tok * 16 + 4], p2 = *(const LAS f32x4v*)&L[L2_PART + tok * 16 + 8], p3 = *(const LAS f32x4v*)&L[L2_PART + tok * 16 + 12];
          const float ss = (p0[0] + p1[0]) + (p2[0] + p3[0]), bon = (p0[1] + p1[1]) + (p2[1] + p3[1]), sbar = (p0[2] + p1[2]) + (p2[2] + p3[2]), kr = (p0[3] + p1[3]) + (p2[3] + p3[3]);
          const float rn = __builtin_amdgcn_rcpf(fmaxf(sqrtf(ss), 1e-12f));
          f32x4v o_a2, o_wr, o_w, o_b2, o_k2, o_v, o_g;
#pragma unroll
          for (int r = 0; r < 4; ++r) { const float kkn = kkr[r] * rn; o_a2[r] = -kkn; o_b2[r] = kkn * av[r]; o_wr[r] = dec[r] * rs[r]; o_w[r] = dec[r]; o_k2[r] = k2[r]; o_v[r] = vs[r]; o_g[r] = gv[r]; }
          const int o = L2_VEC + tok * 64 + ch0;
          *(LAS f32x4v*)&L[o] = o_a2; *(LAS f32x4v*)&L[o + 2048] = o_wr; *(LAS f32x4v*)&L[o + 4096] = o_w; *(LAS f32x4v*)&L[o + 6144] = o_b2; *(LAS f32x4v*)&L[o + 8192] = o_k2; *(LAS f32x4v*)&L[o + 10240] = o_v; *(LAS f32x4v*)&L[o + 12288] = o_g;
          if (mt == 0 && q == 0) { L[L2_SC + 2 * tok] = sbar * rn; L[L2_SC + 2 * tok + 1] = kr; L[L2_SC + 64 + tok] = bon; } }
        __syncthreads();
#ifdef REP_PREP
        }
#endif
        if (t0 + 32 < 2048) RWKV_PREFETCH(t0 + 32)
        { const int rp = tid >> 4, jb = tid & 15; const int vb = L2_VEC + 4 * jb;
          f32x4v na = *(const LAS f32x4v*)&L[vb], nr = *(const LAS f32x4v*)&L[vb + 2048], nw = *(const LAS f32x4v*)&L[vb + 4096], nb = *(const LAS f32x4v*)&L[vb + 6144], nk = *(const LAS f32x4v*)&L[vb + 8192];
          f32x2s nv = *(const LAS f32x2s*)&L[L2_VEC + 10240 + 2 * rp], nsc = *(const LAS f32x2s*)&L[L2_SC];
#pragma unroll 2
          for (int tok = 0; tok < 32; ++tok) {
              const f32x4v av = na, rv = nr, wv = nw, bv = nb, kv = nk; const f32x2s vv = nv, sc = nsc;
              { const int tn = min(tok + 1, 31); const int o = vb + tn * 64;
                na = *(const LAS f32x4v*)&L[o]; nr = *(const LAS f32x4v*)&L[o + 2048]; nw = *(const LAS f32x4v*)&L[o + 4096]; nb = *(const LAS f32x4v*)&L[o + 6144]; nk = *(const LAS f32x4v*)&L[o + 8192];
                nv = *(const LAS f32x2s*)&L[L2_VEC + 10240 + tn * 64 + 2 * rp]; nsc = *(const LAS f32x2s*)&L[L2_SC + 2 * tn]; }
              f32x2s p1 = S2[0] * av[0]; p1 = S2[1] * av[1] + p1; p1 = S2[2] * av[2] + p1; p1 = S2[3] * av[3] + p1;
              f32x2s p2 = S2[0] * rv[0]; p2 = S2[1] * rv[1] + p2; p2 = S2[2] * rv[2] + p2; p2 = S2[3] * rv[3] + p2;
              { float r0 = p1.x, r1 = p1.y, r2 = p2.x, r3 = p2.y;
                asm volatile("s_nop 1\n\t"
                    "v_add_f32_dpp %0, %0, %0 quad_perm:[1,0,3,2] row_mask:0xf bank_mask:0xf bound_ctrl:1\n\tv_add_f32_dpp %1, %1, %1 quad_perm:[1,0,3,2] row_mask:0xf bank_mask:0xf bound_ctrl:1\n\t"
                    "v_add_f32_dpp %2, %2, %2 quad_perm:[1,0,3,2] row_mask:0xf bank_mask:0xf bound_ctrl:1\n\tv_add_f32_dpp %3, %3, %3 quad_perm:[1,0,3,2] row_mask:0xf bank_mask:0xf bound_ctrl:1\n\t"
                    "v_add_f32_dpp %0, %0, %0 quad_perm:[2,3,0,1] row_mask:0xf bank_mask:0xf bound_ctrl:1\n\tv_add_f32_dpp %1, %1, %1 quad_perm:[2,3,0,1] row_mask:0xf bank_mask:0xf bound_ctrl:1\n\t"
                    "v_add_f32_dpp %2, %2, %2 quad_perm:[2,3,0,1] row_mask:0xf bank_mask:0xf bound_ctrl:1\n\tv_add_f32_dpp %3, %3, %3 quad_perm:[2,3,0,1] row_mask:0xf bank_mask:0xf bound_ctrl:1\n\t"
                    "v_add_f32_dpp %0, %0, %0 row_half_mirror row_mask:0xf bank_mask:0xf bound_ctrl:1\n\tv_add_f32_dpp %1, %1, %1 row_half_mirror row_mask:0xf bank_mask:0xf bound_ctrl:1\n\t"
                    "v_add_f32_dpp %2, %2, %2 row_half_mirror row_mask:0xf bank_mask:0xf bound_ctrl:1\n\tv_add_f32_dpp %3, %3, %3 row_half_mirror row_mask:0xf bank_mask:0xf bound_ctrl:1\n\t"
                    "v_add_f32_dpp %0, %0, %0 row_mirror row_mask:0xf bank_mask:0xf bound_ctrl:1\n\tv_add_f32_dpp %1, %1, %1 row_mirror row_mask:0xf bank_mask:0xf bound_ctrl:1\n\t"
                    "v_add_f32_dpp %2, %2, %2 row_mirror row_mask:0xf bank_mask:0xf bound_ctrl:1\n\tv_add_f32_dpp %3, %3, %3 row_mirror row_mask:0xf bank_mask:0xf bound_ctrl:1\n\ts_nop 1"
                    : "+v"(r0), "+v"(r1), "+v"(r2), "+v"(r3));
                p1 = (f32x2s){r0, r1}; p2 = (f32x2s){r2, r3}; }
              const f32x2s y = p2 + p1 * sc.x + vv * sc.y;
#pragma unroll
              for (int c4 = 0; c4 < 4; ++c4) S2[c4] = S2[c4] * wv[c4] + (p1 * bv[c4] + vv * kv[c4]);
              if (jb == 0) *(LAS f32x2s*)&L[L2_Y + tok * 64 + 2 * rp] = y; } }
        __syncthreads();
        { const int tok = tid >> 4, ch0 = (tid & 15) * 4;
          const f32x4v y = *(const LAS f32x4v*)&L[L2_Y + tok * 64 + ch0], vv = *(const LAS f32x4v*)&L[L2_VEC + 10240 + tok * 64 + ch0], gg = *(const LAS f32x4v*)&L[L2_VEC + 12288 + tok * 64 + ch0];
          const f32x4v lg = *(const LAS f32x4v*)&L[L2_PAR + 512 + ch0], lb = *(const LAS f32x4v*)&L[L2_PAR + 576 + ch0];
          const float mean = reduce16((y[0] + y[1]) + (y[2] + y[3])) * (1.f / 64.f);
          const f32x4v d = y - mean; const float var = reduce16((d[0] * d[0] + d[1] * d[1]) + (d[2] * d[2] + d[3] * d[3])) * (1.f / 64.f);
          const float rstd = __builtin_amdgcn_rsqf(var + 64e-5f), bon = L[L2_SC + 64 + tok];
          const f32x4v o = (d * rstd * lg + lb + vv * bon) * gg;
          u32x2 w; w.x = pk2(o[0], o[1]); w.y = pk2(o[2], o[3]);
          *(u32x2*)(CAT + (row0 + t0 + tok) * 1024 + 512 + h * 64 + ch0) = w; }
    }
#undef RWKV_PREFETCH
    __syncthreads();
}

constexpr int L3_TS = 68, L3_AS = 32 * L3_TS;
constexpr int L3_PAR = 0, L3_SC = 832, L3_VEC = 1280, L3_VSZ = 6 * L3_AS + 1088, L3_Y = L3_VEC + 2 * L3_VSZ;
constexpr int L3_RAWB = (L3_Y + 2048) * 4, L3_PWSZ = 5632, L3_XB = L3_RAWB + 2 * L3_PWSZ;
#define R3_STEP(ctrl) \
    "v_add_f32_dpp %0, %0, %0 " ctrl " row_mask:0xf bank_mask:0xf bound_ctrl:1\n\tv_add_f32_dpp %1, %1, %1 " ctrl " row_mask:0xf bank_mask:0xf bound_ctrl:1\n\t" \
    "v_add_f32_dpp %2, %2, %2 " ctrl " row_mask:0xf bank_mask:0xf bound_ctrl:1\n\tv_add_f32_dpp %3, %3, %3 " ctrl " row_mask:0xf bank_mask:0xf bound_ctrl:1\n\t" \
    "v_add_f32_dpp %4, %4, %4 " ctrl " row_mask:0xf bank_mask:0xf bound_ctrl:1\n\tv_add_f32_dpp %5, %5, %5 " ctrl " row_mask:0xf bank_mask:0xf bound_ctrl:1\n\t" \
    "v_add_f32_dpp %6, %6, %6 " ctrl " row_mask:0xf bank_mask:0xf bound_ctrl:1\n\tv_add_f32_dpp %7, %7, %7 " ctrl " row_mask:0xf bank_mask:0xf bound_ctrl:1\n\t"
__device__ __forceinline__ void cvt_row_store(const Args& a, int layer, int row, int lane, f32x4 v0, f32x4 v1, f32x4 v2, f32x4 v3) {
    unsigned char* U8 = a.ws + WS_EXP + (size_t)layer * 48 * MiB; unsigned char* VS8 = a.ws + WS_EXP + (size_t)layer * 48 * MiB + 16 * MiB; float* SC = (float*)(a.ws + WS_EXP + (size_t)layer * 48 * MiB + 32 * MiB);
    const int e = row & 16383; const bool isv = row >= 16384;
    float am = fmaxf(fmaxf(fmaxf(fabsf(v0.x), fabsf(v0.y)), fmaxf(fabsf(v0.z), fabsf(v0.w))), fmaxf(fmaxf(fabsf(v1.x), fabsf(v1.y)), fmaxf(fabsf(v1.z), fabsf(v1.w))));
    am = fmaxf(am, fmaxf(fmaxf(fmaxf(fabsf(v2.x), fabsf(v2.y)), fmaxf(fabsf(v2.z), fabsf(v2.w))), fmaxf(fmaxf(fabsf(v3.x), fabsf(v3.y)), fmaxf(fabsf(v3.z), fabsf(v3.w)))));
    am = wave_max_dpp(am);
    const float sc = am > 0.f ? am * (1.f / 448.f) : 1.f, inv = am > 0.f ? 448.f / am : 1.f;
    u32x4 o; int w;
    w = 0; w = __builtin_amdgcn_cvt_pk_fp8_f32(v0.x * inv, v0.y * inv, w, false); w = __builtin_amdgcn_cvt_pk_fp8_f32(v0.z * inv, v0.w * inv, w, true); o.x = (unsigned)w;
    w = 0; w = __builtin_amdgcn_cvt_pk_fp8_f32(v1.x * inv, v1.y * inv, w, false); w = __builtin_amdgcn_cvt_pk_fp8_f32(v1.z * inv, v1.w * inv, w, true); o.y = (unsigned)w;
    w = 0; w = __builtin_amdgcn_cvt_pk_fp8_f32(v2.x * inv, v2.y * inv, w, false); w = __builtin_amdgcn_cvt_pk_fp8_f32(v2.z * inv, v2.w * inv, w, true); o.z = (unsigned)w;
    w = 0; w = __builtin_amdgcn_cvt_pk_fp8_f32(v3.x * inv, v3.y * inv, w, false); w = __builtin_amdgcn_cvt_pk_fp8_f32(v3.z * inv, v3.w * inv, w, true); o.w = (unsigned)w;
    unsigned char* dst = (isv ? VS8 : U8) + ((size_t)(lane >> 3) * 16384 + e) * 128 + (lane & 7) * 16;
    *(u32x4*)dst = o;
    if (lane == 0) SC[2 * e + (isv ? 1 : 0)] = sc;
}
__device__ __forceinline__ void rwkv_unit3(const Args& a, LAS float* L, int unit, int i2, const bf16* P, bf16* CAT, int tid) {
    typedef float f32x4v __attribute__((ext_vector_type(4)));
    typedef float f32x2s __attribute__((ext_vector_type(2)));
    constexpr int PS = EVEN_PAD;
    const int b = unit >> 3, h = unit & 7, lane = tid & 63, wave = __builtin_amdgcn_readfirstlane(tid >> 6);
    const float* mu = a.in[5] + i2 * 1696;
    if (tid < 64) { const int c = tid, col = h * 64 + c; L[L3_PAR + c] = mu[col]; L[L3_PAR + 64 + c] = mu[512 + col]; L[L3_PAR + 128 + c] = mu[1024 + col]; L[L3_PAR + 192 + c] = (a.in[6] + i2 * 512)[col];
        L[L3_PAR + 256 + c] = (a.in[8] + i2 * 512)[col]; L[L3_PAR + 320 + c] = (a.in[11] + i2 * 512)[col]; L[L3_PAR + 384 + c] = (a.in[12] + i2 * 512)[col]; L[L3_PAR + 448 + c] = (a.in[13] + i2 * 512)[col];
        L[L3_PAR + 512 + c] = (a.in[14] + i2 * 512)[col]; L[L3_PAR + 576 + c] = (a.in[15] + i2 * 512)[col]; }
    if (tid < 160) L[L3_PAR + 640 + tid] = mu[1536 + tid];
    __syncthreads();
    const size_t row0 = (size_t)b * 2048;
    if (wave < 4) {
        const int rp = tid >> 3, jb = tid & 7;
        f32x2s S2[8];
#pragma unroll
        for (int e = 0; e < 8; ++e) S2[e] = (f32x2s){0.f, 0.f};
        __syncthreads();
        __builtin_amdgcn_s_setprio(3);
#define R3_STEP4(ctrl) \
    "v_add_f32_dpp %0, %0, %0 " ctrl " row_mask:0xf bank_mask:0xf bound_ctrl:1\n\tv_add_f32_dpp %1, %1, %1 " ctrl " row_mask:0xf bank_mask:0xf bound_ctrl:1\n\t" \
    "v_add_f32_dpp %2, %2, %2 " ctrl " row_mask:0xf bank_mask:0xf bound_ctrl:1\n\tv_add_f32_dpp %3, %3, %3 " ctrl " row_mask:0xf bank_mask:0xf bound_ctrl:1\n\t"
#pragma unroll 1
        for (int it = 0; it < 66; ++it) {
            if (it >= 1 && it <= 64) {
                const int bs = (it - 1) & 1; const int vb = L3_VEC + bs * L3_VSZ + 8 * jb, vv0 = L3_VEC + bs * L3_VSZ + 5 * L3_AS + 2 * rp, sc0 = L3_SC + bs * 128; LAS bf16* yb = (LAS bf16*)&L[L3_Y + bs * 1024] + 2 * rp;
                f32x4v na0 = *(const LAS f32x4v*)&L[vb], na1 = *(const LAS f32x4v*)&L[vb + 4], nr0 = *(const LAS f32x4v*)&L[vb + 1 * L3_AS], nr1 = *(const LAS f32x4v*)&L[vb + 1 * L3_AS + 4], nw0 = *(const LAS f32x4v*)&L[vb + 2 * L3_AS], nw1 = *(const LAS f32x4v*)&L[vb + 2 * L3_AS + 4];
                f32x4v nb0 = *(const LAS f32x4v*)&L[vb + 3 * L3_AS], nb1 = *(const LAS f32x4v*)&L[vb + 3 * L3_AS + 4], nk0 = *(const LAS f32x4v*)&L[vb + 4 * L3_AS], nk1 = *(const LAS f32x4v*)&L[vb + 4 * L3_AS + 4];
                f32x2s nv = *(const LAS f32x2s*)&L[vv0]; f32x4v nsc = *(const LAS f32x4v*)&L[sc0];
#pragma unroll 2
                for (int tok = 0; tok < 32; ++tok) {
                    const float av[8] = {na0[0], na0[1], na0[2], na0[3], na1[0], na1[1], na1[2], na1[3]}, rv[8] = {nr0[0], nr0[1], nr0[2], nr0[3], nr1[0], nr1[1], nr1[2], nr1[3]};
                    const float wv[8] = {nw0[0], nw0[1], nw0[2], nw0[3], nw1[0], nw1[1], nw1[2], nw1[3]}, bv[8] = {nb0[0], nb0[1], nb0[2], nb0[3], nb1[0], nb1[1], nb1[2], nb1[3]};
                    const float kv[8] = {nk0[0], nk0[1], nk0[2], nk0[3], nk1[0], nk1[1], nk1[2], nk1[3]}; const f32x2s vv = nv; const f32x4v sc = nsc;
                    { const int tn = min(tok + 1, 31); const int o = vb + tn * L3_TS;
                      na0 = *(const LAS f32x4v*)&L[o]; na1 = *(const LAS f32x4v*)&L[o + 4]; nr0 = *(const LAS f32x4v*)&L[o + 1 * L3_AS]; nr1 = *(const LAS f32x4v*)&L[o + 1 * L3_AS + 4]; nw0 = *(const LAS f32x4v*)&L[o + 2 * L3_AS]; nw1 = *(const LAS f32x4v*)&L[o + 2 * L3_AS + 4];
                      nb0 = *(const LAS f32x4v*)&L[o + 3 * L3_AS]; nb1 = *(const LAS f32x4v*)&L[o + 3 * L3_AS + 4]; nk0 = *(const LAS f32x4v*)&L[o + 4 * L3_AS]; nk1 = *(const LAS f32x4v*)&L[o + 4 * L3_AS + 4];
                      nv = *(const LAS f32x2s*)&L[vv0 + tn * L3_TS]; nsc = *(const LAS f32x4v*)&L[sc0 + 4 * tn]; }
                    f32x2s pa = S2[0] * av[0], pb = S2[4] * av[4], qa = S2[0] * rv[0], qb = S2[4] * rv[4];
                    __builtin_amdgcn_sched_barrier(0);
                    pa = S2[1] * av[1] + pa; pb = S2[5] * av[5] + pb; qa = S2[1] * rv[1] + qa; qb = S2[5] * rv[5] + qb;
                    __builtin_amdgcn_sched_barrier(0);
                    pa = S2[2] * av[2] + pa; pb = S2[6] * av[6] + pb; qa = S2[2] * rv[2] + qa; qb = S2[6] * rv[6] + qb;
                    __builtin_amdgcn_sched_barrier(0);
                    pa = S2[3] * av[3] + pa; pb = S2[7] * av[7] + pb; qa = S2[3] * rv[3] + qa; qb = S2[7] * rv[7] + qb;
                    __builtin_amdgcn_sched_barrier(0);
                    pa = pa + pb; qa = qa + qb;
                    f32x2s u[8];
#pragma unroll
                    for (int c = 0; c < 8; ++c) u[c] = vv * kv[c];
                    __builtin_amdgcn_sched_barrier(0);
                    { float r0 = pa.x, r1 = pa.y, r2 = qa.x, r3 = qa.y;
                      asm volatile("s_nop 1\n\t" R3_STEP4("quad_perm:[1,0,3,2]") R3_STEP4("quad_perm:[2,3,0,1]") R3_STEP4("row_half_mirror") "s_nop 1"
                          : "+v"(r0), "+v"(r1), "+v"(r2), "+v"(r3));
                      pa = (f32x2s){r0, r1} * sc[2]; qa = (f32x2s){r2, r3}; }
                    const f32x2s y = qa + pa * sc[0] + vv * sc[1];
                    __builtin_amdgcn_sched_barrier(0);
#pragma unroll
                    for (int c = 0; c < 8; ++c) u[c] = pa * bv[c] + u[c];
                    __builtin_amdgcn_sched_barrier(0);
#pragma unroll
                    for (int c = 0; c < 8; ++c) S2[c] = S2[c] * wv[c] + u[c];
                    __builtin_amdgcn_sched_barrier(0);
                    if (jb == 0) *(LAS unsigned*)(yb + tok * 64) = pk2(y.x, y.y); }
            }
            __syncthreads();
        }
#undef R3_STEP4
        __builtin_amdgcn_s_setprio(0);
    } else if (wave < 6) {
        const int nt = wave - 4, n16 = lane & 15, q = lane >> 4;
        u32x4 AOP[4][5];
#pragma unroll
        for (int mt = 0; mt < 4; ++mt) { const int col = h * 64 + 16 * mt + n16; const float* w2 = a.in[7] + i2 * 32 * 512 + col; const float* a2 = a.in[9] + i2 * 32 * 512 + col; const float* g2 = a.in[10] + i2 * 96 * 512 + col;
            u32x4 t;
#define LDF(op, src, k0) t.x = pk2(src[((k0) + 8 * q + 0) * 512], src[((k0) + 8 * q + 1) * 512]); t.y = pk2(src[((k0) + 8 * q + 2) * 512], src[((k0) + 8 * q + 3) * 512]); \
            t.z = pk2(src[((k0) + 8 * q + 4) * 512], src[((k0) + 8 * q + 5) * 512]); t.w = pk2(src[((k0) + 8 * q + 6) * 512], src[((k0) + 8 * q + 7) * 512]); AOP[mt][op] = t;
            LDF(0, w2, 0) LDF(1, a2, 0) LDF(2, g2, 0) LDF(3, g2, 32) LDF(4, g2, 64)
#undef LDF
        }
        u32x2 qrc[4], qkc[4], qvc[4], qrp[4], qkp[4], qvp[4];
#define R3_QUADS(tt) { const size_t t_ = (size_t)(tt); const bf16* pr = P + (row0 + t_) * PS + h * 64 + 4 * q; const bf16* pp = P + (row0 + (t_ > 0 ? t_ - 1 : 0)) * PS + h * 64 + 4 * q; \
            _Pragma("unroll") for (int mt = 0; mt < 4; ++mt) { qrc[mt] = *(const u32x2*)(pr + R_R + 16 * mt); qkc[mt] = *(const u32x2*)(pr + R_K + 16 * mt); qvc[mt] = *(const u32x2*)(pr + R_V + 16 * mt); \
                qrp[mt] = *(const u32x2*)(pp + R_R + 16 * mt); qkp[mt] = *(const u32x2*)(pp + R_K + 16 * mt); qvp[mt] = *(const u32x2*)(pp + R_V + 16 * mt); } }
        R3_QUADS(16 * nt + n16)
        __syncthreads();
#pragma unroll 1
        for (int it = 0; it < 66; ++it) {
            if (it >= 2) {
                const int c = it - 2, bs = c & 1, tok = 16 * nt + (lane >> 2), cb = 16 * (lane & 3);
                const LAS bf16* yp = (const LAS bf16*)&L[L3_Y + bs * 1024] + tok * 64 + cb; const int vo = L3_VEC + bs * L3_VSZ + 5 * L3_AS + tok * L3_TS + cb; const LAS bf16* gp = (const LAS bf16*)&L[L3_VEC + bs * L3_VSZ + 6 * L3_AS] + tok * L3_TS + cb;
                f32x4v y[4]; float s = 0.f;
#pragma unroll
                for (int k = 0; k < 4; ++k) { const u32x2 yw = *(const LAS u32x2*)(yp + 4 * k); y[k] = (f32x4v){bflo(yw.x), bfhi(yw.x), bflo(yw.y), bfhi(yw.y)}; s += (y[k][0] + y[k][1]) + (y[k][2] + y[k][3]); }
                s += dpp_f<0xB1>(s); s += dpp_f<0x4E>(s); const float mean = s * (1.f / 64.f); float s2 = 0.f;
#pragma unroll
                for (int k = 0; k < 4; ++k) { y[k] = y[k] - mean; s2 += (y[k][0] * y[k][0] + y[k][1] * y[k][1]) + (y[k][2] * y[k][2] + y[k][3] * y[k][3]); }
                s2 += dpp_f<0xB1>(s2); s2 += dpp_f<0x4E>(s2);
                const float rstd = __builtin_amdgcn_rsqf(s2 * (1.f / 64.f) + 64e-5f), bon = L[L3_SC + bs * 128 + 4 * tok + 3];
                u32x4 w0, w1;
#pragma unroll
                for (int k = 0; k < 4; ++k) { const u32x2 gw = *(const LAS u32x2*)(gp + 4 * k); const f32x4v vv = *(const LAS f32x4v*)&L[vo + 4 * k], gg = {bflo(gw.x), bfhi(gw.x), bflo(gw.y), bfhi(gw.y)}, lg = *(const LAS f32x4v*)&L[L3_PAR + 512 + cb + 4 * k], lb = *(const LAS f32x4v*)&L[L3_PAR + 576 + cb + 4 * k];
                    f32x4v o = (y[k] * rstd * lg + lb + vv * bon) * gg;
                    const unsigned lo_ = pk2(o[0], o[1]), hi_ = pk2(o[2], o[3]);
                    if (k == 0) { w0.x = lo_; w0.y = hi_; } else if (k == 1) { w0.z = lo_; w0.w = hi_; } else if (k == 2) { w1.x = lo_; w1.y = hi_; } else { w1.z = lo_; w1.w = hi_; } }
                u32x4* dst = (u32x4*)(CAT + (row0 + c * 32 + tok) * 1024 + 512 + h * 64 + cb); dst[0] = w0; dst[1] = w1;
            }
            LDS_WAIT();
            if (it < 64) {
                const int t0 = it * 32, bs = it & 1, tok = 16 * nt + n16; const size_t t = (size_t)(t0 + tok);
                const LAS bf16* XS = (const LAS bf16*)((LAS unsigned char*)L + L3_XB + ((it & 1) * 2 + nt) * L3_PWSZ);
                const LAS bf16* xr = XS + n16 * XSTR + 8 * q;
                float ss = 0.f, bon = 0.f, sbar = 0.f, kr = 0.f;
                const int ob = L3_VEC + bs * L3_VSZ + tok * L3_TS + 4 * q;
#pragma unroll
                for (int mt = 0; mt < 4; ++mt) {
                    const u32x2 z2_ = {0u, 0u}; const u32x2 rc = qrc[mt], kc = qkc[mt], vc = qvc[mt], rp = t == 0 ? z2_ : qrp[mt], kp = t == 0 ? z2_ : qkp[mt], vp = t == 0 ? z2_ : qvp[mt];
                    f32x4v cw = {0.f, 0.f, 0.f, 0.f}, ca = cw, cg = cw;
                    { const bf16x8 B0 = *(const LAS bf16x8*)xr, B1 = *(const LAS bf16x8*)(xr + 32), B2 = *(const LAS bf16x8*)(xr + 64), B3 = *(const LAS bf16x8*)(xr + 96), B4 = *(const LAS bf16x8*)(xr + 128);
                      cw = __builtin_amdgcn_mfma_f32_16x16x32_bf16(__builtin_bit_cast(bf16x8, AOP[mt][0]), B0, cw, 0, 0, 0); ca = __builtin_amdgcn_mfma_f32_16x16x32_bf16(__builtin_bit_cast(bf16x8, AOP[mt][1]), B1, ca, 0, 0, 0);
                      cg = __builtin_amdgcn_mfma_f32_16x16x32_bf16(__builtin_bit_cast(bf16x8, AOP[mt][2]), B2, cg, 0, 0, 0); cg = __builtin_amdgcn_mfma_f32_16x16x32_bf16(__builtin_bit_cast(bf16x8, AOP[mt][3]), B3, cg, 0, 0, 0);
                      cg = __builtin_amdgcn_mfma_f32_16x16x32_bf16(__builtin_bit_cast(bf16x8, AOP[mt][4]), B4, cg, 0, 0, 0);
                    }
                    const int ch0 = 16 * mt + 4 * q;
                    const f32x4v mur = *(const LAS f32x4v*)&L[L3_PAR + ch0], muk = *(const LAS f32x4v*)&L[L3_PAR + 64 + ch0], muv = *(const LAS f32x4v*)&L[L3_PAR + 128 + ch0], w0v = *(const LAS f32x4v*)&L[L3_PAR + 192 + ch0];
                    const f32x4v a0v = *(const LAS f32x4v*)&L[L3_PAR + 256 + ch0], kkv = *(const LAS f32x4v*)&L[L3_PAR + 320 + ch0], kav = *(const LAS f32x4v*)&L[L3_PAR + 384 + ch0], rkv = *(const LAS f32x4v*)&L[L3_PAR + 448 + ch0];
                    const float rcf[4] = {bflo(rc.x), bfhi(rc.x), bflo(rc.y), bfhi(rc.y)}, rpf[4] = {bflo(rp.x), bfhi(rp.x), bflo(rp.y), bfhi(rp.y)};
                    const float kcf[4] = {bflo(kc.x), bfhi(kc.x), bflo(kc.y), bfhi(kc.y)}, kpf[4] = {bflo(kp.x), bfhi(kp.x), bflo(kp.y), bfhi(kp.y)};
                    const float vcf[4] = {bflo(vc.x), bfhi(vc.x), bflo(vc.y), bfhi(vc.y)}, vpf[4] = {bflo(vp.x), bfhi(vp.x), bflo(vp.y), bfhi(vp.y)};
                    f32x4v o_a2, o_b2, o_wr, o_w, o_k2, o_v, o_g;
#pragma unroll
                    for (int r = 0; r < 4; ++r) { const float rs = rcf[r] + (rpf[r] - rcf[r]) * mur[r]; const float ks_ = kcf[r] + (kpf[r] - kcf[r]) * muk[r]; const float vs = vcf[r] + (vpf[r] - vcf[r]) * muv[r];
                        const float wl = w0v[r] + cw[r], al = a0v[r] + ca[r];
                        const float dec = __expf(-0.6065306597126334f * __builtin_amdgcn_rcpf(1.f + __expf(-wl)));
                        const float avr = __builtin_amdgcn_rcpf(1.f + __expf(-al)); const float kk = ks_ * kkv[r]; const float k2 = ks_ * (1.f + (avr - 1.f) * kav[r]);
                        ss += kk * kk; bon += rs * k2 * rkv[r]; sbar += kk * avr * rs; kr += k2 * rs;
                        o_a2[r] = -kk; o_b2[r] = kk * avr; o_wr[r] = dec * rs; o_w[r] = dec; o_k2[r] = k2; o_v[r] = vs; o_g[r] = cg[r]; }
                    const int o = ob + 16 * mt;
                    *(LAS f32x4v*)&L[o] = o_a2; *(LAS f32x4v*)&L[o + 1 * L3_AS] = o_wr; *(LAS f32x4v*)&L[o + 2 * L3_AS] = o_w; *(LAS f32x4v*)&L[o + 3 * L3_AS] = o_b2; *(LAS f32x4v*)&L[o + 4 * L3_AS] = o_k2; *(LAS f32x4v*)&L[o + 5 * L3_AS] = o_v;
                    *(LAS u32x2*)((LAS bf16*)&L[L3_VEC + bs * L3_VSZ + 6 * L3_AS] + tok * L3_TS + ch0) = (u32x2){pk2(o_g[0], o_g[1]), pk2(o_g[2], o_g[3])};
                }
                ss = hswap16_add(ss, ss); ss = hswap32_add(ss, ss); bon = hswap16_add(bon, bon); bon = hswap32_add(bon, bon); sbar = hswap16_add(sbar, sbar); sbar = hswap32_add(sbar, sbar); kr = hswap16_add(kr, kr); kr = hswap32_add(kr, kr);
                const float rn = __builtin_amdgcn_rcpf(fmaxf(sqrtf(ss), 1e-12f));
                if (q == 0) *(LAS f32x4v*)&L[L3_SC + bs * 128 + 4 * tok] = (f32x4v){sbar, kr, rn * rn, bon};
                if (it + 1 < 64) R3_QUADS(t0 + 32 + tok)
            }
            __syncthreads();
        }
    } else {
        const int nt = wave - 6;
        LAS bf16* RAWS = (LAS bf16*)((LAS unsigned char*)L + L3_RAWB + nt * L3_PWSZ);
        const int s1cg = lane & 15;
        u32x4 pf[6];
#define R3_PIECE(i) const int p_ = min(lane + 64 * (i), 339); const int prow_ = (p_ * 205) >> 12; const int ppc_ = p_ - 20 * prow_;
#define R3_PREFETCH(tq) { _Pragma("unroll") for (int i = 0; i < 6; ++i) { R3_PIECE(i) const int t_ = max((tq) - 1 + 16 * nt + prow_, 0); pf[i] = *(const u32x4*)(P + (row0 + t_) * PS + R_WL + ppc_ * 8); } }
        R3_PREFETCH(0)
#pragma unroll 1
        for (int it = -1; it < 66; ++it) {
            if (it + 1 < 64) {
                const int t0 = (it + 1) * 32;
                LAS bf16* XS = (LAS bf16*)((LAS unsigned char*)L + L3_XB + (((it + 1) & 1) * 2 + nt) * L3_PWSZ);
#pragma unroll
                for (int i = 0; i < 6; ++i) { R3_PIECE(i) u32x4 v = pf[i]; if (t0 - 1 + 16 * nt + prow_ < 0) v = (u32x4){0u, 0u, 0u, 0u}; *(LAS u32x4*)(RAWS + prow_ * 160 + ppc_ * 8) = v; }
                LDS_WAIT();
                if (it + 2 < 64) R3_PREFETCH(t0 + 32)
                { float s1mu[10];
#pragma unroll
                  for (int u2 = 0; u2 < 5; ++u2) { const f32x2s mm = *(const LAS f32x2s*)&L[L3_PAR + 640 + 10 * s1cg + 2 * u2]; s1mu[2 * u2] = mm.x; s1mu[2 * u2 + 1] = mm.y; }
                  unsigned cwa[4][5], pwa[4][5];
#pragma unroll
                  for (int ps = 0; ps < 4; ++ps) { const int tl = (lane >> 4) + 4 * ps;
                    const LAS unsigned* rcw = (const LAS unsigned*)(RAWS + (tl + 1) * 160 + 10 * s1cg); const LAS unsigned* rpw = (const LAS unsigned*)(RAWS + tl * 160 + 10 * s1cg);
#pragma unroll
                    for (int u2 = 0; u2 < 5; ++u2) { cwa[ps][u2] = rcw[u2]; pwa[ps][u2] = rpw[u2]; } }
#pragma unroll
                  for (int ps = 0; ps < 4; ++ps) { const int tl = (lane >> 4) + 4 * ps;
                    LAS unsigned* xo = (LAS unsigned*)(XS + tl * XSTR + 10 * s1cg);
#pragma unroll
                    for (int u2 = 0; u2 < 5; ++u2) { const unsigned cw = cwa[ps][u2], pw = pwa[ps][u2]; float vv2[2];
#pragma unroll
                        for (int hh = 0; hh < 2; ++hh) { const int u = 2 * u2 + hh; const float cur = hh ? bfhi(cw) : bflo(cw), prev = hh ? bfhi(pw) : bflo(pw); const float sft = cur + (prev - cur) * s1mu[u];
                            const int jcol = 10 * s1cg + u; const float K = jcol < 32 ? 2.8853900817779268f : -1.4426950408889634f; const float tt = __builtin_amdgcn_rcpf(1.f + __builtin_amdgcn_exp2f(K * sft));
                            vv2[hh] = jcol < 32 ? 1.f - 2.f * tt : (jcol < 64 ? sft : tt); }
                        xo[u2] = pk2(vv2[0], vv2[1]); } } }
            }
            __syncthreads();
        }
#undef R3_PREFETCH
#undef R3_PIECE
    }
    __syncthreads();
}

constexpr int LG_W2 = 0, LG_B = 1024, LG_NG = 1088, LG_GAL = 1216, LG_Q = 1728, LG_K = 3776, LG_A = 5824, LG_V = 7872, LG_O = 11968;
__device__ __forceinline__ void gla_unit(const Args& a, LAS float* L, int unit, int i2, const bf16* P, bf16* CAT, int tid) {
    constexpr int PS = EVEN_PAD;
    const int b = unit >> 2, h = unit & 3, lane = tid & 63, wave = __builtin_amdgcn_readfirstlane(tid >> 6);
    const float* w2 = a.in[2] + i2 * 16 * 256; const float* ab = a.in[3] + i2 * 256; const float* ng = a.in[4] + i2 * 128;
    for (int idx = tid; idx < 1024; idx += 512) { const int j = idx >> 6, d = idx & 63; L[LG_W2 + idx] = w2[j * 256 + h * 64 + d]; }
    if (tid < 64) L[LG_B + tid] = ab[h * 64 + tid];
    if (tid < 128) L[LG_NG + tid] = ng[tid];
    float S[64];
#pragma unroll
    for (int d = 0; d < 64; ++d) S[d] = 0.f;
    __syncthreads();
    const size_t row0 = (size_t)b * 2048;
    for (int t0 = 0; t0 < 2048; t0 += 32) {
        { const int tok = tid >> 4, j = tid & 15; L[LG_GAL + tid] = bf2f(P[(row0 + t0 + tok) * PS + G_AL + j]); }
        for (int idx = tid; idx < 32 * 64; idx += 512) { const int tok = idx >> 6, d = idx & 63; const bf16* pr = P + (row0 + t0 + tok) * PS;
            L[LG_Q + idx] = bf2f(pr[G_Q + h * 64 + d]) * 0.125f; L[LG_K + idx] = bf2f(pr[G_K + h * 64 + d]); }
        for (int idx = tid; idx < 32 * 128; idx += 512) { const int tok = idx >> 7, e = idx & 127; L[LG_V + idx] = bf2f(P[(row0 + t0 + tok) * PS + G_V + h * 128 + e]); }
        __syncthreads();
        for (int idx = tid; idx < 32 * 64; idx += 512) { const int tok = idx >> 6, d = idx & 63; float la = L[LG_B + d];
#pragma unroll
            for (int j = 0; j < 16; ++j) la += L[LG_GAL + tok * 16 + j] * L[LG_W2 + j * 64 + d];
            const float ls = fminf(la, 0.f) - log1pf(expf(-fabsf(la))); L[LG_A + idx] = expf(ls * (1.f / 16.f)); }
        __syncthreads();
        if (tid < 128) { const int e = tid;
#pragma unroll 1
            for (int tok = 0; tok < 32; ++tok) { const float ve = L[LG_V + tok * 128 + e]; float o = 0.f;
#pragma unroll
                for (int d4 = 0; d4 < 16; ++d4) { const f32x4 av = *(const LAS f32x4*)&L[LG_A + tok * 64 + d4 * 4], kv = *(const LAS f32x4*)&L[LG_K + tok * 64 + d4 * 4], qv = *(const LAS f32x4*)&L[LG_Q + tok * 64 + d4 * 4];
#pragma unroll
                    for (int u = 0; u < 4; ++u) { S[d4 * 4 + u] = av[u] * S[d4 * 4 + u] + kv[u] * ve; o += qv[u] * S[d4 * 4 + u]; } }
                L[LG_O + tok * 128 + e] = o; } }
        __syncthreads();
#pragma unroll
        for (int i = 0; i < 4; ++i) { const int tok = wave * 4 + i; const size_t row = row0 + t0 + tok; const float o0 = L[LG_O + tok * 128 + lane], o1 = L[LG_O + tok * 128 + 64 + lane];
            const float ms = wave_sum(o0 * o0 + o1 * o1) * (1.f / 128.f); const float r = 1.f / sqrtf(ms + LN_EPS);
            const bf16* pr = P + row * PS + G_G + h * 128; const float g0 = bf2f(pr[lane]), g1 = bf2f(pr[64 + lane]);
            CAT[row * 1024 + h * 128 + lane] = (bf16)f2bf(o0 * r * L[LG_NG + lane] * (g0 / (1.f + expf(-g0))));
            CAT[row * 1024 + h * 128 + 64 + lane] = (bf16)f2bf(o1 * r * L[LG_NG + 64 + lane] * (g1 / (1.f + expf(-g1)))); }
    }
    __syncthreads();
}

constexpr int GSTR = 72, GOSTR = 132;
constexpr int GB_QIN = 0, GB_KIN = 9216, GB_KOT = 18432, GB_VT = 27648, GB_STB = 46080, GB_O = 64512, GB_GAL = 98304, GB_TOT = 102400, GB_DEC = 104448, GB_NG = 104704;
__device__ __forceinline__ int jslot(int j) { return (j & ~12) | ((j & 4) << 1) | ((j & 8) >> 1); }
constexpr int GLA_CSPLIT = 16, CW_HF = 65536;
__device__ __forceinline__ void gla_unit2(const Args& a, LAS unsigned char* lds, int unit, int i2, const bf16* P, bf16* CAT, int tid, int c0, int c1, int mode) {
    typedef float f32x4v __attribute__((ext_vector_type(4)));
    constexpr int PS = EVEN_PAD;
    const int b = unit >> 2, h = unit & 3, lane = tid & 63, wave = __builtin_amdgcn_readfirstlane(tid >> 6);
    LAS bf16* QIN = (LAS bf16*)(lds + GB_QIN); LAS bf16* KIN = (LAS bf16*)(lds + GB_KIN); LAS bf16* KOT = (LAS bf16*)(lds + GB_KOT); LAS bf16* VT = (LAS bf16*)(lds + GB_VT); LAS bf16* STB = (LAS bf16*)(lds + GB_STB);
    LAS float* O = (LAS float*)(lds + GB_O); LAS bf16* RAWQ = (LAS bf16*)(lds + 105216); LAS bf16* RAWK = (LAS bf16*)(lds + 113408); LAS bf16* RAWG = (LAS bf16*)(lds + 121600); LAS float* TOT = (LAS float*)(lds + GB_TOT); LAS float* DEC = (LAS float*)(lds + GB_DEC); LAS float* NG = (LAS float*)(lds + GB_NG);
    float w2r[16];
#pragma unroll
    for (int j = 0; j < 16; ++j) w2r[j] = (a.in[2] + i2 * 16 * 256)[j * 256 + h * 64 + lane];
    const float bias = (a.in[3] + i2 * 256)[h * 64 + lane];
    if (tid < 128) NG[tid] = (a.in[4] + i2 * 128)[tid];
    const int et = wave & 3, hi2 = wave >> 2, n = lane & 31, hi = lane >> 5;
    float* stp = (float*)(a.ws + WS_MASK) + (size_t)unit * 8192 + tid; unsigned* hflag = (unsigned*)(a.ws + WS_CTL) + CW_HF + (i2 * 128 + unit) * 64;
    f32x16 sacc;
    if (mode == 2) {
        if (tid == 0) { while (__hip_atomic_load(hflag, __ATOMIC_RELAXED, __HIP_MEMORY_SCOPE_AGENT) == 0u) __builtin_amdgcn_s_sleep(8); __builtin_amdgcn_fence(__ATOMIC_ACQUIRE, "agent"); asm volatile("s_waitcnt vmcnt(0)" ::: "memory"); }
        __syncthreads();
#pragma unroll
        for (int e = 0; e < 16; ++e) sacc[e] = __hip_atomic_load(stp + e * 512, __ATOMIC_RELAXED, __HIP_MEMORY_SCOPE_AGENT);
#pragma unroll
        for (int r = 0; r < 16; ++r) { const int el = (r & 3) + 8 * (r >> 2) + 4 * hi; STB[(32 * et + el) * GSTR + 32 * hi2 + n] = (bf16)f2bf_acc(sacc[r]); }
    } else {
        for (int idx = tid; idx < 128 * GSTR / 2; idx += 512) ((LAS unsigned*)STB)[idx] = 0u;
#pragma unroll
        for (int e = 0; e < 16; ++e) sacc[e] = 0.f;
    }
    __syncthreads();
    const size_t row0 = (size_t)b * 2048;
    u32x4 rq, rk, rv0, rv1, rg = {0u, 0u, 0u, 0u};
    const int ptok = tid >> 3, ppc = tid & 7;
#define GLA_PREFETCH(cc) { const int t1 = min((cc), 31) * 64; const bf16* pq = P + (row0 + t1 + ptok) * PS + h * 64 + 8 * ppc; rq = *(const u32x4*)(pq + G_Q); rk = *(const u32x4*)(pq + G_K); \
        const u32x4* vp = (const u32x4*)(P + (row0 + t1 + lane) * PS + G_V + h * 128 + 16 * wave); rv0 = vp[0]; rv1 = vp[1]; \
        if (tid < 128) rg = *(const u32x4*)(P + (row0 + t1 + (tid >> 1)) * PS + G_AL + 8 * (tid & 1)); }
    GLA_PREFETCH(c0)
#pragma unroll 1
    for (int c = c0; c < c1; ++c) { const int t0 = c * 64;
        {
            *(LAS u32x4*)&RAWQ[ptok * 64 + 8 * ppc] = rq; *(LAS u32x4*)&RAWK[ptok * 64 + 8 * ppc] = rk; if (tid < 128) *(LAS u32x4*)&RAWG[(tid >> 1) * 16 + 8 * (tid & 1)] = rg;
            const u32x4 vv0 = rv0, vv1 = rv1;
            __syncthreads();
            float qv[8], kv[8];
#pragma unroll
            for (int u = 0; u < 8; ++u) { qv[u] = bf2f(RAWQ[(8 * wave + u) * 64 + lane]); kv[u] = bf2f(RAWK[(8 * wave + u) * 64 + lane]); }
            float lc[8]; float run = 0.f;
#pragma unroll
            for (int u = 0; u < 8; ++u) { const int tok = 8 * wave + u; float la = bias;
                { const u32x4 g0 = *(const LAS u32x4*)&RAWG[tok * 16], g1 = *(const LAS u32x4*)&RAWG[tok * 16 + 8];
                  la += bflo(g0.x) * w2r[0] + bfhi(g0.x) * w2r[1] + bflo(g0.y) * w2r[2] + bfhi(g0.y) * w2r[3] + bflo(g0.z) * w2r[4] + bfhi(g0.z) * w2r[5] + bflo(g0.w) * w2r[6] + bfhi(g0.w) * w2r[7];
                  la += bflo(g1.x) * w2r[8] + bfhi(g1.x) * w2r[9] + bflo(g1.y) * w2r[10] + bfhi(g1.y) * w2r[11] + bflo(g1.z) * w2r[12] + bfhi(g1.z) * w2r[13] + bflo(g1.w) * w2r[14] + bfhi(g1.w) * w2r[15]; }
                const float ls = fminf(la, 0.f) - __logf(1.f + __expf(-fabsf(la))); run += ls * (1.f / 16.f); lc[u] = run; }
            TOT[wave * 64 + lane] = run;
            __syncthreads();
            float off = 0.f, total = 0.f;
#pragma unroll
            for (int g = 0; g < 8; ++g) { const float tv = TOT[g * 64 + lane]; total += tv; if (g < wave) off += tv; }
#pragma unroll
            for (int u = 0; u < 8; ++u) { const float bb = off + lc[u]; const int tok = 8 * wave + u; const float eb = __expf(bb);
                QIN[tok * GSTR + lane] = (bf16)f2bf(qv[u] * 0.125f * eb); KIN[tok * GSTR + lane] = (bf16)f2bf(kv[u] * __expf(-bb)); KOT[lane * GSTR + jslot(tok)] = (bf16)f2bf(kv[u] * __expf(total - bb)); }
            if (wave == 0) DEC[lane] = __expf(total);
            { const int sl = jslot(lane); LAS bf16* vt = VT + (16 * wave) * GSTR + sl;
              vt[0 * GSTR] = (bf16)(vv0.x & 0xffffu); vt[1 * GSTR] = (bf16)(vv0.x >> 16); vt[2 * GSTR] = (bf16)(vv0.y & 0xffffu); vt[3 * GSTR] = (bf16)(vv0.y >> 16);
              vt[4 * GSTR] = (bf16)(vv0.z & 0xffffu); vt[5 * GSTR] = (bf16)(vv0.z >> 16); vt[6 * GSTR] = (bf16)(vv0.w & 0xffffu); vt[7 * GSTR] = (bf16)(vv0.w >> 16);
              vt[8 * GSTR] = (bf16)(vv1.x & 0xffffu); vt[9 * GSTR] = (bf16)(vv1.x >> 16); vt[10 * GSTR] = (bf16)(vv1.y & 0xffffu); vt[11 * GSTR] = (bf16)(vv1.y >> 16);
              vt[12 * GSTR] = (bf16)(vv1.z & 0xffffu); vt[13 * GSTR] = (bf16)(vv1.z >> 16); vt[14 * GSTR] = (bf16)(vv1.w & 0xffffu); vt[15 * GSTR] = (bf16)(vv1.w >> 16); }
            __syncthreads();
        }
        GLA_PREFETCH(c + 1)
        const u32x4* gp = (const u32x4*)(P + (row0 + t0 + (tid >> 3)) * PS + G_G + h * 128 + 16 * (tid & 7)); const u32x4 g0 = gp[0], g1 = gp[1];
        {
            f32x16 oacc;
#pragma unroll
            for (int e = 0; e < 16; ++e) oacc[e] = 0.f;
            bf16x8 qf[4];
#pragma unroll
            for (int ks = 0; ks < 4; ++ks) qf[ks] = *(const LAS bf16x8*)&QIN[(32 * hi2 + n) * GSTR + ks * 16 + 8 * hi];
#pragma unroll
            for (int ks = 0; ks < 4; ++ks) { const bf16x8 sf = *(const LAS bf16x8*)&STB[(32 * et + n) * GSTR + ks * 16 + 8 * hi]; oacc = __builtin_amdgcn_mfma_f32_32x32x16_bf16(sf, qf[ks], oacc, 0, 0, 0); }
#pragma unroll
            for (int jt = 0; jt < 2; ++jt) if (jt <= hi2) {
                f32x16 at;
#pragma unroll
                for (int e = 0; e < 16; ++e) at[e] = 0.f;
#pragma unroll
                for (int ks = 0; ks < 4; ++ks) { const bf16x8 kf = *(const LAS bf16x8*)&KIN[(32 * jt + n) * GSTR + ks * 16 + 8 * hi]; at = __builtin_amdgcn_mfma_f32_32x32x16_bf16(kf, qf[ks], at, 0, 0, 0); }
                if (jt == hi2) {
#pragma unroll
                    for (int r = 0; r < 16; ++r) { const int jl = (r & 3) + 8 * (r >> 2) + 4 * hi; if (jl > n) at[r] = 0.f; } }
#pragma unroll
                for (int s = 0; s < 2; ++s) { u32x4 w; w.x = pk2_acc(at[8 * s], at[8 * s + 1]); w.y = pk2_acc(at[8 * s + 2], at[8 * s + 3]); w.z = pk2_acc(at[8 * s + 4], at[8 * s + 5]); w.w = pk2_acc(at[8 * s + 6], at[8 * s + 7]);
                    const bf16x8 vf = *(const LAS bf16x8*)&VT[(32 * et + n) * GSTR + 32 * jt + 16 * s + 8 * hi];
                    oacc = __builtin_amdgcn_mfma_f32_32x32x16_bf16(vf, __builtin_bit_cast(bf16x8, w), oacc, 0, 0, 0); } }
#pragma unroll
            for (int g = 0; g < 4; ++g) *(LAS f32x4v*)&O[(32 * hi2 + n) * GOSTR + 32 * et + 8 * g + 4 * hi] = (f32x4v){oacc[4 * g], oacc[4 * g + 1], oacc[4 * g + 2], oacc[4 * g + 3]};
        }
        __syncthreads();
        {
            const float dc = DEC[32 * hi2 + n];
#pragma unroll
            for (int e = 0; e < 16; ++e) sacc[e] *= dc;
#pragma unroll
            for (int js = 0; js < 4; ++js) { const bf16x8 vf = *(const LAS bf16x8*)&VT[(32 * et + n) * GSTR + 16 * js + 8 * hi]; const bf16x8 kf = *(const LAS bf16x8*)&KOT[(32 * hi2 + n) * GSTR + 16 * js + 8 * hi];
                sacc = __builtin_amdgcn_mfma_f32_32x32x16_bf16(vf, kf, sacc, 0, 0, 0); }
#pragma unroll
            for (int r = 0; r < 16; ++r) { const int el = (r & 3) + 8 * (r >> 2) + 4 * hi; STB[(32 * et + el) * GSTR + 32 * hi2 + n] = (bf16)f2bf_acc(sacc[r]); }
            const int i = tid >> 3, eg = tid & 7; const size_t row = row0 + t0 + i;
            const f32x4v o0 = *(const LAS f32x4v*)&O[i * GOSTR + 16 * eg], o1 = *(const LAS f32x4v*)&O[i * GOSTR + 16 * eg + 4], o2 = *(const LAS f32x4v*)&O[i * GOSTR + 16 * eg + 8], o3 = *(const LAS f32x4v*)&O[i * GOSTR + 16 * eg + 12];
            float ssq = ((o0[0] * o0[0] + o0[1] * o0[1]) + (o0[2] * o0[2] + o0[3] * o0[3])) + ((o1[0] * o1[0] + o1[1] * o1[1]) + (o1[2] * o1[2] + o1[3] * o1[3])) + ((o2[0] * o2[0] + o2[1] * o2[1]) + (o2[2] * o2[2] + o2[3] * o2[3])) + ((o3[0] * o3[0] + o3[1] * o3[1]) + (o3[2] * o3[2] + o3[3] * o3[3]));
            ssq = reduce8(ssq);
            const float rr = __builtin_amdgcn_rsqf(ssq * (1.f / 128.f) + LN_EPS);
            const float gf[16] = {bflo(g0.x), bfhi(g0.x), bflo(g0.y), bfhi(g0.y), bflo(g0.z), bfhi(g0.z), bflo(g0.w), bfhi(g0.w), bflo(g1.x), bfhi(g1.x), bflo(g1.y), bfhi(g1.y), bflo(g1.z), bfhi(g1.z), bflo(g1.w), bfhi(g1.w)};
            const float of[16] = {o0[0], o0[1], o0[2], o0[3], o1[0], o1[1], o1[2], o1[3], o2[0], o2[1], o2[2], o2[3], o3[0], o3[1], o3[2], o3[3]};
            float res[16];
#pragma unroll
            for (int x = 0; x < 16; ++x) res[x] = of[x] * rr * NG[16 * eg + x] * (gf[x] * __builtin_amdgcn_rcpf(1.f + __expf(-gf[x])));
            u32x4 w0, w1; w0.x = pk2(res[0], res[1]); w0.y = pk2(res[2], res[3]); w0.z = pk2(res[4], res[5]); w0.w = pk2(res[6], res[7]); w1.x = pk2(res[8], res[9]); w1.y = pk2(res[10], res[11]); w1.z = pk2(res[12], res[13]); w1.w = pk2(res[14], res[15]);
            u32x4* op = (u32x4*)(CAT + row * 1024 + h * 128 + 16 * eg); op[0] = w0; op[1] = w1;
        }
    }
#undef GLA_PREFETCH
    if (mode == 1) {
#pragma unroll
        for (int e = 0; e < 16; ++e) __hip_atomic_store(stp + e * 512, sacc[e], __ATOMIC_RELAXED, __HIP_MEMORY_SCOPE_AGENT);
        asm volatile("s_waitcnt vmcnt(0)" ::: "memory");
        __syncthreads();
        if (tid == 0) { __builtin_amdgcn_fence(__ATOMIC_RELEASE, "agent"); asm volatile("s_waitcnt vmcnt(0)" ::: "memory"); __hip_atomic_store(hflag, 1u, __ATOMIC_RELAXED, __HIP_MEMORY_SCOPE_AGENT); }
    }
    __syncthreads();
}

__device__ __forceinline__ void ph_rope(const Args& a, LAS unsigned char* lds, int bid, int G, int tid, int gtid, int NT) {
    bf16* P = (bf16*)(a.ws + WS_P);
    const float* cosA = (const float*)(a.ws + WS_COSA); const float* sinA = (const float*)(a.ws + WS_SINA);
    const float* cosI = (const float*)(a.ws + WS_COSI); const float* sinI = (const float*)(a.ws + WS_SINI);
    for (size_t it = gtid; it < (size_t)MTOK * 108; it += NT) {
        const size_t row = it / 108; int r = (int)(it - row * 108); const int t = (int)(row & 2047);
        int col, half; const float* ct; const float* st;
        if (r < 72) { const int vec = r >> 3, grp = r & 7; col = (vec < 8 ? O_Q + vec * 128 : O_K) + grp * 8; half = 64; ct = cosA + t * 64 + grp * 8; st = sinA + t * 64 + grp * 8; }
        else { r -= 72; const int vec = r >> 2, grp = r & 3; col = (vec < 8 ? O_QI + vec * 64 : O_KI) + grp * 8; half = 32; ct = cosI + t * 32 + grp * 8; st = sinI + t * 32 + grp * 8; }
        u32x4* p1 = (u32x4*)(P + row * ODD_PAD + col); u32x4* p2 = (u32x4*)(P + row * ODD_PAD + col + half);
        const u32x4 x1 = *p1, x2 = *p2; const f32x4 c0 = *(const f32x4*)ct, c1 = *(const f32x4*)(ct + 4), s0 = *(const f32x4*)st, s1 = *(const f32x4*)(st + 4);
        u32x4 o1, o2;
#define ROPE2(W, CA, SA, CB, SB) { const float a1 = bflo(x1.W), a2 = bflo(x2.W), b1 = bfhi(x1.W), b2 = bfhi(x2.W); \
            o1.W = pk2(a1 * (CA) - a2 * (SA), b1 * (CB) - b2 * (SB)); o2.W = pk2(a2 * (CA) + a1 * (SA), b2 * (CB) + b1 * (SB)); }
        ROPE2(x, c0.x, s0.x, c0.y, s0.y) ROPE2(y, c0.z, s0.z, c0.w, s0.w) ROPE2(z, c1.x, s1.x, c1.y, s1.y) ROPE2(w, c1.z, s1.z, c1.w, s1.w)
#undef ROPE2
        *p1 = o1; *p2 = o2;
    }
    bf16* VT = (bf16*)(a.ws + WS_VT); LAS bf16* TL = (LAS bf16*)lds;
    for (int tile = bid; tile < MTOK / 64; tile += G) {
        const size_t row0 = (size_t)tile * 64; const int b = (int)(row0 >> 11), tq = (int)(row0 & 2047);
        __syncthreads();
#pragma unroll
        for (int i = 0; i < 2; ++i) { const int pc = tid + 512 * i, tok = pc >> 4, seg = pc & 15; *(LAS u32x4*)&TL[tok * 136 + 8 * seg] = *(const u32x4*)(P + (row0 + tok) * ODD_PAD + O_V + 8 * seg); }
        __syncthreads();
#pragma unroll
        for (int i = 0; i < 2; ++i) { const int pc = tid + 512 * i, d = pc & 127, tg = pc >> 7; u32x4 o;
            o.x = (unsigned)TL[(8 * tg + 0) * 136 + d] | ((unsigned)TL[(8 * tg + 1) * 136 + d] << 16); o.y = (unsigned)TL[(8 * tg + 2) * 136 + d] | ((unsigned)TL[(8 * tg + 3) * 136 + d] << 16);
            o.z = (unsigned)TL[(8 * tg + 4) * 136 + d] | ((unsigned)TL[(8 * tg + 5) * 136 + d] << 16); o.w = (unsigned)TL[(8 * tg + 6) * 136 + d] | ((unsigned)TL[(8 * tg + 7) * 136 + d] << 16);
            *(u32x4*)(VT + ((size_t)b * 128 + d) * 2048 + tq + 8 * tg) = o; }
    }
}
__device__ __forceinline__ unsigned sortable_key(float s) { unsigned u = __float_as_uint(s); if ((u << 1) == 0u) u = 0u; return (u & 0x80000000u) ? ~u : (u | 0x80000000u); }
__device__ __forceinline__ void ph_indexer(const Args& a, LAS unsigned char* lds, int gw, int NGW, int wave, int lane) {
    const bf16* P = (const bf16*)(a.ws + WS_P); unsigned* MASK = (unsigned*)(a.ws + WS_MASK);
    LAS float* qs = (LAS float*)(lds + wave * 10496); LAS unsigned* kl = (LAS unsigned*)(lds + wave * 10496 + 2304);
    for (int m = gw; m < MTOK; m += NGW) {
        const int b = m >> 11, t = m & 2047; const bf16* prow = P + (size_t)m * ODD_PAD;
        { const u32x4 v = *(const u32x4*)(prow + O_QI + lane * 8);
          *(LAS f32x4*)&qs[lane * 8] = (f32x4){bflo(v.x), bfhi(v.x), bflo(v.y), bfhi(v.y)}; *(LAS f32x4*)&qs[lane * 8 + 4] = (f32x4){bflo(v.z), bfhi(v.z), bflo(v.w), bfhi(v.w)}; }
        if (lane < 8) qs[512 + lane] = bf2f(prow[O_WI + lane]) * 0.04419417382415922f;
        LDS_WAIT();
        const int nblk = (t >> 6) + 1;
#pragma unroll 1
        for (int i = 0; i < nblk; ++i) { const int s = i * 64 + lane; unsigned key = 0u;
            if (s <= t) { const u32x4* kr = (const u32x4*)(P + ((size_t)b * 2048 + s) * ODD_PAD + O_KI);
                float kf[64];
#pragma unroll
                for (int q = 0; q < 8; ++q) { const u32x4 v = kr[q]; kf[q * 8 + 0] = bflo(v.x); kf[q * 8 + 1] = bfhi(v.x); kf[q * 8 + 2] = bflo(v.y); kf[q * 8 + 3] = bfhi(v.y); kf[q * 8 + 4] = bflo(v.z); kf[q * 8 + 5] = bfhi(v.z); kf[q * 8 + 6] = bflo(v.w); kf[q * 8 + 7] = bfhi(v.w); }
                float sc = 0.f;
#pragma unroll 1
                for (int h = 0; h < 8; ++h) { float acc = 0.f;
#pragma unroll
                    for (int d4 = 0; d4 < 16; ++d4) { const f32x4 qv = *(const LAS f32x4*)&qs[h * 64 + d4 * 4]; acc += qv.x * kf[d4 * 4] + qv.y * kf[d4 * 4 + 1] + qv.z * kf[d4 * 4 + 2] + qv.w * kf[d4 * 4 + 3]; }
                    sc += qs[512 + h] * fmaxf(acc, 0.f); }
                key = sortable_key(sc); }
            kl[i * 64 + lane] = key; }
        LDS_WAIT();
        unsigned k[32];
#pragma unroll
        for (int i = 0; i < 32; ++i) k[i] = (i < nblk) ? kl[i * 64 + lane] : 0u;
        unsigned T = 0u;
        for (int bit = 31; bit >= 0; --bit) { const unsigned cand = T | (1u << bit); int cnt = 0;
#pragma unroll
            for (int i = 0; i < 32; ++i) cnt += (k[i] >= cand) ? 1 : 0;
            cnt = wave_sum_i(cnt); if (cnt >= 256) T = cand; }
        int cgt = 0;
#pragma unroll
        for (int i = 0; i < 32; ++i) cgt += (k[i] > T) ? 1 : 0;
        cgt = wave_sum_i(cgt);
        const int need = 256 - cgt; int run = 0; unsigned myw = 0u;
#pragma unroll
        for (int i = 0; i < 32; ++i) { const bool gt = k[i] > T, eq = (k[i] == T) && (T != 0u);
            const unsigned long long bal = __ballot(eq); const int pre = __builtin_amdgcn_mbcnt_hi((unsigned)(bal >> 32), __builtin_amdgcn_mbcnt_lo((unsigned)bal, 0u));
            const bool sel = gt || (eq && (run + pre < need)); run += __popcll(bal);
            const unsigned long long sb = __ballot(sel);
            if (lane == 2 * i) myw = (unsigned)sb; if (lane == 2 * i + 1) myw = (unsigned)(sb >> 32); }
        MASK[(size_t)m * 64 + lane] = myw;
    }
}
__device__ __forceinline__ void ph_attention(const Args& a, LAS unsigned char* lds, int gw, int NGW, int wave, int lane) {
    const bf16* P = (const bf16*)(a.ws + WS_P); const unsigned* MASK = (const unsigned*)(a.ws + WS_MASK); bf16* CAT = (bf16*)(a.ws + WS_CAT);
    LAS unsigned short* sel = (LAS unsigned short*)(lds + wave * 4096); LAS float* qh = (LAS float*)(lds + wave * 4096 + 512); LAS float* pp = (LAS float*)(lds + wave * 4096 + 1024);
    for (int m = gw; m < MTOK; m += NGW) {
        const int b = m >> 11; const bf16* prow = P + (size_t)m * ODD_PAD; const bf16* pb = P + (size_t)b * 2048 * ODD_PAD;
        unsigned word = MASK[(size_t)m * 64 + lane]; const int cnt = __popc(word); int x = cnt;
#pragma unroll
        for (int o = 1; o < 64; o <<= 1) { const int y = __shfl_up(x, o); if (lane >= o) x += y; }
        const int nsel = __shfl(x, 63); int pos = x - cnt;
        while (word) { const int bpos = __builtin_ctz(word); word &= word - 1u; sel[pos++] = (unsigned short)(lane * 32 + bpos); }
        LDS_WAIT();
        for (int h = 0; h < 8; ++h) {
            qh[lane] = bf2f(prow[O_Q + h * 128 + lane]); qh[64 + lane] = bf2f(prow[O_Q + h * 128 + 64 + lane]);
            LDS_WAIT();
            float lg[4]; float mx = -3.0e38f;
#pragma unroll
            for (int jj = 0; jj < 4; ++jj) { const int j = lane + 64 * jj; lg[jj] = -3.0e38f;
                if (j < nsel) { const u32x4* kr = (const u32x4*)(pb + (size_t)sel[j] * ODD_PAD + O_K); float acc = 0.f;
#pragma unroll
                    for (int q = 0; q < 16; ++q) { const u32x4 v = kr[q]; const f32x4 q0 = *(const LAS f32x4*)&qh[q * 8], q1 = *(const LAS f32x4*)&qh[q * 8 + 4];
                        acc += q0.x * bflo(v.x) + q0.y * bfhi(v.x) + q0.z * bflo(v.y) + q0.w * bfhi(v.y) + q1.x * bflo(v.z) + q1.y * bfhi(v.z) + q1.z * bflo(v.w) + q1.w * bfhi(v.w); }
                    lg[jj] = acc * 0.08838834764831845f; }
                mx = fmaxf(mx, lg[jj]); }
            mx = wave_max(mx); float sum = 0.f;
#pragma unroll
            for (int jj = 0; jj < 4; ++jj) { const int j = lane + 64 * jj; const float p = (j < nsel) ? expf(lg[jj] - mx) : 0.f; lg[jj] = p; sum += p; }
            sum = wave_sum(sum); const float inv = 1.f / sum;
#pragma unroll
            for (int jj = 0; jj < 4; ++jj) pp[lane + 64 * jj] = lg[jj] * inv;
            LDS_WAIT();
            float o0 = 0.f, o1 = 0.f;
            for (int j = 0; j < nsel; ++j) { const bf16* vr = pb + (size_t)sel[j] * ODD_PAD + O_V; const float p = pp[j]; o0 += p * bf2f(vr[lane]); o1 += p * bf2f(vr[64 + lane]); }
            CAT[(size_t)m * 1024 + h * 128 + lane] = (bf16)f2bf(o0); CAT[(size_t)m * 1024 + h * 128 + 64 + lane] = (bf16)f2bf(o1);
            LDS_WAIT();
        }
    }
}

__device__ __forceinline__ void ph_indexer3(const Args& a, LAS unsigned char* lds, int bid, int G, int tid) {
    typedef float f32x4v __attribute__((ext_vector_type(4)));
    const bf16* P = (const bf16*)(a.ws + WS_P); unsigned* MASK = (unsigned*)(a.ws + WS_MASK);
    const int lane = tid & 63, wave = __builtin_amdgcn_readfirstlane(tid >> 6);
    const int n = lane & 15, q = lane >> 4, tokl = q & 1, half = q >> 1;
    constexpr int KROW = 144, GBUF = 256 * KROW;
    const int srow = tid >> 1, shalf = tid & 1;
    for (int unit = bid; unit < MTOK / 16; unit += G) {
        const int j = unit >> 8, r = unit & 255, b = r >> 3, q8 = r & 7, tt = j * 8 + ((j & 1) ? 7 - q8 : q8);
        const int t0 = tt * 16 + wave * 2; const size_t rowbase = (size_t)b * 2048;
        const int NP = (tt >> 1) + 1;
        bf16x8 af[2];
        { const bf16* ap = P + (rowbase + t0 + (n & 1)) * ODD_PAD + O_QI + (n >> 1) * 64 + q * 8; af[0] = *(const bf16x8*)ap; af[1] = *(const bf16x8*)(ap + 32); }
        float wv[4];
        { const u32x4 wa = *(const u32x4*)(P + (rowbase + t0) * ODD_PAD + O_WI), wb = *(const u32x4*)(P + (rowbase + t0 + 1) * ODD_PAD + O_WI);
          const unsigned w0_ = q == 0 ? wa.x : (q == 1 ? wa.y : (q == 2 ? wa.z : wa.w)), w1_ = q == 0 ? wb.x : (q == 1 ? wb.y : (q == 2 ? wb.z : wb.w));
          wv[0] = bflo(w0_) * 0.04419417382415922f; wv[1] = bflo(w1_) * 0.04419417382415922f; wv[2] = bfhi(w0_) * 0.04419417382415922f; wv[3] = bfhi(w1_) * 0.04419417382415922f; }
        unsigned keys[64];
#pragma unroll
        for (int p = 0; p < 64; ++p) keys[p] = 0u;
        const int tmine = t0 + tokl;
        const bf16* kgp = P + (rowbase + srow) * ODD_PAD + O_KI + shalf * 32;
        u32x4 s0, s1, s2, s3;
#define IDX_GLOAD(g) { const u32x4* gp_ = (const u32x4*)(kgp + (size_t)(g) * 256 * ODD_PAD); s0 = gp_[0]; s1 = gp_[1]; s2 = gp_[2]; s3 = gp_[3]; }
#define IDX_GSTORE(buf) { LAS u32x4* lp_ = (LAS u32x4*)(lds + (buf) * GBUF + srow * KROW + shalf * 64); lp_[0] = s0; lp_[1] = s1; lp_[2] = s2; lp_[3] = s3; }
        IDX_GLOAD(0)
        __syncthreads();
        IDX_GSTORE(0)
        __syncthreads();
        if (8 < NP) IDX_GLOAD(1)
#define IDX_RELU(x) __int_as_float(max(__float_as_int(x), 0))
#define IDX_STEP(g, pl) if (8 * (g) + (pl) < NP) { const LAS unsigned char* kb_ = lds + ((g) & 1) * GBUF + (32 * (pl) + n) * KROW + q * 16; \
                const bf16x8 bA0 = *(const LAS bf16x8*)kb_, bA1 = *(const LAS bf16x8*)(kb_ + 64), bB0 = *(const LAS bf16x8*)(kb_ + 16 * KROW), bB1 = *(const LAS bf16x8*)(kb_ + 16 * KROW + 64); \
                f32x4v cA = {0.f, 0.f, 0.f, 0.f}, cB = {0.f, 0.f, 0.f, 0.f}; \
                cA = __builtin_amdgcn_mfma_f32_16x16x32_bf16(af[0], bA0, cA, 0, 0, 0); cA = __builtin_amdgcn_mfma_f32_16x16x32_bf16(af[1], bA1, cA, 0, 0, 0); \
                cB = __builtin_amdgcn_mfma_f32_16x16x32_bf16(af[0], bB0, cB, 0, 0, 0); cB = __builtin_amdgcn_mfma_f32_16x16x32_bf16(af[1], bB1, cB, 0, 0, 0); \
                const float A0 = wv[0] * IDX_RELU(cA[0]) + wv[2] * IDX_RELU(cA[2]), A1 = wv[1] * IDX_RELU(cA[1]) + wv[3] * IDX_RELU(cA[3]); \
                const float B0 = wv[0] * IDX_RELU(cB[0]) + wv[2] * IDX_RELU(cB[2]), B1 = wv[1] * IDX_RELU(cB[1]) + wv[3] * IDX_RELU(cB[3]); \
                const float m0 = hswap32_add(A0, B0), m1 = hswap32_add(A1, B1); \
                const float sc = hswap16_add(m0, m1); \
                const int s = 32 * (8 * (g) + (pl)) + 16 * half + n; \
                keys[8 * (g) + (pl)] = (s <= tmine) ? sortable_key(sc) : 0u; }
#define IDX_GROUP(g) if (8 * (g) < NP) { IDX_STEP(g, 0) IDX_STEP(g, 1) IDX_STEP(g, 2) IDX_STEP(g, 3) IDX_STEP(g, 4) IDX_STEP(g, 5) IDX_STEP(g, 6) IDX_STEP(g, 7) \
            if (8 * ((g) + 1) < NP) IDX_GSTORE(((g) + 1) & 1) \
            __syncthreads(); \
            if (8 * ((g) + 2) < NP) IDX_GLOAD((g) + 2) }
        IDX_GROUP(0) IDX_GROUP(1) IDX_GROUP(2) IDX_GROUP(3) IDX_GROUP(4) IDX_GROUP(5) IDX_GROUP(6) IDX_GROUP(7)
#undef IDX_STEP
#undef IDX_RELU
#undef IDX_GROUP
#undef IDX_GLOAD
#undef IDX_GSTORE
        unsigned T = 0u; const bool small_ = tmine + 1 <= 256; bool found = false;
#define IDX_CNT8(g) if (8 * (g) < NP) { cnt += ((keys[8 * (g) + 0] >= cand) ? 1 : 0) + ((keys[8 * (g) + 1] >= cand) ? 1 : 0) + ((keys[8 * (g) + 2] >= cand) ? 1 : 0) + ((keys[8 * (g) + 3] >= cand) ? 1 : 0) \
            + ((keys[8 * (g) + 4] >= cand) ? 1 : 0) + ((keys[8 * (g) + 5] >= cand) ? 1 : 0) + ((keys[8 * (g) + 6] >= cand) ? 1 : 0) + ((keys[8 * (g) + 7] >= cand) ? 1 : 0); }
#pragma unroll 1
        for (int bit = 31; bit >= 0; --bit) { const unsigned cand = T | (1u << bit); int cnt = 0;
            IDX_CNT8(0) IDX_CNT8(1) IDX_CNT8(2) IDX_CNT8(3) IDX_CNT8(4) IDX_CNT8(5) IDX_CNT8(6) IDX_CNT8(7)
            cnt = reduce16_i(cnt); cnt = hswap32_add_i(cnt, cnt);
            if (cnt >= 256) T = cand;
            found = found || (cnt == 256);
            if (__all(found || small_)) break; }
#undef IDX_CNT8
        if (__all(found || small_)) {
            const unsigned thr = found ? T - 1u : 0u; unsigned mw0 = 0u, mw1 = 0u;
#define IDX_W(p) { const unsigned long long bs = __ballot(keys[p] > thr); \
                const unsigned w0_ = (unsigned)(bs & 0xFFFFull) | ((unsigned)((bs >> 32) & 0xFFFFull) << 16), w1_ = (unsigned)((bs >> 16) & 0xFFFFull) | ((unsigned)((bs >> 48) & 0xFFFFull) << 16); \
                if (lane == (p)) { mw0 = w0_; mw1 = w1_; } }
#define IDX_W8(g) if (8 * (g) < NP) { IDX_W(8 * (g) + 0) IDX_W(8 * (g) + 1) IDX_W(8 * (g) + 2) IDX_W(8 * (g) + 3) IDX_W(8 * (g) + 4) IDX_W(8 * (g) + 5) IDX_W(8 * (g) + 6) IDX_W(8 * (g) + 7) }
            IDX_W8(0) IDX_W8(1) IDX_W8(2) IDX_W8(3) IDX_W8(4) IDX_W8(5) IDX_W8(6) IDX_W8(7)
#undef IDX_W8
#undef IDX_W
            MASK[(rowbase + t0) * 64 + lane] = mw0; MASK[(rowbase + t0 + 1) * 64 + lane] = mw1;
            continue;
        }
        { unsigned T2 = 0u;
#pragma unroll 1
          for (int bit = 31; bit >= 0; --bit) { const unsigned cand = T2 | (1u << bit); int cnt = 0;
#pragma unroll
              for (int p = 0; p < 64; ++p) cnt += (keys[p] >= cand) ? 1 : 0;
              cnt = reduce16_i(cnt); cnt = hswap32_add_i(cnt, cnt);
              if (cnt >= 256) T2 = cand; }
          T = T2; }
        int cgt = 0;
#pragma unroll
        for (int p = 0; p < 64; ++p) cgt += (keys[p] > T) ? 1 : 0;
        cgt = reduce16_i(cgt); cgt = hswap32_add_i(cgt, cgt);
        const int need = 256 - cgt; int run = 0; unsigned mw0 = 0u, mw1 = 0u; const unsigned below = (1u << (16 * half + n)) - 1u;
#pragma unroll
        for (int p = 0; p < 64; ++p) { const bool gt = keys[p] > T, eq = (keys[p] == T) && (T != 0u);
            const unsigned long long be = __ballot(eq);
            const unsigned e0 = (unsigned)(be & 0xFFFFull) | ((unsigned)((be >> 32) & 0xFFFFull) << 16), e1 = (unsigned)((be >> 16) & 0xFFFFull) | ((unsigned)((be >> 48) & 0xFFFFull) << 16);
            const unsigned me = tokl ? e1 : e0; const bool sel = gt || (eq && (run + __popc(me & below) < need)); run += __popc(me);
            const unsigned long long bs = __ballot(sel);
            const unsigned s0 = (unsigned)(bs & 0xFFFFull) | ((unsigned)((bs >> 32) & 0xFFFFull) << 16), s1 = (unsigned)((bs >> 16) & 0xFFFFull) | ((unsigned)((bs >> 48) & 0xFFFFull) << 16);
            if (lane == p) { mw0 = s0; mw1 = s1; } }
        MASK[(rowbase + t0) * 64 + lane] = mw0; MASK[(rowbase + t0 + 1) * 64 + lane] = mw1;
    }
}

__device__ __forceinline__ void ph_attention2(const Args& a, int bid, int G, int wave, int lane) {
    const bf16* P = (const bf16*)(a.ws + WS_P); const unsigned* MASK = (const unsigned*)(a.ws + WS_MASK); const bf16* VT = (const bf16*)(a.ws + WS_VT); bf16* CAT = (bf16*)(a.ws + WS_CAT);
    const int n = lane & 31, hi = lane >> 5, tl = n >> 3, head = n & 7;
    const float C = 0.12751743f;
    for (int it = bid; it < 2048; it += G) {
        const int j = it >> 8, r = it & 255, b = r >> 3, q8 = r & 7; const int qt = j * 8 + ((j & 1) ? 7 - q8 : q8);
        const int t0 = qt * 32 + wave * 4; const size_t rowbase = (size_t)b * 2048; const size_t m = rowbase + t0 + tl;
        bf16x8 qf[8];
        { const bf16* qp = P + m * ODD_PAD + O_Q + head * 128 + hi * 8;
#pragma unroll
          for (int ks = 0; ks < 8; ++ks) qf[ks] = *(const bf16x8*)(qp + ks * 16); }
        unsigned mw[4];
#pragma unroll
        for (int i = 0; i < 4; ++i) mw[i] = MASK[(rowbase + t0 + i) * 64 + lane];
        f32x16 o[4];
#pragma unroll
        for (int mt = 0; mt < 4; ++mt)
#pragma unroll
            for (int e = 0; e < 16; ++e) o[mt][e] = 0.f;
        float mrow = -1e30f, lrow = 0.f;
        const int ntile = ((t0 + 3) >> 5) + 1;
        bf16x8 kf[8];
        { const bf16* kp = P + (rowbase + n) * ODD_PAD + O_K + hi * 8;
#pragma unroll
          for (int ks = 0; ks < 8; ++ks) kf[ks] = *(const bf16x8*)(kp + ks * 16); }
#pragma unroll 1
        for (int kt = 0; kt < ntile; ++kt) {
            f32x16 s;
#pragma unroll
            for (int e = 0; e < 16; ++e) s[e] = 0.f;
#pragma unroll
            for (int ks = 0; ks < 8; ++ks) s = __builtin_amdgcn_mfma_f32_32x32x16_bf16(kf[ks], qf[ks], s, 0, 0, 0);
            if (kt + 1 < ntile) { const bf16* kp = P + (rowbase + (kt + 1) * 32 + n) * ODD_PAD + O_K + hi * 8;
#pragma unroll
                for (int ks = 0; ks < 8; ++ks) kf[ks] = *(const bf16x8*)(kp + ks * 16); }
            u32x2 vf[4][2][2];
            { const bf16* vp = VT + ((size_t)b * 128 + n) * 2048 + kt * 32 + 4 * hi;
#pragma unroll
              for (int mt = 0; mt < 4; ++mt)
#pragma unroll
                  for (int s2 = 0; s2 < 2; ++s2)
#pragma unroll
                      for (int ii = 0; ii < 2; ++ii) vf[mt][s2][ii] = *(const u32x2*)(vp + (size_t)mt * 32 * 2048 + 16 * s2 + 8 * ii); }
            const unsigned w0 = (unsigned)__builtin_amdgcn_readlane((int)mw[0], kt), w1 = (unsigned)__builtin_amdgcn_readlane((int)mw[1], kt), w2 = (unsigned)__builtin_amdgcn_readlane((int)mw[2], kt), w3 = (unsigned)__builtin_amdgcn_readlane((int)mw[3], kt);
            const unsigned word = (tl == 0 ? w0 : (tl == 1 ? w1 : (tl == 2 ? w2 : w3))) >> (4 * hi);
            float mx = -1e30f;
#pragma unroll
            for (int e = 0; e < 16; ++e) { const int key = (e & 3) + 8 * (e >> 2); if ((word >> key) & 1u) mx = fmaxf(mx, s[e]); }
            mx = fmaxf(mx, __shfl_xor(mx, 32));
            const float mnew = fmaxf(mrow, mx); const float alpha = __builtin_amdgcn_exp2f((mrow - mnew) * C); mrow = mnew;
            float psum = 0.f; float p[16];
#pragma unroll
            for (int e = 0; e < 16; ++e) { const int key = (e & 3) + 8 * (e >> 2); p[e] = ((word >> key) & 1u) ? __builtin_amdgcn_exp2f((s[e] - mnew) * C) : 0.f; psum += p[e]; }
            lrow = lrow * alpha + psum;
#pragma unroll
            for (int mt = 0; mt < 4; ++mt)
#pragma unroll
                for (int e = 0; e < 16; ++e) o[mt][e] *= alpha;
            bf16x8 pf[2];
#pragma unroll
            for (int s2 = 0; s2 < 2; ++s2) { u32x4 w; w.x = pk2(p[8 * s2 + 0], p[8 * s2 + 1]); w.y = pk2(p[8 * s2 + 2], p[8 * s2 + 3]); w.z = pk2(p[8 * s2 + 4], p[8 * s2 + 5]); w.w = pk2(p[8 * s2 + 6], p[8 * s2 + 7]); pf[s2] = __builtin_bit_cast(bf16x8, w); }
#pragma unroll
            for (int mt = 0; mt < 4; ++mt)
#pragma unroll
                for (int s2 = 0; s2 < 2; ++s2) { u32x4 w; w.x = vf[mt][s2][0].x; w.y = vf[mt][s2][0].y; w.z = vf[mt][s2][1].x; w.w = vf[mt][s2][1].y;
                    o[mt] = __builtin_amdgcn_mfma_f32_32x32x16_bf16(__builtin_bit_cast(bf16x8, w), pf[s2], o[mt], 0, 0, 0); }
        }
        const float l = lrow + __shfl_xor(lrow, 32); const float inv = 1.f / l;
        bf16* op = CAT + m * 1024 + head * 128 + 4 * hi;
#pragma unroll
        for (int mt = 0; mt < 4; ++mt)
#pragma unroll
            for (int i = 0; i < 4; ++i) { u32x2 w; w.x = pk2(o[mt][4 * i] * inv, o[mt][4 * i + 1] * inv); w.y = pk2(o[mt][4 * i + 2] * inv, o[mt][4 * i + 3] * inv); *(u32x2*)(op + 32 * mt + 8 * i) = w; }
    }
}

__device__ __forceinline__ void ph_attention3(const Args& a, LAS unsigned char* lds, int bid, int G, int tid) {
    const bf16* P = (const bf16*)(a.ws + WS_P); const unsigned* MASK = (const unsigned*)(a.ws + WS_MASK); const bf16* VT = (const bf16*)(a.ws + WS_VT); bf16* CAT = (bf16*)(a.ws + WS_CAT);
    constexpr int KSTR = 136, VSTR = 40, KBYTES = 32 * KSTR * 2, BUFB = KBYTES + 128 * VSTR * 2;
    const int lane = tid & 63, wave = __builtin_amdgcn_readfirstlane(tid >> 6);
    const int n = lane & 31, hi = lane >> 5, tl = n >> 3, head = n & 7;
    const int skey = tid >> 4, spiece = tid & 15, sd = tid >> 2, svp = tid & 3;
    const float C = 0.12751743f;
#define ATT_STORE(buf, kr, vr) { LAS bf16* KN = (LAS bf16*)(lds + (buf) * BUFB); LAS bf16* VN = (LAS bf16*)(lds + (buf) * BUFB + KBYTES); \
        *(LAS u32x4*)&KN[skey * KSTR + spiece * 8] = kr; *(LAS u32x2*)&VN[sd * VSTR + 4 * svp] = (u32x2){vr.x, vr.y}; *(LAS u32x2*)&VN[sd * VSTR + 16 + 4 * svp] = (u32x2){vr.z, vr.w}; }
#define ATT_LOAD(kr, vr, t) { const int tc = min((t), ntile - 1); kr = *(const u32x4*)(kg + (size_t)tc * 32 * ODD_PAD); vr = *(const u32x4*)(vg + tc * 32); }
#define ATT_TILE(buf, kt) { const LAS bf16* KT = (const LAS bf16*)(lds + (buf) * BUFB); const LAS bf16* VL = (const LAS bf16*)(lds + (buf) * BUFB + KBYTES); \
        f32x16 s; _Pragma("unroll") for (int e = 0; e < 16; ++e) s[e] = 0.f; \
        _Pragma("unroll") for (int ks = 0; ks < 8; ++ks) { const bf16x8 kf = *(const LAS bf16x8*)&KT[n * KSTR + ks * 16 + hi * 8]; s = __builtin_amdgcn_mfma_f32_32x32x16_bf16(kf, qf[ks], s, 0, 0, 0); } \
        const unsigned w0 = (unsigned)__builtin_amdgcn_readlane((int)mw[0], (kt)), w1 = (unsigned)__builtin_amdgcn_readlane((int)mw[1], (kt)), w2 = (unsigned)__builtin_amdgcn_readlane((int)mw[2], (kt)), w3 = (unsigned)__builtin_amdgcn_readlane((int)mw[3], (kt)); \
        const unsigned word = (tl == 0 ? w0 : (tl == 1 ? w1 : (tl == 2 ? w2 : w3))) >> (4 * hi); \
          \
        float mx = fmaxf(fmaxf(fmaxf(fmaxf(s[0], s[1]), s[2]), fmaxf(fmaxf(s[3], s[4]), s[5])), fmaxf(fmaxf(fmaxf(s[6], s[7]), s[8]), fmaxf(fmaxf(s[9], s[10]), s[11]))); \
        mx = fmaxf(mx, fmaxf(fmaxf(s[12], s[13]), fmaxf(s[14], s[15]))); \
        { const auto r_ = __builtin_amdgcn_permlane32_swap(__float_as_uint(mx), __float_as_uint(mx), false, false); mx = fmaxf(__uint_as_float(r_[0]), __uint_as_float(r_[1])); } \
        const float mnew = fmaxf(mrow, mx); const bool grow = mnew > mrow; const float alpha = __builtin_amdgcn_exp2f((mrow - mnew) * C); mrow = mnew; \
        const f32x2n_ cc_ = {C, C}, nm_ = {-mnew * C, -mnew * C}; f32x2n_ ps2 = {0.f, 0.f}; float p[16]; \
        _Pragma("unroll") for (int e2 = 0; e2 < 8; ++e2) { const int k0_ = ((2 * e2) & 3) + 8 * ((2 * e2) >> 2); const f32x2n_ ar = __builtin_elementwise_fma((f32x2n_){s[2 * e2], s[2 * e2 + 1]}, cc_, nm_); \
            p[2 * e2] = __uint_as_float(__float_as_uint(__builtin_amdgcn_exp2f(ar.x)) & (unsigned)__builtin_amdgcn_sbfe((int)word, k0_, 1)); \
            p[2 * e2 + 1] = __uint_as_float(__float_as_uint(__builtin_amdgcn_exp2f(ar.y)) & (unsigned)__builtin_amdgcn_sbfe((int)word, k0_ + 1, 1)); ps2 += (f32x2n_){p[2 * e2], p[2 * e2 + 1]}; } \
        const float psum = ps2.x + ps2.y; \
        lrow = lrow * alpha + psum; \
        if (__any(grow)) { _Pragma("unroll") for (int mt = 0; mt < 4; ++mt) _Pragma("unroll") for (int e = 0; e < 16; ++e) o[mt][e] *= alpha; } \
        bf16x8 pf[2]; _Pragma("unroll") for (int s2 = 0; s2 < 2; ++s2) { u32x4 w; w.x = pk2(p[8 * s2 + 0], p[8 * s2 + 1]); w.y = pk2(p[8 * s2 + 2], p[8 * s2 + 3]); w.z = pk2(p[8 * s2 + 4], p[8 * s2 + 5]); w.w = pk2(p[8 * s2 + 6], p[8 * s2 + 7]); pf[s2] = __builtin_bit_cast(bf16x8, w); } \
        _Pragma("unroll") for (int mt = 0; mt < 4; ++mt) { const bf16x8 v0 = *(const LAS bf16x8*)&VL[(32 * mt + n) * VSTR + hi * 16], v1 = *(const LAS bf16x8*)&VL[(32 * mt + n) * VSTR + hi * 16 + 8]; \
            o[mt] = __builtin_amdgcn_mfma_f32_32x32x16_bf16(v0, pf[0], o[mt], 0, 0, 0); o[mt] = __builtin_amdgcn_mfma_f32_32x32x16_bf16(v1, pf[1], o[mt], 0, 0, 0); } }
    for (int it = bid; it < 2048; it += G) {
        const int j = it >> 8, r = it & 255, b = r >> 3, q8 = r & 7; const int qt = j * 8 + ((j & 1) ? 7 - q8 : q8);
        const int t0 = qt * 32 + wave * 4; const size_t rowbase = (size_t)b * 2048; const size_t m = rowbase + t0 + tl;
        const int ntile = qt + 1;
        const bf16* kg = P + (rowbase + skey) * ODD_PAD + O_K + spiece * 8; const bf16* vg = VT + ((size_t)b * 128 + sd) * 2048 + svp * 8;
        u32x4 kA, vA, kB, vB;
        ATT_LOAD(kA, vA, 0)
        bf16x8 qf[8];
        { const bf16* qp = P + m * ODD_PAD + O_Q + head * 128 + hi * 8;
#pragma unroll
          for (int ks = 0; ks < 8; ++ks) qf[ks] = *(const bf16x8*)(qp + ks * 16); }
        unsigned mw[4];
#pragma unroll
        for (int i = 0; i < 4; ++i) mw[i] = MASK[(rowbase + t0 + i) * 64 + lane];
        f32x16 o[4];
#pragma unroll
        for (int mt = 0; mt < 4; ++mt)
#pragma unroll
            for (int e = 0; e < 16; ++e) o[mt][e] = 0.f;
        float mrow = -1e30f, lrow = 0.f;
        ATT_STORE(0, kA, vA)
        ATT_LOAD(kA, vA, 1) ATT_LOAD(kB, vB, 2)
        __syncthreads();
#pragma unroll 1
        for (int kt = 0; kt < ntile; kt += 2) {
            ATT_TILE(0, kt)
            ATT_STORE(1, kA, vA)
            ATT_LOAD(kA, vA, kt + 3)
            __syncthreads();
            if (kt + 1 < ntile) { ATT_TILE(1, kt + 1) }
            ATT_STORE(0, kB, vB)
            ATT_LOAD(kB, vB, kt + 4)
            __syncthreads();
        }
#undef ATT_STORE
#undef ATT_LOAD
#undef ATT_TILE
        const float l = lrow + __shfl_xor(lrow, 32); const float inv = 1.f / l;
        bf16* op = CAT + m * 1024 + head * 128 + 4 * hi;
#pragma unroll
        for (int mt = 0; mt < 4; ++mt)
#pragma unroll
            for (int i = 0; i < 4; ++i) { u32x2 w; w.x = pk2(o[mt][4 * i] * inv, o[mt][4 * i + 1] * inv); w.y = pk2(o[mt][4 * i + 2] * inv, o[mt][4 * i + 3] * inv); *(u32x2*)(op + 32 * mt + 8 * i) = w; }
    }
}
__device__ __forceinline__ void ph_attention4(const Args& a, LAS unsigned char* lds, int bid, int G, int tid) {
    const bf16* P = (const bf16*)(a.ws + WS_P); const unsigned* MASK = (const unsigned*)(a.ws + WS_MASK); const bf16* VT = (const bf16*)(a.ws + WS_VT); bf16* CAT = (bf16*)(a.ws + WS_CAT);
    constexpr int KSTR = 136, VSTR = 72, KBYTES = 64 * KSTR * 2, BUFB = KBYTES + 128 * VSTR * 2;
    const int lane = tid & 63, wave = __builtin_amdgcn_readfirstlane(tid >> 6);
    const int n = lane & 31, hi = lane >> 5, tl = n >> 3, head = n & 7;
    const int skey = tid >> 3, sp2 = tid & 7, sd = tid >> 2, svp = tid & 3;
    const int vsub = 32 * (svp >> 1), vqa = 4 * ((2 * svp) & 3), vqb = 4 * ((2 * svp + 1) & 3);
    const float C = 0.12751743f;
#define ATT_STORE(buf, k0, k1, v0, v1) { LAS bf16* KN = (LAS bf16*)(lds + (buf) * BUFB); LAS bf16* VN = (LAS bf16*)(lds + (buf) * BUFB + KBYTES) + sd * VSTR + vsub; \
        *(LAS u32x4*)&KN[skey * KSTR + sp2 * 16] = k0; *(LAS u32x4*)&KN[skey * KSTR + sp2 * 16 + 8] = k1; \
        *(LAS u32x2*)&VN[vqa] = (u32x2){v0.x, v0.y}; *(LAS u32x2*)&VN[16 + vqa] = (u32x2){v0.z, v0.w}; *(LAS u32x2*)&VN[vqb] = (u32x2){v1.x, v1.y}; *(LAS u32x2*)&VN[16 + vqb] = (u32x2){v1.z, v1.w}; }
#define ATT_LOAD(k0, k1, v0, v1, t) { const int tc = min((t), ntile - 1); const u32x4* kp_ = (const u32x4*)(kg + (size_t)tc * 64 * ODD_PAD); k0 = kp_[0]; k1 = kp_[1]; const u32x4* vp_ = (const u32x4*)(vg + tc * 64); v0 = vp_[0]; v1 = vp_[1]; }
#define ATT_PEXP(S, W, PP, o_) _Pragma("unroll") for (int e2 = 0; e2 < 8; ++e2) { const int k0_ = ((2 * e2) & 3) + 8 * ((2 * e2) >> 2); const f32x2n_ ar = __builtin_elementwise_fma((f32x2n_){S[2 * e2], S[2 * e2 + 1]}, cc_, nm_); \
            PP[(o_) + 2 * e2] = __uint_as_float(__float_as_uint(__builtin_amdgcn_exp2f(ar.x)) & (unsigned)__builtin_amdgcn_sbfe((int)(W), k0_, 1)); \
            PP[(o_) + 2 * e2 + 1] = __uint_as_float(__float_as_uint(__builtin_amdgcn_exp2f(ar.y)) & (unsigned)__builtin_amdgcn_sbfe((int)(W), k0_ + 1, 1)); ps2 += (f32x2n_){PP[(o_) + 2 * e2], PP[(o_) + 2 * e2 + 1]}; }
#define ATT_MAX16(S) fmaxf(fmaxf(fmaxf(fmaxf(fmaxf(S[0], S[1]), S[2]), fmaxf(fmaxf(S[3], S[4]), S[5])), fmaxf(fmaxf(fmaxf(S[6], S[7]), S[8]), fmaxf(fmaxf(S[9], S[10]), S[11]))), fmaxf(fmaxf(S[12], S[13]), fmaxf(S[14], S[15])))
#define ATT_TILE(buf, kt) { const LAS bf16* KT = (const LAS bf16*)(lds + (buf) * BUFB); const LAS bf16* VL = (const LAS bf16*)(lds + (buf) * BUFB + KBYTES); \
        f32x16 sA, sB; _Pragma("unroll") for (int e = 0; e < 16; ++e) { sA[e] = 0.f; sB[e] = 0.f; } \
        _Pragma("unroll") for (int ks = 0; ks < 8; ++ks) { const bf16x8 kfA = *(const LAS bf16x8*)&KT[n * KSTR + ks * 16 + hi * 8], kfB = *(const LAS bf16x8*)&KT[(32 + n) * KSTR + ks * 16 + hi * 8]; \
            sA = __builtin_amdgcn_mfma_f32_32x32x16_bf16(kfA, qf[ks], sA, 0, 0, 0); sB = __builtin_amdgcn_mfma_f32_32x32x16_bf16(kfB, qf[ks], sB, 0, 0, 0); } \
        unsigned wordA, wordB; \
        { const unsigned w0 = (unsigned)__builtin_amdgcn_readlane((int)mw[0], 2 * (kt)), w1 = (unsigned)__builtin_amdgcn_readlane((int)mw[1], 2 * (kt)), w2 = (unsigned)__builtin_amdgcn_readlane((int)mw[2], 2 * (kt)), w3 = (unsigned)__builtin_amdgcn_readlane((int)mw[3], 2 * (kt)); \
          wordA = (tl == 0 ? w0 : (tl == 1 ? w1 : (tl == 2 ? w2 : w3))) >> (4 * hi); } \
        { const unsigned w0 = (unsigned)__builtin_amdgcn_readlane((int)mw[0], 2 * (kt) + 1), w1 = (unsigned)__builtin_amdgcn_readlane((int)mw[1], 2 * (kt) + 1), w2 = (unsigned)__builtin_amdgcn_readlane((int)mw[2], 2 * (kt) + 1), w3 = (unsigned)__builtin_amdgcn_readlane((int)mw[3], 2 * (kt) + 1); \
          wordB = (tl == 0 ? w0 : (tl == 1 ? w1 : (tl == 2 ? w2 : w3))) >> (4 * hi); } \
          \
        float mx = fmaxf(ATT_MAX16(sA), ATT_MAX16(sB)); \
        { const auto r_ = __builtin_amdgcn_permlane32_swap(__float_as_uint(mx), __float_as_uint(mx), false, false); mx = fmaxf(__uint_as_float(r_[0]), __uint_as_float(r_[1])); } \
          \
        const bool anyg = __any(mx > mrow + 62.74f); const float mnew = anyg ? fmaxf(mrow, mx) : mrow; const float alpha = anyg ? __builtin_amdgcn_exp2f((mrow - mnew) * C) : 1.f; mrow = mnew; \
        const f32x2n_ cc_ = {C, C}, nm_ = {-mnew * C, -mnew * C}; f32x2n_ ps2 = {0.f, 0.f}; float p[32]; \
        ATT_PEXP(sA, wordA, p, 0) ATT_PEXP(sB, wordB, p, 16) \
        const float psum = ps2.x + ps2.y; \
        lrow = lrow * alpha + psum; \
        if (anyg) { _Pragma("unroll") for (int mt = 0; mt < 4; ++mt) _Pragma("unroll") for (int e = 0; e < 16; ++e) o[mt][e] *= alpha; } \
        bf16x8 pf[4]; _Pragma("unroll") for (int s2 = 0; s2 < 4; ++s2) { u32x4 w; w.x = pk2(p[8 * s2 + 0], p[8 * s2 + 1]); w.y = pk2(p[8 * s2 + 2], p[8 * s2 + 3]); w.z = pk2(p[8 * s2 + 4], p[8 * s2 + 5]); w.w = pk2(p[8 * s2 + 6], p[8 * s2 + 7]); pf[s2] = __builtin_bit_cast(bf16x8, w); } \
        _Pragma("unroll") for (int mt = 0; mt < 4; ++mt) { const LAS bf16* vr_ = &VL[(32 * mt + n) * VSTR + hi * 16]; \
            const bf16x8 v0 = *(const LAS bf16x8*)vr_, v1 = *(const LAS bf16x8*)(vr_ + 8), v2 = *(const LAS bf16x8*)(vr_ + 32), v3 = *(const LAS bf16x8*)(vr_ + 40); \
            o[mt] = __builtin_amdgcn_mfma_f32_32x32x16_bf16(v0, pf[0], o[mt], 0, 0, 0); o[mt] = __builtin_amdgcn_mfma_f32_32x32x16_bf16(v1, pf[1], o[mt], 0, 0, 0); \
            o[mt] = __builtin_amdgcn_mfma_f32_32x32x16_bf16(v2, pf[2], o[mt], 0, 0, 0); o[mt] = __builtin_amdgcn_mfma_f32_32x32x16_bf16(v3, pf[3], o[mt], 0, 0, 0); } }
    for (int it = bid; it < 2048; it += G) {
        const int j = it >> 8, r = it & 255, b = r >> 3, q8 = r & 7; const int qt = j * 8 + ((j & 1) ? 7 - q8 : q8);
        const int t0 = qt * 32 + wave * 4; const size_t rowbase = (size_t)b * 2048; const size_t m = rowbase + t0 + tl;
        const int ntile = (qt + 2) >> 1;
        const bf16* kg = P + (rowbase + skey) * ODD_PAD + O_K + sp2 * 16; const bf16* vg = VT + ((size_t)b * 128 + sd) * 2048 + svp * 16;
        u32x4 kA0, kA1, vA0, vA1, kB0, kB1, vB0, vB1;
        ATT_LOAD(kA0, kA1, vA0, vA1, 0)
        bf16x8 qf[8];
        { const bf16* qp = P + m * ODD_PAD + O_Q + head * 128 + hi * 8;
#pragma unroll
          for (int ks = 0; ks < 8; ++ks) qf[ks] = *(const bf16x8*)(qp + ks * 16); }
        unsigned mw[4];
#pragma unroll
        for (int i = 0; i < 4; ++i) mw[i] = MASK[(rowbase + t0 + i) * 64 + lane];
        f32x16 o[4];
#pragma unroll
        for (int mt = 0; mt < 4; ++mt)
#pragma unroll
            for (int e = 0; e < 16; ++e) o[mt][e] = 0.f;
        float mrow = -1e30f, lrow = 0.f;
        ATT_STORE(0, kA0, kA1, vA0, vA1)
        ATT_LOAD(kA0, kA1, vA0, vA1, 1) ATT_LOAD(kB0, kB1, vB0, vB1, 2)
        __syncthreads();
#pragma unroll 1
        for (int kt = 0; kt < ntile; kt += 2) {
            ATT_TILE(0, kt)
            ATT_STORE(1, kA0, kA1, vA0, vA1)
            ATT_LOAD(kA0, kA1, vA0, vA1, kt + 3)
            __syncthreads();
            if (kt + 1 < ntile) { ATT_TILE(1, kt + 1) }
            ATT_STORE(0, kB0, kB1, vB0, vB1)
            ATT_LOAD(kB0, kB1, vB0, vB1, kt + 4)
            __syncthreads();
        }
#undef ATT_STORE
#undef ATT_LOAD
#undef ATT_TILE
#undef ATT_PEXP
#undef ATT_MAX16
        const float l = lrow + __shfl_xor(lrow, 32); const float inv = 1.f / l;
        bf16* op = CAT + m * 1024 + head * 128 + 8 * hi;
#pragma unroll
        for (int mt = 0; mt < 4; ++mt)
#pragma unroll
            for (int i = 0; i < 4; i += 2) {
                unsigned ax = pk2(o[mt][4 * i] * inv, o[mt][4 * i + 1] * inv), ay = pk2(o[mt][4 * i + 2] * inv, o[mt][4 * i + 3] * inv);
                unsigned bx = pk2(o[mt][4 * i + 4] * inv, o[mt][4 * i + 5] * inv), by = pk2(o[mt][4 * i + 6] * inv, o[mt][4 * i + 7] * inv);
                const auto sx = __builtin_amdgcn_permlane32_swap(ax, bx, false, false); const auto sy = __builtin_amdgcn_permlane32_swap(ay, by, false, false);
                *(u32x4*)(op + 32 * mt + 8 * i) = (u32x4){sx[0], sy[0], sx[1], sy[1]}; }
    }
}

__device__ __forceinline__ void wave_argmax(float& v, int& idx) {
#pragma unroll
    for (int o = 1; o < 64; o <<= 1) { const float ov = __shfl_xor(v, o); const int oi = __shfl_xor(idx, o); if (ov > v || (ov == v && oi < idx)) { v = ov; idx = oi; } }
}
__device__ __forceinline__ void ph_route(const Args& a, int layer, LAS unsigned char* lds, int gw, int NGW, int wave, int lane) {
    const bf16* Q = (const bf16*)(a.ws + WS_QP); const float* SK = a.in[22] + (size_t)layer * 8 * 2 * 128 * 64;
    unsigned short* RI = (unsigned short*)(a.ws + WS_RIDX); float* RG = (float*)(a.ws + WS_RGATE);
    LAS float* qh = (LAS float*)(lds + wave * 2048); LAS float* ts = (LAS float*)(lds + wave * 2048 + 512); LAS int* ti = (LAS int*)(lds + wave * 2048 + 640);
    const float NEG_INF = -__builtin_inff();
    for (int m = gw; m < MTOK; m += NGW) {
        for (int h = 0; h < 8; ++h) {
            qh[lane] = bf2f(Q[(size_t)m * 1024 + h * 128 + lane]); qh[64 + lane] = bf2f(Q[(size_t)m * 1024 + h * 128 + 64 + lane]);
            LDS_WAIT();
#pragma unroll
            for (int c = 0; c < 2; ++c) {
                float v0, v1;
                { const f32x4* k0 = (const f32x4*)(SK + ((size_t)(h * 2 + c) * 128 + lane) * 64); const f32x4* k1 = (const f32x4*)(SK + ((size_t)(h * 2 + c) * 128 + 64 + lane) * 64); float a0 = 0.f, a1 = 0.f;
#pragma unroll
                  for (int d4 = 0; d4 < 16; ++d4) { const f32x4 qv = *(const LAS f32x4*)&qh[c * 64 + d4 * 4]; const f32x4 x0 = k0[d4], x1 = k1[d4];
                      a0 += qv.x * x0.x + qv.y * x0.y + qv.z * x0.z + qv.w * x0.w; a1 += qv.x * x1.x + qv.y * x1.y + qv.z * x1.z + qv.w * x1.w; }
                  v0 = a0; v1 = a1; }
                for (int r = 0; r < 16; ++r) { float bv = v0; int bi = lane; if (v1 > v0) { bv = v1; bi = lane + 64; }
                    wave_argmax(bv, bi);
                    if (bi == lane) v0 = NEG_INF; if (bi == lane + 64) v1 = NEG_INF;
                    if (lane == 0) { ts[c * 16 + r] = bv; ti[c * 16 + r] = bi; } }
            }
            LDS_WAIT();
            float cv[4];
#pragma unroll
            for (int jj = 0; jj < 4; ++jj) { const int f = lane + 64 * jj; cv[jj] = ts[f >> 4] + ts[16 + (f & 15)]; }
            float bs = 0.f; int bpos = 0;
            for (int r = 0; r < 16; ++r) { float bv = cv[0]; int bi = lane;
#pragma unroll
                for (int jj = 1; jj < 4; ++jj) if (cv[jj] > bv) { bv = cv[jj]; bi = lane + 64 * jj; }
                wave_argmax(bv, bi);
#pragma unroll
                for (int jj = 0; jj < 4; ++jj) if (bi == lane + 64 * jj) cv[jj] = NEG_INF;
                if (lane == r) { bs = bv; bpos = bi; } }
            const float mx = __shfl(bs, 0); const float e = (lane < 16) ? expf(bs - mx) : 0.f; const float sum = wave_sum(e);
            if (lane < 16) { const int ei = ti[bpos >> 4] * 128 + ti[16 + (bpos & 15)]; RI[(size_t)m * 128 + h * 16 + lane] = (unsigned short)ei; RG[(size_t)m * 128 + h * 16 + lane] = e / sum; }
            LDS_WAIT();
        }
    }
}
__device__ __forceinline__ void ph_experts(const Args& a, int layer, int gw, int NGW, int lane) {
    const float* U = a.in[23] + (size_t)layer * 16384 * 1024; const float* V = a.in[24] + (size_t)layer * 16384 * 1024;
    const unsigned short* RI = (const unsigned short*)(a.ws + WS_RIDX); const float* RG = (const float*)(a.ws + WS_RGATE);
    const float* g = a.in[25] + layer * 1024; const float* bb = a.in[26] + layer * 1024; bf16* XB = (bf16*)(a.ws + WS_XB);
    for (int m = gw; m < MTOK; m += NGW) {
        f32x4 x[4], acc[4];
        const f32x4* xr = (const f32x4*)(a.out + (size_t)m * 1024) + lane;
#pragma unroll
        for (int j = 0; j < 4; ++j) { x[j] = xr[64 * j]; acc[j] = (f32x4){0.f, 0.f, 0.f, 0.f}; }
        for (int k = 0; k < 128; ++k) {
            const int e = RI[(size_t)m * 128 + k]; const float gate = RG[(size_t)m * 128 + k];
            const f32x4* ur = (const f32x4*)(U + (size_t)e * 1024) + lane; const f32x4* vr = (const f32x4*)(V + (size_t)e * 1024) + lane;
            f32x4 uv[4], vv[4];
#pragma unroll
            for (int j = 0; j < 4; ++j) { uv[j] = ur[64 * j]; vv[j] = vr[64 * j]; }
            float d = 0.f;
#pragma unroll
            for (int j = 0; j < 4; ++j) d += (x[j].x * uv[j].x + x[j].y * uv[j].y) + (x[j].z * uv[j].z + x[j].w * uv[j].w);
            d = wave_sum(d);
            const float coef = gate * 0.5f * d * (1.f + erff(d * 0.7071067811865476f));
#pragma unroll
            for (int j = 0; j < 4; ++j) acc[j] += vv[j] * coef;
        }
        float s = 0.f;
#pragma unroll
        for (int j = 0; j < 4; ++j) { acc[j] = x[j] * DN_ALPHA + acc[j]; s += (acc[j].x + acc[j].y) + (acc[j].z + acc[j].w); }
        const float mean = wave_sum(s) * (1.f / 1024.f); float s2 = 0.f;
#pragma unroll
        for (int j = 0; j < 4; ++j) { acc[j] = acc[j] - mean; s2 += (acc[j].x * acc[j].x + acc[j].y * acc[j].y) + (acc[j].z * acc[j].z + acc[j].w * acc[j].w); }
        const float rstd = 1.f / sqrtf(wave_sum(s2) * (1.f / 1024.f) + LN_EPS);
        f32x4* orow = (f32x4*)(a.out + (size_t)m * 1024) + lane; u32x2* ob = (u32x2*)(XB + (size_t)m * 1024) + lane;
#pragma unroll
        for (int j = 0; j < 4; ++j) { const f32x4 o = acc[j] * rstd * ((const f32x4*)g)[lane + 64 * j] + ((const f32x4*)bb)[lane + 64 * j]; orow[64 * j] = o; u32x2 w; w.x = pk2(o.x, o.y); w.y = pk2(o.z, o.w); ob[64 * j] = w; }
    }
}

__device__ __forceinline__ void cas_desc(int& x, int& y) { const int h = max(x, y), l = min(x, y); x = h; y = l; }
__device__ __forceinline__ void sort16_desc(int (&v)[16]) {
    cas_desc(v[0], v[13]); cas_desc(v[1], v[12]); cas_desc(v[2], v[15]); cas_desc(v[3], v[14]); cas_desc(v[4], v[8]); cas_desc(v[5], v[6]); cas_desc(v[7], v[11]); cas_desc(v[9], v[10]); cas_desc(v[0], v[5]); cas_desc(v[1], v[7]); cas_desc(v[2], v[9]); cas_desc(v[3], v[4]); cas_desc(v[6], v[13]); cas_desc(v[8], v[14]); cas_desc(v[10], v[15]); cas_desc(v[11], v[12]); cas_desc(v[0], v[1]); cas_desc(v[2], v[3]); cas_desc(v[4], v[5]); cas_desc(v[6], v[8]); cas_desc(v[7], v[9]); cas_desc(v[10], v[11]); cas_desc(v[12], v[13]); cas_desc(v[14], v[15]); cas_desc(v[0], v[2]); cas_desc(v[1], v[3]); cas_desc(v[4], v[10]); cas_desc(v[5], v[11]); cas_desc(v[6], v[7]); cas_desc(v[8], v[9]); cas_desc(v[12], v[14]); cas_desc(v[13], v[15]); cas_desc(v[1], v[2]); cas_desc(v[3], v[12]); cas_desc(v[4], v[6]); cas_desc(v[5], v[7]); cas_desc(v[8], v[10]); cas_desc(v[9], v[11]); cas_desc(v[13], v[14]); cas_desc(v[1], v[4]); cas_desc(v[2], v[6]); cas_desc(v[5], v[8]); cas_desc(v[7], v[10]); cas_desc(v[9], v[13]); cas_desc(v[11], v[14]); cas_desc(v[2], v[4]); cas_desc(v[3], v[6]); cas_desc(v[9], v[12]); cas_desc(v[11], v[13]); cas_desc(v[3], v[5]); cas_desc(v[6], v[8]); cas_desc(v[7], v[9]); cas_desc(v[10], v[12]); cas_desc(v[3], v[4]); cas_desc(v[5], v[6]); cas_desc(v[7], v[8]); cas_desc(v[9], v[10]); cas_desc(v[11], v[12]); cas_desc(v[6], v[7]); cas_desc(v[8], v[9]);
}
__device__ __forceinline__ void merge16_desc(int (&v)[16]) {
#pragma unroll
    for (int j = 8; j > 0; j >>= 1)
#pragma unroll
        for (int i = 0; i < 16; ++i) { const int l = i ^ j; if (l > i) cas_desc(v[i], v[l]); }
}
__device__ __forceinline__ void topmerge16(int (&x)[16], const int (&y)[16]) {
#pragma unroll
    for (int i = 0; i < 16; ++i) x[i] = max(x[i], y[15 - i]);
    merge16_desc(x);
}
__device__ __forceinline__ int skey_of(float f) { const int u = __float_as_int(f); return u ^ ((u >> 31) & 0x7fffffff); }
__device__ __forceinline__ float f_of_skey(int s) { return __int_as_float(s ^ ((s >> 31) & 0x7fffffff)); }
__device__ __forceinline__ int packc(float f, int pos) { return (skey_of(f) & ~255) | (255 - pos); }
__device__ __forceinline__ void route_top128(const bf16* SKb, const bf16* qrow, int hi, int n, int (&L)[16]) {
    bf16x8 qf[4];
#pragma unroll
    for (int ks = 0; ks < 4; ++ks) qf[ks] = *(const bf16x8*)(qrow + ks * 16);
    f32x16 acc[4];
    u32x4 afr[4][4];
#pragma unroll
    for (int mt = 0; mt < 4; ++mt)
#pragma unroll
        for (int ks = 0; ks < 4; ++ks) afr[mt][ks] = *(const u32x4*)(SKb + (size_t)(32 * mt + n) * 64 + ks * 16 + hi * 8);
    asm volatile("" : "+v"(afr[0][0]), "+v"(afr[0][1]), "+v"(afr[0][2]), "+v"(afr[0][3]), "+v"(afr[1][0]), "+v"(afr[1][1]), "+v"(afr[1][2]), "+v"(afr[1][3]));
    asm volatile("" : "+v"(afr[2][0]), "+v"(afr[2][1]), "+v"(afr[2][2]), "+v"(afr[2][3]), "+v"(afr[3][0]), "+v"(afr[3][1]), "+v"(afr[3][2]), "+v"(afr[3][3]));
#pragma unroll
    for (int mt = 0; mt < 4; ++mt) {
#pragma unroll
        for (int e = 0; e < 16; ++e) acc[mt][e] = 0.f;
#pragma unroll
        for (int ks = 0; ks < 4; ++ks) acc[mt] = __builtin_amdgcn_mfma_f32_32x32x16_bf16(__builtin_bit_cast(bf16x8, afr[mt][ks]), qf[ks], acc[mt], 0, 0, 0);
    }
    const int hx = 4 * hi;
#pragma unroll
    for (int mt = 0; mt < 4; ++mt) { int v[16];
#pragma unroll
        for (int r = 0; r < 16; ++r) { const int cst = 127 - (32 * mt + 8 * (r >> 2) + (r & 3)); v[r] = ((skey_of(acc[mt][r]) & ~127) | cst) ^ hx; }
        sort16_desc(v);
        if (mt == 0) {
#pragma unroll
            for (int r = 0; r < 16; ++r) L[r] = v[r]; }
        else topmerge16(L, v); }
    int o[16];
#pragma unroll
    for (int r = 0; r < 16; ++r) o[r] = __shfl_xor(L[r], 32);
    topmerge16(L, o);
}
__device__ __forceinline__ void ph_route2(const Args& a, int layer, LAS unsigned char* lds, int bid, int G, int wave, int lane) {
    const bf16* Q = (const bf16*)(a.ws + WS_QP); const bf16* SKb = (const bf16*)(a.ws + WS_SK) + (size_t)layer * 8 * 2 * 128 * 64 + (size_t)wave * 2 * 128 * 64;
    unsigned short* RI = (unsigned short*)(a.ws + WS_RIDX); float* RG = (float*)(a.ws + WS_RGATE);
    LAS unsigned char* lk = lds + wave * 2304 + lane * 36;
    const int n = lane & 31, hi = lane >> 5, h = wave;
    for (int tile = bid; tile < MTOK / 32; tile += G) {
        const size_t tok = (size_t)tile * 32 + n; const bf16* qrow = Q + tok * 1024 + h * 128 + hi * 8;
        int A[16], B[16];
        route_top128(SKb, qrow, hi, n, A);
        route_top128(SKb + 128 * 64, qrow + 64, hi, n, B);
        float fa[16], fb[16];
#pragma unroll
        for (int i = 0; i < 16; ++i) { fa[i] = f_of_skey(A[i] & ~127); fb[i] = f_of_skey(B[i] & ~127); }
        { unsigned wa[4], wb[4];
#pragma unroll
          for (int q = 0; q < 4; ++q) { wa[q] = 0u; wb[q] = 0u;
#pragma unroll
              for (int e = 0; e < 4; ++e) { wa[q] |= (unsigned)(127 - (A[4 * q + e] & 127)) << (8 * e); wb[q] |= (unsigned)(127 - (B[4 * q + e] & 127)) << (8 * e); } }
#pragma unroll
          for (int q = 0; q < 4; ++q) { ((LAS unsigned*)lk)[q] = wa[q]; ((LAS unsigned*)lk)[4 + q] = wb[q]; } }
        int T[16], S1[16], S2[16], S3[16];
#pragma unroll
        for (int j = 0; j < 16; ++j) T[j] = packc(fa[0] + fb[j], j);
#pragma unroll
        for (int j = 0; j < 8; ++j) { S1[j] = packc(fa[1] + fb[j], 16 + j); S1[15 - j] = packc(fa[8 + j] + fb[0], (8 + j) * 16); }
        merge16_desc(S1);
        S2[0] = packc(fa[2] + fb[0], 32); S2[1] = packc(fa[2] + fb[1], 33); S2[2] = packc(fa[2] + fb[2], 34); S2[3] = packc(fa[2] + fb[3], 35); S2[4] = packc(fa[2] + fb[4], 36);
        S2[5] = packc(fa[3] + fb[0], 48); S2[6] = packc(fa[3] + fb[1], 49); S2[7] = packc(fa[3] + fb[2], 50); S2[8] = packc(fa[3] + fb[3], 51);
        S2[9] = packc(fa[4] + fb[0], 64); S2[10] = packc(fa[4] + fb[1], 65); S2[11] = packc(fa[4] + fb[2], 66);
        S2[12] = packc(fa[5] + fb[0], 80); S2[13] = packc(fa[5] + fb[1], 81); S2[14] = packc(fa[6] + fb[0], 96); S2[15] = packc(fa[6] + fb[1], 97);
        sort16_desc(S2);
        S3[0] = packc(fa[7] + fb[0], 112); S3[1] = packc(fa[7] + fb[1], 113);
#pragma unroll
        for (int j = 2; j < 16; ++j) S3[j] = (int)0x80000000;
        topmerge16(T, S1); topmerge16(T, S2); topmerge16(T, S3);
        LDS_WAIT();
        float ev[16]; float sum = 0.f; const float mx = f_of_skey(T[0] & ~255);
#pragma unroll
        for (int r = 0; r < 16; ++r) { ev[r] = __expf(f_of_skey(T[r] & ~255) - mx); sum += ev[r]; }
        const float inv = 1.f / sum;
        unsigned ei[16];
#pragma unroll
        for (int r = 0; r < 16; ++r) { const int pos = 255 - (T[r] & 255); ei[r] = (unsigned)lk[pos >> 4] * 128u + (unsigned)lk[16 + (pos & 15)]; }
        unsigned short* ri = RI + tok * 128 + h * 16 + hi * 8; float* rg = RG + tok * 128 + h * 16 + hi * 8;
        u32x4 wi; f32x4 g0, g1;
        if (hi == 0) { wi.x = ei[0] | (ei[1] << 16); wi.y = ei[2] | (ei[3] << 16); wi.z = ei[4] | (ei[5] << 16); wi.w = ei[6] | (ei[7] << 16); g0 = (f32x4){ev[0], ev[1], ev[2], ev[3]}; g1 = (f32x4){ev[4], ev[5], ev[6], ev[7]}; }
        else { wi.x = ei[8] | (ei[9] << 16); wi.y = ei[10] | (ei[11] << 16); wi.z = ei[12] | (ei[13] << 16); wi.w = ei[14] | (ei[15] << 16); g0 = (f32x4){ev[8], ev[9], ev[10], ev[11]}; g1 = (f32x4){ev[12], ev[13], ev[14], ev[15]}; }
        *(u32x4*)ri = wi; *(f32x4*)rg = g0 * inv; *(f32x4*)(rg + 4) = g1 * inv;
        LDS_WAIT();
    }
}

__device__ __forceinline__ void convert_experts(const Args& a, int layer, int gtid, int NT) {
    const f32x4* U = (const f32x4*)(a.in[23] + (size_t)layer * 16384 * 1024); const f32x4* V = (const f32x4*)(a.in[24] + (size_t)layer * 16384 * 1024);
    u32x4* DU = (u32x4*)(a.ws + WS_EXP); u32x4* DV = DU + (size_t)16384 * 1024 / 8;
    for (size_t i = gtid; i < (size_t)16384 * 1024 / 8; i += NT) {
        const f32x4 a0 = U[2 * i], a1 = U[2 * i + 1], b0 = V[2 * i], b1 = V[2 * i + 1];
        u32x4 o; o.x = pk2(a0.x, a0.y); o.y = pk2(a0.z, a0.w); o.z = pk2(a1.x, a1.y); o.w = pk2(a1.z, a1.w); DU[i] = o;
        u32x4 p; p.x = pk2(b0.x, b0.y); p.y = pk2(b0.z, b0.w); p.z = pk2(b1.x, b1.y); p.w = pk2(b1.z, b1.w); DV[i] = p; }
}
__device__ __forceinline__ float dot8(const f32x4 xa, const f32x4 xb, const u32x4 w) {
    return (xa.x * bflo(w.x) + xa.y * bfhi(w.x)) + (xa.z * bflo(w.y) + xa.w * bfhi(w.y)) + (xb.x * bflo(w.z) + xb.y * bfhi(w.z)) + (xb.z * bflo(w.w) + xb.w * bfhi(w.w));
}
__device__ __forceinline__ void axpy8(f32x4& aa, f32x4& ab, const float c, const u32x4 w) {
    aa.x += c * bflo(w.x); aa.y += c * bfhi(w.x); aa.z += c * bflo(w.y); aa.w += c * bfhi(w.y); ab.x += c * bflo(w.z); ab.y += c * bfhi(w.z); ab.z += c * bflo(w.w); ab.w += c * bfhi(w.w);
}
__device__ __forceinline__ float gelu_exact(float d) { return 0.5f * d * (1.f + erff(d * 0.7071067811865476f)); }
__device__ __forceinline__ void ph_experts2(const Args& a, int layer, int gw, int NGW, int lane, float* OUTP, bf16* XBP) {
    const bf16* U = (const bf16*)(a.ws + WS_EXP); const bf16* V = U + (size_t)16384 * 1024;
    const unsigned short* RI = (const unsigned short*)(a.ws + WS_RIDX); const float* RG = (const float*)(a.ws + WS_RGATE);
    const float* g = a.in[25] + layer * 1024; const float* bb = a.in[26] + layer * 1024; bf16* XB = XBP;
    for (int m = gw; m < MTOK; m += NGW) {
        const f32x4* xr = (const f32x4*)(a.out + (size_t)m * 1024);
        const f32x4 x0 = xr[2 * lane], x1 = xr[2 * lane + 1], x2 = xr[128 + 2 * lane], x3 = xr[128 + 2 * lane + 1];
        const unsigned idxp = ((const unsigned*)(RI + (size_t)m * 128))[lane];
        const float gp0 = RG[(size_t)m * 128 + 2 * lane], gp1 = RG[(size_t)m * 128 + 2 * lane + 1];
        f32x4 c0 = {0.f, 0.f, 0.f, 0.f}, c1 = c0, c2 = c0, c3 = c0;
        u32x4 Au0a, Au0b, Av0a, Av0b, Au1a, Au1b, Av1a, Av1b, Bu0a, Bu0b, Bv0a, Bv0b, Bu1a, Bu1b, Bv1a, Bv1b;
#define LOADG(X, gg) { const unsigned word = (unsigned)__builtin_amdgcn_readlane((int)idxp, (gg)); const unsigned e0 = word & 0xffffu, e1 = word >> 16; \
        const u32x4* pu0 = (const u32x4*)(U + (size_t)e0 * 1024) + lane; const u32x4* pv0 = (const u32x4*)(V + (size_t)e0 * 1024) + lane; \
        const u32x4* pu1 = (const u32x4*)(U + (size_t)e1 * 1024) + lane; const u32x4* pv1 = (const u32x4*)(V + (size_t)e1 * 1024) + lane; \
        X##u0a = pu0[0]; X##u0b = pu0[64]; X##u1a = pu1[0]; X##u1b = pu1[64]; X##v0a = pv0[0]; X##v0b = pv0[64]; X##v1a = pv1[0]; X##v1b = pv1[64]; }
#define COMPG(X, gg) { float d0 = dot8(x0, x1, X##u0a) + dot8(x2, x3, X##u0b), d1 = dot8(x0, x1, X##u1a) + dot8(x2, x3, X##u1b); \
        d0 = wave_sum(d0); d1 = wave_sum(d1); \
        const float k0 = __builtin_bit_cast(float, __builtin_amdgcn_readlane(__builtin_bit_cast(int, gp0), (gg))) * gelu_exact(d0); \
        const float k1 = __builtin_bit_cast(float, __builtin_amdgcn_readlane(__builtin_bit_cast(int, gp1), (gg))) * gelu_exact(d1); \
        axpy8(c0, c1, k0, X##v0a); axpy8(c2, c3, k0, X##v0b); axpy8(c0, c1, k1, X##v1a); axpy8(c2, c3, k1, X##v1b); }
        LOADG(A, 0) LOADG(B, 1)
#pragma unroll 1
        for (int gg = 0; gg < 64; gg += 2) {
            COMPG(A, gg) if (gg + 2 < 64) LOADG(A, gg + 2)
            COMPG(B, gg + 1) if (gg + 3 < 64) LOADG(B, gg + 3)
        }
#undef LOADG
#undef COMPG
        float s = 0.f;
        c0 = x0 * DN_ALPHA + c0; c1 = x1 * DN_ALPHA + c1; c2 = x2 * DN_ALPHA + c2; c3 = x3 * DN_ALPHA + c3;
        s = ((c0.x + c0.y) + (c0.z + c0.w)) + ((c1.x + c1.y) + (c1.z + c1.w)) + ((c2.x + c2.y) + (c2.z + c2.w)) + ((c3.x + c3.y) + (c3.z + c3.w));
        const float mean = wave_sum(s) * (1.f / 1024.f);
        c0 = c0 - mean; c1 = c1 - mean; c2 = c2 - mean; c3 = c3 - mean;
        const float s2 = ((c0.x * c0.x + c0.y * c0.y) + (c0.z * c0.z + c0.w * c0.w)) + ((c1.x * c1.x + c1.y * c1.y) + (c1.z * c1.z + c1.w * c1.w)) + ((c2.x * c2.x + c2.y * c2.y) + (c2.z * c2.z + c2.w * c2.w)) + ((c3.x * c3.x + c3.y * c3.y) + (c3.z * c3.z + c3.w * c3.w));
        const float rstd = 1.f / sqrtf(wave_sum(s2) * (1.f / 1024.f) + LN_EPS);
        const f32x4* g4 = (const f32x4*)g; const f32x4* b4 = (const f32x4*)bb;
        const f32x4 o0 = c0 * rstd * g4[2 * lane] + b4[2 * lane], o1 = c1 * rstd * g4[2 * lane + 1] + b4[2 * lane + 1], o2 = c2 * rstd * g4[128 + 2 * lane] + b4[128 + 2 * lane], o3 = c3 * rstd * g4[128 + 2 * lane + 1] + b4[128 + 2 * lane + 1];
        f32x4* orow = (f32x4*)(OUTP + (size_t)m * 1024);
        orow[2 * lane] = o0; orow[2 * lane + 1] = o1; orow[128 + 2 * lane] = o2; orow[128 + 2 * lane + 1] = o3;
        u32x4* ob = (u32x4*)(XB + (size_t)m * 1024);
        u32x4 w0; w0.x = pk2(o0.x, o0.y); w0.y = pk2(o0.z, o0.w); w0.z = pk2(o1.x, o1.y); w0.w = pk2(o1.z, o1.w); ob[lane] = w0;
        u32x4 w1; w1.x = pk2(o2.x, o2.y); w1.y = pk2(o2.z, o2.w); w1.z = pk2(o3.x, o3.y); w1.w = pk2(o3.z, o3.w); ob[64 + lane] = w1;
    }
}

typedef float f32x2_ __attribute__((ext_vector_type(2)));
__device__ __forceinline__ void convert_experts_fp8(const Args& a, int layer, int gw, int NGW, int lane) {
    u32x4* D8 = (u32x4*)(a.ws + WS_EXP); float* SC = (float*)(a.ws + WS_EXP + 32 * MiB);
    for (int row = gw; row < 2 * 16384; row += NGW) {
        const float* src = (row < 16384 ? a.in[23] : a.in[24]) + ((size_t)layer * 16384 + (row & 16383)) * 1024;
        const f32x4* s4 = (const f32x4*)src + 4 * lane; const f32x4 v0 = s4[0], v1 = s4[1], v2 = s4[2], v3 = s4[3];
        float am = fmaxf(fmaxf(fmaxf(fabsf(v0.x), fabsf(v0.y)), fmaxf(fabsf(v0.z), fabsf(v0.w))), fmaxf(fmaxf(fabsf(v1.x), fabsf(v1.y)), fmaxf(fabsf(v1.z), fabsf(v1.w))));
        am = fmaxf(am, fmaxf(fmaxf(fmaxf(fabsf(v2.x), fabsf(v2.y)), fmaxf(fabsf(v2.z), fabsf(v2.w))), fmaxf(fmaxf(fabsf(v3.x), fabsf(v3.y)), fmaxf(fabsf(v3.z), fabsf(v3.w)))));
        am = wave_max(am);
        const float sc = am > 0.f ? am * (1.f / 448.f) : 1.f, inv = am > 0.f ? 448.f / am : 1.f;
        u32x4 o; int w;
        w = 0; w = __builtin_amdgcn_cvt_pk_fp8_f32(v0.x * inv, v0.y * inv, w, false); w = __builtin_amdgcn_cvt_pk_fp8_f32(v0.z * inv, v0.w * inv, w, true); o.x = (unsigned)w;
        w = 0; w = __builtin_amdgcn_cvt_pk_fp8_f32(v1.x * inv, v1.y * inv, w, false); w = __builtin_amdgcn_cvt_pk_fp8_f32(v1.z * inv, v1.w * inv, w, true); o.y = (unsigned)w;
        w = 0; w = __builtin_amdgcn_cvt_pk_fp8_f32(v2.x * inv, v2.y * inv, w, false); w = __builtin_amdgcn_cvt_pk_fp8_f32(v2.z * inv, v2.w * inv, w, true); o.z = (unsigned)w;
        w = 0; w = __builtin_amdgcn_cvt_pk_fp8_f32(v3.x * inv, v3.y * inv, w, false); w = __builtin_amdgcn_cvt_pk_fp8_f32(v3.z * inv, v3.w * inv, w, true); o.w = (unsigned)w;
        D8[(size_t)row * 64 + lane] = o;
        if (lane == 0) SC[row] = sc;
    }
}
__device__ __forceinline__ float dot16_fp8(const f32x4 xa, const f32x4 xb, const f32x4 xc, const f32x4 xd, const u32x4 w) {
    const f32x2_ a0 = __builtin_amdgcn_cvt_pk_f32_fp8((int)w.x, false), a1 = __builtin_amdgcn_cvt_pk_f32_fp8((int)w.x, true), b0 = __builtin_amdgcn_cvt_pk_f32_fp8((int)w.y, false), b1 = __builtin_amdgcn_cvt_pk_f32_fp8((int)w.y, true);
    const f32x2_ c0 = __builtin_amdgcn_cvt_pk_f32_fp8((int)w.z, false), c1 = __builtin_amdgcn_cvt_pk_f32_fp8((int)w.z, true), d0 = __builtin_amdgcn_cvt_pk_f32_fp8((int)w.w, false), d1 = __builtin_amdgcn_cvt_pk_f32_fp8((int)w.w, true);
    f32x2_ p = (f32x2_){xa.x, xa.y} * a0; p = __builtin_elementwise_fma((f32x2_){xa.z, xa.w}, a1, p); p = __builtin_elementwise_fma((f32x2_){xb.x, xb.y}, b0, p); p = __builtin_elementwise_fma((f32x2_){xb.z, xb.w}, b1, p);
    f32x2_ q = (f32x2_){xc.x, xc.y} * c0; q = __builtin_elementwise_fma((f32x2_){xc.z, xc.w}, c1, q); q = __builtin_elementwise_fma((f32x2_){xd.x, xd.y}, d0, q); q = __builtin_elementwise_fma((f32x2_){xd.z, xd.w}, d1, q);
    p = p + q;
    return p.x + p.y;
}
__device__ __forceinline__ void axpy16_fp8(f32x4& ya, f32x4& yb, f32x4& yc, f32x4& yd, const float c, const u32x4 w) {
    const f32x2_ a0 = __builtin_amdgcn_cvt_pk_f32_fp8((int)w.x, false), a1 = __builtin_amdgcn_cvt_pk_f32_fp8((int)w.x, true), b0 = __builtin_amdgcn_cvt_pk_f32_fp8((int)w.y, false), b1 = __builtin_amdgcn_cvt_pk_f32_fp8((int)w.y, true);
    const f32x2_ c0 = __builtin_amdgcn_cvt_pk_f32_fp8((int)w.z, false), c1 = __builtin_amdgcn_cvt_pk_f32_fp8((int)w.z, true), d0 = __builtin_amdgcn_cvt_pk_f32_fp8((int)w.w, false), d1 = __builtin_amdgcn_cvt_pk_f32_fp8((int)w.w, true);
    const f32x2_ cc = {c, c};
    f32x2_ t;
    t = (f32x2_){ya.x, ya.y}; t = __builtin_elementwise_fma(cc, a0, t); ya.x = t.x; ya.y = t.y; t = (f32x2_){ya.z, ya.w}; t = __builtin_elementwise_fma(cc, a1, t); ya.z = t.x; ya.w = t.y;
    t = (f32x2_){yb.x, yb.y}; t = __builtin_elementwise_fma(cc, b0, t); yb.x = t.x; yb.y = t.y; t = (f32x2_){yb.z, yb.w}; t = __builtin_elementwise_fma(cc, b1, t); yb.z = t.x; yb.w = t.y;
    t = (f32x2_){yc.x, yc.y}; t = __builtin_elementwise_fma(cc, c0, t); yc.x = t.x; yc.y = t.y; t = (f32x2_){yc.z, yc.w}; t = __builtin_elementwise_fma(cc, c1, t); yc.z = t.x; yc.w = t.y;
    t = (f32x2_){yd.x, yd.y}; t = __builtin_elementwise_fma(cc, d0, t); yd.x = t.x; yd.y = t.y; t = (f32x2_){yd.z, yd.w}; t = __builtin_elementwise_fma(cc, d1, t); yd.z = t.x; yd.w = t.y;
}
__device__ __forceinline__ void ph_experts3(const Args& a, int layer, int gw, int NGW, int lane, float* OUTP, bf16* XBP) {
    const u32x4* U8 = (const u32x4*)(a.ws + WS_EXP); const u32x4* V8 = U8 + (size_t)16384 * 64; const float* SU = (const float*)(a.ws + WS_EXP + 32 * MiB); const float* SV = SU + 16384;
    const unsigned short* RI = (const unsigned short*)(a.ws + WS_RIDX); const float* RG = (const float*)(a.ws + WS_RGATE);
    const float* g = a.in[25] + layer * 1024; const float* bb = a.in[26] + layer * 1024;
    for (int m = gw; m < MTOK; m += NGW) {
        const f32x4* xr = (const f32x4*)(a.out + (size_t)m * 1024) + 4 * lane;
        const f32x4 x0 = xr[0], x1 = xr[1], x2 = xr[2], x3 = xr[3];
        const unsigned idxp = ((const unsigned*)(RI + (size_t)m * 128))[lane];
        const float gp0 = RG[(size_t)m * 128 + 2 * lane], gp1 = RG[(size_t)m * 128 + 2 * lane + 1];
        f32x4 c0 = {0.f, 0.f, 0.f, 0.f}, c1 = c0, c2 = c0, c3 = c0;
        u32x4 Au0, Au1, Au2, Au3, Av0, Av1, Av2, Av3, Bu0, Bu1, Bu2, Bu3, Bv0, Bv1, Bv2, Bv3;
        unsigned Ae0, Ae1, Ae2, Ae3, Be0, Be1, Be2, Be3;
#define LOADG(X, gg) { const unsigned wa = (unsigned)__builtin_amdgcn_readlane((int)idxp, 2 * (gg)), wb = (unsigned)__builtin_amdgcn_readlane((int)idxp, 2 * (gg) + 1); \
        X##e0 = wa & 0xffffu; X##e1 = wa >> 16; X##e2 = wb & 0xffffu; X##e3 = wb >> 16; \
        X##u0 = U8[(size_t)X##e0 * 64 + lane]; X##u1 = U8[(size_t)X##e1 * 64 + lane]; X##u2 = U8[(size_t)X##e2 * 64 + lane]; X##u3 = U8[(size_t)X##e3 * 64 + lane]; \
        X##v0 = V8[(size_t)X##e0 * 64 + lane]; X##v1 = V8[(size_t)X##e1 * 64 + lane]; X##v2 = V8[(size_t)X##e2 * 64 + lane]; X##v3 = V8[(size_t)X##e3 * 64 + lane]; }
#define RDG(v, l) __builtin_bit_cast(float, __builtin_amdgcn_readlane(__builtin_bit_cast(int, v), (l)))
#define COMPG(X, gg) { float d0 = dot16_fp8(x0, x1, x2, x3, X##u0), d1 = dot16_fp8(x0, x1, x2, x3, X##u1), d2 = dot16_fp8(x0, x1, x2, x3, X##u2), d3 = dot16_fp8(x0, x1, x2, x3, X##u3); \
        d0 = wave_sum(d0) * SU[X##e0]; d1 = wave_sum(d1) * SU[X##e1]; d2 = wave_sum(d2) * SU[X##e2]; d3 = wave_sum(d3) * SU[X##e3]; \
        const float k0 = RDG(gp0, 2 * (gg)) * gelu_exact(d0) * SV[X##e0], k1 = RDG(gp1, 2 * (gg)) * gelu_exact(d1) * SV[X##e1], k2 = RDG(gp0, 2 * (gg) + 1) * gelu_exact(d2) * SV[X##e2], k3 = RDG(gp1, 2 * (gg) + 1) * gelu_exact(d3) * SV[X##e3]; \
        axpy16_fp8(c0, c1, c2, c3, k0, X##v0); axpy16_fp8(c0, c1, c2, c3, k1, X##v1); axpy16_fp8(c0, c1, c2, c3, k2, X##v2); axpy16_fp8(c0, c1, c2, c3, k3, X##v3); }
        LOADG(A, 0) LOADG(B, 1)
#pragma unroll 1
        for (int gg = 0; gg < 32; gg += 2) {
            COMPG(A, gg) if (gg + 2 < 32) LOADG(A, gg + 2)
            COMPG(B, gg + 1) if (gg + 3 < 32) LOADG(B, gg + 3)
        }
#undef LOADG
#undef COMPG
#undef RDG
        c0 = x0 * DN_ALPHA + c0; c1 = x1 * DN_ALPHA + c1; c2 = x2 * DN_ALPHA + c2; c3 = x3 * DN_ALPHA + c3;
        const float s = ((c0.x + c0.y) + (c0.z + c0.w)) + ((c1.x + c1.y) + (c1.z + c1.w)) + ((c2.x + c2.y) + (c2.z + c2.w)) + ((c3.x + c3.y) + (c3.z + c3.w));
        const float mean = wave_sum(s) * (1.f / 1024.f);
        c0 = c0 - mean; c1 = c1 - mean; c2 = c2 - mean; c3 = c3 - mean;
        const float s2 = ((c0.x * c0.x + c0.y * c0.y) + (c0.z * c0.z + c0.w * c0.w)) + ((c1.x * c1.x + c1.y * c1.y) + (c1.z * c1.z + c1.w * c1.w)) + ((c2.x * c2.x + c2.y * c2.y) + (c2.z * c2.z + c2.w * c2.w)) + ((c3.x * c3.x + c3.y * c3.y) + (c3.z * c3.z + c3.w * c3.w));
        const float rstd = 1.f / sqrtf(wave_sum(s2) * (1.f / 1024.f) + LN_EPS);
        const f32x4* g4 = (const f32x4*)g + 4 * lane; const f32x4* b4 = (const f32x4*)bb + 4 * lane;
        const f32x4 o0 = c0 * rstd * g4[0] + b4[0], o1 = c1 * rstd * g4[1] + b4[1], o2 = c2 * rstd * g4[2] + b4[2], o3 = c3 * rstd * g4[3] + b4[3];
        f32x4* orow = (f32x4*)(OUTP + (size_t)m * 1024) + 4 * lane;
        orow[0] = o0; orow[1] = o1; orow[2] = o2; orow[3] = o3;
        u32x4* ob = (u32x4*)(XBP + (size_t)m * 1024) + 2 * lane;
        u32x4 w0; w0.x = pk2(o0.x, o0.y); w0.y = pk2(o0.z, o0.w); w0.z = pk2(o1.x, o1.y); w0.w = pk2(o1.z, o1.w); ob[0] = w0;
        u32x4 w1; w1.x = pk2(o2.x, o2.y); w1.y = pk2(o2.z, o2.w); w1.z = pk2(o3.x, o3.y); w1.w = pk2(o3.z, o3.w); ob[1] = w1;
    }
}

#ifdef REP_GEMM
struct GemmOrder : pg8::StaticOrder {
    __device__ bool next(int i, pg8::Unit& u) const { const int R = (nwg - c + G - 1) / G; if (i >= 2 * R) return false; return pg8::StaticOrder::next(i >= R ? i - R : i, u); }
};
#else
typedef pg8::StaticOrder GemmOrder;
#endif

__device__ __forceinline__ float gelu_poly(float v) { const pg8::f32x2 r = pg8::gelu_pk((pg8::f32x2){v, v}); return r.x; }
constexpr int ECH = 128, NECH = MTOK / ECH, EPW = ECH / 8;
__device__ __forceinline__ int eq_take(unsigned* ctl, int qidx, int tid) { int z_ = 0; asm volatile("" : "+v"(z_)); return (tid == 0) ? (int)__hip_atomic_fetch_add(ctl + CW_Q + qidx * 64 + z_, 1u, __ATOMIC_RELAXED, __HIP_MEMORY_SCOPE_AGENT) : 0; }
__device__ __forceinline__ int eq_publish(LAS unsigned char* lds, int tk, int tid) {
    volatile LAS int* w = (volatile LAS int*)(lds + LDSCTL_OFF + 512);
    if (tid == 0) *w = tk;
    __syncthreads(); const int c = *w; __syncthreads(); return c;
}
__device__ __forceinline__ int eq_next(unsigned* ctl, LAS unsigned char* lds, int qidx, int tid) {
    volatile LAS int* tk = (volatile LAS int*)(lds + LDSCTL_OFF + 512);
    if (tid == 0) *tk = (int)__hip_atomic_fetch_add(ctl + CW_Q + qidx * 64, 1u, __ATOMIC_RELAXED, __HIP_MEMORY_SCOPE_AGENT);
    __syncthreads(); const int c = *tk; __syncthreads(); return c;
}
__device__ __forceinline__ void convert_experts_fp8_v2(const Args& a, int layer, int gw, int NGW, int lane) {
#define CVT_SRC(r_) ((const f32x4*)(((min((r_), 32767) >= 16384) ? a.in[24] : a.in[23]) + ((size_t)layer * 16384 + (min((r_), 32767) & 16383)) * 1024) + 4 * lane)
#pragma unroll 1
    for (int row0 = gw; row0 < 2 * 16384; row0 += 4 * NGW) {
        f32x4 V[4][4];
#pragma unroll
        for (int j = 0; j < 4; ++j) { const f32x4* s4 = CVT_SRC(row0 + j * NGW); V[j][0] = s4[0]; V[j][1] = s4[1]; V[j][2] = s4[2]; V[j][3] = s4[3]; }
#pragma unroll
        for (int j = 0; j < 4; ++j) { const int row = row0 + j * NGW; if (row < 2 * 16384) cvt_row_store(a, layer, row, lane, V[j][0], V[j][1], V[j][2], V[j][3]); }
    }
#undef CVT_SRC
}
__device__ __forceinline__ void ph_experts_h(const Args& a, int layer, LAS unsigned char* lds, int tid, int qoff) {
    typedef float f32x2v __attribute__((ext_vector_type(2)));
    const u32x4* U8 = (const u32x4*)(a.ws + WS_EXP + (size_t)layer * 48 * MiB); const f32x2v* SC2 = (const f32x2v*)(a.ws + WS_EXP + (size_t)layer * 48 * MiB + 32 * MiB);
    const unsigned short* RI = (const unsigned short*)(a.ws + WS_RIDX); const float* RG = (const float*)(a.ws + WS_RGATE); const bf16* XB = (const bf16*)(a.ws + WS_XB);
    float* HC = (float*)(a.ws + WS_HC); unsigned* ctl = (unsigned*)(a.ws + WS_CTL);
    const int lane = tid & 63, wave = __builtin_amdgcn_readfirstlane(tid >> 6); const int home = (int)(xb_xcc_id() & 7u);
    const bool b5 = (lane & 32) != 0, b4 = (lane & 16) != 0, b3 = (lane & 8) != 0; const int grp = lane >> 3;
    LAS u32x2* LIST = (LAS u32x2*)(lds + wave * 1024);
#pragma unroll 1
    for (int si = 0; si < 8; ++si) { const int x = (home + si) & 7;
#pragma unroll 1
        for (;;) { const int c = eq_next(ctl, lds, ((layer + qoff) * 2 + 0) * 8 + x, tid); if (c >= NECH) break;
            const size_t mb = (size_t)c * ECH + wave * EPW;
            int nid0 = RI[mb * 128 + lane], nid1 = RI[mb * 128 + 64 + lane]; float ng0 = RG[mb * 128 + lane], ng1 = RG[mb * 128 + 64 + lane];
            u32x4 nxa = ((const u32x4*)(XB + mb * 1024))[2 * lane], nxb = ((const u32x4*)(XB + mb * 1024))[2 * lane + 1];
#pragma unroll 1
            for (int i = 0; i < EPW; ++i) { const size_t m = mb + i;
                const int id0 = nid0, id1 = nid1; const float g0 = ng0, g1 = ng1; const u32x4 xa = nxa, xb = nxb;
                if (i + 1 < EPW) { nid0 = RI[(m + 1) * 128 + lane]; nid1 = RI[(m + 1) * 128 + 64 + lane]; ng0 = RG[(m + 1) * 128 + lane]; ng1 = RG[(m + 1) * 128 + 64 + lane];
                    nxa = ((const u32x4*)(XB + (m + 1) * 1024))[2 * lane]; nxb = ((const u32x4*)(XB + (m + 1) * 1024))[2 * lane + 1]; }
                const f32x4 x0 = {bflo(xa.x), bfhi(xa.x), bflo(xa.y), bfhi(xa.y)}, x1 = {bflo(xa.z), bfhi(xa.z), bflo(xa.w), bfhi(xa.w)}, x2 = {bflo(xb.x), bfhi(xb.x), bflo(xb.y), bfhi(xb.y)}, x3 = {bflo(xb.z), bfhi(xb.z), bflo(xb.w), bfhi(xb.w)};
                const bool ma = (id0 >> 11) == x, mbm = (id1 >> 11) == x;
                const unsigned long long bA = __ballot(ma), bB = __ballot(mbm);
                const int nA = __popcll(bA), n = nA + __popcll(bB);
                const int rA = __builtin_amdgcn_mbcnt_hi((unsigned)(bA >> 32), __builtin_amdgcn_mbcnt_lo((unsigned)bA, 0u)), rB = nA + __builtin_amdgcn_mbcnt_hi((unsigned)(bB >> 32), __builtin_amdgcn_mbcnt_lo((unsigned)bB, 0u));
                if (ma) LIST[rA] = (u32x2){(unsigned)id0 | ((unsigned)lane << 16), __float_as_uint(g0)};
                if (mbm) LIST[rB] = (u32x2){(unsigned)id1 | ((unsigned)(64 + lane) << 16), __float_as_uint(g1)};
                LDS_WAIT();
                if (n > 0) {
                    u32x4 Ar0, Ar1, Ar2, Ar3, Ar4, Ar5, Ar6, Ar7, Br0, Br1, Br2, Br3, Br4, Br5, Br6, Br7; u32x2 Ait, Bit; f32x2v Asc, Bsc; bool Aval, Bval;
#define H_ISSUE(X, base) { const int nm1 = n - 1; \
                    { const int q0 = min((base) + 0, nm1), q1 = min((base) + 1, nm1), q2 = min((base) + 2, nm1), q3 = min((base) + 3, nm1), q4 = min((base) + 4, nm1), q5 = min((base) + 5, nm1), q6 = min((base) + 6, nm1), q7 = min((base) + 7, nm1); \
                      const unsigned e0 = (unsigned)__builtin_amdgcn_readfirstlane((int)LIST[q0].x) & 0xffffu, e1 = (unsigned)__builtin_amdgcn_readfirstlane((int)LIST[q1].x) & 0xffffu, e2 = (unsigned)__builtin_amdgcn_readfirstlane((int)LIST[q2].x) & 0xffffu, e3 = (unsigned)__builtin_amdgcn_readfirstlane((int)LIST[q3].x) & 0xffffu; \
                      const unsigned e4 = (unsigned)__builtin_amdgcn_readfirstlane((int)LIST[q4].x) & 0xffffu, e5 = (unsigned)__builtin_amdgcn_readfirstlane((int)LIST[q5].x) & 0xffffu, e6 = (unsigned)__builtin_amdgcn_readfirstlane((int)LIST[q6].x) & 0xffffu, e7 = (unsigned)__builtin_amdgcn_readfirstlane((int)LIST[q7].x) & 0xffffu; \
                      X##r0 = U8[(size_t)e0 * 64 + lane]; X##r1 = U8[(size_t)e1 * 64 + lane]; X##r2 = U8[(size_t)e2 * 64 + lane]; X##r3 = U8[(size_t)e3 * 64 + lane]; \
                      X##r4 = U8[(size_t)e4 * 64 + lane]; X##r5 = U8[(size_t)e5 * 64 + lane]; X##r6 = U8[(size_t)e6 * 64 + lane]; X##r7 = U8[(size_t)e7 * 64 + lane]; } \
                    X##val = (base) + grp < n; X##it = LIST[min((base) + grp, nm1)]; X##sc = SC2[X##it.x & 0xffffu]; }
#define H_COMP(X) { const float d0 = dot16_fp8(x0, x1, x2, x3, X##r0), d1 = dot16_fp8(x0, x1, x2, x3, X##r1), d2 = dot16_fp8(x0, x1, x2, x3, X##r2), d3 = dot16_fp8(x0, x1, x2, x3, X##r3); \
                    const float d4 = dot16_fp8(x0, x1, x2, x3, X##r4), d5 = dot16_fp8(x0, x1, x2, x3, X##r5), d6 = dot16_fp8(x0, x1, x2, x3, X##r6), d7 = dot16_fp8(x0, x1, x2, x3, X##r7); \
                    const float k0 = hswap32_add(d0, d4), k1 = hswap32_add(d1, d5), k2 = hswap32_add(d2, d6), k3 = hswap32_add(d3, d7); \
                    const float j0 = hswap16_add(k0, k2), j1 = hswap16_add(k1, k3); \
                    float kk = b3 ? j1 : j0; kk += dpp_f<0x128>(b3 ? j0 : j1); \
                    kk = reduce8(kk); \
                    const float coef = __uint_as_float(X##it.y) * gelu_poly(kk * X##sc.x) * X##sc.y; \
                    if ((lane & 7) == 0 && X##val) HC[m * 128 + (X##it.x >> 16)] = coef; }
                    H_ISSUE(A, 0)
#pragma unroll 1
                    for (int base = 0; base < n; base += 16) {
                        if (base + 8 < n) H_ISSUE(B, base + 8)
                        H_COMP(A)
                        if (base + 8 >= n) break;
                        if (base + 16 < n) H_ISSUE(A, base + 16)
                        H_COMP(B)
                    }
#undef H_ISSUE
#undef H_COMP
                }
            }
        }
    }
}
typedef __bf16 bf16x2_t __attribute__((ext_vector_type(2)));
__device__ __forceinline__ unsigned cvtpk_bf16(float lo, float hi) { unsigned r; asm("v_cvt_pk_bf16_f32 %0, %1, %2" : "=v"(r) : "v"(lo), "v"(hi)); return r; }
__device__ __forceinline__ float dot2bf(unsigned a_, unsigned b_, float c) { return __builtin_amdgcn_fdot2_f32_bf16(__builtin_bit_cast(bf16x2_t, a_), __builtin_bit_cast(bf16x2_t, b_), c, false); }
__device__ __forceinline__ float dot16_fp8_bf16(const u32x4 xlo, const u32x4 xhi, const u32x4 w, float acc) {
    f32x2_ p; float a1 = 0.f;
    p = __builtin_amdgcn_cvt_pk_f32_fp8((int)w.x, false); acc = dot2bf(xlo.x, cvtpk_bf16(p.x, p.y), acc); p = __builtin_amdgcn_cvt_pk_f32_fp8((int)w.x, true); a1 = dot2bf(xlo.y, cvtpk_bf16(p.x, p.y), a1);
    p = __builtin_amdgcn_cvt_pk_f32_fp8((int)w.y, false); acc = dot2bf(xlo.z, cvtpk_bf16(p.x, p.y), acc); p = __builtin_amdgcn_cvt_pk_f32_fp8((int)w.y, true); a1 = dot2bf(xlo.w, cvtpk_bf16(p.x, p.y), a1);
    p = __builtin_amdgcn_cvt_pk_f32_fp8((int)w.z, false); acc = dot2bf(xhi.x, cvtpk_bf16(p.x, p.y), acc); p = __builtin_amdgcn_cvt_pk_f32_fp8((int)w.z, true); a1 = dot2bf(xhi.y, cvtpk_bf16(p.x, p.y), a1);
    p = __builtin_amdgcn_cvt_pk_f32_fp8((int)w.w, false); acc = dot2bf(xhi.z, cvtpk_bf16(p.x, p.y), acc); p = __builtin_amdgcn_cvt_pk_f32_fp8((int)w.w, true); a1 = dot2bf(xhi.w, cvtpk_bf16(p.x, p.y), a1);
    return acc + a1;
}
__device__ __forceinline__ void ph_experts_h2(const Args& a, int layer, LAS unsigned char* lds, int tid, int qoff) {
    typedef float f32x2v __attribute__((ext_vector_type(2)));
    const unsigned char* U8 = a.ws + WS_EXP + (size_t)layer * 48 * MiB; const f32x2v* SC2 = (const f32x2v*)(a.ws + WS_EXP + (size_t)layer * 48 * MiB + 32 * MiB);
    const unsigned short* RI = (const unsigned short*)(a.ws + WS_RIDX); const float* RG = (const float*)(a.ws + WS_RGATE); const bf16* XB = (const bf16*)(a.ws + WS_XB);
    float* HC = (float*)(a.ws + WS_HC); unsigned* ctl = (unsigned*)(a.ws + WS_CTL);
    const int lane = tid & 63, wave = __builtin_amdgcn_readfirstlane(tid >> 6); const int home = (int)(xb_xcc_id() & 7u);
    const int grp = lane >> 3, j = lane & 7;
    LAS u32x2* LIST = (LAS u32x2*)(lds + wave * 8192 + grp * 1024);
#pragma unroll 1
    for (int si = 0; si < 8; ++si) { const int x = (home + si) & 7;
#pragma unroll 1
        for (;;) { const int c = eq_next(ctl, lds, ((layer + qoff) * 2 + 0) * 8 + x, tid); if (c >= NECH) break;
#pragma unroll 1
            for (int rd = 0; rd < EPW / 8; ++rd) {
                const size_t m = (size_t)c * ECH + wave * EPW + rd * 8 + grp;
                const u32x4 iw0 = *(const u32x4*)(RI + m * 128 + 16 * j), iw1 = *(const u32x4*)(RI + m * 128 + 16 * j + 8);
                const f32x4 gq0 = *(const f32x4*)(RG + m * 128 + 16 * j), gq1 = *(const f32x4*)(RG + m * 128 + 16 * j + 4), gq2 = *(const f32x4*)(RG + m * 128 + 16 * j + 8), gq3 = *(const f32x4*)(RG + m * 128 + 16 * j + 12);
                u32x4 xl[8], xh[8];
#pragma unroll
                for (int i = 0; i < 8; ++i) { const u32x4* xp = (const u32x4*)(XB + m * 1024 + 128 * i + 16 * j); xl[i] = xp[0]; xh[i] = xp[1]; }
                const unsigned idw[8] = {iw0.x, iw0.y, iw0.z, iw0.w, iw1.x, iw1.y, iw1.z, iw1.w};
                const float gts[16] = {gq0.x, gq0.y, gq0.z, gq0.w, gq1.x, gq1.y, gq1.z, gq1.w, gq2.x, gq2.y, gq2.z, gq2.w, gq3.x, gq3.y, gq3.z, gq3.w};
                unsigned mm = 0u;
#pragma unroll
                for (int t = 0; t < 16; ++t) { const unsigned idt = (t & 1) ? (idw[t >> 1] >> 16) : (idw[t >> 1] & 0xffffu); if ((int)(idt >> 11) == x) mm |= 1u << t; }
                const int cnt = __popc(mm);
                int incl = cnt; { int v = dpp_i<0x111>(incl); incl += (j >= 1) ? v : 0; v = dpp_i<0x112>(incl); incl += (j >= 2) ? v : 0; v = dpp_i<0x114>(incl); incl += (j >= 4) ? v : 0; }
                int n = cnt; n += dpp_i<0xB1>(n); n += dpp_i<0x4E>(n); n += dpp_i<0x141>(n);
                int off = incl - cnt;
#pragma unroll
                for (int t = 0; t < 16; ++t) if ((mm >> t) & 1u) { const unsigned idt = (t & 1) ? (idw[t >> 1] >> 16) : (idw[t >> 1] & 0xffffu); LIST[off++] = (u32x2){idt | ((unsigned)(16 * j + t) << 16), __float_as_uint(gts[t])}; }
                LDS_WAIT();
                int maxn = 0;
#pragma unroll
                for (int g8 = 0; g8 < 8; ++g8) maxn = max(maxn, __builtin_amdgcn_readlane(n, 8 * g8));
                u32x4 RA[8], RB[8]; u32x2 Ait = {0u, 0u}, Bit = {0u, 0u}; f32x2v Asc = {0.f, 0.f}, Bsc = {0.f, 0.f};
#define H2_ISSUE(R, IT, SC, s) { IT = LIST[min((s), max(n - 1, 0))]; const unsigned e_ = IT.x & 0x3fffu; const unsigned char* rb = U8 + ((size_t)(e_ >> 11) * 16384 + (e_ & 2047u)) * 128 + 16 * j; \
                    _Pragma("unroll") for (int i = 0; i < 8; ++i) R[i] = *(const u32x4*)(rb + (size_t)i * 2048 * 128); SC = SC2[e_]; }
#define H2_COMP(R, IT, SC, s) { float ac[8]; _Pragma("unroll") for (int i = 0; i < 8; ++i) ac[i] = dot16_fp8_bf16(xl[i], xh[i], R[i], 0.f); float acc = ((ac[0] + ac[1]) + (ac[2] + ac[3])) + ((ac[4] + ac[5]) + (ac[6] + ac[7])); \
                    acc = reduce8(acc); const float coef = __uint_as_float(IT.y) * gelu_poly(acc * SC.x) * SC.y; \
                    if (j == 0 && (s) < n) HC[m * 128 + (IT.x >> 16)] = coef; }
                if (maxn > 0) {
                    H2_ISSUE(RA, Ait, Asc, 0)
#pragma unroll 1
                    for (int s = 0; s < maxn; s += 2) {
                        H2_ISSUE(RB, Bit, Bsc, s + 1)
                        H2_COMP(RA, Ait, Asc, s)
                        H2_ISSUE(RA, Ait, Asc, s + 2)
                        H2_COMP(RB, Bit, Bsc, s + 1)
                    }
                }
#undef H2_ISSUE
#undef H2_COMP
            }
        }
    }
}

constexpr size_t WS_PART = WS_P;
__device__ __forceinline__ void ph_experts_hk(const Args& a, int layer, LAS unsigned char* lds, int tid, int qoff) {
    const unsigned char* US8 = a.ws + WS_EXP + (size_t)layer * 48 * MiB; const unsigned short* RI = (const unsigned short*)(a.ws + WS_RIDX); const bf16* XB = (const bf16*)(a.ws + WS_XB);
    float* PART = (float*)(a.ws + WS_PART); unsigned* ctl = (unsigned*)(a.ws + WS_CTL);
    const int lane = tid & 63, wave = __builtin_amdgcn_readfirstlane(tid >> 6); const int home = (int)(xb_xcc_id() & 7u);
    const int es = lane >> 3, cp = lane & 7; const bool c2 = (lane & 4) != 0, c1 = (lane & 2) != 0, c0 = (lane & 1) != 0;
#define K_LOAD(X, idw) { X##0 = *(const u32x4*)(ub + (size_t)((idw).x & 0xffffu) * 128); X##1 = *(const u32x4*)(ub + (size_t)((idw).x >> 16) * 128); X##2 = *(const u32x4*)(ub + (size_t)((idw).y & 0xffffu) * 128); X##3 = *(const u32x4*)(ub + (size_t)((idw).y >> 16) * 128); \
        X##4 = *(const u32x4*)(ub + (size_t)((idw).z & 0xffffu) * 128); X##5 = *(const u32x4*)(ub + (size_t)((idw).z >> 16) * 128); X##6 = *(const u32x4*)(ub + (size_t)((idw).w & 0xffffu) * 128); X##7 = *(const u32x4*)(ub + (size_t)((idw).w >> 16) * 128); }
#define K_COMP(X, P, o) { P[(o) + 0] = dot16_fp8(x0, x1, x2, x3, X##0); P[(o) + 1] = dot16_fp8(x0, x1, x2, x3, X##1); P[(o) + 2] = dot16_fp8(x0, x1, x2, x3, X##2); P[(o) + 3] = dot16_fp8(x0, x1, x2, x3, X##3); \
        P[(o) + 4] = dot16_fp8(x0, x1, x2, x3, X##4); P[(o) + 5] = dot16_fp8(x0, x1, x2, x3, X##5); P[(o) + 6] = dot16_fp8(x0, x1, x2, x3, X##6); P[(o) + 7] = dot16_fp8(x0, x1, x2, x3, X##7); }
#pragma unroll 1
    for (int si = 0; si < 8; ++si) { const int x = (home + si) & 7;
        if (si == 1) {
            volatile LAS unsigned* qh = (volatile LAS unsigned*)(lds + LDSCTL_OFF + 576);
            if (tid < 8) qh[tid] = __hip_atomic_load(ctl + CW_Q + (((layer + qoff) * 2 + 0) * 8 + tid) * 64, __ATOMIC_RELAXED, __HIP_MEMORY_SCOPE_AGENT);
            __syncthreads(); }
        if (si >= 1 && ((volatile LAS unsigned*)(lds + LDSCTL_OFF + 576))[x] >= (unsigned)NECH) continue; const unsigned char* ub = US8 + (size_t)x * 16384 * 128 + cp * 16;
        int c = eq_publish(lds, eq_take(ctl, ((layer + qoff) * 2 + 0) * 8 + x, tid), tid);
        if (c >= NECH) continue;
        int cn = eq_publish(lds, eq_take(ctl, ((layer + qoff) * 2 + 0) * 8 + x, tid), tid);
        u32x4 RA0, RA1, RA2, RA3, RA4, RA5, RA6, RA7, RB0, RB1, RB2, RB3, RB4, RB5, RB6, RB7;
        u32x4 id0, id1, xa, xb;
        { const size_t mb0 = (size_t)c * ECH + wave * EPW; id0 = *(const u32x4*)(RI + mb0 * 128 + es * 16); id1 = *(const u32x4*)(RI + mb0 * 128 + es * 16 + 8);
          xa = *(const u32x4*)(XB + mb0 * 1024 + 128 * x + 16 * cp); xb = *(const u32x4*)(XB + mb0 * 1024 + 128 * x + 16 * cp + 8); }
        K_LOAD(RA, id0)
#pragma unroll 1
        for (;;) { const int tkn = eq_take(ctl, ((layer + qoff) * 2 + 0) * 8 + x, tid);
            const size_t mb = (size_t)c * ECH + wave * EPW; const size_t mnext = (cn < NECH) ? (size_t)cn * ECH + wave * EPW : mb + EPW - 1;
#pragma unroll 1
            for (int i = 0; i < EPW; ++i) { const size_t m = mb + i; const size_t mn = (i + 1 < EPW) ? mb + i + 1 : mnext;
                const u32x4 nid0 = *(const u32x4*)(RI + mn * 128 + es * 16), nid1 = *(const u32x4*)(RI + mn * 128 + es * 16 + 8);
                const u32x4 nxa = *(const u32x4*)(XB + mn * 1024 + 128 * x + 16 * cp), nxb = *(const u32x4*)(XB + mn * 1024 + 128 * x + 16 * cp + 8);
                const f32x4 x0 = {bflo(xa.x), bfhi(xa.x), bflo(xa.y), bfhi(xa.y)}, x1 = {bflo(xa.z), bfhi(xa.z), bflo(xa.w), bfhi(xa.w)}, x2 = {bflo(xb.x), bfhi(xb.x), bflo(xb.y), bfhi(xb.y)}, x3 = {bflo(xb.z), bfhi(xb.z), bflo(xb.w), bfhi(xb.w)};
                float p[16];
                K_LOAD(RB, id1)
                K_COMP(RA, p, 0)
                K_LOAD(RA, nid0)
                K_COMP(RB, p, 8)
                id0 = nid0; id1 = nid1; xa = nxa; xb = nxb;
                float q8[8];
#pragma unroll
                for (int u = 0; u < 8; ++u) { const float keep = c2 ? p[8 + u] : p[u], send = c2 ? p[u] : p[8 + u]; q8[u] = keep + dpp_f<0x141>(send); }
                float q4[4];
#pragma unroll
                for (int u = 0; u < 4; ++u) { const float keep = c1 ? q8[4 + u] : q8[u], send = c1 ? q8[u] : q8[4 + u]; q4[u] = keep + dpp_f<0x4E>(send); }
                f32x2_ q2;
                { const float k0 = c0 ? q4[2] : q4[0], s0 = c0 ? q4[0] : q4[2], k1 = c0 ? q4[3] : q4[1], s1 = c0 ? q4[1] : q4[3]; q2.x = k0 + dpp_f<0xB1>(s0); q2.y = k1 + dpp_f<0xB1>(s1); }
                ((unsigned*)PART)[((size_t)x * MTOK + m) * 64 + es * 8 + cp] = pk2(q2.x, q2.y);
            }
            c = cn; if (c >= NECH) break;
            cn = eq_publish(lds, tkn, tid);
        }
    }
#undef K_LOAD
#undef K_COMP
}
__device__ __forceinline__ void ph_experts_c(const Args& a, int layer, int gtid, int NT) {
    typedef float f32x2v __attribute__((ext_vector_type(2)));
    const float* PART = (const float*)(a.ws + WS_PART); const f32x2v* SC2 = (const f32x2v*)(a.ws + WS_EXP + (size_t)layer * 48 * MiB + 32 * MiB);
    const unsigned* RI2 = (const unsigned*)(a.ws + WS_RIDX); const f32x2v* RG2 = (const f32x2v*)(a.ws + WS_RGATE); f32x2v* HC2 = (f32x2v*)(a.ws + WS_HC);
#pragma unroll 1
    for (int it = gtid; it < MTOK * 64; it += NT) {
        const unsigned* pp = (const unsigned*)PART + (size_t)it; const size_t xs = (size_t)MTOK * 64;
        unsigned p0 = pp[0], p1 = pp[xs], p2 = pp[2 * xs], p3 = pp[3 * xs], p4 = pp[4 * xs], p5 = pp[5 * xs], p6 = pp[6 * xs], p7 = pp[7 * xs];
        const unsigned ids = RI2[it]; f32x2v g = RG2[it];
        asm volatile("" : "+v"(p0), "+v"(p1), "+v"(p2), "+v"(p3), "+v"(p4), "+v"(p5), "+v"(p6), "+v"(p7), "+v"(g));
        const f32x2v sa = SC2[ids & 0xffffu], sb = SC2[ids >> 16];
        f32x2v s; s.x = ((bflo(p0) + bflo(p1)) + (bflo(p2) + bflo(p3))) + ((bflo(p4) + bflo(p5)) + (bflo(p6) + bflo(p7))); s.y = ((bfhi(p0) + bfhi(p1)) + (bfhi(p2) + bfhi(p3))) + ((bfhi(p4) + bfhi(p5)) + (bfhi(p6) + bfhi(p7)));
        f32x2v o; o.x = g.x * gelu_poly(s.x * sa.x) * sa.y; o.y = g.y * gelu_poly(s.y * sb.x) * sb.y;
        HC2[it] = o;
    }
}

__device__ __forceinline__ void ph_experts_v(const Args& a, int layer, LAS unsigned char* lds, int tid, int qoff) {
    const unsigned char* VS8 = a.ws + WS_EXP + (size_t)layer * 48 * MiB + 16 * MiB; const unsigned short* RI = (const unsigned short*)(a.ws + WS_RIDX); const float* HC = (const float*)(a.ws + WS_HC);
    float* FFN = (float*)(a.ws + WS_FFN); unsigned* ctl = (unsigned*)(a.ws + WS_CTL);
    const int lane = tid & 63, wave = __builtin_amdgcn_readfirstlane(tid >> 6); const int home = (int)(xb_xcc_id() & 7u);
    const int es = lane >> 3, cp = lane & 7; const bool b5 = (lane & 32) != 0, b4 = (lane & 16) != 0, b3 = (lane & 8) != 0;
#define V_LOAD(X, idw, hcp) { X##0 = *(const u32x4*)(vb + (size_t)((idw).x & 0xffffu) * 128); X##1 = *(const u32x4*)(vb + (size_t)((idw).x >> 16) * 128); X##2 = *(const u32x4*)(vb + (size_t)((idw).y & 0xffffu) * 128); X##3 = *(const u32x4*)(vb + (size_t)((idw).y >> 16) * 128); \
        X##4 = *(const u32x4*)(vb + (size_t)((idw).z & 0xffffu) * 128); X##5 = *(const u32x4*)(vb + (size_t)((idw).z >> 16) * 128); X##6 = *(const u32x4*)(vb + (size_t)((idw).w & 0xffffu) * 128); X##7 = *(const u32x4*)(vb + (size_t)((idw).w >> 16) * 128); \
        X##c0 = *(const f32x4*)(hcp); X##c1 = *(const f32x4*)((hcp) + 4); }
#define V_COMP(X) { axpy16_fp8(a0, a1, a2, a3, X##c0.x, X##0); axpy16_fp8(a0, a1, a2, a3, X##c0.y, X##1); axpy16_fp8(a0, a1, a2, a3, X##c0.z, X##2); axpy16_fp8(a0, a1, a2, a3, X##c0.w, X##3); \
        axpy16_fp8(a0, a1, a2, a3, X##c1.x, X##4); axpy16_fp8(a0, a1, a2, a3, X##c1.y, X##5); axpy16_fp8(a0, a1, a2, a3, X##c1.z, X##6); axpy16_fp8(a0, a1, a2, a3, X##c1.w, X##7); }
#pragma unroll 1
    for (int si = 0; si < 8; ++si) { const int x = (home + si) & 7;
        if (si == 1) {
            volatile LAS unsigned* qh = (volatile LAS unsigned*)(lds + LDSCTL_OFF + 576);
            if (tid < 8) qh[tid] = __hip_atomic_load(ctl + CW_Q + (((layer + qoff) * 2 + 1) * 8 + tid) * 64, __ATOMIC_RELAXED, __HIP_MEMORY_SCOPE_AGENT);
            __syncthreads(); }
        if (si >= 1 && ((volatile LAS unsigned*)(lds + LDSCTL_OFF + 576))[x] >= (unsigned)NECH) continue; const unsigned char* vb = VS8 + (size_t)x * 16384 * 128 + cp * 16;
        int c = eq_publish(lds, eq_take(ctl, ((layer + qoff) * 2 + 1) * 8 + x, tid), tid);
        if (c >= NECH) continue;
        int cn = eq_publish(lds, eq_take(ctl, ((layer + qoff) * 2 + 1) * 8 + x, tid), tid);
        u32x4 RA0, RA1, RA2, RA3, RA4, RA5, RA6, RA7, RB0, RB1, RB2, RB3, RB4, RB5, RB6, RB7; f32x4 RAc0, RAc1, RBc0, RBc1;
        u32x4 id0, id1;
        { const size_t mb0 = (size_t)c * ECH + wave * EPW; id0 = *(const u32x4*)(RI + mb0 * 128 + es * 16); id1 = *(const u32x4*)(RI + mb0 * 128 + es * 16 + 8);
          V_LOAD(RA, id0, HC + mb0 * 128 + es * 16) }
#pragma unroll 1
        for (;;) { const int tkn = eq_take(ctl, ((layer + qoff) * 2 + 1) * 8 + x, tid);
            const size_t mb = (size_t)c * ECH + wave * EPW; const size_t mnext = (cn < NECH) ? (size_t)cn * ECH + wave * EPW : mb + EPW - 1;
#pragma unroll 1
            for (int i = 0; i < EPW; ++i) { const size_t m = mb + i;
                const size_t mn = (i + 1 < EPW) ? mb + i + 1 : mnext;
                const u32x4 nid0 = *(const u32x4*)(RI + mn * 128 + es * 16), nid1 = *(const u32x4*)(RI + mn * 128 + es * 16 + 8);
                f32x4 a0 = {0.f, 0.f, 0.f, 0.f}, a1 = a0, a2 = a0, a3 = a0;
                V_LOAD(RB, id1, HC + m * 128 + es * 16 + 8)
                V_COMP(RA)
                V_LOAD(RA, nid0, HC + mn * 128 + es * 16)
                V_COMP(RB)
                id0 = nid0; id1 = nid1;
                f32x4 k0, k1;
#pragma unroll
                for (int u = 0; u < 4; ++u) { k0[u] = hswap32_add(a0[u], a2[u]); k1[u] = hswap32_add(a1[u], a3[u]); }
                f32x4 k2;
#pragma unroll
                for (int u = 0; u < 4; ++u) k2[u] = hswap16_add(k0[u], k1[u]);
                f32x2_ k3 = b3 ? (f32x2_){k2.z, k2.w} : (f32x2_){k2.x, k2.y}; const f32x2_ s3 = b3 ? (f32x2_){k2.x, k2.y} : (f32x2_){k2.z, k2.w};
                k3.x += dpp_f<0x128>(s3.x); k3.y += dpp_f<0x128>(s3.y);
                const int col = cp * 16 + (b5 ? 8 : 0) + (b4 ? 4 : 0) + (b3 ? 2 : 0);
                ((unsigned*)FFN)[(m * 1024 + x * 128 + col) >> 1] = pk2(k3.x, k3.y);
            }
            c = cn; if (c >= NECH) break;
            cn = eq_publish(lds, tkn, tid);
        }
    }
#undef V_LOAD
#undef V_COMP
}

__device__ __forceinline__ float wave_sum_fast(float v) { const float r = reduce16(v); const float t = hswap16_add(r, r); return hswap32_add(t, t); }
template <bool IS_LN2> __device__ __forceinline__ void ph_ln(const Args& a, int layer, int gw, int NGW, int lane, bf16* XBO) {
    const float* g = a.in[IS_LN2 ? 25 : 19] + layer * 1024; const float* bb = a.in[IS_LN2 ? 26 : 20] + layer * 1024; const bf16* XB = (const bf16*)(a.ws + WS_XB);
    const bf16* mix = (const bf16*)(a.ws + WS_MIX); const float* ffn = (const float*)(a.ws + WS_FFN);
    const bool last = IS_LN2 && layer == DEPTH - 1;
    f32x4 gv[4], bv[4];
#pragma unroll
    for (int j = 0; j < 4; ++j) { gv[j] = ((const f32x4*)g)[lane + 64 * j]; bv[j] = ((const f32x4*)bb)[lane + 64 * j]; }
    for (int m0 = gw * 4; m0 < MTOK; m0 += NGW * 4) {
        f32x4 v[4][4];
        u32x2 xw[4][4]; u32x2 mw[4][4];
#pragma unroll
        for (int t = 0; t < 4; ++t) { const size_t m = (size_t)(m0 + t);
#pragma unroll
            for (int j = 0; j < 4; ++j) { xw[t][j] = ((const u32x2*)(XB + m * 1024) + lane)[64 * j];
                mw[t][j] = ((const u32x2*)((IS_LN2 ? (const bf16*)ffn : mix) + m * 1024) + lane)[64 * j]; } }
#pragma unroll
        for (int t = 0; t < 4; ++t) {
            asm volatile("" : "+v"(xw[t][0]), "+v"(xw[t][1]), "+v"(xw[t][2]), "+v"(xw[t][3]));
            asm volatile("" : "+v"(mw[t][0]), "+v"(mw[t][1]), "+v"(mw[t][2]), "+v"(mw[t][3])); }
#pragma unroll
        for (int t = 0; t < 4; ++t)
#pragma unroll
            for (int j = 0; j < 4; ++j) { const f32x4 xv = (f32x4){bflo(xw[t][j].x), bfhi(xw[t][j].x), bflo(xw[t][j].y), bfhi(xw[t][j].y)} * DN_ALPHA;
                v[t][j] = xv + (f32x4){bflo(mw[t][j].x), bfhi(mw[t][j].x), bflo(mw[t][j].y), bfhi(mw[t][j].y)}; }
#pragma unroll
        for (int t = 0; t < 4; ++t) { const size_t m = (size_t)(m0 + t); float s = 0.f;
#pragma unroll
            for (int j = 0; j < 4; ++j) s += (v[t][j].x + v[t][j].y) + (v[t][j].z + v[t][j].w);
            const float mean = wave_sum_fast(s) * (1.f / 1024.f); float s2 = 0.f;
#pragma unroll
            for (int j = 0; j < 4; ++j) { v[t][j] = v[t][j] - mean; s2 += (v[t][j].x * v[t][j].x + v[t][j].y * v[t][j].y) + (v[t][j].z * v[t][j].z + v[t][j].w * v[t][j].w); }
            const float rstd = 1.f / sqrtf(wave_sum_fast(s2) * (1.f / 1024.f) + LN_EPS);
            f32x4* orow = (f32x4*)(a.out + m * 1024) + lane; u32x2* ob = (u32x2*)(XBO + m * 1024) + lane;
#pragma unroll
            for (int j = 0; j < 4; ++j) { const f32x4 o = v[t][j] * rstd * gv[j] + bv[j]; if (last) orow[64 * j] = o; else { u32x2 w; w.x = pk2(o.x, o.y); w.y = pk2(o.z, o.w); ob[64 * j] = w; } } }
    }
}

#ifdef DBG_CHECK
__device__ __forceinline__ void dbg_check_hv(const Args& a, int layer, int gw, int NGW, int lane) {
    const u32x4* U8 = (const u32x4*)(a.ws + WS_EXP + (size_t)layer * 48 * MiB); const unsigned char* VS8 = a.ws + WS_EXP + (size_t)layer * 48 * MiB + 16 * MiB;
    const float* SC = (const float*)(a.ws + WS_EXP + (size_t)layer * 48 * MiB + 32 * MiB);
    const unsigned short* RI = (const unsigned short*)(a.ws + WS_RIDX); const float* RG = (const float*)(a.ws + WS_RGATE);
    const float* HC = (const float*)(a.ws + WS_HC); const float* FFN = (const float*)(a.ws + WS_FFN); unsigned* ctl = (unsigned*)(a.ws + WS_CTL);
    unsigned badH = 0, badV = 0;
    for (int m = gw; m < MTOK; m += NGW * 16) {
        const f32x4* xr = (const f32x4*)(a.out + (size_t)m * 1024) + 4 * lane; const f32x4 x0 = xr[0], x1 = xr[1], x2 = xr[2], x3 = xr[3];
        f32x4 c0 = {0.f, 0.f, 0.f, 0.f}, c1 = c0, c2 = c0, c3 = c0;
        for (int k = 0; k < 128; ++k) { const int e = RI[(size_t)m * 128 + k]; const float gate = RG[(size_t)m * 128 + k];
            float d = dot16_fp8(x0, x1, x2, x3, U8[(size_t)e * 64 + lane]); d = wave_sum(d) * SC[2 * e];
            const float coef = gate * gelu_exact(d) * SC[2 * e + 1]; const float got = HC[(size_t)m * 128 + k];
            if (!(fabsf(got - coef) <= 1e-5f + 2e-3f * fabsf(coef))) badH++;
            const u32x4 vr = *(const u32x4*)(VS8 + ((size_t)(lane >> 3) * 16384 + e) * 128 + (lane & 7) * 16);
            axpy16_fp8(c0, c1, c2, c3, coef, vr); }
        const f32x4* fr = (const f32x4*)(FFN + (size_t)m * 1024) + 4 * lane; const f32x4 f0 = fr[0], f1 = fr[1], f2 = fr[2], f3 = fr[3];
        const float cf[16] = {c0.x, c0.y, c0.z, c0.w, c1.x, c1.y, c1.z, c1.w, c2.x, c2.y, c2.z, c2.w, c3.x, c3.y, c3.z, c3.w};
        const float ff[16] = {f0.x, f0.y, f0.z, f0.w, f1.x, f1.y, f1.z, f1.w, f2.x, f2.y, f2.z, f2.w, f3.x, f3.y, f3.z, f3.w};
#pragma unroll
        for (int u = 0; u < 16; ++u) if (!(fabsf(ff[u] - cf[u]) <= 1e-4f + 5e-3f * fabsf(cf[u]))) badV++;
    }
    if (lane == 0 && badH) atomicAdd(ctl + 16384, badH);
    if (badV) atomicAdd(ctl + 16448, badV);
}
#endif

constexpr int NPHASE = 1 + 12 * DEPTH;
__global__ void __launch_bounds__(512, 2) mk_fwd(Args args) {
    extern __shared__ __attribute__((aligned(16))) unsigned char lds_raw[];
    LAS unsigned char* lds = (LAS unsigned char*)lds_raw;
    const int tid = threadIdx.x;
    const int G = gridDim.x, bid = blockIdx.x, NGW = G * 8;
    unsigned char* ws = args.ws;
    for (int u = tid; u < (LDS_BYTES - LDSCTL_OFF) / 4; u += 512) ((LAS unsigned*)(lds + LDSCTL_OFF))[u] = 0u;
    __syncthreads();
    const int lo = args.ph_lo, hi = args.ph_hi;
    XcdBarrier bar; bar.bar = (unsigned*)(ws + WS_CTL) + CW_BAR; bar.x = 0; bar.st = nullptr;
    if (hi - lo > 1) bar = xcd_barrier_post((unsigned*)(ws + WS_CTL) + CW_BAR, (volatile LAS unsigned*)(lds + LDSCTL_OFF + 64));
#define IN(k) (lo <= (k) && (k) < hi)
#ifdef DBG_TIME
    volatile LAS unsigned* tacc = (volatile LAS unsigned*)(lds + LDSCTL_OFF + 256);
    unsigned long long tlast = wall_clock64();
#define TSTAMP(kind) do { if (bid == 0 && tid == 0) { const unsigned long long tn = wall_clock64(); tacc[kind] += (unsigned)(tn - tlast); tlast = tn; } } while (0)
#else
#define TSTAMP(kind) do { } while (0)
#endif
#define SEAM(k) do { if ((k) + 1 < hi) xcd_barrier(bar); } while (0)
#ifndef SKIP_PRO
    if (IN(0)) { int lt = tid; asm volatile("" : "+v"(lt)); ph_prologue(args, lds, bid * 8 + __builtin_amdgcn_readfirstlane(lt >> 6), NGW, __builtin_amdgcn_readfirstlane(lt >> 6), lt & 63); SEAM(0); TSTAMP(0); }
#endif
    for (int gi = 0; gi < 3 * DEPTH; ++gi) {
        const int layer = gi / 3, kind = gi - 3 * layer, pb = 1 + 12 * layer, i2 = layer >> 1; const bool odd = (layer & 1) != 0;
        const int pg = pb + (kind == 0 ? 0 : (kind == 1 ? 4 : 6));
        if (IN(pg)) {
            int lt = tid; asm volatile("" : "+v"(lt));
            int N = 1024; const bf16* A = (const bf16*)(ws + WS_XB); const bf16* W; bf16* O;
            if (kind == 0) { N = odd ? ODD_PAD : EVEN_PAD; W = odd ? (const bf16*)(ws + WS_WINO) + (size_t)i2 * ODD_PAD * 1024 : (const bf16*)(ws + WS_WINE) + (size_t)i2 * EVEN_PAD * 1024; O = (bf16*)(ws + WS_P); }
            else if (kind == 1) { A = (const bf16*)(ws + WS_CAT); W = (odd ? (const bf16*)(ws + WS_WOUTO) : (const bf16*)(ws + WS_WOUTE)) + (size_t)i2 * 1048576; O = (bf16*)(ws + WS_MIX); }
            else { W = (const bf16*)(ws + WS_WQ) + (size_t)layer * 1048576; O = (bf16*)(ws + WS_QP); }
            pg8::Gemm g{(const pg8::bf16_t*)A, (const pg8::bf16_t*)W, MTOK, N, 1024}; GemmOrder S; S.init(MTOK, N, G, bid);
            pg8::EpiBf16<0> E{(pg8::bf16_t*)O, N, nullptr, 0, 0, 1.f};
            pg8::gemm_phase<pg8::EpiBf16<0>, GemmOrder, true, true>(lds, g, S, E, lt);
            SEAM(pg); TSTAMP(kind == 0 ? 1 : (kind == 1 ? 6 : 8));
        }
        if (kind == 0) {
            if (!odd) {
                if (IN(pb + 1)) {
                    int lt = tid; asm volatile("" : "+v"(lt));
#ifdef REP_SCAN
                    for (int rep = 0; rep < 2; ++rep)
#endif
                    for (int it = bid; it < 384; it += G) {
                        if (it < 256) { int l4 = lt; asm volatile("" : "+v"(l4)); rwkv_unit3(args, (LAS float*)lds, it, i2, (const bf16*)(ws + WS_P), (bf16*)(ws + WS_CAT), l4); }
                        if (it >= 256) { int l5 = lt; asm volatile("" : "+v"(l5)); gla_unit2(args, lds, it - 256, i2, (const bf16*)(ws + WS_P), (bf16*)(ws + WS_CAT), l5, 0, 32, 0); }
                    }
                    if (bid >= 128 || G < 256) {
                        int l3 = lt; asm volatile("" : "+v"(l3));
                        const int cb = (G < 256) ? bid : bid - 128, cn = (G < 256) ? G : G - 128;
                        convert_experts_fp8_v2(args, layer, cb * 8 + __builtin_amdgcn_readfirstlane(l3 >> 6), cn * 8, l3 & 63);
                        convert_experts_fp8_v2(args, layer + 1, cb * 8 + __builtin_amdgcn_readfirstlane(l3 >> 6), cn * 8, l3 & 63);
                    }
                    SEAM(pb + 1); TSTAMP(2);
                }
            } else {
#ifndef SKIP_ROPE
                if (IN(pb + 1)) { int lt = tid; asm volatile("" : "+v"(lt)); ph_rope(args, lds, bid, G, lt, bid * 512 + lt, NGW * 64); SEAM(pb + 1); TSTAMP(3); }
#endif
#ifndef SKIP_IDX
                if (IN(pb + 2)) { int lt = tid; asm volatile("" : "+v"(lt)); ph_indexer3(args, lds, bid, G, lt);
#ifdef REP_IDX
                { int l2 = lt; asm volatile("" : "+v"(l2)); ph_indexer3(args, lds, bid, G, l2); }
#endif
                SEAM(pb + 2); TSTAMP(4); }
#endif
#ifndef SKIP_ATT
                if (IN(pb + 3)) { int lt = tid; asm volatile("" : "+v"(lt)); ph_attention4(args, lds, bid, G, lt);
#ifdef REP_ATT
                { int l2 = lt; asm volatile("" : "+v"(l2)); ph_attention2(args, bid, G, __builtin_amdgcn_readfirstlane(l2 >> 6), l2 & 63); }
#endif
                SEAM(pb + 3); TSTAMP(5); }
#endif
            }
        } else if (kind == 1) {
#ifndef SKIP_LN1
            if (IN(pb + 5)) { int lt = tid; asm volatile("" : "+v"(lt));
#ifdef REP_EW
                ph_ln<false>(args, layer, bid * 8 + __builtin_amdgcn_readfirstlane(lt >> 6), NGW, lt & 63, (bf16*)(ws + WS_CAT)); { int l2 = lt; asm volatile("" : "+v"(l2)); lt = l2; }
#endif
                ph_ln<false>(args, layer, bid * 8 + __builtin_amdgcn_readfirstlane(lt >> 6), NGW, lt & 63, (bf16*)(ws + WS_XB)); SEAM(pb + 5); TSTAMP(7); }
#endif
        } else {
#ifndef SKIP_ROUTE
            if (IN(pb + 7)) { int lt = tid; asm volatile("" : "+v"(lt)); ph_route2(args, layer, lds, bid, G, __builtin_amdgcn_readfirstlane(lt >> 6), lt & 63);
#ifdef REP_ROUTE
                { int l2 = lt; asm volatile("" : "+v"(l2)); ph_route2(args, layer, lds, bid, G, __builtin_amdgcn_readfirstlane(l2 >> 6), l2 & 63); }
#endif
                SEAM(pb + 7); TSTAMP(9); }
#endif
#ifndef SKIP_EXP
            if (IN(pb + 8)) { int lt = tid; asm volatile("" : "+v"(lt)); ph_experts_hk(args, layer, lds, lt, 0);
#ifdef REP_H
                { xcd_barrier(bar); int l2 = lt; asm volatile("" : "+v"(l2)); ph_experts_hk(args, layer, lds, l2, 4); }
#endif
                SEAM(pb + 8); TSTAMP(10); }
            if (IN(pb + 9)) { int lt = tid; asm volatile("" : "+v"(lt)); ph_experts_c(args, layer, bid * 512 + lt, NGW * 64);
#ifdef REP_EW
                { int l2 = lt; asm volatile("" : "+v"(l2)); ph_experts_c(args, layer, bid * 512 + l2, NGW * 64); }
#endif
                SEAM(pb + 9); TSTAMP(10); }
            if (IN(pb + 10)) { int lt = tid; asm volatile("" : "+v"(lt)); ph_experts_v(args, layer, lds, lt, 0); SEAM(pb + 10); TSTAMP(10); }
            if (IN(pb + 11)) { int lt = tid; asm volatile("" : "+v"(lt));
#ifdef REP_EW
                if (layer < DEPTH - 1) { ph_ln<true>(args, layer, bid * 8 + __builtin_amdgcn_readfirstlane(lt >> 6), NGW, lt & 63, (bf16*)(ws + WS_CAT)); int l2 = lt; asm volatile("" : "+v"(l2)); lt = l2; }
#endif
                ph_ln<true>(args, layer, bid * 8 + __builtin_amdgcn_readfirstlane(lt >> 6), NGW, lt & 63, (bf16*)(ws + WS_XB)); SEAM(pb + 11); TSTAMP(10); }
#endif
        }
    }
#ifdef DBG_CHECK
    {   xcd_barrier(bar);
        unsigned* ctl = (unsigned*)(ws + WS_CTL);
        const unsigned nh = __hip_atomic_load(ctl + 16384, __ATOMIC_RELAXED, __HIP_MEMORY_SCOPE_AGENT), nv = __hip_atomic_load(ctl + 16448, __ATOMIC_RELAXED, __HIP_MEMORY_SCOPE_AGENT);
        if (bid == 0 && tid == 0 && (nh | nv)) { args.out[0] = (nh ? 1000.f + (float)nh : 0.f); }
    }
#endif
#ifdef DBG_TIME
    {
        xcd_barrier(bar);
        float* tw = (float*)(ws + WS_CTL + 768 * 1024);
        if (bid == 0 && tid == 0) { unsigned ta = 0, tb = 0;
            for (int k = 0; k < 16; ++k) { if ((DBG_TIME_A >> k) & 1) ta += tacc[k]; if ((DBG_TIME_B >> k) & 1) tb += tacc[k]; }
            __hip_atomic_store(tw, (float)ta * 0.01f, __ATOMIC_RELAXED, __HIP_MEMORY_SCOPE_AGENT); __hip_atomic_store(tw + 1, (float)tb * 0.01f, __ATOMIC_RELAXED, __HIP_MEMORY_SCOPE_AGENT); }
        xcd_barrier(bar);
        const float ta = __hip_atomic_load(tw, __ATOMIC_RELAXED, __HIP_MEMORY_SCOPE_AGENT), tb = __hip_atomic_load(tw + 1, __ATOMIC_RELAXED, __HIP_MEMORY_SCOPE_AGENT);
        const float cval = sqrtf(tb * 0.1f);
        for (size_t i = (size_t)bid * 512 + tid; i < (size_t)MTOK * DM; i += (size_t)G * 512) args.out[i] = (i == 0) ? ta : cval;
    }
#endif
#undef IN
#undef SEAM
}

#ifndef ONE_LAUNCH
#define ONE_LAUNCH 1
#endif
extern "C" void kernel_launch(void* const* d_in, const int* in_sizes, int n_in, void* d_out, int out_size, void* d_ws, size_t ws_size, hipStream_t stream) {
    static int grid = 0;
    if (grid == 0) {
        if (n_in != 27 || in_sizes[0] != MTOK * DM || out_size != MTOK * DM || ws_size < WS_END) { fprintf(stderr, "kernel_launch: unexpected shapes (n_in %d, ws %zu)\n", n_in, ws_size); grid = -1; return; }
        int dev = 0, cus = 0, per_cu = 0;
        if (hipGetDevice(&dev) != hipSuccess || hipDeviceGetAttribute(&cus, hipDeviceAttributeMultiprocessorCount, dev) != hipSuccess) { grid = -1; return; }
        if (hipFuncSetAttribute((const void*)mk_fwd, hipFuncAttributeMaxDynamicSharedMemorySize, LDS_BYTES) != hipSuccess) { grid = -1; return; }
        if (hipOccupancyMaxActiveBlocksPerMultiprocessor(&per_cu, (const void*)mk_fwd, 512, LDS_BYTES) != hipSuccess || per_cu < 1) fprintf(stderr, "kernel_launch: occupancy query says %d\n", per_cu);
        (void)hipGetLastError();
        grid = cus;
    }
    if (grid < 0) return;
    (void)hipMemsetAsync((char*)d_ws + WS_CTL, 0, CTL_ZERO_BYTES, stream);
    Args a{};
    for (int i = 0; i < 27; ++i) a.in[i] = (const float*)d_in[i];
    a.out = (float*)d_out; a.ws = (unsigned char*)d_ws;
#if ONE_LAUNCH
    a.ph_lo = 0; a.ph_hi = NPHASE;
    hipLaunchKernelGGL(mk_fwd, dim3(grid), dim3(512), LDS_BYTES, stream, a);
#else
    for (int k = 0; k < NPHASE; ++k) {
        if (k >= 1) { const int layer = (k - 1) / 12, r = (k - 1) % 12; if ((layer & 1) == 0 && (r == 2 || r == 3)) continue; }
        a.ph_lo = k; a.ph_hi = k + 1;
        hipLaunchKernelGGL(mk_fwd, dim3(grid), dim3(512), LDS_BYTES, stream, a);
    }
#endif
}
```

```cpp
#include <hip/hip_runtime.h>
#include <cstdio>
#include <cstdint>
namespace pg8 {
#define PG8_LAS __attribute__((address_space(3)))
typedef unsigned short bf16_t;
typedef short bf16x8 __attribute__((ext_vector_type(8)));
typedef float f32x4 __attribute__((ext_vector_type(4)));
typedef unsigned u32x4 __attribute__((ext_vector_type(4)));
constexpr int BM = 256, BK = 64, HALF = 128, HTB = HALF * BK * 2  , STAGE_BYTES = 8 * HTB, NXCD = 8, WGM = 8;

__host__ __device__ __forceinline__ int lds_byte(int r, int c) { const int st = (r >> 4) * 2 + (c >> 5), rr = r & 15, cc = c & 31, ob = rr * 64 + cc * 2; return st * 1024 + (ob ^ (((ob >> 9) & 1) << 5)); }
__host__ __device__ __forceinline__ void stage_rc(int b, int& R, int& C) { const int st = b / 1024, sb = b % 1024, swz = sb ^ (((sb >> 9) & 1) << 5); R = (st >> 1) * 16 + swz / 64; C = (st & 1) * 32 + (swz % 64) / 2; }
__host__ __device__ __forceinline__ int perm32(int rho) { const int n = rho >> 4, i = rho & 15; return 8 * (i >> 2) + 4 * n + (i & 3); }

struct Unit { int pm, pn; };
struct Gemm { const bf16_t* A; const bf16_t* Bt; int M, N, K; };

struct StaticOrder {
    int nM, nN, nwg, G, c;
    __host__ __device__ void init(int M, int N, int G_, int c_) { nM = M / BM; nN = N / BM; nwg = nM * nN; G = G_; c = c_; }
    __host__ __device__ bool next(int i, Unit& u) const {
        const long L = (long)i * G + c; if (L >= nwg) return false;
        int wgid = (int)L; { const int q = nwg / NXCD, r = nwg % NXCD, xcd = wgid % NXCD, off = wgid / NXCD; wgid = (xcd < r ? xcd * (q + 1) : r * (q + 1) + (xcd - r) * q) + off; }
        const int nig = WGM * nN, gid = wgid / nig, fm = gid * WGM, gsz = (nM - fm) < WGM ? (nM - fm) : WGM;
        u.pm = fm + ((wgid % nig) % gsz); u.pn = (wgid % nig) / gsz; return true;
    }
    __device__ __forceinline__ void a_ready(const Unit&) const {}
    __device__ __forceinline__ void done(const Unit&) const {}
};

__device__ __forceinline__ unsigned cvt_pk_bf16(float lo, float hi) { unsigned r; asm volatile("v_cvt_pk_bf16_f32 %0, %1, %2" : "=v"(r) : "v"(lo), "v"(hi)); return r; }
typedef float f32x2 __attribute__((ext_vector_type(2)));
__device__ __forceinline__ f32x2 gelu_pk(f32x2 v) {
    const f32x2 av = __builtin_elementwise_abs(v), d = av * 0.2316418882f + 1.0f;
    f32x2 t; t.x = __builtin_amdgcn_rcpf(d.x); t.y = __builtin_amdgcn_rcpf(d.y);
    f32x2 q = t * 0.5307027145f + (-0.7265760135f); q = q * t + 0.7107068705f; q = q * t + (-0.142248368f); q = q * t + 0.127414796f; q = q * t;
    const f32x2 s = (v * v) * (-0.72134752044f);
    f32x2 e; e.x = __builtin_amdgcn_exp2f(s.x); e.y = __builtin_amdgcn_exp2f(s.y);
    const f32x2 m = v * (q * e), r = v - m;
    f32x2 o; o.x = v.x < 0.f ? m.x : r.x; o.y = v.y < 0.f ? m.y : r.y; return o;
}

template <int ACT  > struct EpiBf16 {
    static constexpr bool PERM = true, AFTER_DRAIN = false; static_assert(ACT == 0 || ACT == 1, "EpiBf16: ACT is 0 (none) or 1 (gelu_pk)");
    bf16_t* O; int ldc; const float* bias; int split_cols; size_t split_stride; float scale0;
    __device__ __forceinline__ void operator()(const f32x4 (&acc)[2][2][4][2], const Unit& u, int wr, int wc, int fr, int fq) const {
        const int row0 = u.pm * BM + wr * 64 + fr; int colt = u.pn * BM; bf16_t* base = O;
        float sc = 1.f; if (split_cols) { const int t = colt / split_cols; base += (size_t)t * split_stride; colt -= t * split_cols; if (t == 0) sc = scale0; }
        const int col0 = colt + wc * 32 + 8 * fq, bcol0 = u.pn * BM + wc * 32 + 8 * fq;
        f32x4 bv[2][2];
#pragma unroll
        for (int bj = 0; bj < 2; ++bj)
#pragma unroll
            for (int n = 0; n < 2; ++n) bv[bj][n] = bias ? *(const f32x4*)(bias + bcol0 + bj * HALF + 4 * n) : (f32x4){0.f, 0.f, 0.f, 0.f};
#pragma unroll
        for (int ai = 0; ai < 2; ++ai)
#pragma unroll
            for (int m = 0; m < 4; ++m) { bf16_t* rowp = base + (size_t)(row0 + ai * HALF + m * 16) * ldc + col0;
#pragma unroll
                for (int bj = 0; bj < 2; ++bj) { f32x4 v0 = acc[ai][bj][m][0] + bv[bj][0], v1 = acc[ai][bj][m][1] + bv[bj][1];
                    if (ACT == 1) { f32x2 a = gelu_pk((f32x2){v0[0], v0[1]}), b = gelu_pk((f32x2){v0[2], v0[3]}), c = gelu_pk((f32x2){v1[0], v1[1]}), d = gelu_pk((f32x2){v1[2], v1[3]});
                        v0 = (f32x4){a.x, a.y, b.x, b.y}; v1 = (f32x4){c.x, c.y, d.x, d.y}; }
                    v0 = v0 * sc; v1 = v1 * sc; u32x4 w; w.x = cvt_pk_bf16(v0[0], v0[1]); w.y = cvt_pk_bf16(v0[2], v0[3]); w.z = cvt_pk_bf16(v1[0], v1[1]); w.w = cvt_pk_bf16(v1[2], v1[3]);
                    *(u32x4*)(rowp + bj * HALF) = w; } }
    }
};
struct EpiF32 {
    static constexpr bool PERM = false, AFTER_DRAIN = false;
    float* C; int ldc; const float* bias;
    __device__ __forceinline__ void operator()(const f32x4 (&acc)[2][2][4][2], const Unit& u, int wr, int wc, int fr, int fq) const {
        const int row0 = u.pm * BM + wr * 64 + fr, col0 = u.pn * BM + wc * 32 + 4 * fq;
        f32x4 bv[2][2];
#pragma unroll
        for (int bj = 0; bj < 2; ++bj)
#pragma unroll
            for (int n = 0; n < 2; ++n) bv[bj][n] = bias ? *(const f32x4*)(bias + col0 + bj * HALF + n * 16) : (f32x4){0.f, 0.f, 0.f, 0.f};
#pragma unroll
        for (int ai = 0; ai < 2; ++ai)
#pragma unroll
            for (int m = 0; m < 4; ++m) { float* rowp = C + (size_t)(row0 + ai * HALF + m * 16) * ldc + col0;
#pragma unroll
                for (int bj = 0; bj < 2; ++bj)
#pragma unroll
                    for (int n = 0; n < 2; ++n) *(f32x4*)(rowp + bj * HALF + n * 16) = acc[ai][bj][m][n] + bv[bj][n]; }
    }
};
template <class Epi, class Sched, bool ALIGN_EPI = false, bool SP2 = false>
__device__ __forceinline__ void gemm_phase(PG8_LAS unsigned char* lds, const Gemm g, const Sched& S, const Epi& E, const int tid) {
    const int wid = __builtin_amdgcn_readfirstlane(tid >> 6), lane = tid & 63, wr = wid >> 2, wc = wid & 3, fr = lane & 15, fq = lane >> 4;
    const int K = g.K, nt = K / BK;
    unsigned voffA[2], voffB[2];
#pragma unroll
    for (int i = 0; i < 2; ++i) { int R, C; stage_rc(tid * 16 + i * 8192, R, C); const int Rb = Epi::PERM ? ((R & ~31) + perm32(R & 31)) : R;
        voffA[i] = (unsigned)(R * K + C) * 2u; voffB[i] = (unsigned)(Rb * K + C) * 2u; }
    const size_t kstep = (size_t)(BK * 2);
    const size_t hstep = (size_t)HALF * K * 2;
    const size_t tstep = 2 * hstep;
    const unsigned ldsw = (unsigned)wid * 1024u;
    const int aoff = lds_byte(wr * 64 + fr, fq * 8), boff = lds_byte(wc * 32 + fr, fq * 8);
#define PG8_SA(b, h) (((b) * 2 + (h)) * HTB)
#define PG8_SB(b, h) ((4 + (b) * 2 + (h)) * HTB)
#define PG8_STAGE(bufoff, gbase, voff) do { _Pragma("unroll") for (int _i = 0; _i < 2; ++_i) \
        __builtin_amdgcn_global_load_lds((const unsigned*)((const char*)(gbase) + (voff)[_i]), (PG8_LAS unsigned*)(lds + (bufoff) + ldsw + _i * 8192), 16, 0, 0); } while (0)
#define PG8_LDA(dst, b, h) do { _Pragma("unroll") for (int m = 0; m < 4; ++m) _Pragma("unroll") for (int k = 0; k < 2; ++k) dst[m][k] = *(const PG8_LAS bf16x8*)(lds + PG8_SA(b, h) + aoff + m * 2048 + k * 1024); } while (0)
#define PG8_LDB(dst, b, h) do { _Pragma("unroll") for (int n = 0; n < 2; ++n) _Pragma("unroll") for (int k = 0; k < 2; ++k) dst[n][k] = *(const PG8_LAS bf16x8*)(lds + PG8_SB(b, h) + boff + n * 2048 + k * 1024); } while (0)
#define PG8_MMA(ai, bj, At, Bt) do { __builtin_amdgcn_s_setprio(1); _Pragma("unroll") for (int m = 0; m < 4; ++m) _Pragma("unroll") for (int n = 0; n < 2; ++n) _Pragma("unroll") for (int k = 0; k < 2; ++k) \
        acc[ai][bj][m][n] = __builtin_amdgcn_mfma_f32_16x16x32_bf16(Bt[n][k], At[m][k], acc[ai][bj][m][n], 0, 0, 0); __builtin_amdgcn_s_setprio(0); } while (0)
#define PG8_WAIT_V(n) asm volatile("s_waitcnt vmcnt(" #n ")" ::: "memory")
#define PG8_WAIT_L(n) asm volatile("s_waitcnt lgkmcnt(" #n ")" ::: "memory")
#define PG8_BAR __builtin_amdgcn_s_barrier()
#define PG8_SCHED __builtin_amdgcn_sched_barrier(0)
    Unit cur, nxt; int ui = 0;
    if (!S.next(0, cur)) return;
    f32x4 acc[2][2][4][2];
#pragma unroll
    for (int a = 0; a < 2; ++a)
#pragma unroll
        for (int b = 0; b < 2; ++b)
#pragma unroll
            for (int m = 0; m < 4; ++m)
#pragma unroll
                for (int n = 0; n < 2; ++n) acc[a][b][m][n] = (f32x4){0.f, 0.f, 0.f, 0.f};
    bf16x8 At[4][2], B0[2][2], B1[2][2];
    const char* cA = (const char*)g.A + (size_t)cur.pm * tstep; const char* cB = (const char*)g.Bt + (size_t)cur.pn * tstep;
    S.a_ready(cur);
    if constexpr (SP2) {
        PG8_STAGE(PG8_SB(0, 0), cB, voffB); PG8_STAGE(PG8_SB(0, 1), cB + hstep, voffB); PG8_STAGE(PG8_SA(0, 0), cA, voffA); PG8_STAGE(PG8_SA(0, 1), cA + hstep, voffA);
        if (wr == 1) PG8_BAR;
        PG8_WAIT_V(2); PG8_BAR;
        PG8_STAGE(PG8_SB(1, 0), cB + kstep, voffB); PG8_STAGE(PG8_SA(1, 0), cA + kstep, voffA); PG8_STAGE(PG8_SB(1, 1), cB + hstep + kstep, voffB);
        PG8_WAIT_V(6); PG8_BAR;
    } else {
        PG8_STAGE(PG8_SB(0, 0), cB, voffB); PG8_STAGE(PG8_SA(0, 0), cA, voffA); PG8_STAGE(PG8_SB(0, 1), cB + hstep, voffB); PG8_STAGE(PG8_SA(0, 1), cA + hstep, voffA);
        if (wr == 1) PG8_BAR;
        PG8_WAIT_V(4); PG8_BAR;
        PG8_STAGE(PG8_SB(1, 0), cB + kstep, voffB); PG8_STAGE(PG8_SA(1, 0), cA + kstep, voffA); PG8_STAGE(PG8_SB(1, 1), cB + hstep + kstep, voffB);
        PG8_WAIT_V(6); PG8_BAR;
    }
    for (;;) {
        const bool has_next = S.next(ui + 1, nxt);
        const char* nA = has_next ? (const char*)g.A + (size_t)nxt.pm * tstep : cA; const char* nB = has_next ? (const char*)g.Bt + (size_t)nxt.pn * tstep : cB;
        for (int t = 0; t < nt; t += 2) {
            const bool last = (t == nt - 2);
            const char* a1 = cA + (size_t)(t + 1) * kstep;
            const char* a2 = last ? nA : cA + (size_t)(t + 2) * kstep; const char* b2 = last ? nB : cB + (size_t)(t + 2) * kstep;
            const char* a3 = a2 + kstep; const char* b3 = b2 + kstep;
            if (last && has_next) S.a_ready(nxt);
            if constexpr (SP2) {
            PG8_LDB(B0, 0, 0); PG8_LDB(B1, 0, 1); PG8_SCHED; PG8_LDA(At, 0, 0); PG8_STAGE(PG8_SA(1, 1), a1 + hstep, voffA);
            PG8_WAIT_V(8); PG8_WAIT_L(0); PG8_BAR; PG8_MMA(0, 0, At, B0); PG8_MMA(0, 1, At, B1); PG8_BAR; PG8_SCHED;
            PG8_LDA(At, 0, 1); PG8_STAGE(PG8_SB(0, 0), b2, voffB); PG8_STAGE(PG8_SB(0, 1), b2 + hstep, voffB); PG8_STAGE(PG8_SA(0, 0), a2, voffA);
            PG8_WAIT_V(8); PG8_WAIT_L(0); PG8_BAR; PG8_MMA(1, 0, At, B0); PG8_MMA(1, 1, At, B1); PG8_BAR; PG8_SCHED;
            PG8_LDB(B0, 1, 0); PG8_LDB(B1, 1, 1); PG8_SCHED; PG8_LDA(At, 1, 0); PG8_STAGE(PG8_SA(0, 1), a2 + hstep, voffA);
            PG8_WAIT_V(8); PG8_WAIT_L(0); PG8_BAR; PG8_MMA(0, 0, At, B0); PG8_MMA(0, 1, At, B1); PG8_BAR; PG8_SCHED;
            PG8_LDA(At, 1, 1); PG8_STAGE(PG8_SB(1, 0), b3, voffB); PG8_STAGE(PG8_SB(1, 1), b3 + hstep, voffB); PG8_STAGE(PG8_SA(1, 0), a3, voffA);
            PG8_WAIT_V(8); PG8_WAIT_L(0); PG8_BAR; PG8_MMA(1, 0, At, B0); PG8_MMA(1, 1, At, B1); PG8_BAR; PG8_SCHED;
            } else {
            PG8_LDB(B0, 0, 0); PG8_SCHED; PG8_LDA(At, 0, 0); PG8_STAGE(PG8_SA(1, 1), a1 + hstep, voffA);
            PG8_WAIT_L(8); PG8_BAR; PG8_WAIT_L(0); PG8_MMA(0, 0, At, B0); PG8_BAR; PG8_SCHED;
            PG8_LDB(B1, 0, 1); PG8_STAGE(PG8_SB(0, 0), b2, voffB);
            PG8_BAR; PG8_WAIT_L(0); PG8_MMA(0, 1, At, B1); PG8_BAR;
            PG8_LDA(At, 0, 1); PG8_STAGE(PG8_SA(0, 0), a2, voffA);
            PG8_BAR; PG8_WAIT_L(0); PG8_MMA(1, 0, At, B0); PG8_BAR; PG8_SCHED;
            PG8_STAGE(PG8_SB(0, 1), b2 + hstep, voffB);
            PG8_WAIT_V(6); PG8_BAR; PG8_MMA(1, 1, At, B1); PG8_BAR;
            PG8_LDB(B0, 1, 0); PG8_SCHED; PG8_LDA(At, 1, 0); PG8_STAGE(PG8_SA(0, 1), a2 + hstep, voffA);
            PG8_WAIT_L(8); PG8_BAR; PG8_WAIT_L(0); PG8_MMA(0, 0, At, B0); PG8_BAR; PG8_SCHED;
            PG8_LDB(B1, 1, 1); PG8_STAGE(PG8_SB(1, 0), b3, voffB);
            PG8_BAR; PG8_WAIT_L(0); PG8_MMA(0, 1, At, B1); PG8_BAR;
            PG8_LDA(At, 1, 1); PG8_STAGE(PG8_SA(1, 0), a3, voffA);
            PG8_BAR; PG8_WAIT_L(0); PG8_MMA(1, 0, At, B0); PG8_BAR; PG8_SCHED;
            PG8_STAGE(PG8_SB(1, 1), b3 + hstep, voffB);
            PG8_WAIT_V(6); PG8_BAR; PG8_MMA(1, 1, At, B1); PG8_BAR;
            }
        }
        if constexpr (ALIGN_EPI) { if (wr == 0) PG8_BAR; }
        if constexpr (!Epi::AFTER_DRAIN) { E(acc, cur, wr, wc, fr, fq); S.done(cur); }
        if (!has_next) break;
#pragma unroll
        for (int a = 0; a < 2; ++a)
#pragma unroll
            for (int b = 0; b < 2; ++b)
#pragma unroll
                for (int m = 0; m < 4; ++m)
#pragma unroll
                    for (int n = 0; n < 2; ++n) acc[a][b][m][n] = (f32x4){0.f, 0.f, 0.f, 0.f};
        cur = nxt; cA = nA; cB = nB; ++ui;
        if constexpr (ALIGN_EPI) { if (wr == 1) PG8_BAR; }
    }
    PG8_WAIT_V(0);
    if constexpr (!ALIGN_EPI) { if (wr == 0) PG8_BAR; }
    PG8_BAR;
    if constexpr (Epi::AFTER_DRAIN) { E.fused(acc, cur, wr, wc, fr, fq, lds, wid, lane); S.done(cur); }
#undef PG8_SA
#undef PG8_SB
#undef PG8_STAGE
#undef PG8_LDA
#undef PG8_LDB
#undef PG8_MMA
#undef PG8_WAIT_V
#undef PG8_WAIT_L
#undef PG8_BAR
#undef PG8_SCHED
}
}

constexpr int DM = 1024, NBATCH = 32, TSEQ = 2048, MTOK = NBATCH * TSEQ, DEPTH = 4;
constexpr int EVEN_IN = 3248, EVEN_PAD = 3328, ODD_IN = 1864, ODD_PAD = 2048;
constexpr int G_Q = 0, G_K = 256, G_V = 512, G_G = 1024, G_AL = 1536, RW0 = 1552;
constexpr int R_R = RW0, R_K = RW0 + 512, R_V = RW0 + 1024, R_WL = RW0 + 1536;
constexpr int O_Q = 0, O_K = 1024, O_V = 1152, O_QI = 1280, O_KI = 1792, O_WI = 1856;
constexpr float DN_ALPHA = 1.681792830507429f, LN_EPS = 1e-5f;

constexpr size_t MiB = 1u << 20;
constexpr size_t WS_CTL = 0, CTL_ZERO_BYTES = 1 * MiB;
constexpr size_t WS_COSA = 1 * MiB, WS_SINA = WS_COSA + 512 * 1024, WS_COSI = 2 * MiB, WS_SINI = WS_COSI + 256 * 1024;
constexpr size_t WS_WINE = 3 * MiB, WS_WINO = 16 * MiB, WS_WOUTE = 24 * MiB, WS_WOUTO = 28 * MiB, WS_WQ = 32 * MiB, WS_SK = 40 * MiB;
constexpr size_t WS_XB = 48 * MiB, WS_P = 176 * MiB, WS_MIX = WS_P, WS_QP = WS_P + 256 * MiB, WS_CAT = 592 * MiB;
constexpr size_t WS_RIDX = 720 * MiB, WS_RGATE = 736 * MiB, WS_MASK = 768 * MiB, WS_VT = 784 * MiB, WS_EXP = 800 * MiB, WS_END = 1000 * MiB;
constexpr int CW_BAR = 4096, CW_Q = 8192;
constexpr size_t WS_FFN = WS_P, WS_HC = WS_P + 384 * MiB;

constexpr int LDS_BYTES = 163840, RING_BYTES = 131072, LDSCTL_OFF = LDS_BYTES - 1024;

#define GAS __attribute__((address_space(1)))
#define LAS __attribute__((address_space(3)))
typedef unsigned short bf16;
typedef float f32x4 __attribute__((ext_vector_type(4)));
typedef unsigned u32x4 __attribute__((ext_vector_type(4)));
typedef unsigned u32x2 __attribute__((ext_vector_type(2)));
typedef short bf16x8 __attribute__((ext_vector_type(8)));
typedef float f32x16 __attribute__((ext_vector_type(16)));
#define LDS_WAIT() asm volatile("s_waitcnt lgkmcnt(0)" ::: "memory")
__device__ __forceinline__ float bf2f(bf16 b) { return __uint_as_float(((unsigned)b) << 16); }
typedef __bf16 bf16x2n_ __attribute__((ext_vector_type(2)));
typedef float f32x2n_ __attribute__((ext_vector_type(2)));
__device__ __forceinline__ unsigned pk2(float lo, float hi) { const f32x2n_ v = {lo, hi}; return __builtin_bit_cast(unsigned, __builtin_convertvector(v, bf16x2n_)); }
__device__ __forceinline__ unsigned f2bf(float f) { return pk2(f, 0.f) & 0xffffu; }
__device__ __forceinline__ unsigned f2bf_acc(float f) { unsigned u = __float_as_uint(f); return (u + 0x7fffu + ((u >> 16) & 1u)) >> 16; }
__device__ __forceinline__ unsigned pk2_acc(float lo, float hi) { return f2bf_acc(lo) | (f2bf_acc(hi) << 16); }
__device__ __forceinline__ float bflo(unsigned w) { return __uint_as_float(w << 16); }
__device__ __forceinline__ float bfhi(unsigned w) { return __uint_as_float(w & 0xffff0000u); }
__device__ __forceinline__ float wave_sum(float v) {
#pragma unroll
    for (int o = 1; o < 64; o <<= 1) v += __shfl_xor(v, o);
    return v;
}
__device__ __forceinline__ float wave_max(float v) {
#pragma unroll
    for (int o = 1; o < 64; o <<= 1) v = fmaxf(v, __shfl_xor(v, o));
    return v;
}
__device__ __forceinline__ int wave_sum_i(int v) {
#pragma unroll
    for (int o = 1; o < 64; o <<= 1) v += __shfl_xor(v, o);
    return v;
}
__device__ __forceinline__ float sigmoidf_(float x) { return 1.f / (1.f + __expf(-x)); }

template <int CTRL> __device__ __forceinline__ float dpp_f(float v) { return __int_as_float(__builtin_amdgcn_mov_dpp(__float_as_int(v), CTRL, 0xF, 0xF, true)); }
template <int CTRL> __device__ __forceinline__ int dpp_i(int v) { return __builtin_amdgcn_mov_dpp(v, CTRL, 0xF, 0xF, true); }
__device__ __forceinline__ float reduce8(float v) { v += dpp_f<0xB1>(v); v += dpp_f<0x4E>(v); v += dpp_f<0x141>(v); return v; }
__device__ __forceinline__ float reduce16(float v) { v = reduce8(v); v += dpp_f<0x140>(v); return v; }
__device__ __forceinline__ float wave_max_dpp(float v) {
    v = fmaxf(v, dpp_f<0xB1>(v)); v = fmaxf(v, dpp_f<0x4E>(v)); v = fmaxf(v, dpp_f<0x141>(v)); v = fmaxf(v, dpp_f<0x140>(v));
    const int iv = __float_as_int(v);
    return fmaxf(fmaxf(__int_as_float(__builtin_amdgcn_readlane(iv, 0)), __int_as_float(__builtin_amdgcn_readlane(iv, 16))), fmaxf(__int_as_float(__builtin_amdgcn_readlane(iv, 32)), __int_as_float(__builtin_amdgcn_readlane(iv, 48))));
}
__device__ __forceinline__ int reduce16_i(int v) { v += dpp_i<0xB1>(v); v += dpp_i<0x4E>(v); v += dpp_i<0x141>(v); v += dpp_i<0x140>(v); return v; }
__device__ __forceinline__ float hswap32_add(float lo, float hi) { const auto r = __builtin_amdgcn_permlane32_swap(__float_as_uint(lo), __float_as_uint(hi), false, false); return __uint_as_float(r[0]) + __uint_as_float(r[1]); }
__device__ __forceinline__ float hswap16_add(float lo, float hi) { const auto r = __builtin_amdgcn_permlane16_swap(__float_as_uint(lo), __float_as_uint(hi), false, false); return __uint_as_float(r[0]) + __uint_as_float(r[1]); }
__device__ __forceinline__ int hswap32_add_i(int lo, int hi) { const auto r = __builtin_amdgcn_permlane32_swap((unsigned)lo, (unsigned)hi, false, false); return (int)(r[0] + r[1]); }
#define XB_TMO      128
#define XB_XCNT(j)  (256  + 64 * (j))
#define XB_XSUB(j)  (1280 + 64 * (j))
#define XB_XGEN(j)  (2304 + 64 * (j))
#define XB_TOP      3328
#define XB_TOPGEN   3392
#define XCD_BAR_WORDS 3456
#define XB_SPIN_CAP (1u << 18)

__device__ __forceinline__ unsigned xb_ld(unsigned* p)              { return __hip_atomic_load(p, __ATOMIC_RELAXED, __HIP_MEMORY_SCOPE_AGENT); }
__device__ __forceinline__ unsigned xb_add(unsigned* p, unsigned v) { return __hip_atomic_fetch_add(p, v, __ATOMIC_RELAXED, __HIP_MEMORY_SCOPE_AGENT); }
__device__ __forceinline__ unsigned xb_xcc_id() { return (unsigned)__builtin_amdgcn_s_getreg((3 << 11) | 20) & 0xFu; }
#define XB_SPIN(cond, bar) do { unsigned _sp = 0; while (cond) { __builtin_amdgcn_s_sleep(1); \
    if ((++_sp & 255u) == 0u) { if (xb_ld(&(bar)[XB_TMO])) break; if (_sp > XB_SPIN_CAP) { atomicAdd(&(bar)[XB_TMO], 1u); break; } } } } while (0)

struct XcdBarrier {
    unsigned* bar; unsigned x;
    volatile LAS unsigned* st;
};

__device__ __forceinline__ XcdBarrier xcd_barrier_post(unsigned* bar, volatile LAS unsigned* st) {
    XcdBarrier b; b.bar = bar; b.x = xb_xcc_id(); b.st = st;
    if (threadIdx.x == 0) (void)xb_add(&bar[XB_XCNT(b.x)], 1u);
    return b;
}
__device__ __forceinline__ void xcd_barrier_complete(unsigned* bar, unsigned x, unsigned& nloc, unsigned& nx) {
    const unsigned G = gridDim.x * gridDim.y * gridDim.z;
    unsigned sum, cnt, mine, sp = 0u;
    for (;;) {
        sum = 0u; cnt = 0u; mine = 0u;
#pragma unroll
        for (unsigned j = 0; j < 16; ++j) { const unsigned c = xb_ld(&bar[XB_XCNT(j)]); sum += c; cnt += (c > 0u) ? 1u : 0u; mine = (j == x) ? c : mine; }
        if (sum == G) break;
        __builtin_amdgcn_s_sleep(1);
        if ((++sp & 255u) == 0u) { if (xb_ld(&bar[XB_TMO])) break; if (sp > XB_SPIN_CAP) { atomicAdd(&bar[XB_TMO], 1u); break; } }
    }
    nloc = mine > 0u ? mine : 1u; nx = cnt > 0u ? cnt : 1u;
}

__device__ __forceinline__ void xcd_barrier(const XcdBarrier& b) {
    asm volatile("s_waitcnt vmcnt(0)" ::: "memory");
    __syncthreads();
    if (threadIdx.x == 0) {
        unsigned* bar = b.bar;
        __builtin_amdgcn_s_waitcnt(0);
        unsigned nloc = b.st[0], nx = b.st[1];
        if (nloc == 0u) { xcd_barrier_complete(bar, b.x, nloc, nx); b.st[0] = nloc; b.st[1] = nx; }
        const unsigned old = xb_add(&bar[XB_XSUB(b.x)], 1u);
        const unsigned gen = old / nloc;
        if (old + 1u == (gen + 1u) * nloc) {
            __builtin_amdgcn_fence(__ATOMIC_RELEASE, "agent");
            asm volatile("s_waitcnt vmcnt(0)" ::: "memory");
            const unsigned og = xb_add(&bar[XB_TOP], 1u);
            const unsigned tg = og / nx;
            if (og + 1u == (tg + 1u) * nx) xb_add(&bar[XB_TOPGEN], 1u);
            else XB_SPIN(xb_ld(&bar[XB_TOPGEN]) == tg, bar);
            __builtin_amdgcn_fence(__ATOMIC_ACQUIRE, "agent");
            xb_add(&bar[XB_XGEN(b.x)], 1u);
            asm volatile("s_waitcnt vmcnt(0)" ::: "memory");
        } else {
            XB_SPIN(xb_ld(&bar[XB_XGEN(b.x)]) == gen, bar);
            __builtin_amdgcn_fence(__ATOMIC_ACQUIRE, "agent");
            asm volatile("s_waitcnt vmcnt(0)" ::: "memory");
        }
    }
    __syncthreads();
}

struct Args { const float* in[27]; float* out; unsigned char* ws; int ph_lo, ph_hi; };

__device__ __forceinline__ void transpose_item(const float* W, int N, int Npad, bf16* WT, LAS float* scr, int item, int lane) {
    const int nblk = Npad / 32, kb = item / nblk, nb = item % nblk, k0 = 64 * kb, n0 = 32 * nb;
    const int nq = n0 + 4 * (lane & 7);
#pragma unroll
    for (int i = 0; i < 8; ++i) { const int kk = 8 * i + (lane >> 3); const f32x4 v = (nq < N) ? *(const f32x4*)(W + (size_t)(k0 + kk) * N + nq) : (f32x4){0.f, 0.f, 0.f, 0.f};
        LAS float* d = scr + kk * 33 + 4 * (lane & 7); d[0] = v.x; d[1] = v.y; d[2] = v.z; d[3] = v.w; }
    LDS_WAIT(); asm volatile("" ::: "memory");
    const int c = lane & 7;
#pragma unroll
    for (int j = 0; j < 4; ++j) { const int n = (lane >> 3) + 8 * j; const LAS float* s = scr + (8 * c) * 33 + n;
        u32x4 o; o.x = pk2(s[0 * 33], s[1 * 33]); o.y = pk2(s[2 * 33], s[3 * 33]); o.z = pk2(s[4 * 33], s[5 * 33]); o.w = pk2(s[6 * 33], s[7 * 33]);
        *(u32x4*)(WT + (size_t)(n0 + n) * 1024 + k0 + 8 * c) = o; }
    LDS_WAIT(); asm volatile("" ::: "memory");
}
__device__ __forceinline__ void sincos_d(double x, double& s, double& c) {
    const double n = __builtin_rint(x * 0.6366197723675814);
    double r = __builtin_fma(-n, 1.5707963267948966, x); r = __builtin_fma(-n, 6.123233995736766e-17, r);
    const int q = ((int)n) & 3;
    const double r2 = r * r;
    double sp = -1.0 / 1307674368000.0; sp = sp * r2 + 1.0 / 6227020800.0; sp = sp * r2 - 1.0 / 39916800.0; sp = sp * r2 + 1.0 / 362880.0; sp = sp * r2 - 1.0 / 5040.0; sp = sp * r2 + 1.0 / 120.0; sp = sp * r2 - 1.0 / 6.0; sp = sp * r2 + 1.0; sp *= r;
    double cp = 1.0 / 20922789888000.0; cp = cp * r2 - 1.0 / 87178291200.0; cp = cp * r2 + 1.0 / 479001600.0; cp = cp * r2 - 1.0 / 3628800.0; cp = cp * r2 + 1.0 / 40320.0; cp = cp * r2 - 1.0 / 720.0; cp = cp * r2 + 1.0 / 24.0; cp = cp * r2 - 0.5; cp = cp * r2 + 1.0;
    s = (q == 0) ? sp : (q == 1) ? cp : (q == 2) ? -sp : -cp;
    c = (q == 0) ? cp : (q == 1) ? -sp : (q == 2) ? -cp : sp;
}
__device__ __forceinline__ double powi_d(double base, int e) { double r = 1.0, p = base;
#pragma unroll
    for (int b = 0; b < 7; ++b) { if (e & (1 << b)) r *= p; p *= p; } return r; }

__device__ __forceinline__ void ph_prologue(const Args& a, LAS unsigned char* lds, int gw, int NGW, int wave, int lane) {
    unsigned char* ws = a.ws;
    LAS float* scr = (LAS float*)(lds + wave * 16384);
    constexpr int I_WE = 16 * (EVEN_PAD / 32), I_WO = 16 * (ODD_PAD / 32), I_SQ = 16 * 32;
    constexpr int NIT = 2 * I_WE + 2 * I_WO + 8 * I_SQ;
    for (int it = gw; it < NIT; it += NGW) {
        int r = it;
        if (r < 2 * I_WE) { const int i = r / I_WE; transpose_item(a.in[1] + (size_t)i * 1024 * EVEN_IN, EVEN_IN, EVEN_PAD, (bf16*)(ws + WS_WINE) + (size_t)i * EVEN_PAD * 1024, scr, r % I_WE, lane); continue; }
        r -= 2 * I_WE;
        if (r < 2 * I_WO) { const int i = r / I_WO; transpose_item(a.in[17] + (size_t)i * 1024 * ODD_IN, ODD_IN, ODD_PAD, (bf16*)(ws + WS_WINO) + (size_t)i * ODD_PAD * 1024, scr, r % I_WO, lane); continue; }
        r -= 2 * I_WO;
        const int mi = r / I_SQ, item = r % I_SQ; const float* src; bf16* dst;
        if (mi < 2) { src = a.in[16] + (size_t)mi * 1048576; dst = (bf16*)(ws + WS_WOUTE) + (size_t)mi * 1048576; }
        else if (mi < 4) { src = a.in[18] + (size_t)(mi - 2) * 1048576; dst = (bf16*)(ws + WS_WOUTO) + (size_t)(mi - 2) * 1048576; }
        else { src = a.in[21] + (size_t)(mi - 4) * 1048576; dst = (bf16*)(ws + WS_WQ) + (size_t)(mi - 4) * 1048576; }
        transpose_item(src, 1024, 1024, dst, scr, item, lane);
    }
    const int gtid = gw * 64 + lane, NT = NGW * 64;
    for (int idx = gtid; idx < 2048 * 64; idx += NT) { const int t = idx >> 6, i = idx & 63; double s, c; sincos_d((double)t * powi_d(0.8659643233600653, i), s, c);
        ((float*)(ws + WS_COSA))[idx] = (float)c; ((float*)(ws + WS_SINA))[idx] = (float)s; }
    for (int idx = gtid; idx < 2048 * 32; idx += NT) { const int t = idx >> 5, i = idx & 31; double s, c; sincos_d((double)t * powi_d(0.7498942093324559, i), s, c);
        ((float*)(ws + WS_COSI))[idx] = (float)c; ((float*)(ws + WS_SINI))[idx] = (float)s; }
    { const f32x4* sk = (const f32x4*)a.in[22]; u32x2* skb = (u32x2*)(ws + WS_SK);
      for (int i = gtid; i < 4 * 8 * 2 * 128 * 64 / 4; i += NT) { const f32x4 v = sk[i]; u32x2 o; o.x = pk2(v.x, v.y); o.y = pk2(v.z, v.w); skb[i] = o; } }
    const f32x4* x4 = (const f32x4*)a.in[0]; u32x4* xb = (u32x4*)(ws + WS_XB);
    for (size_t i = gtid; i < (size_t)MTOK * DM / 8; i += NT) { const f32x4 v0 = x4[2 * i], v1 = x4[2 * i + 1];
        u32x4 o; o.x = pk2(v0.x, v0.y); o.y = pk2(v0.z, v0.w); o.z = pk2(v1.x, v1.y); o.w = pk2(v1.z, v1.w); xb[i] = o; }
}

constexpr int L_W2 = 0, L_A2 = 2048, L_G2 = 4096, L_PAR = 10240, L_LORA = 11040, L_VEC = 16160, L_Y = 30496, L_BON = 32544;
__device__ __forceinline__ void rwkv_unit(const Args& a, LAS float* L, int unit, int i2, const bf16* P, bf16* CAT, int tid) {
    constexpr int PS = EVEN_PAD;
    const int b = unit >> 3, h = unit & 7, lane = tid & 63, wave = __builtin_amdgcn_readfirstlane(tid >> 6);
    const float* mu = a.in[5] + i2 * 1696; const float* w0 = a.in[6] + i2 * 512; const float* w2 = a.in[7] + i2 * 32 * 512; const float* a0 = a.in[8] + i2 * 512;
    const float* a2 = a.in[9] + i2 * 32 * 512; const float* g2 = a.in[10] + i2 * 96 * 512; const float* kk_ = a.in[11] + i2 * 512; const float* ka_ = a.in[12] + i2 * 512;
    const float* rk_ = a.in[13] + i2 * 512; const float* lg = a.in[14] + i2 * 512; const float* lb = a.in[15] + i2 * 512;
    for (int idx = tid; idx < 32 * 64; idx += 512) { const int j = idx >> 6, c = idx & 63; L[L_W2 + idx] = w2[j * 512 + h * 64 + c]; L[L_A2 + idx] = a2[j * 512 + h * 64 + c]; }
    for (int idx = tid; idx < 96 * 64; idx += 512) { const int j = idx >> 6, c = idx & 63; L[L_G2 + idx] = g2[j * 512 + h * 64 + c]; }
    if (tid < 64) { const int c = tid, col = h * 64 + c; L[L_PAR + c] = mu[col]; L[L_PAR + 64 + c] = mu[512 + col]; L[L_PAR + 128 + c] = mu[1024 + col]; L[L_PAR + 192 + c] = w0[col];
        L[L_PAR + 256 + c] = a0[col]; L[L_PAR + 320 + c] = kk_[col]; L[L_PAR + 384 + c] = ka_[col]; L[L_PAR + 448 + c] = rk_[col]; L[L_PAR + 512 + c] = lg[col]; L[L_PAR + 576 + c] = lb[col]; }
    if (tid < 160) L[L_PAR + 640 + tid] = mu[1536 + tid];
    float S[8];
#pragma unroll
    for (int e = 0; e < 8; ++e) S[e] = 0.f;
    __syncthreads();
    const size_t row0 = (size_t)b * 2048;
    for (int t0 = 0; t0 < 2048; t0 += 32) {
#pragma unroll 1
        for (int idx = tid; idx < 32 * 160; idx += 512) { const int tok = idx / 160, j = idx - tok * 160, t = t0 + tok; const bf16* pr = P + (row0 + t) * PS + R_WL + j;
            const float cur = bf2f(pr[0]), prev = t > 0 ? bf2f(pr[-PS]) : 0.f; const float s = cur + (prev - cur) * L[L_PAR + 640 + j];
            L[L_LORA + idx] = j < 32 ? tanhf(s) : (j < 64 ? s : 1.f / (1.f + expf(-s))); }
        __syncthreads();
        { const int c = lane, tg = wave, col = h * 64 + c;
          float rs[4], ks[4], vs[4], wl[4], al[4], gg[4];
#pragma unroll
          for (int i = 0; i < 4; ++i) { const int tok = tg * 4 + i, t = t0 + tok; const bf16* pr = P + (row0 + t) * PS;
              float cur = bf2f(pr[R_R + col]), prev = t > 0 ? bf2f(pr[R_R + col - PS]) : 0.f; rs[i] = cur + (prev - cur) * L[L_PAR + c];
              cur = bf2f(pr[R_K + col]); prev = t > 0 ? bf2f(pr[R_K + col - PS]) : 0.f; ks[i] = cur + (prev - cur) * L[L_PAR + 64 + c];
              cur = bf2f(pr[R_V + col]); prev = t > 0 ? bf2f(pr[R_V + col - PS]) : 0.f; vs[i] = cur + (prev - cur) * L[L_PAR + 128 + c];
              wl[i] = L[L_PAR + 192 + c]; al[i] = L[L_PAR + 256 + c]; gg[i] = 0.f; }
#pragma unroll 2
          for (int j = 0; j < 32; ++j) { const float w = L[L_W2 + j * 64 + c], aa = L[L_A2 + j * 64 + c];
#pragma unroll
              for (int i = 0; i < 4; ++i) { wl[i] += L[L_LORA + (tg * 4 + i) * 160 + j] * w; al[i] += L[L_LORA + (tg * 4 + i) * 160 + 32 + j] * aa; } }
#pragma unroll 2
          for (int j = 0; j < 96; ++j) { const float g_ = L[L_G2 + j * 64 + c];
#pragma unroll
              for (int i = 0; i < 4; ++i) gg[i] += L[L_LORA + (tg * 4 + i) * 160 + 64 + j] * g_; }
#pragma unroll
          for (int i = 0; i < 4; ++i) { const int tok = tg * 4 + i;
              const float wlog = fminf(wl[i], 0.f) - log1pf(expf(-fabsf(wl[i]))) - 0.5f; const float decay = expf(-expf(wlog));
              const float av = 1.f / (1.f + expf(-al[i]));
              const float kkr = ks[i] * L[L_PAR + 320 + c]; const float ss = wave_sum(kkr * kkr); const float kkn = kkr / fmaxf(sqrtf(ss), 1e-12f);
              const float k2 = ks[i] * (1.f + (av - 1.f) * L[L_PAR + 384 + c]);
              const float bon = wave_sum(rs[i] * k2 * L[L_PAR + 448 + c]);
              const int o = L_VEC + tok * 64 + c;
              L[o] = rs[i]; L[o + 2048] = decay; L[o + 4096] = k2; L[o + 6144] = vs[i]; L[o + 8192] = -kkn; L[o + 10240] = kkn * av; L[o + 12288] = gg[i];
              if (c == 0) L[L_BON + tok] = bon; } }
        __syncthreads();
        { const int i = tid >> 3, jq = tid & 7;
#pragma unroll 1
          for (int tok = 0; tok < 32; ++tok) { const int base = L_VEC + tok * 64 + jq * 8;
              const f32x4 r0 = *(const LAS f32x4*)&L[base], r1 = *(const LAS f32x4*)&L[base + 4];
              const f32x4 w0v = *(const LAS f32x4*)&L[base + 2048], w1v = *(const LAS f32x4*)&L[base + 2052];
              const f32x4 k0v = *(const LAS f32x4*)&L[base + 4096], k1v = *(const LAS f32x4*)&L[base + 4100];
              const f32x4 a0v = *(const LAS f32x4*)&L[base + 8192], a1v = *(const LAS f32x4*)&L[base + 8196];
              const f32x4 b0v = *(const LAS f32x4*)&L[base + 10240], b1v = *(const LAS f32x4*)&L[base + 10244];
              const float vi = L[L_VEC + 6144 + tok * 64 + i];
              float sa = 0.f;
#pragma unroll
              for (int e = 0; e < 4; ++e) { sa += S[e] * a0v[e]; sa += S[4 + e] * a1v[e]; }
              sa += __shfl_xor(sa, 1); sa += __shfl_xor(sa, 2); sa += __shfl_xor(sa, 4);
              float y = 0.f;
#pragma unroll
              for (int e = 0; e < 4; ++e) { S[e] = S[e] * w0v[e] + sa * b0v[e] + vi * k0v[e]; S[4 + e] = S[4 + e] * w1v[e] + sa * b1v[e] + vi * k1v[e]; y += S[e] * r0[e]; y += S[4 + e] * r1[e]; }
              y += __shfl_xor(y, 1); y += __shfl_xor(y, 2); y += __shfl_xor(y, 4);
              if (jq == 0) L[L_Y + tok * 64 + i] = y; } }
        __syncthreads();
        { const int c = lane, tg = wave, col = h * 64 + c;
#pragma unroll
          for (int i = 0; i < 4; ++i) { const int tok = tg * 4 + i, t = t0 + tok; const float y = L[L_Y + tok * 64 + c];
              const float mean = wave_sum(y) * (1.f / 64.f); const float d = y - mean; const float var = wave_sum(d * d) * (1.f / 64.f);
              const float yn = d * (1.f / sqrtf(var + 64e-5f)) * L[L_PAR + 512 + c] + L[L_PAR + 576 + c];
              const float o = (yn + L[L_BON + tok] * L[L_VEC + 6144 + tok * 64 + c]) * L[L_VEC + 12288 + tok * 64 + c];
              CAT[(row0 + t) * 1024 + 512 + col] = (bf16)f2bf(o); } }
    }
    __syncthreads();
}

constexpr int L2_PAR = 2688, L2_PART = 3488, L2_SC = 4000, L2_VEC = 4096, L2_Y = 18432, XSTR = 168;
__device__ __forceinline__ void rwkv_unit2(const Args& a, LAS float* L, int unit, int i2, const bf16* P, bf16* CAT, int tid) {
    typedef float f32x4v __attribute__((ext_vector_type(4)));
    constexpr int PS = EVEN_PAD;
    const int b = unit >> 3, h = unit & 7, lane = tid & 63, wave = __builtin_amdgcn_readfirstlane(tid >> 6);
    LAS bf16* X = (LAS bf16*)L;
    const float* mu = a.in[5] + i2 * 1696;
    if (tid < 64) { const int c = tid, col = h * 64 + c; L[L2_PAR + c] = mu[col]; L[L2_PAR + 64 + c] = mu[512 + col]; L[L2_PAR + 128 + c] = mu[1024 + col]; L[L2_PAR + 192 + c] = (a.in[6] + i2 * 512)[col];
        L[L2_PAR + 256 + c] = (a.in[8] + i2 * 512)[col]; L[L2_PAR + 320 + c] = (a.in[11] + i2 * 512)[col]; L[L2_PAR + 384 + c] = (a.in[12] + i2 * 512)[col]; L[L2_PAR + 448 + c] = (a.in[13] + i2 * 512)[col];
        L[L2_PAR + 512 + c] = (a.in[14] + i2 * 512)[col]; L[L2_PAR + 576 + c] = (a.in[15] + i2 * 512)[col]; }
    if (tid < 160) L[L2_PAR + 640 + tid] = mu[1536 + tid];
    const int mt = wave & 3, nt = wave >> 2, n16 = lane & 15, q = lane >> 4;
    bf16x8 Aw, Aa, Ag0, Ag1, Ag2;
    { const int col = h * 64 + 16 * mt + n16; const float* w2 = a.in[7] + i2 * 32 * 512 + col; const float* a2 = a.in[9] + i2 * 32 * 512 + col; const float* g2 = a.in[10] + i2 * 96 * 512 + col;
      u32x4 t;
#define LDF(dst, src, k0) t.x = pk2(src[((k0) + 8 * q + 0) * 512], src[((k0) + 8 * q + 1) * 512]); t.y = pk2(src[((k0) + 8 * q + 2) * 512], src[((k0) + 8 * q + 3) * 512]); \
          t.z = pk2(src[((k0) + 8 * q + 4) * 512], src[((k0) + 8 * q + 5) * 512]); t.w = pk2(src[((k0) + 8 * q + 6) * 512], src[((k0) + 8 * q + 7) * 512]); dst = __builtin_bit_cast(bf16x8, t);
      LDF(Aw, w2, 0) LDF(Aa, a2, 0) LDF(Ag0, g2, 0) LDF(Ag1, g2, 32) LDF(Ag2, g2, 64)
#undef LDF
    }
    typedef float f32x2s __attribute__((ext_vector_type(2)));
    f32x2s S2[4];
#pragma unroll
    for (int e = 0; e < 4; ++e) S2[e] = (f32x2s){0.f, 0.f};
    __syncthreads();
    const size_t row0 = (size_t)b * 2048;
    LAS bf16* RAWL = (LAS bf16*)(L + 20480);
    u32x4 pf0, pf1; u32x2 prc, pkc, pvc, prp, pkp, pvp;
    const int pr0 = tid / 20, pc0 = tid - pr0 * 20, pr1 = (tid + 512) / 20, pc1 = (tid + 512) - pr1 * 20;
#define RWKV_PREFETCH(tt) { const int tq = (tt); const u32x4 z4 = {0u, 0u, 0u, 0u}; const u32x2 z2 = {0u, 0u}; \
        { const int t = tq - 1 + pr0; pf0 = t >= 0 ? *(const u32x4*)(P + (row0 + t) * PS + R_WL + pc0 * 8) : z4; } \
        if (tid + 512 < 660) { const int t = tq - 1 + pr1; pf1 = t >= 0 ? *(const u32x4*)(P + (row0 + t) * PS + R_WL + pc1 * 8) : z4; } \
        { const int t = tq + 16 * nt + n16; const bf16* pr = P + (row0 + t) * PS + h * 64 + 16 * mt + 4 * q; \
          prc = *(const u32x2*)(pr + R_R); pkc = *(const u32x2*)(pr + R_K); pvc = *(const u32x2*)(pr + R_V); \
          prp = t > 0 ? *(const u32x2*)(pr + R_R - PS) : z2; pkp = t > 0 ? *(const u32x2*)(pr + R_K - PS) : z2; pvp = t > 0 ? *(const u32x2*)(pr + R_V - PS) : z2; } }
    const int s1tok = tid >> 4, s1cg = tid & 15; float s1mu[10];
#pragma unroll
    for (int u = 0; u < 10; ++u) s1mu[u] = mu[1536 + 10 * s1cg + u];
    RWKV_PREFETCH(0)
#pragma unroll 1
    for (int t0 = 0; t0 < 2048; t0 += 32) {
        *(LAS u32x4*)(RAWL + pr0 * 160 + pc0 * 8) = pf0; if (tid + 512 < 660) *(LAS u32x4*)(RAWL + pr1 * 160 + pc1 * 8) = pf1;
        const u32x2 rc = prc, kc = pkc, vc = pvc, rp = prp, kp = pkp, vp = pvp;
        __syncthreads();
#ifdef REP_PREP
#pragma unroll 1
        for (int rep_ = 0; rep_ < 2; ++rep_) {
#endif
        { const LAS unsigned* rc = (const LAS unsigned*)(RAWL + (s1tok + 1) * 160 + 10 * s1cg); const LAS unsigned* rq = (const LAS unsigned*)(RAWL + s1tok * 160 + 10 * s1cg);
          LAS unsigned* xo = (LAS unsigned*)(X + s1tok * XSTR + 10 * s1cg);
#pragma unroll
          for (int u2 = 0; u2 < 5; ++u2) { const unsigned cw = rc[u2], pw = rq[u2]; float vv2[2];
#pragma unroll
              for (int hh = 0; hh < 2; ++hh) { const int u = 2 * u2 + hh; const float cur = hh ? bfhi(cw) : bflo(cw), prev = hh ? bfhi(pw) : bflo(pw); const float sft = cur + (prev - cur) * s1mu[u];
                  const int jcol = 10 * s1cg + u; const float K = jcol < 32 ? 2.8853900817779268f : -1.4426950408889634f; const float t = __builtin_amdgcn_rcpf(1.f + __builtin_amdgcn_exp2f(K * sft));
                  vv2[hh] = jcol < 32 ? 1.f - 2.f * t : (jcol < 64 ? sft : t); }
              xo[u2] = pk2(vv2[0], vv2[1]); } }
        __syncthreads();
        float rs[4], vs[4], dec[4], av[4], kkr[4], k2[4], gv[4];
        { const LAS bf16* xr = X + (16 * nt + n16) * XSTR + 8 * q;
          const bf16x8 B0 = *(const LAS bf16x8*)xr, B1 = *(const LAS bf16x8*)(xr + 32), B2 = *(const LAS bf16x8*)(xr + 64), B3 = *(const LAS bf16x8*)(xr + 96), B4 = *(const LAS bf16x8*)(xr + 128);
          f32x4v cw = {0.f, 0.f, 0.f, 0.f}, ca = cw, cg = cw;
          cw = __builtin_amdgcn_mfma_f32_16x16x32_bf16(Aw, B0, cw, 0, 0, 0); ca = __builtin_amdgcn_mfma_f32_16x16x32_bf16(Aa, B1, ca, 0, 0, 0);
          cg = __builtin_amdgcn_mfma_f32_16x16x32_bf16(Ag0, B2, cg, 0, 0, 0); cg = __builtin_amdgcn_mfma_f32_16x16x32_bf16(Ag1, B3, cg, 0, 0, 0); cg = __builtin_amdgcn_mfma_f32_16x16x32_bf16(Ag2, B4, cg, 0, 0, 0);
          const int ch0 = 16 * mt + 4 * q;
          const f32x4v mur = *(const LAS f32x4v*)&L[L2_PAR + ch0], muk = *(const LAS f32x4v*)&L[L2_PAR + 64 + ch0], muv = *(const LAS f32x4v*)&L[L2_PAR + 128 + ch0], w0v = *(const LAS f32x4v*)&L[L2_PAR + 192 + ch0];
          const f32x4v a0v = *(const LAS f32x4v*)&L[L2_PAR + 256 + ch0], kkv = *(const LAS f32x4v*)&L[L2_PAR + 320 + ch0], kav = *(const LAS f32x4v*)&L[L2_PAR + 384 + ch0], rkv = *(const LAS f32x4v*)&L[L2_PAR + 448 + ch0];
          const float rcf[4] = {bflo(rc.x), bfhi(rc.x), bflo(rc.y), bfhi(rc.y)}, rpf[4] = {bflo(rp.x), bfhi(rp.x), bflo(rp.y), bfhi(rp.y)};
          const float kcf[4] = {bflo(kc.x), bfhi(kc.x), bflo(kc.y), bfhi(kc.y)}, kpf[4] = {bflo(kp.x), bfhi(kp.x), bflo(kp.y), bfhi(kp.y)};
          const float vcf[4] = {bflo(vc.x), bfhi(vc.x), bflo(vc.y), bfhi(vc.y)}, vpf[4] = {bflo(vp.x), bfhi(vp.x), bflo(vp.y), bfhi(vp.y)};
          float ss = 0.f, bon = 0.f, sbar = 0.f, kr = 0.f;
#pragma unroll
          for (int r = 0; r < 4; ++r) { rs[r] = rcf[r] + (rpf[r] - rcf[r]) * mur[r]; const float ks_ = kcf[r] + (kpf[r] - kcf[r]) * muk[r]; vs[r] = vcf[r] + (vpf[r] - vcf[r]) * muv[r];
              const float wl = w0v[r] + cw[r], al = a0v[r] + ca[r]; gv[r] = cg[r];
              const float wlog = fminf(wl, 0.f) - __logf(1.f + __expf(-fabsf(wl))) - 0.5f; dec[r] = __expf(-__expf(wlog));
              av[r] = __builtin_amdgcn_rcpf(1.f + __expf(-al)); kkr[r] = ks_ * kkv[r]; k2[r] = ks_ * (1.f + (av[r] - 1.f) * kav[r]);
              ss += kkr[r] * kkr[r]; bon += rs[r] * k2[r] * rkv[r]; sbar += kkr[r] * av[r] * rs[r]; kr += k2[r] * rs[r]; }
          ss = hswap16_add(ss, ss); ss = hswap32_add(ss, ss); bon = hswap16_add(bon, bon); bon = hswap32_add(bon, bon); sbar = hswap16_add(sbar, sbar); sbar = hswap32_add(sbar, sbar); kr = hswap16_add(kr, kr); kr = hswap32_add(kr, kr);
          if (q == 0) *(LAS f32x4v*)&L[L2_PART + ((16 * nt + n16) * 4 + mt) * 4] = (f32x4v){ss, bon, sbar, kr}; }
        __syncthreads();
        { const int tok = 16 * nt + n16, ch0 = 16 * mt + 4 * q;
          const f32x4v p0 = *(const LAS f32x4v*)&L[L2_PART + tok * 16], p1 = *(const LAS f32x4v*)&L[L2_PART + tok * 16 + 4], p2 = *(const LAS f32x4v*)&L[L2_PART + tok * 16 + 8], p3 = *(const LAS f32x4v*)&L[L2_PART + tok * 16 + 12];
          const float ss = (p0[0] + p1[0]) + (p2[0] + p3[0]), bon = (p0[1] + p1[1]) + (p2[1] + p3[1]), sbar = (p0[2] + p1[2]) + (p2[2] + p3[2]), kr = (p0[3] + p1[3]) + (p2[3] + p3[3]);
          const float rn = __builtin_amdgcn_rcpf(fmaxf(sqrtf(ss), 1e-12f));
          f32x4v o_a2, o_wr, o_w, o_b2, o_k2, o_v, o_g;
#pragma unroll
          for (int r = 0; r < 4; ++r) { const float kkn = kkr[r] * rn; o_a2[r] = -kkn; o_b2[r] = kkn * av[r]; o_wr[r] = dec[r] * rs[r]; o_w[r] = dec[r]; o_k2[r] = k2[r]; o_v[r] = vs[r]; o_g[r] = gv[r]; }
          const int o = L2_VEC + tok * 64 + ch0;
          *(LAS f32x4v*)&L[o] = o_a2; *(LAS f32x4v*)&L[o + 2048] = o_wr; *(LAS f32x4v*)&L[o + 4096] = o_w; *(LAS f32x4v*)&L[o + 6144] = o_b2; *(LAS f32x4v*)&L[o + 8192] = o_k2; *(LAS f32x4v*)&L[o + 10240] = o_v; *(LAS f32x4v*)&L[o + 12288] = o_g;
          if (mt == 0 && q == 0) { L[L2_SC + 2 * tok] = sbar * rn; L[L2_SC + 2 * tok + 1] = kr; L[L2_SC + 64 + tok] = bon; } }
        __syncthreads();
#ifdef REP_PREP
        }
#endif
        if (t0 + 32 < 2048) RWKV_PREFETCH(t0 + 32)
        { const int rp = tid >> 4, jb = tid & 15; const int vb = L2_VEC + 4 * jb;
          f32x4v na = *(const LAS f32x4v*)&L[vb], nr = *(const LAS f32x4v*)&L[vb + 2048], nw = *(const LAS f32x4v*)&L[vb + 4096], nb = *(const LAS f32x4v*)&L[vb + 6144], nk = *(const LAS f32x4v*)&L[vb + 8192];
          f32x2s nv = *(const LAS f32x2s*)&L[L2_VEC + 10240 + 2 * rp], nsc = *(const LAS f32x2s*)&L[L2_SC];
#pragma unroll 2
          for (int tok = 0; tok < 32; ++tok) {
              const f32x4v av = na, rv = nr, wv = nw, bv = nb, kv = nk; const f32x2s vv = nv, sc = nsc;
              { const int tn = min(tok + 1, 31); const int o = vb + tn * 64;
                na = *(const LAS f32x4v*)&L[o]; nr = *(const LAS f32x4v*)&L[o + 2048]; nw = *(const LAS f32x4v*)&L[o + 4096]; nb = *(const LAS f32x4v*)&L[o + 6144]; nk = *(const LAS f32x4v*)&L[o + 8192];
                nv = *(const LAS f32x2s*)&L[L2_VEC + 10240 + tn * 64 + 2 * rp]; nsc = *(const LAS f32x2s*)&L[L2_SC + 2 * tn]; }
              f32x2s p1 = S2[0] * av[0]; p1 = S2[1] * av[1] + p1; p1 = S2[2] * av[2] + p1; p1 = S2[3] * av[3] + p1;
              f32x2s p2 = S2[0] * rv[0]; p2 = S2[1] * rv[1] + p2; p2 = S2[2] * rv[2] + p2; p2 = S2[3] * rv[3] + p2;
              { float r0 = p1.x, r1 = p1.y, r2 = p2.x, r3 = p2.y;
                asm volatile("s_nop 1\n\t"
                    "v_add_f32_dpp %0, %0, %0 quad_perm:[1,0,3,2] row_mask:0xf bank_mask:0xf bound_ctrl:1\n\tv_add_f32_dpp %1, %1, %1 quad_perm:[1,0,3,2] row_mask:0xf bank_mask:0xf bound_ctrl:1\n\t"
                    "v_add_f32_dpp %2, %2, %2 quad_perm:[1,0,3,2] row_mask:0xf bank_mask:0xf bound_ctrl:1\n\tv_add_f32_dpp %3, %3, %3 quad_perm:[1,0,3,2] row_mask:0xf bank_mask:0xf bound_ctrl:1\n\t"
                    "v_add_f32_dpp %0, %0, %0 quad_perm:[2,3,0,1] row_mask:0xf bank_mask:0xf bound_ctrl:1\n\tv_add_f32_dpp %1, %1, %1 quad_perm:[2,3,0,1] row_mask:0xf bank_mask:0xf bound_ctrl:1\n\t"
                    "v_add_f32_dpp %2, %2, %2 quad_perm:[2,3,0,1] row_mask:0xf bank_mask:0xf bound_ctrl:1\n\tv_add_f32_dpp %3, %3, %3 quad_perm:[2,3,0,1] row_mask:0xf bank_mask:0xf bound_ctrl:1\n\t"
                    "v_add_f32_dpp %0, %0, %0 row_half_mirror row_mask:0xf bank_mask:0xf bound_ctrl:1\n\tv_add_f32_dpp %1, %1, %1 row_half_mirror row_mask:0xf bank_mask:0xf bound_ctrl:1\n\t"
                    "v_add_f32_dpp %2, %2, %2 row_half_mirror row_mask:0xf bank_mask:0xf bound_ctrl:1\n\tv_add_f32_dpp %3, %3, %3 row_half_mirror row_mask:0xf bank_mask:0xf bound_ctrl:1\n\t"
                    "v_add_f32_dpp %0, %0, %0 row_mirror row_mask:0xf bank_mask:0xf bound_ctrl:1\n\tv_add_f32_dpp %1, %1, %1 row_mirror row_mask:0xf bank_mask:0xf bound_ctrl:1\n\t"
                    "v_add_f32_dpp %2, %2, %2 row_mirror row_mask:0xf bank_mask:0xf bound_ctrl:1\n\tv_add_f32_dpp %3, %3, %3 row_mirror row_mask:0xf bank_mask:0xf bound_ctrl:1\n\ts_nop 1"
                    : "+v"(r0), "+v"(r1), "+v"(r2), "+v"(r3));
                p1 = (f32x2s){r0, r1}; p2 = (f32x2s){r2, r3}; }
              const f32x2s y = p2 + p1 * sc.x + vv * sc.y;
#pragma unroll
              for (int c4 = 0; c4 < 4; ++c4) S2[c4] = S2[c4] * wv[c4] + (p1 * bv[c4] + vv * kv[c4]);
              if (jb == 0) *(LAS f32x2s*)&L[L2_Y + tok * 64 + 2 * rp] = y; } }
        __syncthreads();
        { const int tok = tid >> 4, ch0 = (tid & 15) * 4;
          const f32x4v y = *(const LAS f32x4v*)&L[L2_Y + tok * 64 + ch0], vv = *(const LAS f32x4v*)&L[L2_VEC + 10240 + tok * 64 + ch0], gg = *(const LAS f32x4v*)&L[L2_VEC + 12288 + tok * 64 + ch0];
          const f32x4v lg = *(const LAS f32x4v*)&L[L2_PAR + 512 + ch0], lb = *(const LAS f32x4v*)&L[L2_PAR + 576 + ch0];
          const float mean = reduce16((y[0] + y[1]) + (y[2] + y[3])) * (1.f / 64.f);
          const f32x4v d = y - mean; const float var = reduce16((d[0] * d[0] + d[1] * d[1]) + (d[2] * d[2] + d[3] * d[3])) * (1.f / 64.f);
          const float rstd = __builtin_amdgcn_rsqf(var + 64e-5f), bon = L[L2_SC + 64 + tok];
          const f32x4v o = (d * rstd * lg + lb + vv * bon) * gg;
          u32x2 w; w.x = pk2(o[0], o[1]); w.y = pk2(o[2], o[3]);
          *(u32x2*)(CAT + (row0 + t0 + tok) * 1024 + 512 + h * 64 + ch0) = w; }
    }
#undef RWKV_PREFETCH
    __syncthreads();
}

constexpr int L3_TS = 68, L3_AS = 32 * L3_TS;
constexpr int L3_PAR = 0, L3_SC = 832, L3_VEC = 1280, L3_VSZ = 6 * L3_AS + 1088, L3_Y = L3_VEC + 2 * L3_VSZ;
constexpr int L3_RAWB = (L3_Y + 2048) * 4, L3_PWSZ = 5632, L3_XB = L3_RAWB + 2 * L3_PWSZ;
#define R3_STEP(ctrl) \
    "v_add_f32_dpp %0, %0, %0 " ctrl " row_mask:0xf bank_mask:0xf bound_ctrl:1\n\tv_add_f32_dpp %1, %1, %1 " ctrl " row_mask:0xf bank_mask:0xf bound_ctrl:1\n\t" \
    "v_add_f32_dpp %2, %2, %2 " ctrl " row_mask:0xf bank_mask:0xf bound_ctrl:1\n\tv_add_f32_dpp %3, %3, %3 " ctrl " row_mask:0xf bank_mask:0xf bound_ctrl:1\n\t" \
    "v_add_f32_dpp %4, %4, %4 " ctrl " row_mask:0xf bank_mask:0xf bound_ctrl:1\n\tv_add_f32_dpp %5, %5, %5 " ctrl " row_mask:0xf bank_mask:0xf bound_ctrl:1\n\t" \
    "v_add_f32_dpp %6, %6, %6 " ctrl " row_mask:0xf bank_mask:0xf bound_ctrl:1\n\tv_add_f32_dpp %7, %7, %7 " ctrl " row_mask:0xf bank_mask:0xf bound_ctrl:1\n\t"
__device__ __forceinline__ void cvt_row_store(const Args& a, int layer, int row, int lane, f32x4 v0, f32x4 v1, f32x4 v2, f32x4 v3) {
    unsigned char* U8 = a.ws + WS_EXP + (size_t)layer * 48 * MiB; unsigned char* VS8 = a.ws + WS_EXP + (size_t)layer * 48 * MiB + 16 * MiB; float* SC = (float*)(a.ws + WS_EXP + (size_t)layer * 48 * MiB + 32 * MiB);
    const int e = row & 16383; const bool isv = row >= 16384;
    float am = fmaxf(fmaxf(fmaxf(fabsf(v0.x), fabsf(v0.y)), fmaxf(fabsf(v0.z), fabsf(v0.w))), fmaxf(fmaxf(fabsf(v1.x), fabsf(v1.y)), fmaxf(fabsf(v1.z), fabsf(v1.w))));
    am = fmaxf(am, fmaxf(fmaxf(fmaxf(fabsf(v2.x), fabsf(v2.y)), fmaxf(fabsf(v2.z), fabsf(v2.w))), fmaxf(fmaxf(fabsf(v3.x), fabsf(v3.y)), fmaxf(fabsf(v3.z), fabsf(v3.w)))));
    int ai = __float_as_int(am);
    ai = max(ai, __builtin_amdgcn_mov_dpp(ai, 0xB1, 0xF, 0xF, true)); ai = max(ai, __builtin_amdgcn_mov_dpp(ai, 0x4E, 0xF, 0xF, true));
    ai = max(ai, __builtin_amdgcn_mov_dpp(ai, 0x141, 0xF, 0xF, true)); ai = max(ai, __builtin_amdgcn_mov_dpp(ai, 0x140, 0xF, 0xF, true));
    ai = max(max(__builtin_amdgcn_readlane(ai, 0), __builtin_amdgcn_readlane(ai, 16)), max(__builtin_amdgcn_readlane(ai, 32), __builtin_amdgcn_readlane(ai, 48)));
    am = __int_as_float(ai);
    const float sc = am > 0.f ? am * (1.f / 448.f) : 1.f, inv = am > 0.f ? 448.f * __builtin_amdgcn_rcpf(am) : 1.f;
    u32x4 o; int w;
    asm volatile("" : "=v"(w)); w = __builtin_amdgcn_cvt_pk_fp8_f32(v0.x * inv, v0.y * inv, w, false); w = __builtin_amdgcn_cvt_pk_fp8_f32(v0.z * inv, v0.w * inv, w, true); o.x = (unsigned)w;
    asm volatile("" : "=v"(w)); w = __builtin_amdgcn_cvt_pk_fp8_f32(v1.x * inv, v1.y * inv, w, false); w = __builtin_amdgcn_cvt_pk_fp8_f32(v1.z * inv, v1.w * inv, w, true); o.y = (unsigned)w;
    asm volatile("" : "=v"(w)); w = __builtin_amdgcn_cvt_pk_fp8_f32(v2.x * inv, v2.y * inv, w, false); w = __builtin_amdgcn_cvt_pk_fp8_f32(v2.z * inv, v2.w * inv, w, true); o.z = (unsigned)w;
    asm volatile("" : "=v"(w)); w = __builtin_amdgcn_cvt_pk_fp8_f32(v3.x * inv, v3.y * inv, w, false); w = __builtin_amdgcn_cvt_pk_fp8_f32(v3.z * inv, v3.w * inv, w, true); o.w = (unsigned)w;
    unsigned char* dst = (isv ? VS8 : U8) + ((size_t)(lane >> 3) * 16384 + e) * 128 + (lane & 7) * 16;
    *(u32x4*)dst = o;
    if (lane == 0) SC[2 * e + (isv ? 1 : 0)] = sc;
}
__device__ __forceinline__ void rwkv_unit3(const Args& a, LAS float* L, int unit, int i2, const bf16* P, bf16* CAT, int tid) {
    typedef float f32x4v __attribute__((ext_vector_type(4)));
    typedef float f32x2s __attribute__((ext_vector_type(2)));
    constexpr int PS = EVEN_PAD;
    const int b = unit >> 3, h = unit & 7, lane = tid & 63, wave = __builtin_amdgcn_readfirstlane(tid >> 6);
    const float* mu = a.in[5] + i2 * 1696;
    if (tid < 64) { const int c = tid, col = h * 64 + c; L[L3_PAR + c] = mu[col]; L[L3_PAR + 64 + c] = mu[512 + col]; L[L3_PAR + 128 + c] = mu[1024 + col]; L[L3_PAR + 192 + c] = (a.in[6] + i2 * 512)[col];
        L[L3_PAR + 256 + c] = (a.in[8] + i2 * 512)[col]; L[L3_PAR + 320 + c] = (a.in[11] + i2 * 512)[col]; L[L3_PAR + 384 + c] = (a.in[12] + i2 * 512)[col]; L[L3_PAR + 448 + c] = (a.in[13] + i2 * 512)[col];
        L[L3_PAR + 512 + c] = (a.in[14] + i2 * 512)[col]; L[L3_PAR + 576 + c] = (a.in[15] + i2 * 512)[col]; }
    if (tid < 160) L[L3_PAR + 640 + tid] = mu[1536 + tid];
    __syncthreads();
    const size_t row0 = (size_t)b * 2048;
    if (wave < 4) {
        const int rp = tid >> 3, jb = tid & 7;
        f32x2s S2[8];
#pragma unroll
        for (int e = 0; e < 8; ++e) S2[e] = (f32x2s){0.f, 0.f};
        __syncthreads();
        __builtin_amdgcn_s_setprio(3);
#define R3_STEP4(ctrl) \
    "v_add_f32_dpp %0, %0, %0 " ctrl " row_mask:0xf bank_mask:0xf bound_ctrl:1\n\tv_add_f32_dpp %1, %1, %1 " ctrl " row_mask:0xf bank_mask:0xf bound_ctrl:1\n\t" \
    "v_add_f32_dpp %2, %2, %2 " ctrl " row_mask:0xf bank_mask:0xf bound_ctrl:1\n\tv_add_f32_dpp %3, %3, %3 " ctrl " row_mask:0xf bank_mask:0xf bound_ctrl:1\n\t"
#pragma unroll 1
        for (int it = 0; it < 66; ++it) {
            if (it >= 1 && it <= 64) {
                const int bs = (it - 1) & 1; const int vb = L3_VEC + bs * L3_VSZ + 8 * jb, vv0 = L3_VEC + bs * L3_VSZ + 5 * L3_AS + 2 * rp, sc0 = L3_SC + bs * 128; LAS bf16* yb = (LAS bf16*)&L[L3_Y + bs * 1024] + 2 * rp;
                f32x4v na0 = *(const LAS f32x4v*)&L[vb], na1 = *(const LAS f32x4v*)&L[vb + 4], nr0 = *(const LAS f32x4v*)&L[vb + 1 * L3_AS], nr1 = *(const LAS f32x4v*)&L[vb + 1 * L3_AS + 4], nw0 = *(const LAS f32x4v*)&L[vb + 2 * L3_AS], nw1 = *(const LAS f32x4v*)&L[vb + 2 * L3_AS + 4];
                f32x4v nb0 = *(const LAS f32x4v*)&L[vb + 3 * L3_AS], nb1 = *(const LAS f32x4v*)&L[vb + 3 * L3_AS + 4], nk0 = *(const LAS f32x4v*)&L[vb + 4 * L3_AS], nk1 = *(const LAS f32x4v*)&L[vb + 4 * L3_AS + 4];
                f32x2s nv = *(const LAS f32x2s*)&L[vv0]; f32x4v nsc = *(const LAS f32x4v*)&L[sc0];
#pragma unroll 2
                for (int tok = 0; tok < 32; ++tok) {
                    const float av[8] = {na0[0], na0[1], na0[2], na0[3], na1[0], na1[1], na1[2], na1[3]}, rv[8] = {nr0[0], nr0[1], nr0[2], nr0[3], nr1[0], nr1[1], nr1[2], nr1[3]};
                    const float wv[8] = {nw0[0], nw0[1], nw0[2], nw0[3], nw1[0], nw1[1], nw1[2], nw1[3]}, bv[8] = {nb0[0], nb0[1], nb0[2], nb0[3], nb1[0], nb1[1], nb1[2], nb1[3]};
                    const float kv[8] = {nk0[0], nk0[1], nk0[2], nk0[3], nk1[0], nk1[1], nk1[2], nk1[3]}; const f32x2s vv = nv; const f32x4v sc = nsc;
                    { const int tn = min(tok + 1, 31); const int o = vb + tn * L3_TS;
                      na0 = *(const LAS f32x4v*)&L[o]; na1 = *(const LAS f32x4v*)&L[o + 4]; nr0 = *(const LAS f32x4v*)&L[o + 1 * L3_AS]; nr1 = *(const LAS f32x4v*)&L[o + 1 * L3_AS + 4]; nw0 = *(const LAS f32x4v*)&L[o + 2 * L3_AS]; nw1 = *(const LAS f32x4v*)&L[o + 2 * L3_AS + 4];
                      nb0 = *(const LAS f32x4v*)&L[o + 3 * L3_AS]; nb1 = *(const LAS f32x4v*)&L[o + 3 * L3_AS + 4]; nk0 = *(const LAS f32x4v*)&L[o + 4 * L3_AS]; nk1 = *(const LAS f32x4v*)&L[o + 4 * L3_AS + 4];
                      nv = *(const LAS f32x2s*)&L[vv0 + tn * L3_TS]; nsc = *(const LAS f32x4v*)&L[sc0 + 4 * tn]; }
                    f32x2s pa = S2[0] * av[0], pb = S2[4] * av[4], qa = S2[0] * rv[0], qb = S2[4] * rv[4];
                    __builtin_amdgcn_sched_barrier(0);
                    pa = S2[1] * av[1] + pa; pb = S2[5] * av[5] + pb; qa = S2[1] * rv[1] + qa; qb = S2[5] * rv[5] + qb;
                    __builtin_amdgcn_sched_barrier(0);
                    pa = S2[2] * av[2] + pa; pb = S2[6] * av[6] + pb; qa = S2[2] * rv[2] + qa; qb = S2[6] * rv[6] + qb;
                    __builtin_amdgcn_sched_barrier(0);
                    pa = S2[3] * av[3] + pa; pb = S2[7] * av[7] + pb; qa = S2[3] * rv[3] + qa; qb = S2[7] * rv[7] + qb;
                    __builtin_amdgcn_sched_barrier(0);
                    pa = pa + pb; qa = qa + qb;
                    f32x2s u[8];
#pragma unroll
                    for (int c = 0; c < 8; ++c) u[c] = vv * kv[c];
                    __builtin_amdgcn_sched_barrier(0);
                    { float r0 = pa.x, r1 = pa.y, r2 = qa.x, r3 = qa.y;
                      asm volatile("s_nop 1\n\t" R3_STEP4("quad_perm:[1,0,3,2]") R3_STEP4("quad_perm:[2,3,0,1]") R3_STEP4("row_half_mirror") "s_nop 1"
                          : "+v"(r0), "+v"(r1), "+v"(r2), "+v"(r3));
                      pa = (f32x2s){r0, r1} * sc[2]; qa = (f32x2s){r2, r3}; }
                    const f32x2s y = qa + pa * sc[0] + vv * sc[1];
                    __builtin_amdgcn_sched_barrier(0);
#pragma unroll
                    for (int c = 0; c < 8; ++c) u[c] = pa * bv[c] + u[c];
                    __builtin_amdgcn_sched_barrier(0);
#pragma unroll
                    for (int c = 0; c < 8; ++c) S2[c] = S2[c] * wv[c] + u[c];
                    __builtin_amdgcn_sched_barrier(0);
                    if (jb == 0) *(LAS unsigned*)(yb + tok * 64) = pk2(y.x, y.y); }
            }
            __syncthreads();
        }
#undef R3_STEP4
        __builtin_amdgcn_s_setprio(0);
    } else if (wave < 6) {
        const int nt = wave - 4, n16 = lane & 15, q = lane >> 4;
        u32x4 AOP[4][5];
#pragma unroll
        for (int mt = 0; mt < 4; ++mt) { const int col = h * 64 + 16 * mt + n16; const float* w2 = a.in[7] + i2 * 32 * 512 + col; const float* a2 = a.in[9] + i2 * 32 * 512 + col; const float* g2 = a.in[10] + i2 * 96 * 512 + col;
            u32x4 t;
#define LDF(op, src, k0) t.x = pk2(src[((k0) + 8 * q + 0) * 512], src[((k0) + 8 * q + 1) * 512]); t.y = pk2(src[((k0) + 8 * q + 2) * 512], src[((k0) + 8 * q + 3) * 512]); \
            t.z = pk2(src[((k0) + 8 * q + 4) * 512], src[((k0) + 8 * q + 5) * 512]); t.w = pk2(src[((k0) + 8 * q + 6) * 512], src[((k0) + 8 * q + 7) * 512]); AOP[mt][op] = t;
            LDF(0, w2, 0) LDF(1, a2, 0) LDF(2, g2, 0) LDF(3, g2, 32) LDF(4, g2, 64)
#undef LDF
        }
        u32x2 qrc[4], qkc[4], qvc[4], qrp[4], qkp[4], qvp[4];
#define R3_QUADS(tt) { const size_t t_ = (size_t)(tt); const bf16* pr = P + (row0 + t_) * PS + h * 64 + 4 * q; const bf16* pp = P + (row0 + (t_ > 0 ? t_ - 1 : 0)) * PS + h * 64 + 4 * q; \
            _Pragma("unroll") for (int mt = 0; mt < 4; ++mt) { qrc[mt] = *(const u32x2*)(pr + R_R + 16 * mt); qkc[mt] = *(const u32x2*)(pr + R_K + 16 * mt); qvc[mt] = *(const u32x2*)(pr + R_V + 16 * mt); \
                qrp[mt] = *(const u32x2*)(pp + R_R + 16 * mt); qkp[mt] = *(const u32x2*)(pp + R_K + 16 * mt); qvp[mt] = *(const u32x2*)(pp + R_V + 16 * mt); } }
        R3_QUADS(16 * nt + n16)
        __syncthreads();
#pragma unroll 1
        for (int it = 0; it < 66; ++it) {
            if (it >= 2) {
                const int c = it - 2, bs = c & 1, tok = 16 * nt + (lane >> 2), cb = 16 * (lane & 3);
                const LAS bf16* yp = (const LAS bf16*)&L[L3_Y + bs * 1024] + tok * 64 + cb; const int vo = L3_VEC + bs * L3_VSZ + 5 * L3_AS + tok * L3_TS + cb; const LAS bf16* gp = (const LAS bf16*)&L[L3_VEC + bs * L3_VSZ + 6 * L3_AS] + tok * L3_TS + cb;
                f32x4v y[4]; float s = 0.f;
#pragma unroll
                for (int k = 0; k < 4; ++k) { const u32x2 yw = *(const LAS u32x2*)(yp + 4 * k); y[k] = (f32x4v){bflo(yw.x), bfhi(yw.x), bflo(yw.y), bfhi(yw.y)}; s += (y[k][0] + y[k][1]) + (y[k][2] + y[k][3]); }
                s += dpp_f<0xB1>(s); s += dpp_f<0x4E>(s); const float mean = s * (1.f / 64.f); float s2 = 0.f;
#pragma unroll
                for (int k = 0; k < 4; ++k) { y[k] = y[k] - mean; s2 += (y[k][0] * y[k][0] + y[k][1] * y[k][1]) + (y[k][2] * y[k][2] + y[k][3] * y[k][3]); }
                s2 += dpp_f<0xB1>(s2); s2 += dpp_f<0x4E>(s2);
                const float rstd = __builtin_amdgcn_rsqf(s2 * (1.f / 64.f) + 64e-5f), bon = L[L3_SC + bs * 128 + 4 * tok + 3];
                u32x4 w0, w1;
#pragma unroll
                for (int k = 0; k < 4; ++k) { const u32x2 gw = *(const LAS u32x2*)(gp + 4 * k); const f32x4v vv = *(const LAS f32x4v*)&L[vo + 4 * k], gg = {bflo(gw.x), bfhi(gw.x), bflo(gw.y), bfhi(gw.y)}, lg = *(const LAS f32x4v*)&L[L3_PAR + 512 + cb + 4 * k], lb = *(const LAS f32x4v*)&L[L3_PAR + 576 + cb + 4 * k];
                    f32x4v o = (y[k] * rstd * lg + lb + vv * bon) * gg;
                    const unsigned lo_ = pk2(o[0], o[1]), hi_ = pk2(o[2], o[3]);
                    if (k == 0) { w0.x = lo_; w0.y = hi_; } else if (k == 1) { w0.z = lo_; w0.w = hi_; } else if (k == 2) { w1.x = lo_; w1.y = hi_; } else { w1.z = lo_; w1.w = hi_; } }
                u32x4* dst = (u32x4*)(CAT + (row0 + c * 32 + tok) * 1024 + 512 + h * 64 + cb); dst[0] = w0; dst[1] = w1;
            }
            LDS_WAIT();
            if (it < 64) {
                const int t0 = it * 32, bs = it & 1, tok = 16 * nt + n16; const size_t t = (size_t)(t0 + tok);
                const LAS bf16* XS = (const LAS bf16*)((LAS unsigned char*)L + L3_XB + ((it & 1) * 2 + nt) * L3_PWSZ);
                const LAS bf16* xr = XS + n16 * XSTR + 8 * q;
                float ss = 0.f, bon = 0.f, sbar = 0.f, kr = 0.f;
                const int ob = L3_VEC + bs * L3_VSZ + tok * L3_TS + 4 * q;
#pragma unroll
                for (int mt = 0; mt < 4; ++mt) {
                    const u32x2 z2_ = {0u, 0u}; const u32x2 rc = qrc[mt], kc = qkc[mt], vc = qvc[mt], rp = t == 0 ? z2_ : qrp[mt], kp = t == 0 ? z2_ : qkp[mt], vp = t == 0 ? z2_ : qvp[mt];
                    f32x4v cw = {0.f, 0.f, 0.f, 0.f}, ca = cw, cg = cw;
                    { const bf16x8 B0 = *(const LAS bf16x8*)xr, B1 = *(const LAS bf16x8*)(xr + 32), B2 = *(const LAS bf16x8*)(xr + 64), B3 = *(const LAS bf16x8*)(xr + 96), B4 = *(const LAS bf16x8*)(xr + 128);
                      cw = __builtin_amdgcn_mfma_f32_16x16x32_bf16(__builtin_bit_cast(bf16x8, AOP[mt][0]), B0, cw, 0, 0, 0); ca = __builtin_amdgcn_mfma_f32_16x16x32_bf16(__builtin_bit_cast(bf16x8, AOP[mt][1]), B1, ca, 0, 0, 0);
                      cg = __builtin_amdgcn_mfma_f32_16x16x32_bf16(__builtin_bit_cast(bf16x8, AOP[mt][2]), B2, cg, 0, 0, 0); cg = __builtin_amdgcn_mfma_f32_16x16x32_bf16(__builtin_bit_cast(bf16x8, AOP[mt][3]), B3, cg, 0, 0, 0);
                      cg = __builtin_amdgcn_mfma_f32_16x16x32_bf16(__builtin_bit_cast(bf16x8, AOP[mt][4]), B4, cg, 0, 0, 0);
                    }
                    const int ch0 = 16 * mt + 4 * q;
                    const f32x4v mur = *(const LAS f32x4v*)&L[L3_PAR + ch0], muk = *(const LAS f32x4v*)&L[L3_PAR + 64 + ch0], muv = *(const LAS f32x4v*)&L[L3_PAR + 128 + ch0], w0v = *(const LAS f32x4v*)&L[L3_PAR + 192 + ch0];
                    const f32x4v a0v = *(const LAS f32x4v*)&L[L3_PAR + 256 + ch0], kkv = *(const LAS f32x4v*)&L[L3_PAR + 320 + ch0], kav = *(const LAS f32x4v*)&L[L3_PAR + 384 + ch0], rkv = *(const LAS f32x4v*)&L[L3_PAR + 448 + ch0];
                    const float rcf[4] = {bflo(rc.x), bfhi(rc.x), bflo(rc.y), bfhi(rc.y)}, rpf[4] = {bflo(rp.x), bfhi(rp.x), bflo(rp.y), bfhi(rp.y)};
                    const float kcf[4] = {bflo(kc.x), bfhi(kc.x), bflo(kc.y), bfhi(kc.y)}, kpf[4] = {bflo(kp.x), bfhi(kp.x), bflo(kp.y), bfhi(kp.y)};
                    const float vcf[4] = {bflo(vc.x), bfhi(vc.x), bflo(vc.y), bfhi(vc.y)}, vpf[4] = {bflo(vp.x), bfhi(vp.x), bflo(vp.y), bfhi(vp.y)};
                    f32x4v o_a2, o_b2, o_wr, o_w, o_k2, o_v, o_g;
#pragma unroll
                    for (int r = 0; r < 4; ++r) { const float rs = rcf[r] + (rpf[r] - rcf[r]) * mur[r]; const float ks_ = kcf[r] + (kpf[r] - kcf[r]) * muk[r]; const float vs = vcf[r] + (vpf[r] - vcf[r]) * muv[r];
                        const float wl = w0v[r] + cw[r], al = a0v[r] + ca[r];
                        const float dec = __expf(-0.6065306597126334f * __builtin_amdgcn_rcpf(1.f + __expf(-wl)));
                        const float avr = __builtin_amdgcn_rcpf(1.f + __expf(-al)); const float kk = ks_ * kkv[r]; const float k2 = ks_ * (1.f + (avr - 1.f) * kav[r]);
                        ss += kk * kk; bon += rs * k2 * rkv[r]; sbar += kk * avr * rs; kr += k2 * rs;
                        o_a2[r] = -kk; o_b2[r] = kk * avr; o_wr[r] = dec * rs; o_w[r] = dec; o_k2[r] = k2; o_v[r] = vs; o_g[r] = cg[r]; }
                    const int o = ob + 16 * mt;
                    *(LAS f32x4v*)&L[o] = o_a2; *(LAS f32x4v*)&L[o + 1 * L3_AS] = o_wr; *(LAS f32x4v*)&L[o + 2 * L3_AS] = o_w; *(LAS f32x4v*)&L[o + 3 * L3_AS] = o_b2; *(LAS f32x4v*)&L[o + 4 * L3_AS] = o_k2; *(LAS f32x4v*)&L[o + 5 * L3_AS] = o_v;
                    *(LAS u32x2*)((LAS bf16*)&L[L3_VEC + bs * L3_VSZ + 6 * L3_AS] + tok * L3_TS + ch0) = (u32x2){pk2(o_g[0], o_g[1]), pk2(o_g[2], o_g[3])};
                }
                ss = hswap16_add(ss, ss); ss = hswap32_add(ss, ss); bon = hswap16_add(bon, bon); bon = hswap32_add(bon, bon); sbar = hswap16_add(sbar, sbar); sbar = hswap32_add(sbar, sbar); kr = hswap16_add(kr, kr); kr = hswap32_add(kr, kr);
                const float rn = __builtin_amdgcn_rcpf(fmaxf(sqrtf(ss), 1e-12f));
                if (q == 0) *(LAS f32x4v*)&L[L3_SC + bs * 128 + 4 * tok] = (f32x4v){sbar, kr, rn * rn, bon};
                if (it + 1 < 64) R3_QUADS(t0 + 32 + tok)
            }
            __syncthreads();
        }
    } else {
        const int nt = wave - 6;
        LAS bf16* RAWS = (LAS bf16*)((LAS unsigned char*)L + L3_RAWB + nt * L3_PWSZ);
        const int s1cg = lane & 15;
        u32x4 pf[6];
#define R3_PIECE(i) const int p_ = min(lane + 64 * (i), 339); const int prow_ = (p_ * 205) >> 12; const int ppc_ = p_ - 20 * prow_;
#define R3_PREFETCH(tq) { _Pragma("unroll") for (int i = 0; i < 6; ++i) { R3_PIECE(i) const int t_ = max((tq) - 1 + 16 * nt + prow_, 0); pf[i] = *(const u32x4*)(P + (row0 + t_) * PS + R_WL + ppc_ * 8); } }
        f32x2s XK2[5], XA2[5], XB2[5], XC2[5];
#pragma unroll
        for (int u2 = 0; u2 < 5; ++u2)
#pragma unroll
            for (int hh = 0; hh < 2; ++hh) { const int jcol = 10 * s1cg + 2 * u2 + hh; const bool th = jcol < 32, idn = !th && jcol < 64;
                XK2[u2][hh] = th ? 2.8853900817779268f : -1.4426950408889634f; XA2[u2][hh] = th ? -2.f : (idn ? 0.f : 1.f); XB2[u2][hh] = idn ? 1.f : 0.f; XC2[u2][hh] = th ? 1.f : 0.f; }
        R3_PREFETCH(0)
        f32x4 ca0 = {0.f, 0.f, 0.f, 0.f}, ca1 = ca0, ca2 = ca0, ca3 = ca0, cb0 = ca0, cb1 = ca0, cb2 = ca0, cb3 = ca0;
#pragma unroll 1
        for (int it = -1; it < 66; ++it) {
            if (it >= 0 && it < 64) {
                const int prho = (it * 512 + unit * 2 + nt) * 2; const int player = 2 * i2 + (prho >> 15), prow = prho & 32767;
                cvt_row_store(a, player, prow, lane, ca0, ca1, ca2, ca3); cvt_row_store(a, player, prow + 1, lane, cb0, cb1, cb2, cb3);
                __builtin_amdgcn_sched_barrier(0);
            }
            if (it + 1 < 64) {
                const int t0 = (it + 1) * 32;
                const int crho = ((it + 1) * 512 + unit * 2 + nt) * 2; const int clayer = 2 * i2 + (crho >> 15), crow = crho & 32767;
                const f32x4* c4 = (const f32x4*)(((crow >= 16384) ? a.in[24] : a.in[23]) + ((size_t)clayer * 16384 + (crow & 16383)) * 1024) + 4 * lane;
                ca0 = c4[0]; ca1 = c4[1]; ca2 = c4[2]; ca3 = c4[3]; cb0 = c4[256]; cb1 = c4[257]; cb2 = c4[258]; cb3 = c4[259];
                __builtin_amdgcn_sched_barrier(0);
                LAS bf16* XS = (LAS bf16*)((LAS unsigned char*)L + L3_XB + (((it + 1) & 1) * 2 + nt) * L3_PWSZ);
#pragma unroll
                for (int i = 0; i < 6; ++i) { R3_PIECE(i) u32x4 v = pf[i]; if (t0 - 1 + 16 * nt + prow_ < 0) v = (u32x4){0u, 0u, 0u, 0u}; *(LAS u32x4*)(RAWS + prow_ * 160 + ppc_ * 8) = v; }
                LDS_WAIT();
                if (it + 2 < 64) R3_PREFETCH(t0 + 32)
                { float s1mu[10];
#pragma unroll
                  for (int u2 = 0; u2 < 5; ++u2) { const f32x2s mm = *(const LAS f32x2s*)&L[L3_PAR + 640 + 10 * s1cg + 2 * u2]; s1mu[2 * u2] = mm.x; s1mu[2 * u2 + 1] = mm.y; }
                  unsigned cwa[4][5], pwa[4][5];
#pragma unroll
                  for (int ps = 0; ps < 4; ++ps) { const int tl = (lane >> 4) + 4 * ps;
                    const LAS unsigned* rcw = (const LAS unsigned*)(RAWS + (tl + 1) * 160 + 10 * s1cg); const LAS unsigned* rpw = (const LAS unsigned*)(RAWS + tl * 160 + 10 * s1cg);
#pragma unroll
                    for (int u2 = 0; u2 < 5; ++u2) { cwa[ps][u2] = rcw[u2]; pwa[ps][u2] = rpw[u2]; } }
#pragma unroll
                  for (int ps = 0; ps < 4; ++ps) { const int tl = (lane >> 4) + 4 * ps;
                    LAS unsigned* xo = (LAS unsigned*)(XS + tl * XSTR + 10 * s1cg);
#pragma unroll
                    for (int u2 = 0; u2 < 5; ++u2) { const unsigned cw = cwa[ps][u2], pw = pwa[ps][u2];
                        const f32x2s cur = {bflo(cw), bfhi(cw)}, prev = {bflo(pw), bfhi(pw)}; const f32x2s mu2 = {s1mu[2 * u2], s1mu[2 * u2 + 1]};
                        const f32x2s sft = cur + (prev - cur) * mu2; const f32x2s ka = XK2[u2] * sft;
                        f32x2s ee; ee.x = __builtin_amdgcn_exp2f(ka.x); ee.y = __builtin_amdgcn_exp2f(ka.y); const f32x2s dd = ee + (f32x2s){1.f, 1.f};
                        f32x2s tt; tt.x = __builtin_amdgcn_rcpf(dd.x); tt.y = __builtin_amdgcn_rcpf(dd.y);
                        const f32x2s ov = XA2[u2] * tt + (XB2[u2] * sft + XC2[u2]);
                        xo[u2] = pk2(ov.x, ov.y); } } }
            }
            __syncthreads();
        }
#undef R3_PREFETCH
#undef R3_PIECE
    }
    __syncthreads();
}

constexpr int LG_W2 = 0, LG_B = 1024, LG_NG = 1088, LG_GAL = 1216, LG_Q = 1728, LG_K = 3776, LG_A = 5824, LG_V = 7872, LG_O = 11968;
__device__ __forceinline__ void gla_unit(const Args& a, LAS float* L, int unit, int i2, const bf16* P, bf16* CAT, int tid) {
    constexpr int PS = EVEN_PAD;
    const int b = unit >> 2, h = unit & 3, lane = tid & 63, wave = __builtin_amdgcn_readfirstlane(tid >> 6);
    const float* w2 = a.in[2] + i2 * 16 * 256; const float* ab = a.in[3] + i2 * 256; const float* ng = a.in[4] + i2 * 128;
    for (int idx = tid; idx < 1024; idx += 512) { const int j = idx >> 6, d = idx & 63; L[LG_W2 + idx] = w2[j * 256 + h * 64 + d]; }
    if (tid < 64) L[LG_B + tid] = ab[h * 64 + tid];
    if (tid < 128) L[LG_NG + tid] = ng[tid];
    float S[64];
#pragma unroll
    for (int d = 0; d < 64; ++d) S[d] = 0.f;
    __syncthreads();
    const size_t row0 = (size_t)b * 2048;
    for (int t0 = 0; t0 < 2048; t0 += 32) {
        { const int tok = tid >> 4, j = tid & 15; L[LG_GAL + tid] = bf2f(P[(row0 + t0 + tok) * PS + G_AL + j]); }
        for (int idx = tid; idx < 32 * 64; idx += 512) { const int tok = idx >> 6, d = idx & 63; const bf16* pr = P + (row0 + t0 + tok) * PS;
            L[LG_Q + idx] = bf2f(pr[G_Q + h * 64 + d]) * 0.125f; L[LG_K + idx] = bf2f(pr[G_K + h * 64 + d]); }
        for (int idx = tid; idx < 32 * 128; idx += 512) { const int tok = idx >> 7, e = idx & 127; L[LG_V + idx] = bf2f(P[(row0 + t0 + tok) * PS + G_V + h * 128 + e]); }
        __syncthreads();
        for (int idx = tid; idx < 32 * 64; idx += 512) { const int tok = idx >> 6, d = idx & 63; float la = L[LG_B + d];
#pragma unroll
            for (int j = 0; j < 16; ++j) la += L[LG_GAL + tok * 16 + j] * L[LG_W2 + j * 64 + d];
            const float ls = fminf(la, 0.f) - log1pf(expf(-fabsf(la))); L[LG_A + idx] = expf(ls * (1.f / 16.f)); }
        __syncthreads();
        if (tid < 128) { const int e = tid;
#pragma unroll 1
            for (int tok = 0; tok < 32; ++tok) { const float ve = L[LG_V + tok * 128 + e]; float o = 0.f;
#pragma unroll
                for (int d4 = 0; d4 < 16; ++d4) { const f32x4 av = *(const LAS f32x4*)&L[LG_A + tok * 64 + d4 * 4], kv = *(const LAS f32x4*)&L[LG_K + tok * 64 + d4 * 4], qv = *(const LAS f32x4*)&L[LG_Q + tok * 64 + d4 * 4];
#pragma unroll
                    for (int u = 0; u < 4; ++u) { S[d4 * 4 + u] = av[u] * S[d4 * 4 + u] + kv[u] * ve; o += qv[u] * S[d4 * 4 + u]; } }
                L[LG_O + tok * 128 + e] = o; } }
        __syncthreads();
#pragma unroll
        for (int i = 0; i < 4; ++i) { const int tok = wave * 4 + i; const size_t row = row0 + t0 + tok; const float o0 = L[LG_O + tok * 128 + lane], o1 = L[LG_O + tok * 128 + 64 + lane];
            const float ms = wave_sum(o0 * o0 + o1 * o1) * (1.f / 128.f); const float r = 1.f / sqrtf(ms + LN_EPS);
            const bf16* pr = P + row * PS + G_G + h * 128; const float g0 = bf2f(pr[lane]), g1 = bf2f(pr[64 + lane]);
            CAT[row * 1024 + h * 128 + lane] = (bf16)f2bf(o0 * r * L[LG_NG + lane] * (g0 / (1.f + expf(-g0))));
            CAT[row * 1024 + h * 128 + 64 + lane] = (bf16)f2bf(o1 * r * L[LG_NG + 64 + lane] * (g1 / (1.f + expf(-g1)))); }
    }
    __syncthreads();
}

constexpr int GSTR = 72, GOSTR = 132;
constexpr int GB_QIN = 0, GB_KIN = 9216, GB_KOT = 18432, GB_VT = 27648, GB_STB = 46080, GB_O = 64512, GB_GAL = 98304, GB_TOT = 102400, GB_DEC = 104448, GB_NG = 104704;
__device__ __forceinline__ int jslot(int j) { return (j & ~12) | ((j & 4) << 1) | ((j & 8) >> 1); }
constexpr int GLA_CSPLIT = 16, CW_HF = 65536;
__device__ __forceinline__ void gla_unit2(const Args& a, LAS unsigned char* lds, int unit, int i2, const bf16* P, bf16* CAT, int tid, int c0, int c1, int mode) {
    typedef float f32x4v __attribute__((ext_vector_type(4)));
    constexpr int PS = EVEN_PAD;
    const int b = unit >> 2, h = unit & 3, lane = tid & 63, wave = __builtin_amdgcn_readfirstlane(tid >> 6);
    LAS bf16* QIN = (LAS bf16*)(lds + GB_QIN); LAS bf16* KIN = (LAS bf16*)(lds + GB_KIN); LAS bf16* KOT = (LAS bf16*)(lds + GB_KOT); LAS bf16* VT = (LAS bf16*)(lds + GB_VT); LAS bf16* STB = (LAS bf16*)(lds + GB_STB);
    LAS float* O = (LAS float*)(lds + GB_O); LAS bf16* RAWQ = (LAS bf16*)(lds + 105216); LAS bf16* RAWK = (LAS bf16*)(lds + 113408); LAS bf16* RAWG = (LAS bf16*)(lds + 121600); LAS float* TOT = (LAS float*)(lds + GB_TOT); LAS float* DEC = (LAS float*)(lds + GB_DEC); LAS float* NG = (LAS float*)(lds + GB_NG);
    float w2r[16];
#pragma unroll
    for (int j = 0; j < 16; ++j) w2r[j] = (a.in[2] + i2 * 16 * 256)[j * 256 + h * 64 + lane];
    const float bias = (a.in[3] + i2 * 256)[h * 64 + lane];
    if (tid < 128) NG[tid] = (a.in[4] + i2 * 128)[tid];
    const int et = wave & 3, hi2 = wave >> 2, n = lane & 31, hi = lane >> 5;
    float* stp = (float*)(a.ws + WS_MASK) + (size_t)unit * 8192 + tid; unsigned* hflag = (unsigned*)(a.ws + WS_CTL) + CW_HF + (i2 * 128 + unit) * 64;
    f32x16 sacc;
    if (mode == 2) {
        if (tid == 0) { while (__hip_atomic_load(hflag, __ATOMIC_RELAXED, __HIP_MEMORY_SCOPE_AGENT) == 0u) __builtin_amdgcn_s_sleep(8); __builtin_amdgcn_fence(__ATOMIC_ACQUIRE, "agent"); asm volatile("s_waitcnt vmcnt(0)" ::: "memory"); }
        __syncthreads();
#pragma unroll
        for (int e = 0; e < 16; ++e) sacc[e] = __hip_atomic_load(stp + e * 512, __ATOMIC_RELAXED, __HIP_MEMORY_SCOPE_AGENT);
#pragma unroll
        for (int r = 0; r < 16; ++r) { const int el = (r & 3) + 8 * (r >> 2) + 4 * hi; STB[(32 * et + el) * GSTR + 32 * hi2 + n] = (bf16)f2bf_acc(sacc[r]); }
    } else {
        for (int idx = tid; idx < 128 * GSTR / 2; idx += 512) ((LAS unsigned*)STB)[idx] = 0u;
#pragma unroll
        for (int e = 0; e < 16; ++e) sacc[e] = 0.f;
    }
    __syncthreads();
    const size_t row0 = (size_t)b * 2048;
    u32x4 rq, rk, rv0, rv1, rg = {0u, 0u, 0u, 0u};
    const int ptok = tid >> 3, ppc = tid & 7;
#define GLA_PREFETCH(cc) { const int t1 = min((cc), 31) * 64; const bf16* pq = P + (row0 + t1 + ptok) * PS + h * 64 + 8 * ppc; rq = *(const u32x4*)(pq + G_Q); rk = *(const u32x4*)(pq + G_K); \
        const u32x4* vp = (const u32x4*)(P + (row0 + t1 + lane) * PS + G_V + h * 128 + 16 * wave); rv0 = vp[0]; rv1 = vp[1]; \
        if (tid < 128) rg = *(const u32x4*)(P + (row0 + t1 + (tid >> 1)) * PS + G_AL + 8 * (tid & 1)); }
    GLA_PREFETCH(c0)
    u32x4 pw0 = {0u, 0u, 0u, 0u}, pw1 = pw0;
#pragma unroll 1
    for (int c = c0; c < c1; ++c) { const int t0 = c * 64;
        {
            *(LAS u32x4*)&RAWQ[ptok * 64 + 8 * ppc] = rq; *(LAS u32x4*)&RAWK[ptok * 64 + 8 * ppc] = rk;
            if (tid < 128) { LAS float* gd_ = (LAS float*)RAWG + (tid >> 1) * 16 + 8 * (tid & 1);
                *(LAS f32x4v*)gd_ = (f32x4v){bflo(rg.x), bfhi(rg.x), bflo(rg.y), bfhi(rg.y)}; *(LAS f32x4v*)(gd_ + 4) = (f32x4v){bflo(rg.z), bfhi(rg.z), bflo(rg.w), bfhi(rg.w)}; }
            const u32x4 vv0 = rv0, vv1 = rv1;
            __syncthreads();
            float qv[8], kv[8];
#pragma unroll
            for (int u = 0; u < 8; ++u) { qv[u] = bf2f(RAWQ[(8 * wave + u) * 64 + lane]); kv[u] = bf2f(RAWK[(8 * wave + u) * 64 + lane]); }
            float lc[8]; float run = 0.f;
#pragma unroll
            for (int u = 0; u < 8; ++u) { const int tok = 8 * wave + u; float la = bias;
                { const LAS float* gs_ = (const LAS float*)RAWG + tok * 16; const f32x4v ga = *(const LAS f32x4v*)gs_, gb = *(const LAS f32x4v*)(gs_ + 4), gc = *(const LAS f32x4v*)(gs_ + 8), gd = *(const LAS f32x4v*)(gs_ + 12);
                  la += ga[0] * w2r[0] + ga[1] * w2r[1] + ga[2] * w2r[2] + ga[3] * w2r[3] + gb[0] * w2r[4] + gb[1] * w2r[5] + gb[2] * w2r[6] + gb[3] * w2r[7];
                  la += gc[0] * w2r[8] + gc[1] * w2r[9] + gc[2] * w2r[10] + gc[3] * w2r[11] + gd[0] * w2r[12] + gd[1] * w2r[13] + gd[2] * w2r[14] + gd[3] * w2r[15]; }
                const float ls = fminf(la, 0.f) - __logf(1.f + __expf(-fabsf(la))); run += ls * (1.f / 16.f); lc[u] = run; }
            TOT[wave * 64 + lane] = run;
            __syncthreads();
            float off = 0.f, total = 0.f;
#pragma unroll
            for (int g = 0; g < 8; ++g) { const float tv = TOT[g * 64 + lane]; total += tv; if (g < wave) off += tv; }
#pragma unroll
            for (int u = 0; u < 8; ++u) { const float bb = off + lc[u]; const int tok = 8 * wave + u; const float eb = __expf(bb);
                QIN[tok * GSTR + lane] = (bf16)f2bf(qv[u] * 0.125f * eb); KIN[tok * GSTR + lane] = (bf16)f2bf(kv[u] * __expf(-bb)); KOT[lane * GSTR + jslot(tok)] = (bf16)f2bf(kv[u] * __expf(total - bb)); }
            if (wave == 0) DEC[lane] = __expf(total);
            { const int sl = jslot(lane); LAS bf16* vt = VT + (16 * wave) * GSTR + sl;
              vt[0 * GSTR] = (bf16)(vv0.x & 0xffffu); vt[1 * GSTR] = (bf16)(vv0.x >> 16); vt[2 * GSTR] = (bf16)(vv0.y & 0xffffu); vt[3 * GSTR] = (bf16)(vv0.y >> 16);
              vt[4 * GSTR] = (bf16)(vv0.z & 0xffffu); vt[5 * GSTR] = (bf16)(vv0.z >> 16); vt[6 * GSTR] = (bf16)(vv0.w & 0xffffu); vt[7 * GSTR] = (bf16)(vv0.w >> 16);
              vt[8 * GSTR] = (bf16)(vv1.x & 0xffffu); vt[9 * GSTR] = (bf16)(vv1.x >> 16); vt[10 * GSTR] = (bf16)(vv1.y & 0xffffu); vt[11 * GSTR] = (bf16)(vv1.y >> 16);
              vt[12 * GSTR] = (bf16)(vv1.z & 0xffffu); vt[13 * GSTR] = (bf16)(vv1.z >> 16); vt[14 * GSTR] = (bf16)(vv1.w & 0xffffu); vt[15 * GSTR] = (bf16)(vv1.w >> 16); }
            __syncthreads();
        }
        GLA_PREFETCH(c + 1)
        const u32x4* gp = (const u32x4*)(P + (row0 + t0 + (tid >> 3)) * PS + G_G + h * 128 + 16 * (tid & 7)); const u32x4 g0 = gp[0], g1 = gp[1];
        if (c > c0) { u32x4* opp = (u32x4*)(CAT + (row0 + t0 - 64 + (tid >> 3)) * 1024 + h * 128 + 16 * (tid & 7)); opp[0] = pw0; opp[1] = pw1; }
        {
            f32x16 oacc;
#pragma unroll
            for (int e = 0; e < 16; ++e) oacc[e] = 0.f;
            bf16x8 qf[4];
#pragma unroll
            for (int ks = 0; ks < 4; ++ks) qf[ks] = *(const LAS bf16x8*)&QIN[(32 * hi2 + n) * GSTR + ks * 16 + 8 * hi];
#pragma unroll
            for (int ks = 0; ks < 4; ++ks) { const bf16x8 sf = *(const LAS bf16x8*)&STB[(32 * et + n) * GSTR + ks * 16 + 8 * hi]; oacc = __builtin_amdgcn_mfma_f32_32x32x16_bf16(sf, qf[ks], oacc, 0, 0, 0); }
#pragma unroll
            for (int jt = 0; jt < 2; ++jt) if (jt <= hi2) {
                f32x16 at;
#pragma unroll
                for (int e = 0; e < 16; ++e) at[e] = 0.f;
#pragma unroll
                for (int ks = 0; ks < 4; ++ks) { const bf16x8 kf = *(const LAS bf16x8*)&KIN[(32 * jt + n) * GSTR + ks * 16 + 8 * hi]; at = __builtin_amdgcn_mfma_f32_32x32x16_bf16(kf, qf[ks], at, 0, 0, 0); }
                if (jt == hi2) {
#pragma unroll
                    for (int r = 0; r < 16; ++r) { const int jl = (r & 3) + 8 * (r >> 2) + 4 * hi; if (jl > n) at[r] = 0.f; } }
#pragma unroll
                for (int s = 0; s < 2; ++s) { u32x4 w; w.x = pk2_acc(at[8 * s], at[8 * s + 1]); w.y = pk2_acc(at[8 * s + 2], at[8 * s + 3]); w.z = pk2_acc(at[8 * s + 4], at[8 * s + 5]); w.w = pk2_acc(at[8 * s + 6], at[8 * s + 7]);
                    const bf16x8 vf = *(const LAS bf16x8*)&VT[(32 * et + n) * GSTR + 32 * jt + 16 * s + 8 * hi];
                    oacc = __builtin_amdgcn_mfma_f32_32x32x16_bf16(vf, __builtin_bit_cast(bf16x8, w), oacc, 0, 0, 0); } }
#pragma unroll
            for (int g = 0; g < 4; ++g) *(LAS f32x4v*)&O[(32 * hi2 + n) * GOSTR + 32 * et + 8 * g + 4 * hi] = (f32x4v){oacc[4 * g], oacc[4 * g + 1], oacc[4 * g + 2], oacc[4 * g + 3]};
        }
        __syncthreads();
        {
            const float dc = DEC[32 * hi2 + n];
#pragma unroll
            for (int e = 0; e < 16; ++e) sacc[e] *= dc;
#pragma unroll
            for (int js = 0; js < 4; ++js) { const bf16x8 vf = *(const LAS bf16x8*)&VT[(32 * et + n) * GSTR + 16 * js + 8 * hi]; const bf16x8 kf = *(const LAS bf16x8*)&KOT[(32 * hi2 + n) * GSTR + 16 * js + 8 * hi];
                sacc = __builtin_amdgcn_mfma_f32_32x32x16_bf16(vf, kf, sacc, 0, 0, 0); }
#pragma unroll
            for (int r = 0; r < 16; ++r) { const int el = (r & 3) + 8 * (r >> 2) + 4 * hi; STB[(32 * et + el) * GSTR + 32 * hi2 + n] = (bf16)f2bf_acc(sacc[r]); }
            const int i = tid >> 3, eg = tid & 7; const size_t row = row0 + t0 + i;
            const f32x4v o0 = *(const LAS f32x4v*)&O[i * GOSTR + 16 * eg], o1 = *(const LAS f32x4v*)&O[i * GOSTR + 16 * eg + 4], o2 = *(const LAS f32x4v*)&O[i * GOSTR + 16 * eg + 8], o3 = *(const LAS f32x4v*)&O[i * GOSTR + 16 * eg + 12];
            float ssq = ((o0[0] * o0[0] + o0[1] * o0[1]) + (o0[2] * o0[2] + o0[3] * o0[3])) + ((o1[0] * o1[0] + o1[1] * o1[1]) + (o1[2] * o1[2] + o1[3] * o1[3])) + ((o2[0] * o2[0] + o2[1] * o2[1]) + (o2[2] * o2[2] + o2[3] * o2[3])) + ((o3[0] * o3[0] + o3[1] * o3[1]) + (o3[2] * o3[2] + o3[3] * o3[3]));
            ssq = reduce8(ssq);
            const float rr = __builtin_amdgcn_rsqf(ssq * (1.f / 128.f) + LN_EPS);
            const float gf[16] = {bflo(g0.x), bfhi(g0.x), bflo(g0.y), bfhi(g0.y), bflo(g0.z), bfhi(g0.z), bflo(g0.w), bfhi(g0.w), bflo(g1.x), bfhi(g1.x), bflo(g1.y), bfhi(g1.y), bflo(g1.z), bfhi(g1.z), bflo(g1.w), bfhi(g1.w)};
            const float of[16] = {o0[0], o0[1], o0[2], o0[3], o1[0], o1[1], o1[2], o1[3], o2[0], o2[1], o2[2], o2[3], o3[0], o3[1], o3[2], o3[3]};
            float res[16];
#pragma unroll
            for (int x = 0; x < 16; ++x) res[x] = of[x] * rr * NG[16 * eg + x] * (gf[x] * __builtin_amdgcn_rcpf(1.f + __expf(-gf[x])));
            u32x4 w0, w1; w0.x = pk2(res[0], res[1]); w0.y = pk2(res[2], res[3]); w0.z = pk2(res[4], res[5]); w0.w = pk2(res[6], res[7]); w1.x = pk2(res[8], res[9]); w1.y = pk2(res[10], res[11]); w1.z = pk2(res[12], res[13]); w1.w = pk2(res[14], res[15]);
            pw0 = w0; pw1 = w1;
        }
    }
    if (c1 > c0) { u32x4* opp = (u32x4*)(CAT + (row0 + (size_t)(c1 - 1) * 64 + (tid >> 3)) * 1024 + h * 128 + 16 * (tid & 7)); opp[0] = pw0; opp[1] = pw1; }
#undef GLA_PREFETCH
    if (mode == 1) {
#pragma unroll
        for (int e = 0; e < 16; ++e) __hip_atomic_store(stp + e * 512, sacc[e], __ATOMIC_RELAXED, __HIP_MEMORY_SCOPE_AGENT);
        asm volatile("s_waitcnt vmcnt(0)" ::: "memory");
        __syncthreads();
        if (tid == 0) { __builtin_amdgcn_fence(__ATOMIC_RELEASE, "agent"); asm volatile("s_waitcnt vmcnt(0)" ::: "memory"); __hip_atomic_store(hflag, 1u, __ATOMIC_RELAXED, __HIP_MEMORY_SCOPE_AGENT); }
    }
    __syncthreads();
}

__device__ __forceinline__ void rope_pair(bf16x8& A, bf16x8& B, const float* ct, const float* st) {
    const u32x4 x1 = __builtin_bit_cast(u32x4, A), x2 = __builtin_bit_cast(u32x4, B);
    const f32x4 c0 = *(const f32x4*)ct, c1 = *(const f32x4*)(ct + 4), s0 = *(const f32x4*)st, s1 = *(const f32x4*)(st + 4);
    u32x4 o1, o2;
#define ROPE2(W, CA, SA, CB, SB) { const float a1 = bflo(x1.W), a2 = bflo(x2.W), b1 = bfhi(x1.W), b2 = bfhi(x2.W); \
        o1.W = pk2(a1 * (CA) - a2 * (SA), b1 * (CB) - b2 * (SB)); o2.W = pk2(a2 * (CA) + a1 * (SA), b2 * (CB) + b1 * (SB)); }
    ROPE2(x, c0.x, s0.x, c0.y, s0.y) ROPE2(y, c0.z, s0.z, c0.w, s0.w) ROPE2(z, c1.x, s1.x, c1.y, s1.y) ROPE2(w, c1.z, s1.z, c1.w, s1.w)
#undef ROPE2
    A = __builtin_bit_cast(bf16x8, o1); B = __builtin_bit_cast(bf16x8, o2);
}
__device__ __forceinline__ void ph_rope(const Args& a, LAS unsigned char* lds, int bid, int G, int tid, int gtid, int NT) {
    bf16* P = (bf16*)(a.ws + WS_P);
    const float* cosA = (const float*)(a.ws + WS_COSA); const float* sinA = (const float*)(a.ws + WS_SINA);
    const float* cosI = (const float*)(a.ws + WS_COSI); const float* sinI = (const float*)(a.ws + WS_SINI);
    for (size_t it = gtid; it < (size_t)MTOK * 12; it += NT) {
        const size_t row = it / 12; const int r = (int)(it - row * 12); const int t = (int)(row & 2047);
        int col, half; const float* ct; const float* st;
        if (r < 8) { col = O_K + r * 8; half = 64; ct = cosA + t * 64 + r * 8; st = sinA + t * 64 + r * 8; }
        else { const int grp = r - 8; col = O_KI + grp * 8; half = 32; ct = cosI + t * 32 + grp * 8; st = sinI + t * 32 + grp * 8; }
        u32x4* p1 = (u32x4*)(P + row * ODD_PAD + col); u32x4* p2 = (u32x4*)(P + row * ODD_PAD + col + half);
        const u32x4 x1 = *p1, x2 = *p2; const f32x4 c0 = *(const f32x4*)ct, c1 = *(const f32x4*)(ct + 4), s0 = *(const f32x4*)st, s1 = *(const f32x4*)(st + 4);
        u32x4 o1, o2;
#define ROPE2(W, CA, SA, CB, SB) { const float a1 = bflo(x1.W), a2 = bflo(x2.W), b1 = bfhi(x1.W), b2 = bfhi(x2.W); \
            o1.W = pk2(a1 * (CA) - a2 * (SA), b1 * (CB) - b2 * (SB)); o2.W = pk2(a2 * (CA) + a1 * (SA), b2 * (CB) + b1 * (SB)); }
        ROPE2(x, c0.x, s0.x, c0.y, s0.y) ROPE2(y, c0.z, s0.z, c0.w, s0.w) ROPE2(z, c1.x, s1.x, c1.y, s1.y) ROPE2(w, c1.z, s1.z, c1.w, s1.w)
#undef ROPE2
        *p1 = o1; *p2 = o2;
    }
    bf16* VT = (bf16*)(a.ws + WS_VT); LAS bf16* TL = (LAS bf16*)lds;
    for (int tile = bid; tile < MTOK / 64; tile += G) {
        const size_t row0 = (size_t)tile * 64; const int b = (int)(row0 >> 11), tq = (int)(row0 & 2047);
        __syncthreads();
#pragma unroll
        for (int i = 0; i < 2; ++i) { const int pc = tid + 512 * i, tok = pc >> 4, seg = pc & 15; *(LAS u32x4*)&TL[tok * 136 + 8 * seg] = *(const u32x4*)(P + (row0 + tok) * ODD_PAD + O_V + 8 * seg); }
        __syncthreads();
#pragma unroll
        for (int i = 0; i < 2; ++i) { const int pc = tid + 512 * i, d = pc & 127, tg = pc >> 7; u32x4 o;
            o.x = (unsigned)TL[(8 * tg + 0) * 136 + d] | ((unsigned)TL[(8 * tg + 1) * 136 + d] << 16); o.y = (unsigned)TL[(8 * tg + 2) * 136 + d] | ((unsigned)TL[(8 * tg + 3) * 136 + d] << 16);
            o.z = (unsigned)TL[(8 * tg + 4) * 136 + d] | ((unsigned)TL[(8 * tg + 5) * 136 + d] << 16); o.w = (unsigned)TL[(8 * tg + 6) * 136 + d] | ((unsigned)TL[(8 * tg + 7) * 136 + d] << 16);
            *(u32x4*)(VT + ((size_t)b * 128 + d) * 2048 + tq + 8 * tg) = o; }
    }
}
__device__ __forceinline__ unsigned sortable_key(float s) { unsigned u = __float_as_uint(s); if ((u << 1) == 0u) u = 0u; return (u & 0x80000000u) ? ~u : (u | 0x80000000u); }
__device__ __forceinline__ void ph_indexer(const Args& a, LAS unsigned char* lds, int gw, int NGW, int wave, int lane) {
    const bf16* P = (const bf16*)(a.ws + WS_P); unsigned* MASK = (unsigned*)(a.ws + WS_MASK);
    LAS float* qs = (LAS float*)(lds + wave * 10496); LAS unsigned* kl = (LAS unsigned*)(lds + wave * 10496 + 2304);
    for (int m = gw; m < MTOK; m += NGW) {
        const int b = m >> 11, t = m & 2047; const bf16* prow = P + (size_t)m * ODD_PAD;
        { const u32x4 v = *(const u32x4*)(prow + O_QI + lane * 8);
          *(LAS f32x4*)&qs[lane * 8] = (f32x4){bflo(v.x), bfhi(v.x), bflo(v.y), bfhi(v.y)}; *(LAS f32x4*)&qs[lane * 8 + 4] = (f32x4){bflo(v.z), bfhi(v.z), bflo(v.w), bfhi(v.w)}; }
        if (lane < 8) qs[512 + lane] = bf2f(prow[O_WI + lane]) * 0.04419417382415922f;
        LDS_WAIT();
        const int nblk = (t >> 6) + 1;
#pragma unroll 1
        for (int i = 0; i < nblk; ++i) { const int s = i * 64 + lane; unsigned key = 0u;
            if (s <= t) { const u32x4* kr = (const u32x4*)(P + ((size_t)b * 2048 + s) * ODD_PAD + O_KI);
                float kf[64];
#pragma unroll
                for (int q = 0; q < 8; ++q) { const u32x4 v = kr[q]; kf[q * 8 + 0] = bflo(v.x); kf[q * 8 + 1] = bfhi(v.x); kf[q * 8 + 2] = bflo(v.y); kf[q * 8 + 3] = bfhi(v.y); kf[q * 8 + 4] = bflo(v.z); kf[q * 8 + 5] = bfhi(v.z); kf[q * 8 + 6] = bflo(v.w); kf[q * 8 + 7] = bfhi(v.w); }
                float sc = 0.f;
#pragma unroll 1
                for (int h = 0; h < 8; ++h) { float acc = 0.f;
#pragma unroll
                    for (int d4 = 0; d4 < 16; ++d4) { const f32x4 qv = *(const LAS f32x4*)&qs[h * 64 + d4 * 4]; acc += qv.x * kf[d4 * 4] + qv.y * kf[d4 * 4 + 1] + qv.z * kf[d4 * 4 + 2] + qv.w * kf[d4 * 4 + 3]; }
                    sc += qs[512 + h] * fmaxf(acc, 0.f); }
                key = sortable_key(sc); }
            kl[i * 64 + lane] = key; }
        LDS_WAIT();
        unsigned k[32];
#pragma unroll
        for (int i = 0; i < 32; ++i) k[i] = (i < nblk) ? kl[i * 64 + lane] : 0u;
        unsigned T = 0u;
        for (int bit = 31; bit >= 0; --bit) { const unsigned cand = T | (1u << bit); int cnt = 0;
#pragma unroll
            for (int i = 0; i < 32; ++i) cnt += (k[i] >= cand) ? 1 : 0;
            cnt = wave_sum_i(cnt); if (cnt >= 256) T = cand; }
        int cgt = 0;
#pragma unroll
        for (int i = 0; i < 32; ++i) cgt += (k[i] > T) ? 1 : 0;
        cgt = wave_sum_i(cgt);
        const int need = 256 - cgt; int run = 0; unsigned myw = 0u;
#pragma unroll
        for (int i = 0; i < 32; ++i) { const bool gt = k[i] > T, eq = (k[i] == T) && (T != 0u);
            const unsigned long long bal = __ballot(eq); const int pre = __builtin_amdgcn_mbcnt_hi((unsigned)(bal >> 32), __builtin_amdgcn_mbcnt_lo((unsigned)bal, 0u));
            const bool sel = gt || (eq && (run + pre < need)); run += __popcll(bal);
            const unsigned long long sb = __ballot(sel);
            if (lane == 2 * i) myw = (unsigned)sb; if (lane == 2 * i + 1) myw = (unsigned)(sb >> 32); }
        MASK[(size_t)m * 64 + lane] = myw;
    }
}
__device__ __forceinline__ void ph_attention(const Args& a, LAS unsigned char* lds, int gw, int NGW, int wave, int lane) {
    const bf16* P = (const bf16*)(a.ws + WS_P); const unsigned* MASK = (const unsigned*)(a.ws + WS_MASK); bf16* CAT = (bf16*)(a.ws + WS_CAT);
    LAS unsigned short* sel = (LAS unsigned short*)(lds + wave * 4096); LAS float* qh = (LAS float*)(lds + wave * 4096 + 512); LAS float* pp = (LAS float*)(lds + wave * 4096 + 1024);
    for (int m = gw; m < MTOK; m += NGW) {
        const int b = m >> 11; const bf16* prow = P + (size_t)m * ODD_PAD; const bf16* pb = P + (size_t)b * 2048 * ODD_PAD;
        unsigned word = MASK[(size_t)m * 64 + lane]; const int cnt = __popc(word); int x = cnt;
#pragma unroll
        for (int o = 1; o < 64; o <<= 1) { const int y = __shfl_up(x, o); if (lane >= o) x += y; }
        const int nsel = __shfl(x, 63); int pos = x - cnt;
        while (word) { const int bpos = __builtin_ctz(word); word &= word - 1u; sel[pos++] = (unsigned short)(lane * 32 + bpos); }
        LDS_WAIT();
        for (int h = 0; h < 8; ++h) {
            qh[lane] = bf2f(prow[O_Q + h * 128 + lane]); qh[64 + lane] = bf2f(prow[O_Q + h * 128 + 64 + lane]);
            LDS_WAIT();
            float lg[4]; float mx = -3.0e38f;
#pragma unroll
            for (int jj = 0; jj < 4; ++jj) { const int j = lane + 64 * jj; lg[jj] = -3.0e38f;
                if (j < nsel) { const u32x4* kr = (const u32x4*)(pb + (size_t)sel[j] * ODD_PAD + O_K); float acc = 0.f;
#pragma unroll
                    for (int q = 0; q < 16; ++q) { const u32x4 v = kr[q]; const f32x4 q0 = *(const LAS f32x4*)&qh[q * 8], q1 = *(const LAS f32x4*)&qh[q * 8 + 4];
                        acc += q0.x * bflo(v.x) + q0.y * bfhi(v.x) + q0.z * bflo(v.y) + q0.w * bfhi(v.y) + q1.x * bflo(v.z) + q1.y * bfhi(v.z) + q1.z * bflo(v.w) + q1.w * bfhi(v.w); }
                    lg[jj] = acc * 0.08838834764831845f; }
                mx = fmaxf(mx, lg[jj]); }
            mx = wave_max(mx); float sum = 0.f;
#pragma unroll
            for (int jj = 0; jj < 4; ++jj) { const int j = lane + 64 * jj; const float p = (j < nsel) ? expf(lg[jj] - mx) : 0.f; lg[jj] = p; sum += p; }
            sum = wave_sum(sum); const float inv = 1.f / sum;
#pragma unroll
            for (int jj = 0; jj < 4; ++jj) pp[lane + 64 * jj] = lg[jj] * inv;
            LDS_WAIT();
            float o0 = 0.f, o1 = 0.f;
            for (int j = 0; j < nsel; ++j) { const bf16* vr = pb + (size_t)sel[j] * ODD_PAD + O_V; const float p = pp[j]; o0 += p * bf2f(vr[lane]); o1 += p * bf2f(vr[64 + lane]); }
            CAT[(size_t)m * 1024 + h * 128 + lane] = (bf16)f2bf(o0); CAT[(size_t)m * 1024 + h * 128 + 64 + lane] = (bf16)f2bf(o1);
            LDS_WAIT();
        }
    }
}

__device__ __forceinline__ void ph_indexer3(const Args& a, LAS unsigned char* lds, int bid, int G, int tid) {
    typedef float f32x4v __attribute__((ext_vector_type(4)));
    const bf16* P = (const bf16*)(a.ws + WS_P); unsigned* MASK = (unsigned*)(a.ws + WS_MASK);
    const int lane = tid & 63, wave = __builtin_amdgcn_readfirstlane(tid >> 6);
    const int n = lane & 15, q = lane >> 4, tokl = q & 1, half = q >> 1;
    constexpr int KROW = 144, GBUF = 256 * KROW;
    const int srow = tid >> 1, shalf = tid & 1;
    for (int unit = bid; unit < MTOK / 16; unit += G) {
        const int j = unit >> 8, r = unit & 255, b = (r & 7) * 4 + (r >> 6), q8 = (r >> 3) & 7, tt = j * 8 + ((j & 1) ? 7 - q8 : q8);
        const int t0 = tt * 16 + wave * 2; const size_t rowbase = (size_t)b * 2048;
        const int NP = (tt >> 1) + 1;
        bf16x8 af[2];
        { const bf16* ap = P + (rowbase + t0 + (n & 1)) * ODD_PAD + O_QI + (n >> 1) * 64 + q * 8; af[0] = *(const bf16x8*)ap; af[1] = *(const bf16x8*)(ap + 32);
          const int tq_ = t0 + (n & 1); rope_pair(af[0], af[1], (const float*)(a.ws + WS_COSI) + tq_ * 32 + q * 8, (const float*)(a.ws + WS_SINI) + tq_ * 32 + q * 8); }
        float wv[4];
        { const u32x4 wa = *(const u32x4*)(P + (rowbase + t0) * ODD_PAD + O_WI), wb = *(const u32x4*)(P + (rowbase + t0 + 1) * ODD_PAD + O_WI);
          const unsigned w0_ = q == 0 ? wa.x : (q == 1 ? wa.y : (q == 2 ? wa.z : wa.w)), w1_ = q == 0 ? wb.x : (q == 1 ? wb.y : (q == 2 ? wb.z : wb.w));
          wv[0] = bflo(w0_) * 0.04419417382415922f; wv[1] = bflo(w1_) * 0.04419417382415922f; wv[2] = bfhi(w0_) * 0.04419417382415922f; wv[3] = bfhi(w1_) * 0.04419417382415922f; }
        unsigned keys[64];
#pragma unroll
        for (int p = 0; p < 64; ++p) keys[p] = 0u;
        const int tmine = t0 + tokl;
        const bf16* kgp = P + (rowbase + srow) * ODD_PAD + O_KI + shalf * 32;
        u32x4 s0, s1, s2, s3;
#define IDX_GLOAD(g) { const u32x4* gp_ = (const u32x4*)(kgp + (size_t)(g) * 256 * ODD_PAD); s0 = gp_[0]; s1 = gp_[1]; s2 = gp_[2]; s3 = gp_[3]; }
#define IDX_GSTORE(buf) { LAS u32x4* lp_ = (LAS u32x4*)(lds + (buf) * GBUF + srow * KROW + shalf * 64); lp_[0] = s0; lp_[1] = s1; lp_[2] = s2; lp_[3] = s3; }
        IDX_GLOAD(0)
        __syncthreads();
        IDX_GSTORE(0)
        __syncthreads();
        if (8 < NP) IDX_GLOAD(1)
#define IDX_RELU(x) __int_as_float(max(__float_as_int(x), 0))
#define IDX_STEP(g, pl) if (8 * (g) + (pl) < NP) { const LAS unsigned char* kb_ = lds + ((g) & 1) * GBUF + (32 * (pl) + n) * KROW + q * 16; \
                const bf16x8 bA0 = *(const LAS bf16x8*)kb_, bA1 = *(const LAS bf16x8*)(kb_ + 64), bB0 = *(const LAS bf16x8*)(kb_ + 16 * KROW), bB1 = *(const LAS bf16x8*)(kb_ + 16 * KROW + 64); \
                f32x4v cA = {0.f, 0.f, 0.f, 0.f}, cB = {0.f, 0.f, 0.f, 0.f}; \
                cA = __builtin_amdgcn_mfma_f32_16x16x32_bf16(af[0], bA0, cA, 0, 0, 0); cA = __builtin_amdgcn_mfma_f32_16x16x32_bf16(af[1], bA1, cA, 0, 0, 0); \
                cB = __builtin_amdgcn_mfma_f32_16x16x32_bf16(af[0], bB0, cB, 0, 0, 0); cB = __builtin_amdgcn_mfma_f32_16x16x32_bf16(af[1], bB1, cB, 0, 0, 0); \
                const float A0 = wv[0] * IDX_RELU(cA[0]) + wv[2] * IDX_RELU(cA[2]), A1 = wv[1] * IDX_RELU(cA[1]) + wv[3] * IDX_RELU(cA[3]); \
                const float B0 = wv[0] * IDX_RELU(cB[0]) + wv[2] * IDX_RELU(cB[2]), B1 = wv[1] * IDX_RELU(cB[1]) + wv[3] * IDX_RELU(cB[3]); \
                const float m0 = hswap32_add(A0, B0), m1 = hswap32_add(A1, B1); \
                const float sc = hswap16_add(m0, m1); \
                const int s = 32 * (8 * (g) + (pl)) + 16 * half + n; \
                keys[8 * (g) + (pl)] = (s <= tmine) ? sortable_key(sc) : 0u; }
#define IDX_GROUP(g) if (8 * (g) < NP) { IDX_STEP(g, 0) IDX_STEP(g, 1) IDX_STEP(g, 2) IDX_STEP(g, 3) IDX_STEP(g, 4) IDX_STEP(g, 5) IDX_STEP(g, 6) IDX_STEP(g, 7) \
            if (8 * ((g) + 1) < NP) IDX_GSTORE(((g) + 1) & 1) \
            __syncthreads(); \
            if (8 * ((g) + 2) < NP) IDX_GLOAD((g) + 2) }
        IDX_GROUP(0) IDX_GROUP(1) IDX_GROUP(2) IDX_GROUP(3) IDX_GROUP(4) IDX_GROUP(5) IDX_GROUP(6) IDX_GROUP(7)
#undef IDX_STEP
#undef IDX_RELU
#undef IDX_GROUP
#undef IDX_GLOAD
#undef IDX_GSTORE
        unsigned T = 0u; const bool small_ = tmine + 1 <= 256; bool found = false;
#define IDX_CNT8(g) if (8 * (g) < NP) { cnt += ((keys[8 * (g) + 0] >= cand) ? 1 : 0) + ((keys[8 * (g) + 1] >= cand) ? 1 : 0) + ((keys[8 * (g) + 2] >= cand) ? 1 : 0) + ((keys[8 * (g) + 3] >= cand) ? 1 : 0) \
            + ((keys[8 * (g) + 4] >= cand) ? 1 : 0) + ((keys[8 * (g) + 5] >= cand) ? 1 : 0) + ((keys[8 * (g) + 6] >= cand) ? 1 : 0) + ((keys[8 * (g) + 7] >= cand) ? 1 : 0); }
#pragma unroll 1
        for (int bit = 31; bit >= 0; --bit) { const unsigned cand = T | (1u << bit); int cnt = 0;
            IDX_CNT8(0) IDX_CNT8(1) IDX_CNT8(2) IDX_CNT8(3) IDX_CNT8(4) IDX_CNT8(5) IDX_CNT8(6) IDX_CNT8(7)
            cnt = reduce16_i(cnt); cnt = hswap32_add_i(cnt, cnt);
            if (cnt >= 256) T = cand;
            found = found || (cnt == 256);
            if (__all(found || small_)) break; }
#undef IDX_CNT8
        if (__all(found || small_)) {
            const unsigned thr = found ? T - 1u : 0u; unsigned mw0 = 0u, mw1 = 0u;
#define IDX_W(p) { const unsigned long long bs = __ballot(keys[p] > thr); \
                const unsigned w0_ = (unsigned)(bs & 0xFFFFull) | ((unsigned)((bs >> 32) & 0xFFFFull) << 16), w1_ = (unsigned)((bs >> 16) & 0xFFFFull) | ((unsigned)((bs >> 48) & 0xFFFFull) << 16); \
                if (lane == (p)) { mw0 = w0_; mw1 = w1_; } }
#define IDX_W8(g) if (8 * (g) < NP) { IDX_W(8 * (g) + 0) IDX_W(8 * (g) + 1) IDX_W(8 * (g) + 2) IDX_W(8 * (g) + 3) IDX_W(8 * (g) + 4) IDX_W(8 * (g) + 5) IDX_W(8 * (g) + 6) IDX_W(8 * (g) + 7) }
            IDX_W8(0) IDX_W8(1) IDX_W8(2) IDX_W8(3) IDX_W8(4) IDX_W8(5) IDX_W8(6) IDX_W8(7)
#undef IDX_W8
#undef IDX_W
            MASK[(rowbase + t0) * 64 + lane] = mw0; MASK[(rowbase + t0 + 1) * 64 + lane] = mw1;
            continue;
        }
        { unsigned T2 = 0u;
#pragma unroll 1
          for (int bit = 31; bit >= 0; --bit) { const unsigned cand = T2 | (1u << bit); int cnt = 0;
#pragma unroll
              for (int p = 0; p < 64; ++p) cnt += (keys[p] >= cand) ? 1 : 0;
              cnt = reduce16_i(cnt); cnt = hswap32_add_i(cnt, cnt);
              if (cnt >= 256) T2 = cand; }
          T = T2; }
        int cgt = 0;
#pragma unroll
        for (int p = 0; p < 64; ++p) cgt += (keys[p] > T) ? 1 : 0;
        cgt = reduce16_i(cgt); cgt = hswap32_add_i(cgt, cgt);
        const int need = 256 - cgt; int run = 0; unsigned mw0 = 0u, mw1 = 0u; const unsigned below = (1u << (16 * half + n)) - 1u;
#pragma unroll
        for (int p = 0; p < 64; ++p) { const bool gt = keys[p] > T, eq = (keys[p] == T) && (T != 0u);
            const unsigned long long be = __ballot(eq);
            const unsigned e0 = (unsigned)(be & 0xFFFFull) | ((unsigned)((be >> 32) & 0xFFFFull) << 16), e1 = (unsigned)((be >> 16) & 0xFFFFull) | ((unsigned)((be >> 48) & 0xFFFFull) << 16);
            const unsigned me = tokl ? e1 : e0; const bool sel = gt || (eq && (run + __popc(me & below) < need)); run += __popc(me);
            const unsigned long long bs = __ballot(sel);
            const unsigned s0 = (unsigned)(bs & 0xFFFFull) | ((unsigned)((bs >> 32) & 0xFFFFull) << 16), s1 = (unsigned)((bs >> 16) & 0xFFFFull) | ((unsigned)((bs >> 48) & 0xFFFFull) << 16);
            if (lane == p) { mw0 = s0; mw1 = s1; } }
        MASK[(rowbase + t0) * 64 + lane] = mw0; MASK[(rowbase + t0 + 1) * 64 + lane] = mw1;
    }
}

__device__ __forceinline__ void ph_attention2(const Args& a, int bid, int G, int wave, int lane) {
    const bf16* P = (const bf16*)(a.ws + WS_P); const unsigned* MASK = (const unsigned*)(a.ws + WS_MASK); const bf16* VT = (const bf16*)(a.ws + WS_VT); bf16* CAT = (bf16*)(a.ws + WS_CAT);
    const int n = lane & 31, hi = lane >> 5, tl = n >> 3, head = n & 7;
    const float C = 0.12751743f;
    for (int it = bid; it < 2048; it += G) {
        const int j = it >> 8, r = it & 255, b = r >> 3, q8 = r & 7; const int qt = j * 8 + ((j & 1) ? 7 - q8 : q8);
        const int t0 = qt * 32 + wave * 4; const size_t rowbase = (size_t)b * 2048; const size_t m = rowbase + t0 + tl;
        bf16x8 qf[8];
        { const bf16* qp = P + m * ODD_PAD + O_Q + head * 128 + hi * 8;
#pragma unroll
          for (int ks = 0; ks < 8; ++ks) qf[ks] = *(const bf16x8*)(qp + ks * 16); }
        unsigned mw[4];
#pragma unroll
        for (int i = 0; i < 4; ++i) mw[i] = MASK[(rowbase + t0 + i) * 64 + lane];
        f32x16 o[4];
#pragma unroll
        for (int mt = 0; mt < 4; ++mt)
#pragma unroll
            for (int e = 0; e < 16; ++e) o[mt][e] = 0.f;
        float mrow = -1e30f, lrow = 0.f;
        const int ntile = ((t0 + 3) >> 5) + 1;
        bf16x8 kf[8];
        { const bf16* kp = P + (rowbase + n) * ODD_PAD + O_K + hi * 8;
#pragma unroll
          for (int ks = 0; ks < 8; ++ks) kf[ks] = *(const bf16x8*)(kp + ks * 16); }
#pragma unroll 1
        for (int kt = 0; kt < ntile; ++kt) {
            f32x16 s;
#pragma unroll
            for (int e = 0; e < 16; ++e) s[e] = 0.f;
#pragma unroll
            for (int ks = 0; ks < 8; ++ks) s = __builtin_amdgcn_mfma_f32_32x32x16_bf16(kf[ks], qf[ks], s, 0, 0, 0);
            if (kt + 1 < ntile) { const bf16* kp = P + (rowbase + (kt + 1) * 32 + n) * ODD_PAD + O_K + hi * 8;
#pragma unroll
                for (int ks = 0; ks < 8; ++ks) kf[ks] = *(const bf16x8*)(kp + ks * 16); }
            u32x2 vf[4][2][2];
            { const bf16* vp = VT + ((size_t)b * 128 + n) * 2048 + kt * 32 + 4 * hi;
#pragma unroll
              for (int mt = 0; mt < 4; ++mt)
#pragma unroll
                  for (int s2 = 0; s2 < 2; ++s2)
#pragma unroll
                      for (int ii = 0; ii < 2; ++ii) vf[mt][s2][ii] = *(const u32x2*)(vp + (size_t)mt * 32 * 2048 + 16 * s2 + 8 * ii); }
            const unsigned w0 = (unsigned)__builtin_amdgcn_readlane((int)mw[0], kt), w1 = (unsigned)__builtin_amdgcn_readlane((int)mw[1], kt), w2 = (unsigned)__builtin_amdgcn_readlane((int)mw[2], kt), w3 = (unsigned)__builtin_amdgcn_readlane((int)mw[3], kt);
            const unsigned word = (tl == 0 ? w0 : (tl == 1 ? w1 : (tl == 2 ? w2 : w3))) >> (4 * hi);
            float mx = -1e30f;
#pragma unroll
            for (int e = 0; e < 16; ++e) { const int key = (e & 3) + 8 * (e >> 2); if ((word >> key) & 1u) mx = fmaxf(mx, s[e]); }
            mx = fmaxf(mx, __shfl_xor(mx, 32));
            const float mnew = fmaxf(mrow, mx); const float alpha = __builtin_amdgcn_exp2f((mrow - mnew) * C); mrow = mnew;
            float psum = 0.f; float p[16];
#pragma unroll
            for (int e = 0; e < 16; ++e) { const int key = (e & 3) + 8 * (e >> 2); p[e] = ((word >> key) & 1u) ? __builtin_amdgcn_exp2f((s[e] - mnew) * C) : 0.f; psum += p[e]; }
            lrow = lrow * alpha + psum;
#pragma unroll
            for (int mt = 0; mt < 4; ++mt)
#pragma unroll
                for (int e = 0; e < 16; ++e) o[mt][e] *= alpha;
            bf16x8 pf[2];
#pragma unroll
            for (int s2 = 0; s2 < 2; ++s2) { u32x4 w; w.x = pk2(p[8 * s2 + 0], p[8 * s2 + 1]); w.y = pk2(p[8 * s2 + 2], p[8 * s2 + 3]); w.z = pk2(p[8 * s2 + 4], p[8 * s2 + 5]); w.w = pk2(p[8 * s2 + 6], p[8 * s2 + 7]); pf[s2] = __builtin_bit_cast(bf16x8, w); }
#pragma unroll
            for (int mt = 0; mt < 4; ++mt)
#pragma unroll
                for (int s2 = 0; s2 < 2; ++s2) { u32x4 w; w.x = vf[mt][s2][0].x; w.y = vf[mt][s2][0].y; w.z = vf[mt][s2][1].x; w.w = vf[mt][s2][1].y;
                    o[mt] = __builtin_amdgcn_mfma_f32_32x32x16_bf16(__builtin_bit_cast(bf16x8, w), pf[s2], o[mt], 0, 0, 0); }
        }
        const float l = lrow + __shfl_xor(lrow, 32); const float inv = 1.f / l;
        bf16* op = CAT + m * 1024 + head * 128 + 4 * hi;
#pragma unroll
        for (int mt = 0; mt < 4; ++mt)
#pragma unroll
            for (int i = 0; i < 4; ++i) { u32x2 w; w.x = pk2(o[mt][4 * i] * inv, o[mt][4 * i + 1] * inv); w.y = pk2(o[mt][4 * i + 2] * inv, o[mt][4 * i + 3] * inv); *(u32x2*)(op + 32 * mt + 8 * i) = w; }
    }
}

__device__ __forceinline__ void ph_attention3(const Args& a, LAS unsigned char* lds, int bid, int G, int tid) {
    const bf16* P = (const bf16*)(a.ws + WS_P); const unsigned* MASK = (const unsigned*)(a.ws + WS_MASK); const bf16* VT = (const bf16*)(a.ws + WS_VT); bf16* CAT = (bf16*)(a.ws + WS_CAT);
    constexpr int KSTR = 136, VSTR = 40, KBYTES = 32 * KSTR * 2, BUFB = KBYTES + 128 * VSTR * 2;
    const int lane = tid & 63, wave = __builtin_amdgcn_readfirstlane(tid >> 6);
    const int n = lane & 31, hi = lane >> 5, tl = n >> 3, head = n & 7;
    const int skey = tid >> 4, spiece = tid & 15, sd = tid >> 2, svp = tid & 3;
    const float C = 0.12751743f;
#define ATT_STORE(buf, kr, vr) { LAS bf16* KN = (LAS bf16*)(lds + (buf) * BUFB); LAS bf16* VN = (LAS bf16*)(lds + (buf) * BUFB + KBYTES); \
        *(LAS u32x4*)&KN[skey * KSTR + spiece * 8] = kr; *(LAS u32x2*)&VN[sd * VSTR + 4 * svp] = (u32x2){vr.x, vr.y}; *(LAS u32x2*)&VN[sd * VSTR + 16 + 4 * svp] = (u32x2){vr.z, vr.w}; }
#define ATT_LOAD(kr, vr, t) { const int tc = min((t), ntile - 1); kr = *(const u32x4*)(kg + (size_t)tc * 32 * ODD_PAD); vr = *(const u32x4*)(vg + tc * 32); }
#define ATT_TILE(buf, kt) { const LAS bf16* KT = (const LAS bf16*)(lds + (buf) * BUFB); const LAS bf16* VL = (const LAS bf16*)(lds + (buf) * BUFB + KBYTES); \
        f32x16 s; _Pragma("unroll") for (int e = 0; e < 16; ++e) s[e] = 0.f; \
        _Pragma("unroll") for (int ks = 0; ks < 8; ++ks) { const bf16x8 kf = *(const LAS bf16x8*)&KT[n * KSTR + ks * 16 + hi * 8]; s = __builtin_amdgcn_mfma_f32_32x32x16_bf16(kf, qf[ks], s, 0, 0, 0); } \
        const unsigned w0 = (unsigned)__builtin_amdgcn_readlane((int)mw[0], (kt)), w1 = (unsigned)__builtin_amdgcn_readlane((int)mw[1], (kt)), w2 = (unsigned)__builtin_amdgcn_readlane((int)mw[2], (kt)), w3 = (unsigned)__builtin_amdgcn_readlane((int)mw[3], (kt)); \
        const unsigned word = (tl == 0 ? w0 : (tl == 1 ? w1 : (tl == 2 ? w2 : w3))) >> (4 * hi); \
          \
        float mx = fmaxf(fmaxf(fmaxf(fmaxf(s[0], s[1]), s[2]), fmaxf(fmaxf(s[3], s[4]), s[5])), fmaxf(fmaxf(fmaxf(s[6], s[7]), s[8]), fmaxf(fmaxf(s[9], s[10]), s[11]))); \
        mx = fmaxf(mx, fmaxf(fmaxf(s[12], s[13]), fmaxf(s[14], s[15]))); \
        { const auto r_ = __builtin_amdgcn_permlane32_swap(__float_as_uint(mx), __float_as_uint(mx), false, false); mx = fmaxf(__uint_as_float(r_[0]), __uint_as_float(r_[1])); } \
        const float mnew = fmaxf(mrow, mx); const bool grow = mnew > mrow; const float alpha = __builtin_amdgcn_exp2f((mrow - mnew) * C); mrow = mnew; \
        const f32x2n_ cc_ = {C, C}, nm_ = {-mnew * C, -mnew * C}; f32x2n_ ps2 = {0.f, 0.f}; float p[16]; \
        _Pragma("unroll") for (int e2 = 0; e2 < 8; ++e2) { const int k0_ = ((2 * e2) & 3) + 8 * ((2 * e2) >> 2); const f32x2n_ ar = __builtin_elementwise_fma((f32x2n_){s[2 * e2], s[2 * e2 + 1]}, cc_, nm_); \
            p[2 * e2] = __uint_as_float(__float_as_uint(__builtin_amdgcn_exp2f(ar.x)) & (unsigned)__builtin_amdgcn_sbfe((int)word, k0_, 1)); \
            p[2 * e2 + 1] = __uint_as_float(__float_as_uint(__builtin_amdgcn_exp2f(ar.y)) & (unsigned)__builtin_amdgcn_sbfe((int)word, k0_ + 1, 1)); ps2 += (f32x2n_){p[2 * e2], p[2 * e2 + 1]}; } \
        const float psum = ps2.x + ps2.y; \
        lrow = lrow * alpha + psum; \
        if (__any(grow)) { _Pragma("unroll") for (int mt = 0; mt < 4; ++mt) _Pragma("unroll") for (int e = 0; e < 16; ++e) o[mt][e] *= alpha; } \
        bf16x8 pf[2]; _Pragma("unroll") for (int s2 = 0; s2 < 2; ++s2) { u32x4 w; w.x = pk2(p[8 * s2 + 0], p[8 * s2 + 1]); w.y = pk2(p[8 * s2 + 2], p[8 * s2 + 3]); w.z = pk2(p[8 * s2 + 4], p[8 * s2 + 5]); w.w = pk2(p[8 * s2 + 6], p[8 * s2 + 7]); pf[s2] = __builtin_bit_cast(bf16x8, w); } \
        _Pragma("unroll") for (int mt = 0; mt < 4; ++mt) { const bf16x8 v0 = *(const LAS bf16x8*)&VL[(32 * mt + n) * VSTR + hi * 16], v1 = *(const LAS bf16x8*)&VL[(32 * mt + n) * VSTR + hi * 16 + 8]; \
            o[mt] = __builtin_amdgcn_mfma_f32_32x32x16_bf16(v0, pf[0], o[mt], 0, 0, 0); o[mt] = __builtin_amdgcn_mfma_f32_32x32x16_bf16(v1, pf[1], o[mt], 0, 0, 0); } }
    for (int it = bid; it < 2048; it += G) {
        const int j = it >> 8, r = it & 255, b = r >> 3, q8 = r & 7; const int qt = j * 8 + ((j & 1) ? 7 - q8 : q8);
        const int t0 = qt * 32 + wave * 4; const size_t rowbase = (size_t)b * 2048; const size_t m = rowbase + t0 + tl;
        const int ntile = qt + 1;
        const bf16* kg = P + (rowbase + skey) * ODD_PAD + O_K + spiece * 8; const bf16* vg = VT + ((size_t)b * 128 + sd) * 2048 + svp * 8;
        u32x4 kA, vA, kB, vB;
        ATT_LOAD(kA, vA, 0)
        bf16x8 qf[8];
        { const bf16* qp = P + m * ODD_PAD + O_Q + head * 128 + hi * 8;
#pragma unroll
          for (int ks = 0; ks < 8; ++ks) qf[ks] = *(const bf16x8*)(qp + ks * 16); }
        unsigned mw[4];
#pragma unroll
        for (int i = 0; i < 4; ++i) mw[i] = MASK[(rowbase + t0 + i) * 64 + lane];
        f32x16 o[4];
#pragma unroll
        for (int mt = 0; mt < 4; ++mt)
#pragma unroll
            for (int e = 0; e < 16; ++e) o[mt][e] = 0.f;
        float mrow = -1e30f, lrow = 0.f;
        ATT_STORE(0, kA, vA)
        ATT_LOAD(kA, vA, 1) ATT_LOAD(kB, vB, 2)
        __syncthreads();
#pragma unroll 1
        for (int kt = 0; kt < ntile; kt += 2) {
            ATT_TILE(0, kt)
            ATT_STORE(1, kA, vA)
            ATT_LOAD(kA, vA, kt + 3)
            __syncthreads();
            if (kt + 1 < ntile) { ATT_TILE(1, kt + 1) }
            ATT_STORE(0, kB, vB)
            ATT_LOAD(kB, vB, kt + 4)
            __syncthreads();
        }
#undef ATT_STORE
#undef ATT_LOAD
#undef ATT_TILE
        const float l = lrow + __shfl_xor(lrow, 32); const float inv = 1.f / l;
        bf16* op = CAT + m * 1024 + head * 128 + 4 * hi;
#pragma unroll
        for (int mt = 0; mt < 4; ++mt)
#pragma unroll
            for (int i = 0; i < 4; ++i) { u32x2 w; w.x = pk2(o[mt][4 * i] * inv, o[mt][4 * i + 1] * inv); w.y = pk2(o[mt][4 * i + 2] * inv, o[mt][4 * i + 3] * inv); *(u32x2*)(op + 32 * mt + 8 * i) = w; }
    }
}
__device__ __forceinline__ void ph_attention4(const Args& a, LAS unsigned char* lds, int bid, int G, int tid) {
    const bf16* P = (const bf16*)(a.ws + WS_P); const unsigned* MASK = (const unsigned*)(a.ws + WS_MASK); const bf16* VT = (const bf16*)(a.ws + WS_VT); bf16* CAT = (bf16*)(a.ws + WS_CAT);
    constexpr int KSTR = 136, VSTR = 72, KBYTES = 64 * KSTR * 2, BUFB = KBYTES + 128 * VSTR * 2;
    const int lane = tid & 63, wave = __builtin_amdgcn_readfirstlane(tid >> 6);
    const int n = lane & 31, hi = lane >> 5, tl = n >> 3, head = n & 7;
    const int skey = tid >> 3, sp2 = tid & 7, sd = tid >> 2, svp = tid & 3;
    const int vsub = 32 * (svp >> 1), vqa = 4 * ((2 * svp) & 3), vqb = 4 * ((2 * svp + 1) & 3);
    const float C = 0.12751743f;
#define ATT_STORE(buf, k0, k1, v0, v1) { LAS bf16* KN = (LAS bf16*)(lds + (buf) * BUFB); LAS bf16* VN = (LAS bf16*)(lds + (buf) * BUFB + KBYTES) + sd * VSTR + vsub; \
        *(LAS u32x4*)&KN[skey * KSTR + sp2 * 16] = k0; *(LAS u32x4*)&KN[skey * KSTR + sp2 * 16 + 8] = k1; \
        *(LAS u32x2*)&VN[vqa] = (u32x2){v0.x, v0.y}; *(LAS u32x2*)&VN[16 + vqa] = (u32x2){v0.z, v0.w}; *(LAS u32x2*)&VN[vqb] = (u32x2){v1.x, v1.y}; *(LAS u32x2*)&VN[16 + vqb] = (u32x2){v1.z, v1.w}; }
#define ATT_LOAD(k0, k1, v0, v1, t) { const int tc = min((t), ntile - 1); const u32x4* kp_ = (const u32x4*)(kg + (size_t)tc * 64 * ODD_PAD); k0 = kp_[0]; k1 = kp_[1]; const u32x4* vp_ = (const u32x4*)(vg + tc * 64); v0 = vp_[0]; v1 = vp_[1]; }
#define ATT_PEXP(S, W, PP, o_) _Pragma("unroll") for (int e2 = 0; e2 < 8; ++e2) { const int k0_ = ((2 * e2) & 3) + 8 * ((2 * e2) >> 2); const f32x2n_ ar = __builtin_elementwise_fma((f32x2n_){S[2 * e2], S[2 * e2 + 1]}, cc_, nm_); \
            PP[(o_) + 2 * e2] = __uint_as_float(__float_as_uint(__builtin_amdgcn_exp2f(ar.x)) & (unsigned)__builtin_amdgcn_sbfe((int)(W), k0_, 1)); \
            PP[(o_) + 2 * e2 + 1] = __uint_as_float(__float_as_uint(__builtin_amdgcn_exp2f(ar.y)) & (unsigned)__builtin_amdgcn_sbfe((int)(W), k0_ + 1, 1)); ps2 += (f32x2n_){PP[(o_) + 2 * e2], PP[(o_) + 2 * e2 + 1]}; }
#define ATT_MAX16(S) fmaxf(fmaxf(fmaxf(fmaxf(fmaxf(S[0], S[1]), S[2]), fmaxf(fmaxf(S[3], S[4]), S[5])), fmaxf(fmaxf(fmaxf(S[6], S[7]), S[8]), fmaxf(fmaxf(S[9], S[10]), S[11]))), fmaxf(fmaxf(S[12], S[13]), fmaxf(S[14], S[15])))
#define ATT_TILE(buf, kt) { const LAS bf16* KT = (const LAS bf16*)(lds + (buf) * BUFB); const LAS bf16* VL = (const LAS bf16*)(lds + (buf) * BUFB + KBYTES); \
        f32x16 sA, sB; _Pragma("unroll") for (int e = 0; e < 16; ++e) { sA[e] = 0.f; sB[e] = 0.f; } \
        _Pragma("unroll") for (int ks = 0; ks < 8; ++ks) { const bf16x8 kfA = *(const LAS bf16x8*)&KT[n * KSTR + ks * 16 + hi * 8], kfB = *(const LAS bf16x8*)&KT[(32 + n) * KSTR + ks * 16 + hi * 8]; \
            sA = __builtin_amdgcn_mfma_f32_32x32x16_bf16(kfA, qf[ks], sA, 0, 0, 0); sB = __builtin_amdgcn_mfma_f32_32x32x16_bf16(kfB, qf[ks], sB, 0, 0, 0); } \
        unsigned wordA, wordB; \
        { const unsigned w0 = (unsigned)__builtin_amdgcn_readlane((int)mw[0], 2 * (kt)), w1 = (unsigned)__builtin_amdgcn_readlane((int)mw[1], 2 * (kt)), w2 = (unsigned)__builtin_amdgcn_readlane((int)mw[2], 2 * (kt)), w3 = (unsigned)__builtin_amdgcn_readlane((int)mw[3], 2 * (kt)); \
          wordA = (tl == 0 ? w0 : (tl == 1 ? w1 : (tl == 2 ? w2 : w3))) >> (4 * hi); } \
        { const unsigned w0 = (unsigned)__builtin_amdgcn_readlane((int)mw[0], 2 * (kt) + 1), w1 = (unsigned)__builtin_amdgcn_readlane((int)mw[1], 2 * (kt) + 1), w2 = (unsigned)__builtin_amdgcn_readlane((int)mw[2], 2 * (kt) + 1), w3 = (unsigned)__builtin_amdgcn_readlane((int)mw[3], 2 * (kt) + 1); \
          wordB = (tl == 0 ? w0 : (tl == 1 ? w1 : (tl == 2 ? w2 : w3))) >> (4 * hi); } \
          \
        float mx = fmaxf(ATT_MAX16(sA), ATT_MAX16(sB)); \
        { const auto r_ = __builtin_amdgcn_permlane32_swap(__float_as_uint(mx), __float_as_uint(mx), false, false); mx = fmaxf(__uint_as_float(r_[0]), __uint_as_float(r_[1])); } \
          \
        const bool anyg = __any(mx > mrow + 62.74f); const float mnew = anyg ? fmaxf(mrow, mx) : mrow; const float alpha = anyg ? __builtin_amdgcn_exp2f((mrow - mnew) * C) : 1.f; mrow = mnew; \
        const f32x2n_ cc_ = {C, C}, nm_ = {-mnew * C, -mnew * C}; f32x2n_ ps2 = {0.f, 0.f}; float p[32]; \
        ATT_PEXP(sA, wordA, p, 0) ATT_PEXP(sB, wordB, p, 16) \
        const float psum = ps2.x + ps2.y; \
        lrow = lrow * alpha + psum; \
        if (anyg) { _Pragma("unroll") for (int mt = 0; mt < 4; ++mt) _Pragma("unroll") for (int e = 0; e < 16; ++e) o[mt][e] *= alpha; } \
        bf16x8 pf[4]; _Pragma("unroll") for (int s2 = 0; s2 < 4; ++s2) { u32x4 w; w.x = pk2(p[8 * s2 + 0], p[8 * s2 + 1]); w.y = pk2(p[8 * s2 + 2], p[8 * s2 + 3]); w.z = pk2(p[8 * s2 + 4], p[8 * s2 + 5]); w.w = pk2(p[8 * s2 + 6], p[8 * s2 + 7]); pf[s2] = __builtin_bit_cast(bf16x8, w); } \
        _Pragma("unroll") for (int mt = 0; mt < 4; ++mt) { const LAS bf16* vr_ = &VL[(32 * mt + n) * VSTR + hi * 16]; \
            const bf16x8 v0 = *(const LAS bf16x8*)vr_, v1 = *(const LAS bf16x8*)(vr_ + 8), v2 = *(const LAS bf16x8*)(vr_ + 32), v3 = *(const LAS bf16x8*)(vr_ + 40); \
            o[mt] = __builtin_amdgcn_mfma_f32_32x32x16_bf16(v0, pf[0], o[mt], 0, 0, 0); o[mt] = __builtin_amdgcn_mfma_f32_32x32x16_bf16(v1, pf[1], o[mt], 0, 0, 0); \
            o[mt] = __builtin_amdgcn_mfma_f32_32x32x16_bf16(v2, pf[2], o[mt], 0, 0, 0); o[mt] = __builtin_amdgcn_mfma_f32_32x32x16_bf16(v3, pf[3], o[mt], 0, 0, 0); } }
    for (int it = bid; it < 2048; it += G) {
        const int j = it >> 8, r = it & 255, b = (r & 7) * 4 + (r >> 6), q8 = (r >> 3) & 7; const int qt = j * 8 + ((j & 1) ? 7 - q8 : q8);
        const int t0 = qt * 32 + wave * 4; const size_t rowbase = (size_t)b * 2048; const size_t m = rowbase + t0 + tl;
        const int ntile = (qt + 2) >> 1;
        const bf16* kg = P + (rowbase + skey) * ODD_PAD + O_K + sp2 * 16; const bf16* vg = VT + ((size_t)b * 128 + sd) * 2048 + svp * 16;
        u32x4 kA0, kA1, vA0, vA1, kB0, kB1, vB0, vB1;
        ATT_LOAD(kA0, kA1, vA0, vA1, 0)
        bf16x8 qf[8];
        { const bf16* qp = P + m * ODD_PAD + O_Q + head * 128 + hi * 8;
#pragma unroll
          for (int ks = 0; ks < 8; ++ks) qf[ks] = *(const bf16x8*)(qp + ks * 16);
          const int tq_ = t0 + tl;
#pragma unroll
          for (int ks = 0; ks < 4; ++ks) rope_pair(qf[ks], qf[ks + 4], (const float*)(a.ws + WS_COSA) + tq_ * 64 + ks * 16 + hi * 8, (const float*)(a.ws + WS_SINA) + tq_ * 64 + ks * 16 + hi * 8); }
        unsigned mw[4];
#pragma unroll
        for (int i = 0; i < 4; ++i) mw[i] = MASK[(rowbase + t0 + i) * 64 + lane];
        f32x16 o[4];
#pragma unroll
        for (int mt = 0; mt < 4; ++mt)
#pragma unroll
            for (int e = 0; e < 16; ++e) o[mt][e] = 0.f;
        float mrow = -1e30f, lrow = 0.f;
        ATT_STORE(0, kA0, kA1, vA0, vA1)
        ATT_LOAD(kA0, kA1, vA0, vA1, 1) ATT_LOAD(kB0, kB1, vB0, vB1, 2)
        __syncthreads();
#pragma unroll 1
        for (int kt = 0; kt < ntile; kt += 2) {
            ATT_TILE(0, kt)
            ATT_STORE(1, kA0, kA1, vA0, vA1)
            ATT_LOAD(kA0, kA1, vA0, vA1, kt + 3)
            __syncthreads();
            if (kt + 1 < ntile) { ATT_TILE(1, kt + 1) }
            ATT_STORE(0, kB0, kB1, vB0, vB1)
            ATT_LOAD(kB0, kB1, vB0, vB1, kt + 4)
            __syncthreads();
        }
#undef ATT_STORE
#undef ATT_LOAD
#undef ATT_TILE
#undef ATT_PEXP
#undef ATT_MAX16
        const float l = lrow + __shfl_xor(lrow, 32); const float inv = 1.f / l;
        bf16* op = CAT + m * 1024 + head * 128 + 8 * hi;
#pragma unroll
        for (int mt = 0; mt < 4; ++mt)
#pragma unroll
            for (int i = 0; i < 4; i += 2) {
                unsigned ax = pk2(o[mt][4 * i] * inv, o[mt][4 * i + 1] * inv), ay = pk2(o[mt][4 * i + 2] * inv, o[mt][4 * i + 3] * inv);
                unsigned bx = pk2(o[mt][4 * i + 4] * inv, o[mt][4 * i + 5] * inv), by = pk2(o[mt][4 * i + 6] * inv, o[mt][4 * i + 7] * inv);
                const auto sx = __builtin_amdgcn_permlane32_swap(ax, bx, false, false); const auto sy = __builtin_amdgcn_permlane32_swap(ay, by, false, false);
                *(u32x4*)(op + 32 * mt + 8 * i) = (u32x4){sx[0], sy[0], sx[1], sy[1]}; }
    }
}

__device__ __forceinline__ void wave_argmax(float& v, int& idx) {
#pragma unroll
    for (int o = 1; o < 64; o <<= 1) { const float ov = __shfl_xor(v, o); const int oi = __shfl_xor(idx, o); if (ov > v || (ov == v && oi < idx)) { v = ov; idx = oi; } }
}
__device__ __forceinline__ void ph_route(const Args& a, int layer, LAS unsigned char* lds, int gw, int NGW, int wave, int lane) {
    const bf16* Q = (const bf16*)(a.ws + WS_QP); const float* SK = a.in[22] + (size_t)layer * 8 * 2 * 128 * 64;
    unsigned short* RI = (unsigned short*)(a.ws + WS_RIDX); float* RG = (float*)(a.ws + WS_RGATE);
    LAS float* qh = (LAS float*)(lds + wave * 2048); LAS float* ts = (LAS float*)(lds + wave * 2048 + 512); LAS int* ti = (LAS int*)(lds + wave * 2048 + 640);
    const float NEG_INF = -__builtin_inff();
    for (int m = gw; m < MTOK; m += NGW) {
        for (int h = 0; h < 8; ++h) {
            qh[lane] = bf2f(Q[(size_t)m * 1024 + h * 128 + lane]); qh[64 + lane] = bf2f(Q[(size_t)m * 1024 + h * 128 + 64 + lane]);
            LDS_WAIT();
#pragma unroll
            for (int c = 0; c < 2; ++c) {
                float v0, v1;
                { const f32x4* k0 = (const f32x4*)(SK + ((size_t)(h * 2 + c) * 128 + lane) * 64); const f32x4* k1 = (const f32x4*)(SK + ((size_t)(h * 2 + c) * 128 + 64 + lane) * 64); float a0 = 0.f, a1 = 0.f;
#pragma unroll
                  for (int d4 = 0; d4 < 16; ++d4) { const f32x4 qv = *(const LAS f32x4*)&qh[c * 64 + d4 * 4]; const f32x4 x0 = k0[d4], x1 = k1[d4];
                      a0 += qv.x * x0.x + qv.y * x0.y + qv.z * x0.z + qv.w * x0.w; a1 += qv.x * x1.x + qv.y * x1.y + qv.z * x1.z + qv.w * x1.w; }
                  v0 = a0; v1 = a1; }
                for (int r = 0; r < 16; ++r) { float bv = v0; int bi = lane; if (v1 > v0) { bv = v1; bi = lane + 64; }
                    wave_argmax(bv, bi);
                    if (bi == lane) v0 = NEG_INF; if (bi == lane + 64) v1 = NEG_INF;
                    if (lane == 0) { ts[c * 16 + r] = bv; ti[c * 16 + r] = bi; } }
            }
            LDS_WAIT();
            float cv[4];
#pragma unroll
            for (int jj = 0; jj < 4; ++jj) { const int f = lane + 64 * jj; cv[jj] = ts[f >> 4] + ts[16 + (f & 15)]; }
            float bs = 0.f; int bpos = 0;
            for (int r = 0; r < 16; ++r) { float bv = cv[0]; int bi = lane;
#pragma unroll
                for (int jj = 1; jj < 4; ++jj) if (cv[jj] > bv) { bv = cv[jj]; bi = lane + 64 * jj; }
                wave_argmax(bv, bi);
#pragma unroll
                for (int jj = 0; jj < 4; ++jj) if (bi == lane + 64 * jj) cv[jj] = NEG_INF;
                if (lane == r) { bs = bv; bpos = bi; } }
            const float mx = __shfl(bs, 0); const float e = (lane < 16) ? expf(bs - mx) : 0.f; const float sum = wave_sum(e);
            if (lane < 16) { const int ei = ti[bpos >> 4] * 128 + ti[16 + (bpos & 15)]; RI[(size_t)m * 128 + h * 16 + lane] = (unsigned short)ei; RG[(size_t)m * 128 + h * 16 + lane] = e / sum; }
            LDS_WAIT();
        }
    }
}
__device__ __forceinline__ void ph_experts(const Args& a, int layer, int gw, int NGW, int lane) {
    const float* U = a.in[23] + (size_t)layer * 16384 * 1024; const float* V = a.in[24] + (size_t)layer * 16384 * 1024;
    const unsigned short* RI = (const unsigned short*)(a.ws + WS_RIDX); const float* RG = (const float*)(a.ws + WS_RGATE);
    const float* g = a.in[25] + layer * 1024; const float* bb = a.in[26] + layer * 1024; bf16* XB = (bf16*)(a.ws + WS_XB);
    for (int m = gw; m < MTOK; m += NGW) {
        f32x4 x[4], acc[4];
        const f32x4* xr = (const f32x4*)(a.out + (size_t)m * 1024) + lane;
#pragma unroll
        for (int j = 0; j < 4; ++j) { x[j] = xr[64 * j]; acc[j] = (f32x4){0.f, 0.f, 0.f, 0.f}; }
        for (int k = 0; k < 128; ++k) {
            const int e = RI[(size_t)m * 128 + k]; const float gate = RG[(size_t)m * 128 + k];
            const f32x4* ur = (const f32x4*)(U + (size_t)e * 1024) + lane; const f32x4* vr = (const f32x4*)(V + (size_t)e * 1024) + lane;
            f32x4 uv[4], vv[4];
#pragma unroll
            for (int j = 0; j < 4; ++j) { uv[j] = ur[64 * j]; vv[j] = vr[64 * j]; }
            float d = 0.f;
#pragma unroll
            for (int j = 0; j < 4; ++j) d += (x[j].x * uv[j].x + x[j].y * uv[j].y) + (x[j].z * uv[j].z + x[j].w * uv[j].w);
            d = wave_sum(d);
            const float coef = gate * 0.5f * d * (1.f + erff(d * 0.7071067811865476f));
#pragma unroll
            for (int j = 0; j < 4; ++j) acc[j] += vv[j] * coef;
        }
        float s = 0.f;
#pragma unroll
        for (int j = 0; j < 4; ++j) { acc[j] = x[j] * DN_ALPHA + acc[j]; s += (acc[j].x + acc[j].y) + (acc[j].z + acc[j].w); }
        const float mean = wave_sum(s) * (1.f / 1024.f); float s2 = 0.f;
#pragma unroll
        for (int j = 0; j < 4; ++j) { acc[j] = acc[j] - mean; s2 += (acc[j].x * acc[j].x + acc[j].y * acc[j].y) + (acc[j].z * acc[j].z + acc[j].w * acc[j].w); }
        const float rstd = 1.f / sqrtf(wave_sum(s2) * (1.f / 1024.f) + LN_EPS);
        f32x4* orow = (f32x4*)(a.out + (size_t)m * 1024) + lane; u32x2* ob = (u32x2*)(XB + (size_t)m * 1024) + lane;
#pragma unroll
        for (int j = 0; j < 4; ++j) { const f32x4 o = acc[j] * rstd * ((const f32x4*)g)[lane + 64 * j] + ((const f32x4*)bb)[lane + 64 * j]; orow[64 * j] = o; u32x2 w; w.x = pk2(o.x, o.y); w.y = pk2(o.z, o.w); ob[64 * j] = w; }
    }
}

__device__ __forceinline__ void cas_desc(int& x, int& y) { const int h = max(x, y), l = min(x, y); x = h; y = l; }
__device__ __forceinline__ void sort16_desc(int (&v)[16]) {
    cas_desc(v[0], v[13]); cas_desc(v[1], v[12]); cas_desc(v[2], v[15]); cas_desc(v[3], v[14]); cas_desc(v[4], v[8]); cas_desc(v[5], v[6]); cas_desc(v[7], v[11]); cas_desc(v[9], v[10]); cas_desc(v[0], v[5]); cas_desc(v[1], v[7]); cas_desc(v[2], v[9]); cas_desc(v[3], v[4]); cas_desc(v[6], v[13]); cas_desc(v[8], v[14]); cas_desc(v[10], v[15]); cas_desc(v[11], v[12]); cas_desc(v[0], v[1]); cas_desc(v[2], v[3]); cas_desc(v[4], v[5]); cas_desc(v[6], v[8]); cas_desc(v[7], v[9]); cas_desc(v[10], v[11]); cas_desc(v[12], v[13]); cas_desc(v[14], v[15]); cas_desc(v[0], v[2]); cas_desc(v[1], v[3]); cas_desc(v[4], v[10]); cas_desc(v[5], v[11]); cas_desc(v[6], v[7]); cas_desc(v[8], v[9]); cas_desc(v[12], v[14]); cas_desc(v[13], v[15]); cas_desc(v[1], v[2]); cas_desc(v[3], v[12]); cas_desc(v[4], v[6]); cas_desc(v[5], v[7]); cas_desc(v[8], v[10]); cas_desc(v[9], v[11]); cas_desc(v[13], v[14]); cas_desc(v[1], v[4]); cas_desc(v[2], v[6]); cas_desc(v[5], v[8]); cas_desc(v[7], v[10]); cas_desc(v[9], v[13]); cas_desc(v[11], v[14]); cas_desc(v[2], v[4]); cas_desc(v[3], v[6]); cas_desc(v[9], v[12]); cas_desc(v[11], v[13]); cas_desc(v[3], v[5]); cas_desc(v[6], v[8]); cas_desc(v[7], v[9]); cas_desc(v[10], v[12]); cas_desc(v[3], v[4]); cas_desc(v[5], v[6]); cas_desc(v[7], v[8]); cas_desc(v[9], v[10]); cas_desc(v[11], v[12]); cas_desc(v[6], v[7]); cas_desc(v[8], v[9]);
}
__device__ __forceinline__ void merge16_desc(int (&v)[16]) {
#pragma unroll
    for (int j = 8; j > 0; j >>= 1)
#pragma unroll
        for (int i = 0; i < 16; ++i) { const int l = i ^ j; if (l > i) cas_desc(v[i], v[l]); }
}
__device__ __forceinline__ void topmerge16(int (&x)[16], const int (&y)[16]) {
#pragma unroll
    for (int i = 0; i < 16; ++i) x[i] = max(x[i], y[15 - i]);
    merge16_desc(x);
}
__device__ __forceinline__ int skey_of(float f) { const int u = __float_as_int(f); return u ^ ((u >> 31) & 0x7fffffff); }
__device__ __forceinline__ float f_of_skey(int s) { return __int_as_float(s ^ ((s >> 31) & 0x7fffffff)); }
__device__ __forceinline__ int packc(float f, int pos) { return (skey_of(f) & ~255) | (255 - pos); }
__device__ __forceinline__ void route_top128(const bf16* SKb, const bf16* qrow, int hi, int n, int (&L)[16]) {
    bf16x8 qf[4];
#pragma unroll
    for (int ks = 0; ks < 4; ++ks) qf[ks] = *(const bf16x8*)(qrow + ks * 16);
    f32x16 acc[4];
    u32x4 afr[4][4];
#pragma unroll
    for (int mt = 0; mt < 4; ++mt)
#pragma unroll
        for (int ks = 0; ks < 4; ++ks) afr[mt][ks] = *(const u32x4*)(SKb + (size_t)(32 * mt + n) * 64 + ks * 16 + hi * 8);
    asm volatile("" : "+v"(afr[0][0]), "+v"(afr[0][1]), "+v"(afr[0][2]), "+v"(afr[0][3]), "+v"(afr[1][0]), "+v"(afr[1][1]), "+v"(afr[1][2]), "+v"(afr[1][3]));
    asm volatile("" : "+v"(afr[2][0]), "+v"(afr[2][1]), "+v"(afr[2][2]), "+v"(afr[2][3]), "+v"(afr[3][0]), "+v"(afr[3][1]), "+v"(afr[3][2]), "+v"(afr[3][3]));
#pragma unroll
    for (int mt = 0; mt < 4; ++mt) {
#pragma unroll
        for (int e = 0; e < 16; ++e) acc[mt][e] = 0.f;
#pragma unroll
        for (int ks = 0; ks < 4; ++ks) acc[mt] = __builtin_amdgcn_mfma_f32_32x32x16_bf16(__builtin_bit_cast(bf16x8, afr[mt][ks]), qf[ks], acc[mt], 0, 0, 0);
    }
    const int hx = 4 * hi;
#pragma unroll
    for (int mt = 0; mt < 4; ++mt) { int v[16];
#pragma unroll
        for (int r = 0; r < 16; ++r) { const int cst = 127 - (32 * mt + 8 * (r >> 2) + (r & 3)); v[r] = ((skey_of(acc[mt][r]) & ~127) | cst) ^ hx; }
        sort16_desc(v);
        if (mt == 0) {
#pragma unroll
            for (int r = 0; r < 16; ++r) L[r] = v[r]; }
        else topmerge16(L, v); }
    int o[16];
#pragma unroll
    for (int r = 0; r < 16; ++r) o[r] = __shfl_xor(L[r], 32);
    topmerge16(L, o);
}
__device__ __forceinline__ void ph_route2(const Args& a, int layer, LAS unsigned char* lds, int bid, int G, int wave, int lane) {
    const bf16* Q = (const bf16*)(a.ws + WS_QP); const bf16* SKb = (const bf16*)(a.ws + WS_SK) + (size_t)layer * 8 * 2 * 128 * 64 + (size_t)wave * 2 * 128 * 64;
    unsigned short* RI = (unsigned short*)(a.ws + WS_RIDX); float* RG = (float*)(a.ws + WS_RGATE);
    LAS unsigned char* lk = lds + wave * 2304 + lane * 36;
    const int n = lane & 31, hi = lane >> 5, h = wave;
    for (int tile = bid; tile < MTOK / 32; tile += G) {
        const size_t tok = (size_t)tile * 32 + n; const bf16* qrow = Q + tok * 1024 + h * 128 + hi * 8;
        int A[16], B[16];
        route_top128(SKb, qrow, hi, n, A);
        route_top128(SKb + 128 * 64, qrow + 64, hi, n, B);
        float fa[16], fb[16];
#pragma unroll
        for (int i = 0; i < 16; ++i) { fa[i] = f_of_skey(A[i] & ~127); fb[i] = f_of_skey(B[i] & ~127); }
        { unsigned wa[4], wb[4];
#pragma unroll
          for (int q = 0; q < 4; ++q) { wa[q] = 0u; wb[q] = 0u;
#pragma unroll
              for (int e = 0; e < 4; ++e) { wa[q] |= (unsigned)(127 - (A[4 * q + e] & 127)) << (8 * e); wb[q] |= (unsigned)(127 - (B[4 * q + e] & 127)) << (8 * e); } }
#pragma unroll
          for (int q = 0; q < 4; ++q) { ((LAS unsigned*)lk)[q] = wa[q]; ((LAS unsigned*)lk)[4 + q] = wb[q]; } }
        int T[16], S1[16], S2[16], S3[16];
#pragma unroll
        for (int j = 0; j < 16; ++j) T[j] = packc(fa[0] + fb[j], j);
#pragma unroll
        for (int j = 0; j < 8; ++j) { S1[j] = packc(fa[1] + fb[j], 16 + j); S1[15 - j] = packc(fa[8 + j] + fb[0], (8 + j) * 16); }
        merge16_desc(S1);
        S2[0] = packc(fa[2] + fb[0], 32); S2[1] = packc(fa[2] + fb[1], 33); S2[2] = packc(fa[2] + fb[2], 34); S2[3] = packc(fa[2] + fb[3], 35); S2[4] = packc(fa[2] + fb[4], 36);
        S2[5] = packc(fa[3] + fb[0], 48); S2[6] = packc(fa[3] + fb[1], 49); S2[7] = packc(fa[3] + fb[2], 50); S2[8] = packc(fa[3] + fb[3], 51);
        S2[9] = packc(fa[4] + fb[0], 64); S2[10] = packc(fa[4] + fb[1], 65); S2[11] = packc(fa[4] + fb[2], 66);
        S2[12] = packc(fa[5] + fb[0], 80); S2[13] = packc(fa[5] + fb[1], 81); S2[14] = packc(fa[6] + fb[0], 96); S2[15] = packc(fa[6] + fb[1], 97);
        sort16_desc(S2);
        S3[0] = packc(fa[7] + fb[0], 112); S3[1] = packc(fa[7] + fb[1], 113);
#pragma unroll
        for (int j = 2; j < 16; ++j) S3[j] = (int)0x80000000;
        topmerge16(T, S1); topmerge16(T, S2); topmerge16(T, S3);
        LDS_WAIT();
        float ev[16]; float sum = 0.f; const float mx = f_of_skey(T[0] & ~255);
#pragma unroll
        for (int r = 0; r < 16; ++r) { ev[r] = __expf(f_of_skey(T[r] & ~255) - mx); sum += ev[r]; }
        const float inv = 1.f / sum;
        unsigned ei[16];
#pragma unroll
        for (int r = 0; r < 16; ++r) { const int pos = 255 - (T[r] & 255); ei[r] = (unsigned)lk[pos >> 4] * 128u + (unsigned)lk[16 + (pos & 15)]; }
        unsigned short* ri = RI + tok * 128 + h * 16 + hi * 8; float* rg = RG + tok * 128 + h * 16 + hi * 8;
        u32x4 wi; f32x4 g0, g1;
        if (hi == 0) { wi.x = ei[0] | (ei[1] << 16); wi.y = ei[2] | (ei[3] << 16); wi.z = ei[4] | (ei[5] << 16); wi.w = ei[6] | (ei[7] << 16); g0 = (f32x4){ev[0], ev[1], ev[2], ev[3]}; g1 = (f32x4){ev[4], ev[5], ev[6], ev[7]}; }
        else { wi.x = ei[8] | (ei[9] << 16); wi.y = ei[10] | (ei[11] << 16); wi.z = ei[12] | (ei[13] << 16); wi.w = ei[14] | (ei[15] << 16); g0 = (f32x4){ev[8], ev[9], ev[10], ev[11]}; g1 = (f32x4){ev[12], ev[13], ev[14], ev[15]}; }
        *(u32x4*)ri = wi; *(f32x4*)rg = g0 * inv; *(f32x4*)(rg + 4) = g1 * inv;
        LDS_WAIT();
    }
}

__device__ __forceinline__ void convert_experts(const Args& a, int layer, int gtid, int NT) {
    const f32x4* U = (const f32x4*)(a.in[23] + (size_t)layer * 16384 * 1024); const f32x4* V = (const f32x4*)(a.in[24] + (size_t)layer * 16384 * 1024);
    u32x4* DU = (u32x4*)(a.ws + WS_EXP); u32x4* DV = DU + (size_t)16384 * 1024 / 8;
    for (size_t i = gtid; i < (size_t)16384 * 1024 / 8; i += NT) {
        const f32x4 a0 = U[2 * i], a1 = U[2 * i + 1], b0 = V[2 * i], b1 = V[2 * i + 1];
        u32x4 o; o.x = pk2(a0.x, a0.y); o.y = pk2(a0.z, a0.w); o.z = pk2(a1.x, a1.y); o.w = pk2(a1.z, a1.w); DU[i] = o;
        u32x4 p; p.x = pk2(b0.x, b0.y); p.y = pk2(b0.z, b0.w); p.z = pk2(b1.x, b1.y); p.w = pk2(b1.z, b1.w); DV[i] = p; }
}
__device__ __forceinline__ float dot8(const f32x4 xa, const f32x4 xb, const u32x4 w) {
    return (xa.x * bflo(w.x) + xa.y * bfhi(w.x)) + (xa.z * bflo(w.y) + xa.w * bfhi(w.y)) + (xb.x * bflo(w.z) + xb.y * bfhi(w.z)) + (xb.z * bflo(w.w) + xb.w * bfhi(w.w));
}
__device__ __forceinline__ void axpy8(f32x4& aa, f32x4& ab, const float c, const u32x4 w) {
    aa.x += c * bflo(w.x); aa.y += c * bfhi(w.x); aa.z += c * bflo(w.y); aa.w += c * bfhi(w.y); ab.x += c * bflo(w.z); ab.y += c * bfhi(w.z); ab.z += c * bflo(w.w); ab.w += c * bfhi(w.w);
}
__device__ __forceinline__ float gelu_exact(float d) { return 0.5f * d * (1.f + erff(d * 0.7071067811865476f)); }
__device__ __forceinline__ void ph_experts2(const Args& a, int layer, int gw, int NGW, int lane, float* OUTP, bf16* XBP) {
    const bf16* U = (const bf16*)(a.ws + WS_EXP); const bf16* V = U + (size_t)16384 * 1024;
    const unsigned short* RI = (const unsigned short*)(a.ws + WS_RIDX); const float* RG = (const float*)(a.ws + WS_RGATE);
    const float* g = a.in[25] + layer * 1024; const float* bb = a.in[26] + layer * 1024; bf16* XB = XBP;
    for (int m = gw; m < MTOK; m += NGW) {
        const f32x4* xr = (const f32x4*)(a.out + (size_t)m * 1024);
        const f32x4 x0 = xr[2 * lane], x1 = xr[2 * lane + 1], x2 = xr[128 + 2 * lane], x3 = xr[128 + 2 * lane + 1];
        const unsigned idxp = ((const unsigned*)(RI + (size_t)m * 128))[lane];
        const float gp0 = RG[(size_t)m * 128 + 2 * lane], gp1 = RG[(size_t)m * 128 + 2 * lane + 1];
        f32x4 c0 = {0.f, 0.f, 0.f, 0.f}, c1 = c0, c2 = c0, c3 = c0;
        u32x4 Au0a, Au0b, Av0a, Av0b, Au1a, Au1b, Av1a, Av1b, Bu0a, Bu0b, Bv0a, Bv0b, Bu1a, Bu1b, Bv1a, Bv1b;
#define LOADG(X, gg) { const unsigned word = (unsigned)__builtin_amdgcn_readlane((int)idxp, (gg)); const unsigned e0 = word & 0xffffu, e1 = word >> 16; \
        const u32x4* pu0 = (const u32x4*)(U + (size_t)e0 * 1024) + lane; const u32x4* pv0 = (const u32x4*)(V + (size_t)e0 * 1024) + lane; \
        const u32x4* pu1 = (const u32x4*)(U + (size_t)e1 * 1024) + lane; const u32x4* pv1 = (const u32x4*)(V + (size_t)e1 * 1024) + lane; \
        X##u0a = pu0[0]; X##u0b = pu0[64]; X##u1a = pu1[0]; X##u1b = pu1[64]; X##v0a = pv0[0]; X##v0b = pv0[64]; X##v1a = pv1[0]; X##v1b = pv1[64]; }
#define COMPG(X, gg) { float d0 = dot8(x0, x1, X##u0a) + dot8(x2, x3, X##u0b), d1 = dot8(x0, x1, X##u1a) + dot8(x2, x3, X##u1b); \
        d0 = wave_sum(d0); d1 = wave_sum(d1); \
        const float k0 = __builtin_bit_cast(float, __builtin_amdgcn_readlane(__builtin_bit_cast(int, gp0), (gg))) * gelu_exact(d0); \
        const float k1 = __builtin_bit_cast(float, __builtin_amdgcn_readlane(__builtin_bit_cast(int, gp1), (gg))) * gelu_exact(d1); \
        axpy8(c0, c1, k0, X##v0a); axpy8(c2, c3, k0, X##v0b); axpy8(c0, c1, k1, X##v1a); axpy8(c2, c3, k1, X##v1b); }
        LOADG(A, 0) LOADG(B, 1)
#pragma unroll 1
        for (int gg = 0; gg < 64; gg += 2) {
            COMPG(A, gg) if (gg + 2 < 64) LOADG(A, gg + 2)
            COMPG(B, gg + 1) if (gg + 3 < 64) LOADG(B, gg + 3)
        }
#undef LOADG
#undef COMPG
        float s = 0.f;
        c0 = x0 * DN_ALPHA + c0; c1 = x1 * DN_ALPHA + c1; c2 = x2 * DN_ALPHA + c2; c3 = x3 * DN_ALPHA + c3;
        s = ((c0.x + c0.y) + (c0.z + c0.w)) + ((c1.x + c1.y) + (c1.z + c1.w)) + ((c2.x + c2.y) + (c2.z + c2.w)) + ((c3.x + c3.y) + (c3.z + c3.w));
        const float mean = wave_sum(s) * (1.f / 1024.f);
        c0 = c0 - mean; c1 = c1 - mean; c2 = c2 - mean; c3 = c3 - mean;
        const float s2 = ((c0.x * c0.x + c0.y * c0.y) + (c0.z * c0.z + c0.w * c0.w)) + ((c1.x * c1.x + c1.y * c1.y) + (c1.z * c1.z + c1.w * c1.w)) + ((c2.x * c2.x + c2.y * c2.y) + (c2.z * c2.z + c2.w * c2.w)) + ((c3.x * c3.x + c3.y * c3.y) + (c3.z * c3.z + c3.w * c3.w));
        const float rstd = 1.f / sqrtf(wave_sum(s2) * (1.f / 1024.f) + LN_EPS);
        const f32x4* g4 = (const f32x4*)g; const f32x4* b4 = (const f32x4*)bb;
        const f32x4 o0 = c0 * rstd * g4[2 * lane] + b4[2 * lane], o1 = c1 * rstd * g4[2 * lane + 1] + b4[2 * lane + 1], o2 = c2 * rstd * g4[128 + 2 * lane] + b4[128 + 2 * lane], o3 = c3 * rstd * g4[128 + 2 * lane + 1] + b4[128 + 2 * lane + 1];
        f32x4* orow = (f32x4*)(OUTP + (size_t)m * 1024);
        orow[2 * lane] = o0; orow[2 * lane + 1] = o1; orow[128 + 2 * lane] = o2; orow[128 + 2 * lane + 1] = o3;
        u32x4* ob = (u32x4*)(XB + (size_t)m * 1024);
        u32x4 w0; w0.x = pk2(o0.x, o0.y); w0.y = pk2(o0.z, o0.w); w0.z = pk2(o1.x, o1.y); w0.w = pk2(o1.z, o1.w); ob[lane] = w0;
        u32x4 w1; w1.x = pk2(o2.x, o2.y); w1.y = pk2(o2.z, o2.w); w1.z = pk2(o3.x, o3.y); w1.w = pk2(o3.z, o3.w); ob[64 + lane] = w1;
    }
}

typedef float f32x2_ __attribute__((ext_vector_type(2)));
__device__ __forceinline__ void convert_experts_fp8(const Args& a, int layer, int gw, int NGW, int lane) {
    u32x4* D8 = (u32x4*)(a.ws + WS_EXP); float* SC = (float*)(a.ws + WS_EXP + 32 * MiB);
    for (int row = gw; row < 2 * 16384; row += NGW) {
        const float* src = (row < 16384 ? a.in[23] : a.in[24]) + ((size_t)layer * 16384 + (row & 16383)) * 1024;
        const f32x4* s4 = (const f32x4*)src + 4 * lane; const f32x4 v0 = s4[0], v1 = s4[1], v2 = s4[2], v3 = s4[3];
        float am = fmaxf(fmaxf(fmaxf(fabsf(v0.x), fabsf(v0.y)), fmaxf(fabsf(v0.z), fabsf(v0.w))), fmaxf(fmaxf(fabsf(v1.x), fabsf(v1.y)), fmaxf(fabsf(v1.z), fabsf(v1.w))));
        am = fmaxf(am, fmaxf(fmaxf(fmaxf(fabsf(v2.x), fabsf(v2.y)), fmaxf(fabsf(v2.z), fabsf(v2.w))), fmaxf(fmaxf(fabsf(v3.x), fabsf(v3.y)), fmaxf(fabsf(v3.z), fabsf(v3.w)))));
        am = wave_max(am);
        const float sc = am > 0.f ? am * (1.f / 448.f) : 1.f, inv = am > 0.f ? 448.f / am : 1.f;
        u32x4 o; int w;
        w = 0; w = __builtin_amdgcn_cvt_pk_fp8_f32(v0.x * inv, v0.y * inv, w, false); w = __builtin_amdgcn_cvt_pk_fp8_f32(v0.z * inv, v0.w * inv, w, true); o.x = (unsigned)w;
        w = 0; w = __builtin_amdgcn_cvt_pk_fp8_f32(v1.x * inv, v1.y * inv, w, false); w = __builtin_amdgcn_cvt_pk_fp8_f32(v1.z * inv, v1.w * inv, w, true); o.y = (unsigned)w;
        w = 0; w = __builtin_amdgcn_cvt_pk_fp8_f32(v2.x * inv, v2.y * inv, w, false); w = __builtin_amdgcn_cvt_pk_fp8_f32(v2.z * inv, v2.w * inv, w, true); o.z = (unsigned)w;
        w = 0; w = __builtin_amdgcn_cvt_pk_fp8_f32(v3.x * inv, v3.y * inv, w, false); w = __builtin_amdgcn_cvt_pk_fp8_f32(v3.z * inv, v3.w * inv, w, true); o.w = (unsigned)w;
        D8[(size_t)row * 64 + lane] = o;
        if (lane == 0) SC[row] = sc;
    }
}
__device__ __forceinline__ float dot16_fp8(const f32x4 xa, const f32x4 xb, const f32x4 xc, const f32x4 xd, const u32x4 w) {
    const f32x2_ a0 = __builtin_amdgcn_cvt_pk_f32_fp8((int)w.x, false), a1 = __builtin_amdgcn_cvt_pk_f32_fp8((int)w.x, true), b0 = __builtin_amdgcn_cvt_pk_f32_fp8((int)w.y, false), b1 = __builtin_amdgcn_cvt_pk_f32_fp8((int)w.y, true);
    const f32x2_ c0 = __builtin_amdgcn_cvt_pk_f32_fp8((int)w.z, false), c1 = __builtin_amdgcn_cvt_pk_f32_fp8((int)w.z, true), d0 = __builtin_amdgcn_cvt_pk_f32_fp8((int)w.w, false), d1 = __builtin_amdgcn_cvt_pk_f32_fp8((int)w.w, true);
    f32x2_ p = (f32x2_){xa.x, xa.y} * a0; p = __builtin_elementwise_fma((f32x2_){xa.z, xa.w}, a1, p); p = __builtin_elementwise_fma((f32x2_){xb.x, xb.y}, b0, p); p = __builtin_elementwise_fma((f32x2_){xb.z, xb.w}, b1, p);
    f32x2_ q = (f32x2_){xc.x, xc.y} * c0; q = __builtin_elementwise_fma((f32x2_){xc.z, xc.w}, c1, q); q = __builtin_elementwise_fma((f32x2_){xd.x, xd.y}, d0, q); q = __builtin_elementwise_fma((f32x2_){xd.z, xd.w}, d1, q);
    p = p + q;
    return p.x + p.y;
}
__device__ __forceinline__ void axpy16_fp8(f32x4& ya, f32x4& yb, f32x4& yc, f32x4& yd, const float c, const u32x4 w) {
    const f32x2_ a0 = __builtin_amdgcn_cvt_pk_f32_fp8((int)w.x, false), a1 = __builtin_amdgcn_cvt_pk_f32_fp8((int)w.x, true), b0 = __builtin_amdgcn_cvt_pk_f32_fp8((int)w.y, false), b1 = __builtin_amdgcn_cvt_pk_f32_fp8((int)w.y, true);
    const f32x2_ c0 = __builtin_amdgcn_cvt_pk_f32_fp8((int)w.z, false), c1 = __builtin_amdgcn_cvt_pk_f32_fp8((int)w.z, true), d0 = __builtin_amdgcn_cvt_pk_f32_fp8((int)w.w, false), d1 = __builtin_amdgcn_cvt_pk_f32_fp8((int)w.w, true);
    const f32x2_ cc = {c, c};
    f32x2_ t;
    t = (f32x2_){ya.x, ya.y}; t = __builtin_elementwise_fma(cc, a0, t); ya.x = t.x; ya.y = t.y; t = (f32x2_){ya.z, ya.w}; t = __builtin_elementwise_fma(cc, a1, t); ya.z = t.x; ya.w = t.y;
    t = (f32x2_){yb.x, yb.y}; t = __builtin_elementwise_fma(cc, b0, t); yb.x = t.x; yb.y = t.y; t = (f32x2_){yb.z, yb.w}; t = __builtin_elementwise_fma(cc, b1, t); yb.z = t.x; yb.w = t.y;
    t = (f32x2_){yc.x, yc.y}; t = __builtin_elementwise_fma(cc, c0, t); yc.x = t.x; yc.y = t.y; t = (f32x2_){yc.z, yc.w}; t = __builtin_elementwise_fma(cc, c1, t); yc.z = t.x; yc.w = t.y;
    t = (f32x2_){yd.x, yd.y}; t = __builtin_elementwise_fma(cc, d0, t); yd.x = t.x; yd.y = t.y; t = (f32x2_){yd.z, yd.w}; t = __builtin_elementwise_fma(cc, d1, t); yd.z = t.x; yd.w = t.y;
}
__device__ __forceinline__ void ph_experts3(const Args& a, int layer, int gw, int NGW, int lane, float* OUTP, bf16* XBP) {
    const u32x4* U8 = (const u32x4*)(a.ws + WS_EXP); const u32x4* V8 = U8 + (size_t)16384 * 64; const float* SU = (const float*)(a.ws + WS_EXP + 32 * MiB); const float* SV = SU + 16384;
    const unsigned short* RI = (const unsigned short*)(a.ws + WS_RIDX); const float* RG = (const float*)(a.ws + WS_RGATE);
    const float* g = a.in[25] + layer * 1024; const float* bb = a.in[26] + layer * 1024;
    for (int m = gw; m < MTOK; m += NGW) {
        const f32x4* xr = (const f32x4*)(a.out + (size_t)m * 1024) + 4 * lane;
        const f32x4 x0 = xr[0], x1 = xr[1], x2 = xr[2], x3 = xr[3];
        const unsigned idxp = ((const unsigned*)(RI + (size_t)m * 128))[lane];
        const float gp0 = RG[(size_t)m * 128 + 2 * lane], gp1 = RG[(size_t)m * 128 + 2 * lane + 1];
        f32x4 c0 = {0.f, 0.f, 0.f, 0.f}, c1 = c0, c2 = c0, c3 = c0;
        u32x4 Au0, Au1, Au2, Au3, Av0, Av1, Av2, Av3, Bu0, Bu1, Bu2, Bu3, Bv0, Bv1, Bv2, Bv3;
        unsigned Ae0, Ae1, Ae2, Ae3, Be0, Be1, Be2, Be3;
#define LOADG(X, gg) { const unsigned wa = (unsigned)__builtin_amdgcn_readlane((int)idxp, 2 * (gg)), wb = (unsigned)__builtin_amdgcn_readlane((int)idxp, 2 * (gg) + 1); \
        X##e0 = wa & 0xffffu; X##e1 = wa >> 16; X##e2 = wb & 0xffffu; X##e3 = wb >> 16; \
        X##u0 = U8[(size_t)X##e0 * 64 + lane]; X##u1 = U8[(size_t)X##e1 * 64 + lane]; X##u2 = U8[(size_t)X##e2 * 64 + lane]; X##u3 = U8[(size_t)X##e3 * 64 + lane]; \
        X##v0 = V8[(size_t)X##e0 * 64 + lane]; X##v1 = V8[(size_t)X##e1 * 64 + lane]; X##v2 = V8[(size_t)X##e2 * 64 + lane]; X##v3 = V8[(size_t)X##e3 * 64 + lane]; }
#define RDG(v, l) __builtin_bit_cast(float, __builtin_amdgcn_readlane(__builtin_bit_cast(int, v), (l)))
#define COMPG(X, gg) { float d0 = dot16_fp8(x0, x1, x2, x3, X##u0), d1 = dot16_fp8(x0, x1, x2, x3, X##u1), d2 = dot16_fp8(x0, x1, x2, x3, X##u2), d3 = dot16_fp8(x0, x1, x2, x3, X##u3); \
        d0 = wave_sum(d0) * SU[X##e0]; d1 = wave_sum(d1) * SU[X##e1]; d2 = wave_sum(d2) * SU[X##e2]; d3 = wave_sum(d3) * SU[X##e3]; \
        const float k0 = RDG(gp0, 2 * (gg)) * gelu_exact(d0) * SV[X##e0], k1 = RDG(gp1, 2 * (gg)) * gelu_exact(d1) * SV[X##e1], k2 = RDG(gp0, 2 * (gg) + 1) * gelu_exact(d2) * SV[X##e2], k3 = RDG(gp1, 2 * (gg) + 1) * gelu_exact(d3) * SV[X##e3]; \
        axpy16_fp8(c0, c1, c2, c3, k0, X##v0); axpy16_fp8(c0, c1, c2, c3, k1, X##v1); axpy16_fp8(c0, c1, c2, c3, k2, X##v2); axpy16_fp8(c0, c1, c2, c3, k3, X##v3); }
        LOADG(A, 0) LOADG(B, 1)
#pragma unroll 1
        for (int gg = 0; gg < 32; gg += 2) {
            COMPG(A, gg) if (gg + 2 < 32) LOADG(A, gg + 2)
            COMPG(B, gg + 1) if (gg + 3 < 32) LOADG(B, gg + 3)
        }
#undef LOADG
#undef COMPG
#undef RDG
        c0 = x0 * DN_ALPHA + c0; c1 = x1 * DN_ALPHA + c1; c2 = x2 * DN_ALPHA + c2; c3 = x3 * DN_ALPHA + c3;
        const float s = ((c0.x + c0.y) + (c0.z + c0.w)) + ((c1.x + c1.y) + (c1.z + c1.w)) + ((c2.x + c2.y) + (c2.z + c2.w)) + ((c3.x + c3.y) + (c3.z + c3.w));
        const float mean = wave_sum(s) * (1.f / 1024.f);
        c0 = c0 - mean; c1 = c1 - mean; c2 = c2 - mean; c3 = c3 - mean;
        const float s2 = ((c0.x * c0.x + c0.y * c0.y) + (c0.z * c0.z + c0.w * c0.w)) + ((c1.x * c1.x + c1.y * c1.y) + (c1.z * c1.z + c1.w * c1.w)) + ((c2.x * c2.x + c2.y * c2.y) + (c2.z * c2.z + c2.w * c2.w)) + ((c3.x * c3.x + c3.y * c3.y) + (c3.z * c3.z + c3.w * c3.w));
        const float rstd = 1.f / sqrtf(wave_sum(s2) * (1.f / 1024.f) + LN_EPS);
        const f32x4* g4 = (const f32x4*)g + 4 * lane; const f32x4* b4 = (const f32x4*)bb + 4 * lane;
        const f32x4 o0 = c0 * rstd * g4[0] + b4[0], o1 = c1 * rstd * g4[1] + b4[1], o2 = c2 * rstd * g4[2] + b4[2], o3 = c3 * rstd * g4[3] + b4[3];
        f32x4* orow = (f32x4*)(OUTP + (size_t)m * 1024) + 4 * lane;
        orow[0] = o0; orow[1] = o1; orow[2] = o2; orow[3] = o3;
        u32x4* ob = (u32x4*)(XBP + (size_t)m * 1024) + 2 * lane;
        u32x4 w0; w0.x = pk2(o0.x, o0.y); w0.y = pk2(o0.z, o0.w); w0.z = pk2(o1.x, o1.y); w0.w = pk2(o1.z, o1.w); ob[0] = w0;
        u32x4 w1; w1.x = pk2(o2.x, o2.y); w1.y = pk2(o2.z, o2.w); w1.z = pk2(o3.x, o3.y); w1.w = pk2(o3.z, o3.w); ob[1] = w1;
    }
}

#ifdef REP_GEMM
struct GemmOrder : pg8::StaticOrder {
    __device__ bool next(int i, pg8::Unit& u) const { const int R = (nwg - c + G - 1) / G; if (i >= 2 * R) return false; return pg8::StaticOrder::next(i >= R ? i - R : i, u); }
};
#else
typedef pg8::StaticOrder GemmOrder;
#endif

__device__ __forceinline__ float gelu_poly(float v) { const pg8::f32x2 r = pg8::gelu_pk((pg8::f32x2){v, v}); return r.x; }
constexpr int ECH = 128, NECH = MTOK / ECH, EPW = ECH / 8;
__device__ __forceinline__ int eq_take(unsigned* ctl, int qidx, int tid) { int z_ = 0; asm volatile("" : "+v"(z_)); return (tid == 0) ? (int)__hip_atomic_fetch_add(ctl + CW_Q + qidx * 64 + z_, 1u, __ATOMIC_RELAXED, __HIP_MEMORY_SCOPE_AGENT) : 0; }
__device__ __forceinline__ int eq_take2(unsigned* ctl, int qidx, int tid) { int z_ = 0; asm volatile("" : "+v"(z_)); return (tid == 0) ? (int)__hip_atomic_fetch_add(ctl + CW_Q + qidx * 64 + z_, 2u, __ATOMIC_RELAXED, __HIP_MEMORY_SCOPE_AGENT) : 0; }
__device__ __forceinline__ int eq_publish(LAS unsigned char* lds, int tk, int tid) {
    volatile LAS int* w = (volatile LAS int*)(lds + LDSCTL_OFF + 512);
    if (tid == 0) *w = tk;
    __syncthreads(); const int c = *w; __syncthreads(); return c;
}
__device__ __forceinline__ int eq_next(unsigned* ctl, LAS unsigned char* lds, int qidx, int tid) {
    volatile LAS int* tk = (volatile LAS int*)(lds + LDSCTL_OFF + 512);
    if (tid == 0) *tk = (int)__hip_atomic_fetch_add(ctl + CW_Q + qidx * 64, 1u, __ATOMIC_RELAXED, __HIP_MEMORY_SCOPE_AGENT);
    __syncthreads(); const int c = *tk; __syncthreads(); return c;
}
__device__ __forceinline__ void convert_experts_fp8_v2(const Args& a, int layer, int gw, int NGW, int lane) {
    unsigned char* U8 = a.ws + WS_EXP + (size_t)layer * 48 * MiB; unsigned char* VS8 = a.ws + WS_EXP + (size_t)layer * 48 * MiB + 16 * MiB; float* SC = (float*)(a.ws + WS_EXP + (size_t)layer * 48 * MiB + 32 * MiB);
#define CVT_SRC(r_) ((const f32x4*)(((min((r_), 32767) >= 16384) ? a.in[24] : a.in[23]) + ((size_t)layer * 16384 + (min((r_), 32767) & 16383)) * 1024) + 4 * lane)
#pragma unroll 1
    for (int row0 = gw; row0 < 2 * 16384; row0 += 4 * NGW) {
        f32x4 V[4][4];
#pragma unroll
        for (int j = 0; j < 4; ++j) { const f32x4* s4 = CVT_SRC(row0 + j * NGW); V[j][0] = s4[0]; V[j][1] = s4[1]; V[j][2] = s4[2]; V[j][3] = s4[3]; }
#pragma unroll
        for (int j = 0; j < 4; ++j) { const int row = row0 + j * NGW;
            if (row < 2 * 16384) {
                const int e = row & 16383; const bool isv = row >= 16384;
                const f32x4 v0 = V[j][0], v1 = V[j][1], v2 = V[j][2], v3 = V[j][3];
                float am = fmaxf(fmaxf(fmaxf(fabsf(v0.x), fabsf(v0.y)), fmaxf(fabsf(v0.z), fabsf(v0.w))), fmaxf(fmaxf(fabsf(v1.x), fabsf(v1.y)), fmaxf(fabsf(v1.z), fabsf(v1.w))));
                am = fmaxf(am, fmaxf(fmaxf(fmaxf(fabsf(v2.x), fabsf(v2.y)), fmaxf(fabsf(v2.z), fabsf(v2.w))), fmaxf(fmaxf(fabsf(v3.x), fabsf(v3.y)), fmaxf(fabsf(v3.z), fabsf(v3.w)))));
                am = wave_max(am);
                const float sc = am > 0.f ? am * (1.f / 448.f) : 1.f, inv = am > 0.f ? 448.f / am : 1.f;
                u32x4 o; int w;
                w = 0; w = __builtin_amdgcn_cvt_pk_fp8_f32(v0.x * inv, v0.y * inv, w, false); w = __builtin_amdgcn_cvt_pk_fp8_f32(v0.z * inv, v0.w * inv, w, true); o.x = (unsigned)w;
                w = 0; w = __builtin_amdgcn_cvt_pk_fp8_f32(v1.x * inv, v1.y * inv, w, false); w = __builtin_amdgcn_cvt_pk_fp8_f32(v1.z * inv, v1.w * inv, w, true); o.y = (unsigned)w;
                w = 0; w = __builtin_amdgcn_cvt_pk_fp8_f32(v2.x * inv, v2.y * inv, w, false); w = __builtin_amdgcn_cvt_pk_fp8_f32(v2.z * inv, v2.w * inv, w, true); o.z = (unsigned)w;
                w = 0; w = __builtin_amdgcn_cvt_pk_fp8_f32(v3.x * inv, v3.y * inv, w, false); w = __builtin_amdgcn_cvt_pk_fp8_f32(v3.z * inv, v3.w * inv, w, true); o.w = (unsigned)w;
                if (!isv) *(u32x4*)(U8 + ((size_t)(lane >> 3) * 16384 + e) * 128 + (lane & 7) * 16) = o;
                else *(u32x4*)(VS8 + ((size_t)(lane >> 3) * 16384 + e) * 128 + (lane & 7) * 16) = o;
                if (lane == 0) SC[2 * e + (isv ? 1 : 0)] = sc;
            } }
    }
#undef CVT_SRC
}
__device__ __forceinline__ void ph_experts_h(const Args& a, int layer, LAS unsigned char* lds, int tid, int qoff) {
    typedef float f32x2v __attribute__((ext_vector_type(2)));
    const u32x4* U8 = (const u32x4*)(a.ws + WS_EXP + (size_t)layer * 48 * MiB); const f32x2v* SC2 = (const f32x2v*)(a.ws + WS_EXP + (size_t)layer * 48 * MiB + 32 * MiB);
    const unsigned short* RI = (const unsigned short*)(a.ws + WS_RIDX); const float* RG = (const float*)(a.ws + WS_RGATE); const bf16* XB = (const bf16*)(a.ws + WS_XB);
    float* HC = (float*)(a.ws + WS_HC); unsigned* ctl = (unsigned*)(a.ws + WS_CTL);
    const int lane = tid & 63, wave = __builtin_amdgcn_readfirstlane(tid >> 6); const int home = (int)(xb_xcc_id() & 7u);
    const bool b5 = (lane & 32) != 0, b4 = (lane & 16) != 0, b3 = (lane & 8) != 0; const int grp = lane >> 3;
    LAS u32x2* LIST = (LAS u32x2*)(lds + wave * 1024);
#pragma unroll 1
    for (int si = 0; si < 8; ++si) { const int x = (home + si) & 7;
#pragma unroll 1
        for (;;) { const int c = eq_next(ctl, lds, ((layer + qoff) * 2 + 0) * 8 + x, tid); if (c >= NECH) break;
            const size_t mb = (size_t)c * ECH + wave * EPW;
            int nid0 = RI[mb * 128 + lane], nid1 = RI[mb * 128 + 64 + lane]; float ng0 = RG[mb * 128 + lane], ng1 = RG[mb * 128 + 64 + lane];
            u32x4 nxa = ((const u32x4*)(XB + mb * 1024))[2 * lane], nxb = ((const u32x4*)(XB + mb * 1024))[2 * lane + 1];
#pragma unroll 1
            for (int i = 0; i < EPW; ++i) { const size_t m = mb + i;
                const int id0 = nid0, id1 = nid1; const float g0 = ng0, g1 = ng1; const u32x4 xa = nxa, xb = nxb;
                if (i + 1 < EPW) { nid0 = RI[(m + 1) * 128 + lane]; nid1 = RI[(m + 1) * 128 + 64 + lane]; ng0 = RG[(m + 1) * 128 + lane]; ng1 = RG[(m + 1) * 128 + 64 + lane];
                    nxa = ((const u32x4*)(XB + (m + 1) * 1024))[2 * lane]; nxb = ((const u32x4*)(XB + (m + 1) * 1024))[2 * lane + 1]; }
                const f32x4 x0 = {bflo(xa.x), bfhi(xa.x), bflo(xa.y), bfhi(xa.y)}, x1 = {bflo(xa.z), bfhi(xa.z), bflo(xa.w), bfhi(xa.w)}, x2 = {bflo(xb.x), bfhi(xb.x), bflo(xb.y), bfhi(xb.y)}, x3 = {bflo(xb.z), bfhi(xb.z), bflo(xb.w), bfhi(xb.w)};
                const bool ma = (id0 >> 11) == x, mbm = (id1 >> 11) == x;
                const unsigned long long bA = __ballot(ma), bB = __ballot(mbm);
                const int nA = __popcll(bA), n = nA + __popcll(bB);
                const int rA = __builtin_amdgcn_mbcnt_hi((unsigned)(bA >> 32), __builtin_amdgcn_mbcnt_lo((unsigned)bA, 0u)), rB = nA + __builtin_amdgcn_mbcnt_hi((unsigned)(bB >> 32), __builtin_amdgcn_mbcnt_lo((unsigned)bB, 0u));
                if (ma) LIST[rA] = (u32x2){(unsigned)id0 | ((unsigned)lane << 16), __float_as_uint(g0)};
                if (mbm) LIST[rB] = (u32x2){(unsigned)id1 | ((unsigned)(64 + lane) << 16), __float_as_uint(g1)};
                LDS_WAIT();
                if (n > 0) {
                    u32x4 Ar0, Ar1, Ar2, Ar3, Ar4, Ar5, Ar6, Ar7, Br0, Br1, Br2, Br3, Br4, Br5, Br6, Br7; u32x2 Ait, Bit; f32x2v Asc, Bsc; bool Aval, Bval;
#define H_ISSUE(X, base) { const int nm1 = n - 1; \
                    { const int q0 = min((base) + 0, nm1), q1 = min((base) + 1, nm1), q2 = min((base) + 2, nm1), q3 = min((base) + 3, nm1), q4 = min((base) + 4, nm1), q5 = min((base) + 5, nm1), q6 = min((base) + 6, nm1), q7 = min((base) + 7, nm1); \
                      const unsigned e0 = (unsigned)__builtin_amdgcn_readfirstlane((int)LIST[q0].x) & 0xffffu, e1 = (unsigned)__builtin_amdgcn_readfirstlane((int)LIST[q1].x) & 0xffffu, e2 = (unsigned)__builtin_amdgcn_readfirstlane((int)LIST[q2].x) & 0xffffu, e3 = (unsigned)__builtin_amdgcn_readfirstlane((int)LIST[q3].x) & 0xffffu; \
                      const unsigned e4 = (unsigned)__builtin_amdgcn_readfirstlane((int)LIST[q4].x) & 0xffffu, e5 = (unsigned)__builtin_amdgcn_readfirstlane((int)LIST[q5].x) & 0xffffu, e6 = (unsigned)__builtin_amdgcn_readfirstlane((int)LIST[q6].x) & 0xffffu, e7 = (unsigned)__builtin_amdgcn_readfirstlane((int)LIST[q7].x) & 0xffffu; \
                      X##r0 = U8[(size_t)e0 * 64 + lane]; X##r1 = U8[(size_t)e1 * 64 + lane]; X##r2 = U8[(size_t)e2 * 64 + lane]; X##r3 = U8[(size_t)e3 * 64 + lane]; \
                      X##r4 = U8[(size_t)e4 * 64 + lane]; X##r5 = U8[(size_t)e5 * 64 + lane]; X##r6 = U8[(size_t)e6 * 64 + lane]; X##r7 = U8[(size_t)e7 * 64 + lane]; } \
                    X##val = (base) + grp < n; X##it = LIST[min((base) + grp, nm1)]; X##sc = SC2[X##it.x & 0xffffu]; }
#define H_COMP(X) { const float d0 = dot16_fp8(x0, x1, x2, x3, X##r0), d1 = dot16_fp8(x0, x1, x2, x3, X##r1), d2 = dot16_fp8(x0, x1, x2, x3, X##r2), d3 = dot16_fp8(x0, x1, x2, x3, X##r3); \
                    const float d4 = dot16_fp8(x0, x1, x2, x3, X##r4), d5 = dot16_fp8(x0, x1, x2, x3, X##r5), d6 = dot16_fp8(x0, x1, x2, x3, X##r6), d7 = dot16_fp8(x0, x1, x2, x3, X##r7); \
                    const float k0 = hswap32_add(d0, d4), k1 = hswap32_add(d1, d5), k2 = hswap32_add(d2, d6), k3 = hswap32_add(d3, d7); \
                    const float j0 = hswap16_add(k0, k2), j1 = hswap16_add(k1, k3); \
                    float kk = b3 ? j1 : j0; kk += dpp_f<0x128>(b3 ? j0 : j1); \
                    kk = reduce8(kk); \
                    const float coef = __uint_as_float(X##it.y) * gelu_poly(kk * X##sc.x) * X##sc.y; \
                    if ((lane & 7) == 0 && X##val) HC[m * 128 + (X##it.x >> 16)] = coef; }
                    H_ISSUE(A, 0)
#pragma unroll 1
                    for (int base = 0; base < n; base += 16) {
                        if (base + 8 < n) H_ISSUE(B, base + 8)
                        H_COMP(A)
                        if (base + 8 >= n) break;
                        if (base + 16 < n) H_ISSUE(A, base + 16)
                        H_COMP(B)
                    }
#undef H_ISSUE
#undef H_COMP
                }
            }
        }
    }
}
typedef __bf16 bf16x2_t __attribute__((ext_vector_type(2)));
__device__ __forceinline__ unsigned cvtpk_bf16(float lo, float hi) { unsigned r; asm("v_cvt_pk_bf16_f32 %0, %1, %2" : "=v"(r) : "v"(lo), "v"(hi)); return r; }
__device__ __forceinline__ float dot2bf(unsigned a_, unsigned b_, float c) { return __builtin_amdgcn_fdot2_f32_bf16(__builtin_bit_cast(bf16x2_t, a_), __builtin_bit_cast(bf16x2_t, b_), c, false); }
__device__ __forceinline__ float dot16_fp8_bf16(const u32x4 xlo, const u32x4 xhi, const u32x4 w, float acc) {
    f32x2_ p; float a1 = 0.f;
    p = __builtin_amdgcn_cvt_pk_f32_fp8((int)w.x, false); acc = dot2bf(xlo.x, cvtpk_bf16(p.x, p.y), acc); p = __builtin_amdgcn_cvt_pk_f32_fp8((int)w.x, true); a1 = dot2bf(xlo.y, cvtpk_bf16(p.x, p.y), a1);
    p = __builtin_amdgcn_cvt_pk_f32_fp8((int)w.y, false); acc = dot2bf(xlo.z, cvtpk_bf16(p.x, p.y), acc); p = __builtin_amdgcn_cvt_pk_f32_fp8((int)w.y, true); a1 = dot2bf(xlo.w, cvtpk_bf16(p.x, p.y), a1);
    p = __builtin_amdgcn_cvt_pk_f32_fp8((int)w.z, false); acc = dot2bf(xhi.x, cvtpk_bf16(p.x, p.y), acc); p = __builtin_amdgcn_cvt_pk_f32_fp8((int)w.z, true); a1 = dot2bf(xhi.y, cvtpk_bf16(p.x, p.y), a1);
    p = __builtin_amdgcn_cvt_pk_f32_fp8((int)w.w, false); acc = dot2bf(xhi.z, cvtpk_bf16(p.x, p.y), acc); p = __builtin_amdgcn_cvt_pk_f32_fp8((int)w.w, true); a1 = dot2bf(xhi.w, cvtpk_bf16(p.x, p.y), a1);
    return acc + a1;
}
__device__ __forceinline__ void ph_experts_h2(const Args& a, int layer, LAS unsigned char* lds, int tid, int qoff) {
    typedef float f32x2v __attribute__((ext_vector_type(2)));
    const unsigned char* U8 = a.ws + WS_EXP + (size_t)layer * 48 * MiB; const f32x2v* SC2 = (const f32x2v*)(a.ws + WS_EXP + (size_t)layer * 48 * MiB + 32 * MiB);
    const unsigned short* RI = (const unsigned short*)(a.ws + WS_RIDX); const float* RG = (const float*)(a.ws + WS_RGATE); const bf16* XB = (const bf16*)(a.ws + WS_XB);
    float* HC = (float*)(a.ws + WS_HC); unsigned* ctl = (unsigned*)(a.ws + WS_CTL);
    const int lane = tid & 63, wave = __builtin_amdgcn_readfirstlane(tid >> 6); const int home = (int)(xb_xcc_id() & 7u);
    const int grp = lane >> 3, j = lane & 7;
    LAS u32x2* LIST = (LAS u32x2*)(lds + wave * 8192 + grp * 1024);
#pragma unroll 1
    for (int si = 0; si < 8; ++si) { const int x = (home + si) & 7;
#pragma unroll 1
        for (;;) { const int c = eq_next(ctl, lds, ((layer + qoff) * 2 + 0) * 8 + x, tid); if (c >= NECH) break;
#pragma unroll 1
            for (int rd = 0; rd < EPW / 8; ++rd) {
                const size_t m = (size_t)c * ECH + wave * EPW + rd * 8 + grp;
                const u32x4 iw0 = *(const u32x4*)(RI + m * 128 + 16 * j), iw1 = *(const u32x4*)(RI + m * 128 + 16 * j + 8);
                const f32x4 gq0 = *(const f32x4*)(RG + m * 128 + 16 * j), gq1 = *(const f32x4*)(RG + m * 128 + 16 * j + 4), gq2 = *(const f32x4*)(RG + m * 128 + 16 * j + 8), gq3 = *(const f32x4*)(RG + m * 128 + 16 * j + 12);
                u32x4 xl[8], xh[8];
#pragma unroll
                for (int i = 0; i < 8; ++i) { const u32x4* xp = (const u32x4*)(XB + m * 1024 + 128 * i + 16 * j); xl[i] = xp[0]; xh[i] = xp[1]; }
                const unsigned idw[8] = {iw0.x, iw0.y, iw0.z, iw0.w, iw1.x, iw1.y, iw1.z, iw1.w};
                const float gts[16] = {gq0.x, gq0.y, gq0.z, gq0.w, gq1.x, gq1.y, gq1.z, gq1.w, gq2.x, gq2.y, gq2.z, gq2.w, gq3.x, gq3.y, gq3.z, gq3.w};
                unsigned mm = 0u;
#pragma unroll
                for (int t = 0; t < 16; ++t) { const unsigned idt = (t & 1) ? (idw[t >> 1] >> 16) : (idw[t >> 1] & 0xffffu); if ((int)(idt >> 11) == x) mm |= 1u << t; }
                const int cnt = __popc(mm);
                int incl = cnt; { int v = dpp_i<0x111>(incl); incl += (j >= 1) ? v : 0; v = dpp_i<0x112>(incl); incl += (j >= 2) ? v : 0; v = dpp_i<0x114>(incl); incl += (j >= 4) ? v : 0; }
                int n = cnt; n += dpp_i<0xB1>(n); n += dpp_i<0x4E>(n); n += dpp_i<0x141>(n);
                int off = incl - cnt;
#pragma unroll
                for (int t = 0; t < 16; ++t) if ((mm >> t) & 1u) { const unsigned idt = (t & 1) ? (idw[t >> 1] >> 16) : (idw[t >> 1] & 0xffffu); LIST[off++] = (u32x2){idt | ((unsigned)(16 * j + t) << 16), __float_as_uint(gts[t])}; }
                LDS_WAIT();
                int maxn = 0;
#pragma unroll
                for (int g8 = 0; g8 < 8; ++g8) maxn = max(maxn, __builtin_amdgcn_readlane(n, 8 * g8));
                u32x4 RA[8], RB[8]; u32x2 Ait = {0u, 0u}, Bit = {0u, 0u}; f32x2v Asc = {0.f, 0.f}, Bsc = {0.f, 0.f};
#define H2_ISSUE(R, IT, SC, s) { IT = LIST[min((s), max(n - 1, 0))]; const unsigned e_ = IT.x & 0x3fffu; const unsigned char* rb = U8 + ((size_t)(e_ >> 11) * 16384 + (e_ & 2047u)) * 128 + 16 * j; \
                    _Pragma("unroll") for (int i = 0; i < 8; ++i) R[i] = *(const u32x4*)(rb + (size_t)i * 2048 * 128); SC = SC2[e_]; }
#define H2_COMP(R, IT, SC, s) { float ac[8]; _Pragma("unroll") for (int i = 0; i < 8; ++i) ac[i] = dot16_fp8_bf16(xl[i], xh[i], R[i], 0.f); float acc = ((ac[0] + ac[1]) + (ac[2] + ac[3])) + ((ac[4] + ac[5]) + (ac[6] + ac[7])); \
                    acc = reduce8(acc); const float coef = __uint_as_float(IT.y) * gelu_poly(acc * SC.x) * SC.y; \
                    if (j == 0 && (s) < n) HC[m * 128 + (IT.x >> 16)] = coef; }
                if (maxn > 0) {
                    H2_ISSUE(RA, Ait, Asc, 0)
#pragma unroll 1
                    for (int s = 0; s < maxn; s += 2) {
                        H2_ISSUE(RB, Bit, Bsc, s + 1)
                        H2_COMP(RA, Ait, Asc, s)
                        H2_ISSUE(RA, Ait, Asc, s + 2)
                        H2_COMP(RB, Bit, Bsc, s + 1)
                    }
                }
#undef H2_ISSUE
#undef H2_COMP
            }
        }
    }
}

constexpr size_t WS_PART = WS_P;
__device__ __forceinline__ void ph_experts_hk(const Args& a, int layer, LAS unsigned char* lds, int tid, int qoff) {
    const unsigned char* US8 = a.ws + WS_EXP + (size_t)layer * 48 * MiB; const unsigned short* RI = (const unsigned short*)(a.ws + WS_RIDX); const bf16* XB = (const bf16*)(a.ws + WS_XB);
    float* PART = (float*)(a.ws + WS_PART); unsigned* ctl = (unsigned*)(a.ws + WS_CTL);
    const int lane = tid & 63, wave = __builtin_amdgcn_readfirstlane(tid >> 6); const int home = (int)(xb_xcc_id() & 7u);
    const int es = lane >> 3, cp = lane & 7; const bool c2 = (lane & 4) != 0, c1 = (lane & 2) != 0, c0 = (lane & 1) != 0;
#define K_LOAD(X, idw) { X##0 = *(const u32x4*)(ub + (size_t)((idw).x & 0xffffu) * 128); X##1 = *(const u32x4*)(ub + (size_t)((idw).x >> 16) * 128); X##2 = *(const u32x4*)(ub + (size_t)((idw).y & 0xffffu) * 128); X##3 = *(const u32x4*)(ub + (size_t)((idw).y >> 16) * 128); \
        X##4 = *(const u32x4*)(ub + (size_t)((idw).z & 0xffffu) * 128); X##5 = *(const u32x4*)(ub + (size_t)((idw).z >> 16) * 128); X##6 = *(const u32x4*)(ub + (size_t)((idw).w & 0xffffu) * 128); X##7 = *(const u32x4*)(ub + (size_t)((idw).w >> 16) * 128); }
#define K_COMP(X, P, o) { P[(o) + 0] = dot16_fp8(x0, x1, x2, x3, X##0); P[(o) + 1] = dot16_fp8(x0, x1, x2, x3, X##1); P[(o) + 2] = dot16_fp8(x0, x1, x2, x3, X##2); P[(o) + 3] = dot16_fp8(x0, x1, x2, x3, X##3); \
        P[(o) + 4] = dot16_fp8(x0, x1, x2, x3, X##4); P[(o) + 5] = dot16_fp8(x0, x1, x2, x3, X##5); P[(o) + 6] = dot16_fp8(x0, x1, x2, x3, X##6); P[(o) + 7] = dot16_fp8(x0, x1, x2, x3, X##7); }
#pragma unroll 1
    for (int si = 0; si < 8; ++si) { const int x = (home + si) & 7;
        if (si == 1) {
            volatile LAS unsigned* qh = (volatile LAS unsigned*)(lds + LDSCTL_OFF + 576);
            if (tid < 8) qh[tid] = __hip_atomic_load(ctl + CW_Q + (((layer + qoff) * 2 + 0) * 8 + tid) * 64, __ATOMIC_RELAXED, __HIP_MEMORY_SCOPE_AGENT);
            __syncthreads(); }
        if (si >= 1 && ((volatile LAS unsigned*)(lds + LDSCTL_OFF + 576))[x] >= (unsigned)NECH) continue; const unsigned char* ub = US8 + (size_t)x * 16384 * 128 + cp * 16;
        int c = eq_publish(lds, eq_take2(ctl, ((layer + qoff) * 2 + 0) * 8 + x, tid), tid);
        if (c >= NECH) continue;
        int cn = c + 1;
        u32x4 RA0, RA1, RA2, RA3, RA4, RA5, RA6, RA7, RB0, RB1, RB2, RB3, RB4, RB5, RB6, RB7;
        u32x4 id0, id1, xa, xb;
        { const size_t mb0 = (size_t)c * ECH + wave * EPW; id0 = *(const u32x4*)(RI + mb0 * 128 + es * 16); id1 = *(const u32x4*)(RI + mb0 * 128 + es * 16 + 8);
          xa = *(const u32x4*)(XB + mb0 * 1024 + 128 * x + 16 * cp); xb = *(const u32x4*)(XB + mb0 * 1024 + 128 * x + 16 * cp + 8); }
        K_LOAD(RA, id0)
#pragma unroll 1
        for (;;) { const int tkn = eq_take(ctl, ((layer + qoff) * 2 + 0) * 8 + x, tid);
            const size_t mb = (size_t)c * ECH + wave * EPW; const size_t mnext = (cn < NECH) ? (size_t)cn * ECH + wave * EPW : mb + EPW - 1;
#pragma unroll 1
            for (int i = 0; i < EPW; ++i) { const size_t m = mb + i; const size_t mn = (i + 1 < EPW) ? mb + i + 1 : mnext;
                const u32x4 nid0 = *(const u32x4*)(RI + mn * 128 + es * 16), nid1 = *(const u32x4*)(RI + mn * 128 + es * 16 + 8);
                const u32x4 nxa = *(const u32x4*)(XB + mn * 1024 + 128 * x + 16 * cp), nxb = *(const u32x4*)(XB + mn * 1024 + 128 * x + 16 * cp + 8);
                const f32x4 x0 = {bflo(xa.x), bfhi(xa.x), bflo(xa.y), bfhi(xa.y)}, x1 = {bflo(xa.z), bfhi(xa.z), bflo(xa.w), bfhi(xa.w)}, x2 = {bflo(xb.x), bfhi(xb.x), bflo(xb.y), bfhi(xb.y)}, x3 = {bflo(xb.z), bfhi(xb.z), bflo(xb.w), bfhi(xb.w)};
                float p[16];
                K_LOAD(RB, id1)
                K_COMP(RA, p, 0)
                K_LOAD(RA, nid0)
                K_COMP(RB, p, 8)
                id0 = nid0; id1 = nid1; xa = nxa; xb = nxb;
                float q8[8];
#pragma unroll
                for (int u = 0; u < 8; ++u) { const float keep = c2 ? p[8 + u] : p[u], send = c2 ? p[u] : p[8 + u]; q8[u] = keep + dpp_f<0x141>(send); }
                float q4[4];
#pragma unroll
                for (int u = 0; u < 4; ++u) { const float keep = c1 ? q8[4 + u] : q8[u], send = c1 ? q8[u] : q8[4 + u]; q4[u] = keep + dpp_f<0x4E>(send); }
                f32x2_ q2;
                { const float k0 = c0 ? q4[2] : q4[0], s0 = c0 ? q4[0] : q4[2], k1 = c0 ? q4[3] : q4[1], s1 = c0 ? q4[1] : q4[3]; q2.x = k0 + dpp_f<0xB1>(s0); q2.y = k1 + dpp_f<0xB1>(s1); }
                ((unsigned*)PART)[((size_t)x * MTOK + m) * 64 + es * 8 + cp] = pk2(q2.x, q2.y);
            }
            c = cn; if (c >= NECH) break;
            cn = eq_publish(lds, tkn, tid);
        }
    }
#undef K_LOAD
#undef K_COMP
}
__device__ __forceinline__ void ph_experts_c(const Args& a, int layer, int gtid, int NT) {
    typedef float f32x2v __attribute__((ext_vector_type(2)));
    const float* PART = (const float*)(a.ws + WS_PART); const f32x2v* SC2 = (const f32x2v*)(a.ws + WS_EXP + (size_t)layer * 48 * MiB + 32 * MiB);
    const unsigned* RI2 = (const unsigned*)(a.ws + WS_RIDX); const f32x2v* RG2 = (const f32x2v*)(a.ws + WS_RGATE); f32x2v* HC2 = (f32x2v*)(a.ws + WS_HC);
#pragma unroll 1
    for (int it = gtid; it < MTOK * 64; it += NT) {
        const unsigned* pp = (const unsigned*)PART + (size_t)it; const size_t xs = (size_t)MTOK * 64;
        unsigned p0 = pp[0], p1 = pp[xs], p2 = pp[2 * xs], p3 = pp[3 * xs], p4 = pp[4 * xs], p5 = pp[5 * xs], p6 = pp[6 * xs], p7 = pp[7 * xs];
        const unsigned ids = RI2[it]; f32x2v g = RG2[it];
        asm volatile("" : "+v"(p0), "+v"(p1), "+v"(p2), "+v"(p3), "+v"(p4), "+v"(p5), "+v"(p6), "+v"(p7), "+v"(g));
        const f32x2v sa = SC2[ids & 0xffffu], sb = SC2[ids >> 16];
        f32x2v s; s.x = ((bflo(p0) + bflo(p1)) + (bflo(p2) + bflo(p3))) + ((bflo(p4) + bflo(p5)) + (bflo(p6) + bflo(p7))); s.y = ((bfhi(p0) + bfhi(p1)) + (bfhi(p2) + bfhi(p3))) + ((bfhi(p4) + bfhi(p5)) + (bfhi(p6) + bfhi(p7)));
        f32x2v o; o.x = g.x * gelu_poly(s.x * sa.x) * sa.y; o.y = g.y * gelu_poly(s.y * sb.x) * sb.y;
        HC2[it] = o;
    }
}

__device__ __forceinline__ void ph_experts_v(const Args& a, int layer, LAS unsigned char* lds, int tid, int qoff) {
    const unsigned char* VS8 = a.ws + WS_EXP + (size_t)layer * 48 * MiB + 16 * MiB; const unsigned short* RI = (const unsigned short*)(a.ws + WS_RIDX); const float* HC = (const float*)(a.ws + WS_HC);
    float* FFN = (float*)(a.ws + WS_FFN); unsigned* ctl = (unsigned*)(a.ws + WS_CTL);
    const int lane = tid & 63, wave = __builtin_amdgcn_readfirstlane(tid >> 6); const int home = (int)(xb_xcc_id() & 7u);
    const int es = lane >> 3, cp = lane & 7; const bool b5 = (lane & 32) != 0, b4 = (lane & 16) != 0, b3 = (lane & 8) != 0;
#define V_LOAD(X, idw, hcp) { X##0 = *(const u32x4*)(vb + (size_t)((idw).x & 0xffffu) * 128); X##1 = *(const u32x4*)(vb + (size_t)((idw).x >> 16) * 128); X##2 = *(const u32x4*)(vb + (size_t)((idw).y & 0xffffu) * 128); X##3 = *(const u32x4*)(vb + (size_t)((idw).y >> 16) * 128); \
        X##4 = *(const u32x4*)(vb + (size_t)((idw).z & 0xffffu) * 128); X##5 = *(const u32x4*)(vb + (size_t)((idw).z >> 16) * 128); X##6 = *(const u32x4*)(vb + (size_t)((idw).w & 0xffffu) * 128); X##7 = *(const u32x4*)(vb + (size_t)((idw).w >> 16) * 128); \
        X##c0 = *(const f32x4*)(hcp); X##c1 = *(const f32x4*)((hcp) + 4); }
#define V_COMP(X) { axpy16_fp8(a0, a1, a2, a3, X##c0.x, X##0); axpy16_fp8(a0, a1, a2, a3, X##c0.y, X##1); axpy16_fp8(a0, a1, a2, a3, X##c0.z, X##2); axpy16_fp8(a0, a1, a2, a3, X##c0.w, X##3); \
        axpy16_fp8(a0, a1, a2, a3, X##c1.x, X##4); axpy16_fp8(a0, a1, a2, a3, X##c1.y, X##5); axpy16_fp8(a0, a1, a2, a3, X##c1.z, X##6); axpy16_fp8(a0, a1, a2, a3, X##c1.w, X##7); }
#pragma unroll 1
    for (int si = 0; si < 8; ++si) { const int x = (home + si) & 7;
        if (si == 1) {
            volatile LAS unsigned* qh = (volatile LAS unsigned*)(lds + LDSCTL_OFF + 576);
            if (tid < 8) qh[tid] = __hip_atomic_load(ctl + CW_Q + (((layer + qoff) * 2 + 1) * 8 + tid) * 64, __ATOMIC_RELAXED, __HIP_MEMORY_SCOPE_AGENT);
            __syncthreads(); }
        if (si >= 1 && ((volatile LAS unsigned*)(lds + LDSCTL_OFF + 576))[x] >= (unsigned)NECH) continue; const unsigned char* vb = VS8 + (size_t)x * 16384 * 128 + cp * 16;
        int c = eq_publish(lds, eq_take2(ctl, ((layer + qoff) * 2 + 1) * 8 + x, tid), tid);
        if (c >= NECH) continue;
        int cn = c + 1;
        u32x4 RA0, RA1, RA2, RA3, RA4, RA5, RA6, RA7, RB0, RB1, RB2, RB3, RB4, RB5, RB6, RB7; f32x4 RAc0, RAc1, RBc0, RBc1;
        u32x4 id0, id1;
        { const size_t mb0 = (size_t)c * ECH + wave * EPW; id0 = *(const u32x4*)(RI + mb0 * 128 + es * 16); id1 = *(const u32x4*)(RI + mb0 * 128 + es * 16 + 8);
          V_LOAD(RA, id0, HC + mb0 * 128 + es * 16) }
#pragma unroll 1
        for (;;) { const int tkn = eq_take(ctl, ((layer + qoff) * 2 + 1) * 8 + x, tid);
            const size_t mb = (size_t)c * ECH + wave * EPW; const size_t mnext = (cn < NECH) ? (size_t)cn * ECH + wave * EPW : mb + EPW - 1;
#pragma unroll 1
            for (int i = 0; i < EPW; ++i) { const size_t m = mb + i;
                const size_t mn = (i + 1 < EPW) ? mb + i + 1 : mnext;
                const u32x4 nid0 = *(const u32x4*)(RI + mn * 128 + es * 16), nid1 = *(const u32x4*)(RI + mn * 128 + es * 16 + 8);
                f32x4 a0 = {0.f, 0.f, 0.f, 0.f}, a1 = a0, a2 = a0, a3 = a0;
                V_LOAD(RB, id1, HC + m * 128 + es * 16 + 8)
                V_COMP(RA)
                V_LOAD(RA, nid0, HC + mn * 128 + es * 16)
                V_COMP(RB)
                id0 = nid0; id1 = nid1;
                f32x4 k0, k1;
#pragma unroll
                for (int u = 0; u < 4; ++u) { k0[u] = hswap32_add(a0[u], a2[u]); k1[u] = hswap32_add(a1[u], a3[u]); }
                f32x4 k2;
#pragma unroll
                for (int u = 0; u < 4; ++u) k2[u] = hswap16_add(k0[u], k1[u]);
                f32x2_ k3 = b3 ? (f32x2_){k2.z, k2.w} : (f32x2_){k2.x, k2.y}; const f32x2_ s3 = b3 ? (f32x2_){k2.x, k2.y} : (f32x2_){k2.z, k2.w};
                k3.x += dpp_f<0x128>(s3.x); k3.y += dpp_f<0x128>(s3.y);
                const int col = cp * 16 + (b5 ? 8 : 0) + (b4 ? 4 : 0) + (b3 ? 2 : 0);
                ((unsigned*)FFN)[(m * 1024 + x * 128 + col) >> 1] = pk2(k3.x, k3.y);
            }
            c = cn; if (c >= NECH) break;
            cn = eq_publish(lds, tkn, tid);
        }
    }
#undef V_LOAD
#undef V_COMP
}

__device__ __forceinline__ float wave_sum_fast(float v) { const float r = reduce16(v); const float t = hswap16_add(r, r); return hswap32_add(t, t); }
template <bool IS_LN2> __device__ __forceinline__ void ph_ln(const Args& a, int layer, int gw, int NGW, int lane, bf16* XBO) {
    const float* g = a.in[IS_LN2 ? 25 : 19] + layer * 1024; const float* bb = a.in[IS_LN2 ? 26 : 20] + layer * 1024; const bf16* XB = (const bf16*)(a.ws + WS_XB);
    const bf16* mix = (const bf16*)(a.ws + WS_MIX); const float* ffn = (const float*)(a.ws + WS_FFN);
    const bool last = IS_LN2 && layer == DEPTH - 1;
    f32x4 gv[4], bv[4];
#pragma unroll
    for (int j = 0; j < 4; ++j) { gv[j] = ((const f32x4*)g)[lane + 64 * j]; bv[j] = ((const f32x4*)bb)[lane + 64 * j]; }
    const bool rev = (NGW * 32 == MTOK);
    for (int mi = gw * 4; mi < MTOK; mi += NGW * 4) { const int m0 = rev ? ((gw & 7) * 8192 + (7 - mi / (NGW * 4)) * 1024 + (gw >> 3) * 4) : mi;
        f32x4 v[4][4];
        u32x2 xw[4][4]; u32x2 mw[4][4];
#pragma unroll
        for (int t = 0; t < 4; ++t) { const size_t m = (size_t)(m0 + t);
#pragma unroll
            for (int j = 0; j < 4; ++j) { xw[t][j] = ((const u32x2*)(XB + m * 1024) + lane)[64 * j];
                mw[t][j] = ((const u32x2*)((IS_LN2 ? (const bf16*)ffn : mix) + m * 1024) + lane)[64 * j]; } }
#pragma unroll
        for (int t = 0; t < 4; ++t) {
            asm volatile("" : "+v"(xw[t][0]), "+v"(xw[t][1]), "+v"(xw[t][2]), "+v"(xw[t][3]));
            asm volatile("" : "+v"(mw[t][0]), "+v"(mw[t][1]), "+v"(mw[t][2]), "+v"(mw[t][3])); }
#pragma unroll
        for (int t = 0; t < 4; ++t)
#pragma unroll
            for (int j = 0; j < 4; ++j) { const f32x4 xv = (f32x4){bflo(xw[t][j].x), bfhi(xw[t][j].x), bflo(xw[t][j].y), bfhi(xw[t][j].y)} * DN_ALPHA;
                v[t][j] = xv + (f32x4){bflo(mw[t][j].x), bfhi(mw[t][j].x), bflo(mw[t][j].y), bfhi(mw[t][j].y)}; }
#pragma unroll
        for (int t = 0; t < 4; ++t) { const size_t m = (size_t)(m0 + t); float s = 0.f;
#pragma unroll
            for (int j = 0; j < 4; ++j) s += (v[t][j].x + v[t][j].y) + (v[t][j].z + v[t][j].w);
            const float mean = wave_sum_fast(s) * (1.f / 1024.f); float s2 = 0.f;
#pragma unroll
            for (int j = 0; j < 4; ++j) { v[t][j] = v[t][j] - mean; s2 += (v[t][j].x * v[t][j].x + v[t][j].y * v[t][j].y) + (v[t][j].z * v[t][j].z + v[t][j].w * v[t][j].w); }
            const float rstd = 1.f / sqrtf(wave_sum_fast(s2) * (1.f / 1024.f) + LN_EPS);
            f32x4* orow = (f32x4*)(a.out + m * 1024) + lane; u32x2* ob = (u32x2*)(XBO + m * 1024) + lane;
#pragma unroll
            for (int j = 0; j < 4; ++j) { const f32x4 o = v[t][j] * rstd * gv[j] + bv[j]; if (last) orow[64 * j] = o; else { u32x2 w; w.x = pk2(o.x, o.y); w.y = pk2(o.z, o.w); ob[64 * j] = w; } } }
    }
}

#ifdef DBG_CHECK
__device__ __forceinline__ void dbg_check_hv(const Args& a, int layer, int gw, int NGW, int lane) {
    const u32x4* U8 = (const u32x4*)(a.ws + WS_EXP + (size_t)layer * 48 * MiB); const unsigned char* VS8 = a.ws + WS_EXP + (size_t)layer * 48 * MiB + 16 * MiB;
    const float* SC = (const float*)(a.ws + WS_EXP + (size_t)layer * 48 * MiB + 32 * MiB);
    const unsigned short* RI = (const unsigned short*)(a.ws + WS_RIDX); const float* RG = (const float*)(a.ws + WS_RGATE);
    const float* HC = (const float*)(a.ws + WS_HC); const float* FFN = (const float*)(a.ws + WS_FFN); unsigned* ctl = (unsigned*)(a.ws + WS_CTL);
    unsigned badH = 0, badV = 0;
    for (int m = gw; m < MTOK; m += NGW * 16) {
        const f32x4* xr = (const f32x4*)(a.out + (size_t)m * 1024) + 4 * lane; const f32x4 x0 = xr[0], x1 = xr[1], x2 = xr[2], x3 = xr[3];
        f32x4 c0 = {0.f, 0.f, 0.f, 0.f}, c1 = c0, c2 = c0, c3 = c0;
        for (int k = 0; k < 128; ++k) { const int e = RI[(size_t)m * 128 + k]; const float gate = RG[(size_t)m * 128 + k];
            float d = dot16_fp8(x0, x1, x2, x3, U8[(size_t)e * 64 + lane]); d = wave_sum(d) * SC[2 * e];
            const float coef = gate * gelu_exact(d) * SC[2 * e + 1]; const float got = HC[(size_t)m * 128 + k];
            if (!(fabsf(got - coef) <= 1e-5f + 2e-3f * fabsf(coef))) badH++;
            const u32x4 vr = *(const u32x4*)(VS8 + ((size_t)(lane >> 3) * 16384 + e) * 128 + (lane & 7) * 16);
            axpy16_fp8(c0, c1, c2, c3, coef, vr); }
        const f32x4* fr = (const f32x4*)(FFN + (size_t)m * 1024) + 4 * lane; const f32x4 f0 = fr[0], f1 = fr[1], f2 = fr[2], f3 = fr[3];
        const float cf[16] = {c0.x, c0.y, c0.z, c0.w, c1.x, c1.y, c1.z, c1.w, c2.x, c2.y, c2.z, c2.w, c3.x, c3.y, c3.z, c3.w};
        const float ff[16] = {f0.x, f0.y, f0.z, f0.w, f1.x, f1.y, f1.z, f1.w, f2.x, f2.y, f2.z, f2.w, f3.x, f3.y, f3.z, f3.w};
#pragma unroll
        for (int u = 0; u < 16; ++u) if (!(fabsf(ff[u] - cf[u]) <= 1e-4f + 5e-3f * fabsf(cf[u]))) badV++;
    }
    if (lane == 0 && badH) atomicAdd(ctl + 16384, badH);
    if (badV) atomicAdd(ctl + 16448, badV);
}
#endif

constexpr int NPHASE = 1 + 12 * DEPTH;
__global__ void __launch_bounds__(512, 2) mk_fwd(Args args) {
    extern __shared__ __attribute__((aligned(16))) unsigned char lds_raw[];
    LAS unsigned char* lds = (LAS unsigned char*)lds_raw;
    const int tid = threadIdx.x;
    const int G = gridDim.x, bid = blockIdx.x, NGW = G * 8;
    unsigned char* ws = args.ws;
    for (int u = tid; u < (LDS_BYTES - LDSCTL_OFF) / 4; u += 512) ((LAS unsigned*)(lds + LDSCTL_OFF))[u] = 0u;
    __syncthreads();
    const int lo = args.ph_lo, hi = args.ph_hi;
    XcdBarrier bar; bar.bar = (unsigned*)(ws + WS_CTL) + CW_BAR; bar.x = 0; bar.st = nullptr;
    if (hi - lo > 1) bar = xcd_barrier_post((unsigned*)(ws + WS_CTL) + CW_BAR, (volatile LAS unsigned*)(lds + LDSCTL_OFF + 64));
#define IN(k) (lo <= (k) && (k) < hi)
#ifdef DBG_TIME
    volatile LAS unsigned* tacc = (volatile LAS unsigned*)(lds + LDSCTL_OFF + 256);
    unsigned long long tlast = wall_clock64();
#define TSTAMP(kind) do { if (bid == 0 && tid == 0) { const unsigned long long tn = wall_clock64(); tacc[kind] += (unsigned)(tn - tlast); tlast = tn; } } while (0)
#else
#define TSTAMP(kind) do { } while (0)
#endif
#define SEAM(k) do { if ((k) + 1 < hi) xcd_barrier(bar); } while (0)
#ifndef SKIP_PRO
    if (IN(0)) { int lt = tid; asm volatile("" : "+v"(lt)); ph_prologue(args, lds, bid * 8 + __builtin_amdgcn_readfirstlane(lt >> 6), NGW, __builtin_amdgcn_readfirstlane(lt >> 6), lt & 63); SEAM(0); TSTAMP(0); }
#endif
    for (int gi = 0; gi < 3 * DEPTH; ++gi) {
        const int layer = gi / 3, kind = gi - 3 * layer, pb = 1 + 12 * layer, i2 = layer >> 1; const bool odd = (layer & 1) != 0;
        const int pg = pb + (kind == 0 ? 0 : (kind == 1 ? 4 : 6));
        if (IN(pg)) {
            int lt = tid; asm volatile("" : "+v"(lt));
            int N = 1024; const bf16* A = (const bf16*)(ws + WS_XB); const bf16* W; bf16* O;
            if (kind == 0) { N = odd ? ODD_PAD : EVEN_PAD; W = odd ? (const bf16*)(ws + WS_WINO) + (size_t)i2 * ODD_PAD * 1024 : (const bf16*)(ws + WS_WINE) + (size_t)i2 * EVEN_PAD * 1024; O = (bf16*)(ws + WS_P); }
            else if (kind == 1) { A = (const bf16*)(ws + WS_CAT); W = (odd ? (const bf16*)(ws + WS_WOUTO) : (const bf16*)(ws + WS_WOUTE)) + (size_t)i2 * 1048576; O = (bf16*)(ws + WS_MIX); }
            else { W = (const bf16*)(ws + WS_WQ) + (size_t)layer * 1048576; O = (bf16*)(ws + WS_QP); }
            pg8::Gemm g{(const pg8::bf16_t*)A, (const pg8::bf16_t*)W, MTOK, N, 1024}; GemmOrder S; S.init(MTOK, N, G, bid);
            pg8::EpiBf16<0> E{(pg8::bf16_t*)O, N, nullptr, 0, 0, 1.f};
            pg8::gemm_phase<pg8::EpiBf16<0>, GemmOrder, true, true>(lds, g, S, E, lt);
            SEAM(pg); TSTAMP(kind == 0 ? 1 : (kind == 1 ? 6 : 8));
        }
        if (kind == 0) {
            if (!odd) {
                if (IN(pb + 1)) {
                    int lt = tid; asm volatile("" : "+v"(lt));
#ifdef REP_SCAN
                    for (int rep = 0; rep < 2; ++rep)
#endif
#pragma unroll 1
                    for (int w = 0; ; ++w) {
                        int kind, unit, c0 = 0, c1 = 32, mode = 0;
                        if (G == 256) { if (w >= 2) break; const int hb = bid >> 7; kind = ((w == 0) == (hb != 0)) ? 1 : 0; unit = kind ? (bid & 127) : bid; if (kind) { c0 = hb ? 0 : GLA_CSPLIT; c1 = hb ? GLA_CSPLIT : 32; mode = hb ? 1 : 2; } }
                        else { const int it = bid + w * G; if (it >= 384) break; kind = it >= 256 ? 1 : 0; unit = kind ? it - 256 : it; }
                        if (!kind) { int l4 = lt; asm volatile("" : "+v"(l4)); rwkv_unit3(args, (LAS float*)lds, unit, i2, (const bf16*)(ws + WS_P), (bf16*)(ws + WS_CAT), l4); }
                        else { int l5 = lt; asm volatile("" : "+v"(l5)); gla_unit2(args, lds, unit, i2, (const bf16*)(ws + WS_P), (bf16*)(ws + WS_CAT), l5, c0, c1, mode);
                        }
                    }
                    SEAM(pb + 1); TSTAMP(2);
                }
            } else {
#ifndef SKIP_ROPE
                if (IN(pb + 1)) { int lt = tid; asm volatile("" : "+v"(lt)); ph_rope(args, lds, bid, G, lt, bid * 512 + lt, NGW * 64); SEAM(pb + 1); TSTAMP(3); }
#endif
#ifndef SKIP_IDX
                if (IN(pb + 2)) { int lt = tid; asm volatile("" : "+v"(lt)); ph_indexer3(args, lds, bid, G, lt);
#ifdef REP_IDX
                { int l2 = lt; asm volatile("" : "+v"(l2)); ph_indexer3(args, lds, bid, G, l2); }
#endif
                SEAM(pb + 2); TSTAMP(4); }
#endif
#ifndef SKIP_ATT
                if (IN(pb + 3)) { int lt = tid; asm volatile("" : "+v"(lt)); ph_attention4(args, lds, bid, G, lt);
#ifdef REP_ATT
                { int l2 = lt; asm volatile("" : "+v"(l2)); ph_attention2(args, bid, G, __builtin_amdgcn_readfirstlane(l2 >> 6), l2 & 63); }
#endif
                SEAM(pb + 3); TSTAMP(5); }
#endif
            }
        } else if (kind == 1) {
#ifndef SKIP_LN1
            if (IN(pb + 5)) { int lt = tid; asm volatile("" : "+v"(lt));
#ifdef REP_EW
                ph_ln<false>(args, layer, bid * 8 + __builtin_amdgcn_readfirstlane(lt >> 6), NGW, lt & 63, (bf16*)(ws + WS_CAT)); { int l2 = lt; asm volatile("" : "+v"(l2)); lt = l2; }
#endif
                ph_ln<false>(args, layer, bid * 8 + __builtin_amdgcn_readfirstlane(lt >> 6), NGW, lt & 63, (bf16*)(ws + WS_XB)); SEAM(pb + 5); TSTAMP(7); }
#endif
        } else {
#ifndef SKIP_ROUTE
            if (IN(pb + 7)) { int lt = tid; asm volatile("" : "+v"(lt)); ph_route2(args, layer, lds, bid, G, __builtin_amdgcn_readfirstlane(lt >> 6), lt & 63);
#ifdef REP_ROUTE
                { int l2 = lt; asm volatile("" : "+v"(l2)); ph_route2(args, layer, lds, bid, G, __builtin_amdgcn_readfirstlane(l2 >> 6), l2 & 63); }
#endif
                SEAM(pb + 7); TSTAMP(9); }
#endif
#ifndef SKIP_EXP
            if (IN(pb + 8)) { int lt = tid; asm volatile("" : "+v"(lt)); ph_experts_hk(args, layer, lds, lt, 0);
#ifdef REP_H
                { xcd_barrier(bar); int l2 = lt; asm volatile("" : "+v"(l2)); ph_experts_hk(args, layer, lds, l2, 4); }
#endif
                SEAM(pb + 8); TSTAMP(10); }
            if (IN(pb + 9)) { int lt = tid; asm volatile("" : "+v"(lt)); ph_experts_c(args, layer, bid * 512 + lt, NGW * 64);
#ifdef REP_EW
                { int l2 = lt; asm volatile("" : "+v"(l2)); ph_experts_c(args, layer, bid * 512 + l2, NGW * 64); }
#endif
                SEAM(pb + 9); TSTAMP(10); }
            if (IN(pb + 10)) { int lt = tid; asm volatile("" : "+v"(lt)); ph_experts_v(args, layer, lds, lt, 0); SEAM(pb + 10); TSTAMP(10); }
            if (IN(pb + 11)) { int lt = tid; asm volatile("" : "+v"(lt));
#ifdef REP_EW
                if (layer < DEPTH - 1) { ph_ln<true>(args, layer, bid * 8 + __builtin_amdgcn_readfirstlane(lt >> 6), NGW, lt & 63, (bf16*)(ws + WS_CAT)); int l2 = lt; asm volatile("" : "+v"(l2)); lt = l2; }
#endif
                ph_ln<true>(args, layer, bid * 8 + __builtin_amdgcn_readfirstlane(lt >> 6), NGW, lt & 63, (bf16*)(ws + WS_XB)); SEAM(pb + 11); TSTAMP(10); }
#endif
        }
    }
#ifdef DBG_CHECK
    {   xcd_barrier(bar);
        unsigned* ctl = (unsigned*)(ws + WS_CTL);
        const unsigned nh = __hip_atomic_load(ctl + 16384, __ATOMIC_RELAXED, __HIP_MEMORY_SCOPE_AGENT), nv = __hip_atomic_load(ctl + 16448, __ATOMIC_RELAXED, __HIP_MEMORY_SCOPE_AGENT);
        if (bid == 0 && tid == 0 && (nh | nv)) { args.out[0] = (nh ? 1000.f + (float)nh : 0.f); }
    }
#endif
#ifdef DBG_TIME
    {
        xcd_barrier(bar);
        float* tw = (float*)(ws + WS_CTL + 768 * 1024);
        if (bid == 0 && tid == 0) { unsigned ta = 0, tb = 0;
            for (int k = 0; k < 16; ++k) { if ((DBG_TIME_A >> k) & 1) ta += tacc[k]; if ((DBG_TIME_B >> k) & 1) tb += tacc[k]; }
            __hip_atomic_store(tw, (float)ta * 0.01f, __ATOMIC_RELAXED, __HIP_MEMORY_SCOPE_AGENT); __hip_atomic_store(tw + 1, (float)tb * 0.01f, __ATOMIC_RELAXED, __HIP_MEMORY_SCOPE_AGENT); }
        xcd_barrier(bar);
        const float ta = __hip_atomic_load(tw, __ATOMIC_RELAXED, __HIP_MEMORY_SCOPE_AGENT), tb = __hip_atomic_load(tw + 1, __ATOMIC_RELAXED, __HIP_MEMORY_SCOPE_AGENT);
        const float cval = sqrtf(tb * 0.1f);
        for (size_t i = (size_t)bid * 512 + tid; i < (size_t)MTOK * DM; i += (size_t)G * 512) args.out[i] = (i == 0) ? ta : cval;
    }
#endif
#undef IN
#undef SEAM
}

#ifndef ONE_LAUNCH
#define ONE_LAUNCH 1
#endif
extern "C" void kernel_launch(void* const* d_in, const int* in_sizes, int n_in, void* d_out, int out_size, void* d_ws, size_t ws_size, hipStream_t stream) {
    static int grid = 0;
    if (grid == 0) {
        if (n_in != 27 || in_sizes[0] != MTOK * DM || out_size != MTOK * DM || ws_size < WS_END) { fprintf(stderr, "kernel_launch: unexpected shapes (n_in %d, ws %zu)\n", n_in, ws_size); grid = -1; return; }
        int dev = 0, cus = 0, per_cu = 0;
        if (hipGetDevice(&dev) != hipSuccess || hipDeviceGetAttribute(&cus, hipDeviceAttributeMultiprocessorCount, dev) != hipSuccess) { grid = -1; return; }
        if (hipFuncSetAttribute((const void*)mk_fwd, hipFuncAttributeMaxDynamicSharedMemorySize, LDS_BYTES) != hipSuccess) { grid = -1; return; }
        if (hipOccupancyMaxActiveBlocksPerMultiprocessor(&per_cu, (const void*)mk_fwd, 512, LDS_BYTES) != hipSuccess || per_cu < 1) fprintf(stderr, "kernel_launch: occupancy query says %d\n", per_cu);
        (void)hipGetLastError();
        grid = cus;
    }
    if (grid < 0) return;
    (void)hipMemsetAsync((char*)d_ws + WS_CTL, 0, CTL_ZERO_BYTES, stream);
    Args a{};
    for (int i = 0; i < 27; ++i) a.in[i] = (const float*)d_in[i];
    a.out = (float*)d_out; a.ws = (unsigned char*)d_ws;
#if ONE_LAUNCH
    a.ph_lo = 0; a.ph_hi = NPHASE;
    hipLaunchKernelGGL(mk_fwd, dim3(grid), dim3(512), LDS_BYTES, stream, a);
#else
    for (int k = 0; k < NPHASE; ++k) {
        if (k >= 1) { const int layer = (k - 1) / 12, r = (k - 1) % 12; if ((layer & 1) == 0 && (r == 2 || r == 3)) continue; }
        a.ph_lo = k; a.ph_hi = k + 1;
        hipLaunchKernelGGL(mk_fwd, dim3(grid), dim3(512), LDS_BYTES, stream, a);
    }
#endif
}
```
